# Optimizing an MI355X kernel written in HIP

```python
import numpy as np
import jax
import jax.numpy as jnp
from jax import lax

D_MODEL = 2048
BATCH = 2
SEQ = 8192
DEPTH = 2

CTX_LEN = 256
GRID_W = 64
EPS = 1e-6

N_BRANCHES = 4
BRANCH_WIDTH = D_MODEL // 4

A_HEAD_DIM = 64
A_HEADS = BRANCH_WIDTH // A_HEAD_DIM
A_KV_HEADS = A_HEADS // 4
A_GROUP = A_HEADS // A_KV_HEADS
A_WINDOW = 128
A_BLOCK = 128
ROPE_BASE = 10000.0

P_GROUPS = 4
P_GROUP_W = BRANCH_WIDTH // P_GROUPS
P_WINDOWS = (2, 4, 8, 16)

C_GROUPS = 4
C_GROUP_W = BRANCH_WIDTH // C_GROUPS
C_CHUNK = 128

G_HEADS = 4
G_KEY_DIM = BRANCH_WIDTH // 2 // G_HEADS
G_VAL_DIM = BRANCH_WIDTH // G_HEADS
G_GATE_RANK = 16
G_GATE_TAU = 16.0
G_CHUNK = 64

N_EXPERTS = 16
N_EXPERT_GROUPS = 4
EXPERTS_PER_GROUP = N_EXPERTS // N_EXPERT_GROUPS
GROUP_SCORE_TOP = 2
TOP_K = 2
D_EXPERT = D_MODEL // 2

IN_SPLITS = (A_HEADS * A_HEAD_DIM, A_KV_HEADS * A_HEAD_DIM, A_KV_HEADS * A_HEAD_DIM,
             BRANCH_WIDTH, 2 * BRANCH_WIDTH,
             G_HEADS * G_KEY_DIM, G_HEADS * G_KEY_DIM, G_HEADS * G_VAL_DIM, BRANCH_WIDTH, 2 * G_GATE_RANK)
D_IN = sum(IN_SPLITS)

kernel_name = 'hybrid_flow_backbone_block'

f32 = jnp.float32


def rms_norm(x, g):
    xf = x.astype(f32)
    y = xf * lax.rsqrt(jnp.mean(xf * xf, axis=-1, keepdims=True) + EPS)
    return (y * g.astype(f32)).astype(x.dtype)


def layer_norm(x, g, b):
    xf = x.astype(f32)
    mu = jnp.mean(xf, axis=-1, keepdims=True)
    var = jnp.mean(jnp.square(xf - mu), axis=-1, keepdims=True)
    return ((xf - mu) * lax.rsqrt(var + EPS) * g.astype(f32) + b.astype(f32)).astype(x.dtype)


def modulate(h, shift, scale):
    return h * (1 + scale) + shift


def axial_rope_tables(n):
    rows = n // GRID_W
    row = jnp.repeat(jnp.arange(rows), GRID_W)
    col = jnp.tile(jnp.arange(GRID_W), rows)
    nf = A_HEAD_DIM // 4
    inv_freq = ROPE_BASE ** (-jnp.arange(nf, dtype=f32) / nf)
    ang = jnp.concatenate([row[:, None].astype(f32) * inv_freq,
                           col[:, None].astype(f32) * inv_freq], axis=-1)
    return jnp.cos(ang), jnp.sin(ang)


def apply_axial_rope(x, cos, sin):
    nf = A_HEAD_DIM // 4
    xf = x.astype(f32)
    parts = []
    for a in range(2):
        p = xf[..., a * 2 * nf:(a + 1) * 2 * nf]
        cs, sn = cos[:, a * nf:(a + 1) * nf], sin[:, a * nf:(a + 1) * nf]
        p1, p2 = p[..., :nf], p[..., nf:]
        parts += [p1 * cs - p2 * sn, p2 * cs + p1 * sn]
    return jnp.concatenate(parts, axis=-1).astype(x.dtype)


def q_heads(t):
    b, n, _ = t.shape
    return t.reshape(b, n, A_KV_HEADS, A_GROUP, A_HEAD_DIM).transpose(0, 2, 3, 1, 4)


def kv_heads(t):
    b, n, _ = t.shape
    return t.reshape(b, n, A_KV_HEADS, A_HEAD_DIM).transpose(0, 2, 1, 3)


def merge_attn_heads(o):
    b, kv, g, n, d = o.shape
    return o.transpose(0, 3, 1, 2, 4).reshape(b, n, kv * g * d)


def sink_softmax(scores, sink):
    m = sink
    for s in scores:
        m = jnp.maximum(m, jnp.max(s, axis=-1, keepdims=True))
    ps = [jnp.exp(s - m) for s in scores]
    denom = jnp.exp(sink - m)
    for p in ps:
        denom = denom + jnp.sum(p, axis=-1, keepdims=True)
    return [p / denom for p in ps]


def window_attention(q, k, v, kc, vc, sink):
    b, kvh, g, n, hd = q.shape
    nb = n // A_BLOCK
    scale = hd ** -0.5
    qb = q.reshape(b, kvh, g, nb, A_BLOCK, hd)

    def band(t):
        tb = jnp.pad(t.reshape(b, kvh, nb, A_BLOCK, hd), ((0, 0), (0, 0), (1, 1), (0, 0), (0, 0)))
        return jnp.concatenate([tb[:, :, :-2], tb[:, :, 1:-1], tb[:, :, 2:]], axis=3)

    kb, vb = band(k), band(v)
    s_band = jnp.einsum('bhgnqd,bhnkd->bhgnqk', qb, kb, preferred_element_type=f32) * scale
    s_ctx = jnp.einsum('bhgnqd,bhkd->bhgnqk', qb, kc, preferred_element_type=f32) * scale
    r = jnp.arange(A_BLOCK)[:, None]
    j = jnp.arange(3 * A_BLOCK)[None, :]
    kpos = (jnp.arange(nb)[:, None, None] - 1) * A_BLOCK + j
    rel = j - A_BLOCK - r
    valid = (jnp.abs(rel) <= A_WINDOW)[None] & (kpos >= 0) & (kpos < n)
    s_band = jnp.where(valid, s_band, -1e30)
    p_band, p_ctx = sink_softmax([s_band, s_ctx], sink[None, :, :, None, None, None])
    o = (jnp.einsum('bhgnqk,bhnkd->bhgnqd', p_band, vb.astype(f32))
         + jnp.einsum('bhgnqk,bhkd->bhgnqd', p_ctx, vc.astype(f32)))
    return o.reshape(b, kvh, g, n, hd).astype(q.dtype)


def context_attention(q, k, v, sink):
    s = jnp.einsum('bhgqd,bhkd->bhgqk', q, k, preferred_element_type=f32) * (A_HEAD_DIM ** -0.5)
    (p,) = sink_softmax([s], sink[None, :, :, None, None])
    return jnp.einsum('bhgqk,bhkd->bhgqd', p, v.astype(f32)).astype(q.dtype)


def multi_scale_pool(x, p_w, p_scale):
    b, n, _ = x.shape
    xf = x.astype(f32).reshape(b, n, P_GROUPS, P_GROUP_W)
    csum = jnp.pad(jnp.cumsum(xf, axis=1), ((0, 0), (1, 0), (0, 0), (0, 0)))
    t = jnp.arange(n)
    outs = []
    for gi, w in enumerate(P_WINDOWS):
        lo = jnp.clip(t - w // 2, 0, n)
        hi = jnp.clip(t + w // 2, 0, n)
        cg = csum[:, :, gi]
        win_sum = jnp.take(cg, hi, axis=1) - jnp.take(cg, lo, axis=1)
        cnt = (hi - lo).astype(f32)[None, :, None]
        outs.append(win_sum / cnt - xf[:, :, gi])
    pooled = jnp.stack(outs, axis=2).astype(x.dtype)
    y = jnp.einsum('bngc,gcd->bngd', pooled, p_w).reshape(b, n, BRANCH_WIDTH)
    return y * p_scale


def chunk_spatial_gate(uv, ln_g, ln_b, ws, bs):
    u, v = jnp.split(jax.nn.gelu(uv), 2, axis=-1)
    v = layer_norm(v, ln_g, ln_b)
    b, n, _ = v.shape
    vc = v.reshape(b, n // C_CHUNK, C_CHUNK, C_GROUPS, C_GROUP_W)
    mixed = jnp.einsum('gpq,bcqgd->bcpgd', ws, vc) + bs.T[None, None, :, :, None]
    return u * mixed.reshape(b, n, BRANCH_WIDTH)


def to_heads(t, h):
    b, n, _ = t.shape
    return t.reshape(b, n, h, -1).transpose(0, 2, 1, 3).astype(f32)


def gla_chunk_scan(q, k, v, logg, s0):
    b, h, n, _ = q.shape
    nc = n // G_CHUNK

    def chunks(t):
        return jnp.moveaxis(t.reshape(b, h, nc, G_CHUNK, t.shape[-1]), 2, 0)

    lower = jnp.tril(jnp.ones((G_CHUNK, G_CHUNK), dtype=bool))[:, :, None]

    def step(state, blk):
        qb, kb, vb, gb = blk
        cum = jnp.cumsum(gb, axis=2)
        o_state = jnp.einsum('bhld,bhde->bhle', qb * jnp.exp(cum), state)
        rel = cum[:, :, :, None, :] - cum[:, :, None, :, :]
        decay = jnp.exp(jnp.where(lower, rel, -jnp.inf))
        att = jnp.einsum('bhid,bhjd,bhijd->bhij', qb, kb, decay)
        o_local = jnp.einsum('bhij,bhje->bhie', att, vb)
        last = cum[:, :, -1:, :]
        new_state = (jnp.exp(last[:, :, 0, :, None]) * state
                     + jnp.einsum('bhld,bhle->bhde', kb * jnp.exp(last - cum), vb))
        return new_state, o_state + o_local

    s_fin, o = lax.scan(step, s0, (chunks(q), chunks(k), chunks(v), chunks(logg)))
    return jnp.moveaxis(o, 0, 2).reshape(b, h, n, -1), s_fin


def gla_output(o_dirs, r, norm_g):
    o = o_dirs[0] + o_dirs[1]
    o = o * lax.rsqrt(jnp.mean(o * o, axis=-1, keepdims=True) + EPS)
    b, h, n, dv = o.shape
    o = o.transpose(0, 2, 1, 3).reshape(b, n, h * dv) * norm_g.astype(f32)
    return (o * jax.nn.silu(r.astype(f32))).astype(r.dtype)


def gla_bidirectional(zx, zc, g_w2, g_b, g_norm_g, need_ctx_out):
    outs_x, outs_c = [], []
    for d in range(2):
        def prep(z):
            q, k, v, _, glr = z
            logit = glr[..., d * G_GATE_RANK:(d + 1) * G_GATE_RANK] @ g_w2[d] + g_b[d]
            logg = jax.nn.log_sigmoid(logit.astype(f32)) / G_GATE_TAU
            t = (to_heads(q, G_HEADS) * (G_KEY_DIM ** -0.5), to_heads(k, G_HEADS),
                 to_heads(v, G_HEADS), to_heads(logg, G_HEADS))
            return tuple(jnp.flip(a, axis=2) for a in t) if d == 1 else t
        s0 = jnp.zeros((zc[0].shape[0], G_HEADS, G_KEY_DIM, G_VAL_DIM), f32)
        oc, s_ctx = gla_chunk_scan(*prep(zc), s0)
        ox, _ = gla_chunk_scan(*prep(zx), s_ctx)
        if d == 1:
            oc, ox = jnp.flip(oc, axis=2), jnp.flip(ox, axis=2)
        outs_c.append(oc)
        outs_x.append(ox)
    out_x = gla_output(outs_x, zx[3], g_norm_g)
    out_c = gla_output(outs_c, zc[3], g_norm_g) if need_ctx_out else None
    return out_x, out_c


def gated_merge(h, branch_outs, w_branch, w_gate, w_out):
    acc = jnp.zeros(h.shape, f32)
    for i, o in enumerate(branch_outs):
        gate = jax.nn.sigmoid((h @ w_gate[i]).astype(f32))
        acc = acc + gate * (o @ w_branch[i]).astype(f32)
    return acc.astype(h.dtype) @ w_out


def mixer_sublayer(hx, hc, w_in, a_sink, p_w, p_scale, c_ln_g, c_ln_b, c_ws, c_bs,
                   g_w2, g_b, g_norm_g, w_branch, w_gate, w_out, rope_cos, rope_sin, need_ctx_out):
    split_at = np.cumsum(IN_SPLITS)[:-1].tolist()
    zx = jnp.split(hx @ w_in, split_at, axis=-1)
    zc = jnp.split(hc @ w_in, split_at, axis=-1)
    sink = a_sink.astype(f32).reshape(A_KV_HEADS, A_GROUP)
    qx = apply_axial_rope(q_heads(zx[0]), rope_cos, rope_sin)
    kx = apply_axial_rope(kv_heads(zx[1]), rope_cos, rope_sin)
    vx = kv_heads(zx[2])
    qc, kc, vc = q_heads(zc[0]), kv_heads(zc[1]), kv_heads(zc[2])
    a_x = merge_attn_heads(window_attention(qx, kx, vx, kc, vc, sink))
    p_x = multi_scale_pool(zx[3], p_w, p_scale)
    s_x = chunk_spatial_gate(zx[4], c_ln_g, c_ln_b, c_ws, c_bs)
    g_x, g_c = gla_bidirectional(zx[5:], zc[5:], g_w2, g_b, g_norm_g, need_ctx_out)
    out_x = gated_merge(hx, (a_x, p_x, s_x, g_x), w_branch, w_gate, w_out)
    if not need_ctx_out:
        return out_x, None
    a_c = merge_attn_heads(context_attention(qc, kc, vc, sink))
    p_c = multi_scale_pool(zc[3], p_w, p_scale)
    s_c = chunk_spatial_gate(zc[4], c_ln_g, c_ln_b, c_ws, c_bs)
    out_c = gated_merge(hc, (a_c, p_c, s_c, g_c), w_branch, w_gate, w_out)
    return out_x, out_c


def moe_ffn(h, router_w, router_b, e_gate, e_up, e_down):
    scores = jax.nn.sigmoid((h @ router_w).astype(f32))
    biased = scores + router_b.astype(f32)
    grp = biased.reshape(*biased.shape[:-1], N_EXPERT_GROUPS, EXPERTS_PER_GROUP)
    grp_score = jnp.sum(lax.top_k(grp, GROUP_SCORE_TOP)[0], axis=-1)
    best = jnp.argmax(grp_score, axis=-1)
    in_grp = (jnp.arange(N_EXPERTS) // EXPERTS_PER_GROUP) == best[..., None]
    _, idx = lax.top_k(jnp.where(in_grp, biased, -jnp.inf), TOP_K)
    w_sel = jnp.take_along_axis(scores, idx, axis=-1)
    w_sel = w_sel / jnp.sum(w_sel, axis=-1, keepdims=True)
    combine = jnp.einsum('bnk,bnke->bne', w_sel, jax.nn.one_hot(idx, N_EXPERTS, dtype=f32))
    out = jnp.zeros(h.shape, f32)
    for e in range(N_EXPERTS):
        act = jax.nn.silu(h @ e_gate[e]) * (h @ e_up[e])
        out = out + combine[..., e:e + 1] * (act @ e_down[e]).astype(f32)
    return out.astype(h.dtype)


def setup_inputs(seed: int = 0) -> dict:
    key = jax.random.key(seed)
    ks = jax.random.split(key, 32)
    L, D = DEPTH, D_MODEL

    def nrm(k, shape, scale):
        return jax.random.normal(k, shape, f32) * scale

    return {
        'x': nrm(ks[0], (BATCH, SEQ, D), 1.0),
        'c': nrm(ks[1], (BATCH, D), 1.0),
        'ctx': nrm(ks[2], (BATCH, CTX_LEN, D), 1.0),
        'c_ctx': nrm(ks[3], (D,), 1.0),
        'w_mod': nrm(ks[4], (L, D, 6 * D), 0.5 * D ** -0.5),
        'b_mod': nrm(ks[5], (L, 6 * D), 0.01),
        'norm1_g': 1 + nrm(ks[6], (L, D), 0.01),
        'norm2_g': 1 + nrm(ks[7], (L, D), 0.01),
        'final_norm_g': 1 + nrm(ks[8], (D,), 0.01),
        'w_in': nrm(ks[9], (L, D, D_IN), D ** -0.5),
        'a_sink': nrm(ks[10], (L, A_HEADS), 1.0),
        'p_w': nrm(ks[11], (L, P_GROUPS, P_GROUP_W, P_GROUP_W), P_GROUP_W ** -0.5),
        'p_scale': 1 + nrm(ks[12], (L, BRANCH_WIDTH), 0.02),
        'c_ln_g': 1 + nrm(ks[13], (L, BRANCH_WIDTH), 0.01),
        'c_ln_b': nrm(ks[14], (L, BRANCH_WIDTH), 0.01),
        'c_ws': nrm(ks[15], (L, C_GROUPS, C_CHUNK, C_CHUNK), C_CHUNK ** -0.5),
        'c_bs': 1 + nrm(ks[16], (L, C_GROUPS, C_CHUNK), 0.01),
        'g_w2': nrm(ks[17], (L, 2, G_GATE_RANK, G_HEADS * G_KEY_DIM), G_GATE_RANK ** -0.5),
        'g_b': nrm(ks[18], (L, 2, G_HEADS * G_KEY_DIM), 0.1),
        'g_norm_g': 1 + nrm(ks[19], (L, BRANCH_WIDTH), 0.01),
        'w_branch': nrm(ks[20], (L, N_BRANCHES, BRANCH_WIDTH, D), BRANCH_WIDTH ** -0.5),
        'w_gate': nrm(ks[21], (L, N_BRANCHES, D, D), D ** -0.5),
        'w_out': nrm(ks[22], (L, D, D), D ** -0.5),
        'router_w': nrm(ks[23], (D, N_EXPERTS), D ** -0.5),
        'router_b': nrm(ks[24], (N_EXPERTS,), 0.01),
        'e_gate': nrm(ks[25], (L, N_EXPERTS, D, D_EXPERT), D ** -0.5),
        'e_up': nrm(ks[26], (L, N_EXPERTS, D, D_EXPERT), D ** -0.5),
        'e_down': nrm(ks[27], (L, N_EXPERTS, D_EXPERT, D), D_EXPERT ** -0.5),
    }


def reference(x, c, ctx, c_ctx, w_mod, b_mod, norm1_g, norm2_g, final_norm_g, w_in, a_sink,
              p_w, p_scale, c_ln_g, c_ln_b, c_ws, c_bs, g_w2, g_b, g_norm_g,
              w_branch, w_gate, w_out, router_w, router_b, e_gate, e_up, e_down):
    n_ctx = ctx.shape[1]
    rope_cos, rope_sin = axial_rope_tables(x.shape[1])
    for l in range(DEPTH):
        last = l == DEPTH - 1
        mod_x = jax.nn.silu(c) @ w_mod[l] + b_mod[l]
        mod_c = jax.nn.silu(c_ctx) @ w_mod[l] + b_mod[l]
        shx1, scx1, gx1, shx2, scx2, gx2 = jnp.split(mod_x[:, None, :], 6, axis=-1)
        shc1, scc1, gc1, shc2, scc2, gc2 = jnp.split(mod_c, 6, axis=-1)
        hx = modulate(rms_norm(x, norm1_g[l]), shx1, scx1)
        hc = modulate(rms_norm(ctx, norm1_g[l]), shc1, scc1)
        mx, mc = mixer_sublayer(hx, hc, w_in[l], a_sink[l], p_w[l], p_scale[l], c_ln_g[l], c_ln_b[l],
                                c_ws[l], c_bs[l], g_w2[l], g_b[l], g_norm_g[l], w_branch[l], w_gate[l],
                                w_out[l], rope_cos, rope_sin, not last)
        x = x + gx1 * mx
        hx = modulate(rms_norm(x, norm2_g[l]), shx2, scx2)
        if last:
            x = x + gx2 * moe_ffn(hx, router_w, router_b, e_gate[l], e_up[l], e_down[l])
        else:
            ctx = ctx + gc1 * mc
            hc = modulate(rms_norm(ctx, norm2_g[l]), shc2, scc2)
            f = moe_ffn(jnp.concatenate([hc, hx], axis=1), router_w, router_b, e_gate[l], e_up[l], e_down[l])
            ctx = ctx + gc2 * f[:, :n_ctx]
            x = x + gx2 * f[:, n_ctx:]
    return rms_norm(x, final_norm_g)
```

```cpp
#include <hip/hip_runtime.h>
#include <cstdio>
#include <cstdint>

#define GAS __attribute__((address_space(1)))
#define LAS __attribute__((address_space(3)))
typedef unsigned short bf16;
typedef short bf16x8 __attribute__((ext_vector_type(8)));
typedef short s16x4 __attribute__((ext_vector_type(4)));
typedef float f32x4 __attribute__((ext_vector_type(4)));
typedef float f32x2 __attribute__((ext_vector_type(2)));
typedef unsigned u32x4 __attribute__((ext_vector_type(4)));
typedef unsigned u32x2 __attribute__((ext_vector_type(2)));
typedef int i32x4q __attribute__((ext_vector_type(4)));

#ifndef USE_G256
#define USE_G256 31
#endif
#ifndef ATTN2
#define ATTN2 1
#endif
#ifndef DYNQ
#define DEFER_CONV 1
#define DYNQ 1
#endif
#ifndef FP8Z
#define FP8Z 1
#endif
#ifndef MIX2
#define MIX2 7
#endif
#ifndef REPEAT
#define REPEAT -1
#endif
#ifndef N_LAUNCH_MODE
#define N_LAUNCH_MODE 1
#endif

constexpr int LDS_BYTES = 147456;
constexpr int D = 2048, SEQ = 8192, CTXL = 256, ML = 16384, MT = 16896;
constexpr int ZS = 4224;
constexpr int DP = 2176;
constexpr int ZQ = 0, ZK = 512, ZV = 640, ZP = 768, ZUV = 1280, ZGQ = 2304, ZGK = 2560, ZGV = 2816, ZGR = 3328, ZGLR = 3840, ZGATE = 4096;
constexpr int NPH = 22;
constexpr int CAP = 16896;
constexpr float LOG2E = 1.4426950408889634f;

constexpr size_t MiB = 1u << 20;
constexpr size_t WS_CTL = 0, CTL_ZERO_BYTES = 1 * MiB;
constexpr size_t WS_MOD = 1 * MiB;
constexpr size_t WS_ROPE = 1 * MiB + 512 * 1024;
constexpr size_t WS_PWT = 2 * MiB;
constexpr size_t WS_WSB = 2 * MiB + 512 * 1024;
constexpr size_t WS_LIST = 3 * MiB;
constexpr size_t WS_LISTW = 5 * MiB;
constexpr size_t WS_DECAY = 7 * MiB;
constexpr size_t WS_WCAT = 8 * MiB;
constexpr size_t WS_WCAT8 = 40 * MiB;
constexpr size_t WS_H8 = 88 * MiB;
constexpr size_t WS_WB = 122 * MiB;
constexpr size_t WS_WO = 138 * MiB;
constexpr size_t WS_WGU = 156 * MiB;
constexpr size_t WS_WD = 412 * MiB;
constexpr size_t WS_X = 540 * MiB;
constexpr size_t WS_H = 672 * MiB;
constexpr size_t WS_O = 738 * MiB;
constexpr size_t WS_S = 804 * MiB;
constexpr size_t WS_Z = 870 * MiB;
constexpr size_t WS_G8 = 1008 * MiB;
constexpr size_t WS_MX = 870 * MiB;
constexpr size_t WS_ACT = 870 * MiB;
constexpr size_t WS_Y = 944 * MiB;
constexpr size_t WS_SB = 1140 * MiB;
constexpr size_t WS_ACC = 1173 * MiB;
constexpr size_t WS_RS = 1244 * MiB;
constexpr size_t WS_H8I = 1245 * MiB;
constexpr size_t WS_ACC8 = 1279 * MiB;
constexpr size_t WS_WO8 = 1311 * MiB;
constexpr size_t WS_END = 1319 * MiB;
constexpr float EXPERT_MARGIN = 1.25f;
constexpr float W8SCALE = 64.f;
constexpr int CW_CNT = 64;
constexpr int CW_BAR = 8192;
constexpr int CW_WMAX = 12288;

__device__ __forceinline__ int fresh_tid() { int t; asm volatile("v_mov_b32 %0, %1" : "=v"(t) : "v"((int)threadIdx.x)); return t; }
__device__ __forceinline__ float bf2f(unsigned b) { return __uint_as_float(b << 16); }
__device__ __forceinline__ unsigned f2bf(float f) { return (unsigned)__builtin_bit_cast(unsigned short, (__bf16)f); }
typedef __bf16 bf16x2n __attribute__((ext_vector_type(2)));
typedef float f32x2n __attribute__((ext_vector_type(2)));
__device__ __forceinline__ unsigned pk2(float lo, float hi) { return __builtin_bit_cast(unsigned, __builtin_convertvector((f32x2n){lo, hi}, bf16x2n)); }
__device__ __forceinline__ unsigned q8pack(float a, float b, float c, float d) {
    const unsigned u0 = __float_as_uint(a + 12582912.f), u1 = __float_as_uint(b + 12582912.f), u2 = __float_as_uint(c + 12582912.f), u3 = __float_as_uint(d + 12582912.f);
    return __builtin_amdgcn_perm(u1, u0, 0x0c0c0400u) | __builtin_amdgcn_perm(u3, u2, 0x04000c0cu); }
__device__ __forceinline__ void unpack8(const u32x4 r, float (&o)[8]) {
    o[0] = __uint_as_float(r.x << 16); o[1] = __uint_as_float(r.x & 0xffff0000u); o[2] = __uint_as_float(r.y << 16); o[3] = __uint_as_float(r.y & 0xffff0000u);
    o[4] = __uint_as_float(r.z << 16); o[5] = __uint_as_float(r.z & 0xffff0000u); o[6] = __uint_as_float(r.w << 16); o[7] = __uint_as_float(r.w & 0xffff0000u);
}
__device__ __forceinline__ u32x4 pack8(const float (&o)[8]) { u32x4 r; r.x = pk2(o[0], o[1]); r.y = pk2(o[2], o[3]); r.z = pk2(o[4], o[5]); r.w = pk2(o[6], o[7]); return r; }
__device__ __forceinline__ float wave_sum(float v) {
#pragma unroll
    for (int o = 1; o < 64; o <<= 1) v += __shfl_xor(v, o);
    return v;
}
__device__ __forceinline__ int perm16(int n, int i) { return 8 * (i >> 2) + 4 * n + (i & 3); }
__device__ __forceinline__ float sigmoidf_(float x) { return __builtin_amdgcn_rcpf(1.f + __builtin_amdgcn_exp2f(-1.4426950408889634f * x)); }
__device__ __forceinline__ float gelu_tanh(float x) { const float u = x * (2.302208198f + 0.1029432397f * x * x); return x * __builtin_amdgcn_rcpf(1.f + __builtin_amdgcn_exp2f(-u)); }
#define MFMA16(a, b, c) __builtin_amdgcn_mfma_f32_16x16x32_bf16((a), (b), (c), 0, 0, 0)

__device__ __forceinline__ size_t g8_off(int i, int pm, int pn, int wv, int ai, int m, int bj, int ln) { return ((size_t)((i * 66 + pm) * 8 + pn) << 16) + (size_t)((((wv * 2 + ai) * 4 + m) * 2 + bj) * 64 + ln) * 8; }
struct Args { const float* in[28]; float* out; unsigned char* ws; int ph_lo, ph_hi; };

#define XB_TMO      128
#define XB_XCNT(j)  (256  + 64 * (j))
#define XB_XSUB(j)  (1280 + 64 * (j))
#define XB_XGEN(j)  (2304 + 64 * (j))
#define XB_TOP      3328
#define XB_TOPGEN   3392
#define XCD_BAR_WORDS 3456
#define XB_SPIN_CAP (1u << 18)
__device__ __forceinline__ unsigned xb_ld(unsigned* p)              { return __hip_atomic_load(p, __ATOMIC_RELAXED, __HIP_MEMORY_SCOPE_AGENT); }
__device__ __forceinline__ unsigned xb_add(unsigned* p, unsigned v) { return __hip_atomic_fetch_add(p, v, __ATOMIC_RELAXED, __HIP_MEMORY_SCOPE_AGENT); }
__device__ __forceinline__ unsigned xb_xcc_id() { return (unsigned)__builtin_amdgcn_s_getreg((3 << 11) | 20) & 0xFu; }
#define XB_SPIN(cond, bar) do { unsigned _sp = 0; while (cond) { __builtin_amdgcn_s_sleep(1); \
    if ((++_sp & 255u) == 0u) { if (xb_ld(&(bar)[XB_TMO])) break; if (_sp > XB_SPIN_CAP) { atomicAdd(&(bar)[XB_TMO], 1u); break; } } } } while (0)
struct XcdBarrier { unsigned* bar; unsigned x; volatile LAS unsigned* st; };
__device__ __forceinline__ XcdBarrier xcd_barrier_post(unsigned* bar, volatile LAS unsigned* st) {
    XcdBarrier b; b.bar = bar; b.x = xb_xcc_id(); b.st = st;
    if (threadIdx.x == 0) (void)xb_add(&bar[XB_XCNT(b.x)], 1u);
    return b;
}
__device__ __forceinline__ void xcd_barrier_complete(unsigned* bar, unsigned x, unsigned& nloc, unsigned& nx) {
    const unsigned G = gridDim.x * gridDim.y * gridDim.z;
    unsigned sum, cnt, mine, sp = 0u;
    for (;;) {
        sum = 0u; cnt = 0u; mine = 0u;
#pragma unroll
        for (unsigned j = 0; j < 16; ++j) { const unsigned c = xb_ld(&bar[XB_XCNT(j)]); sum += c; cnt += (c > 0u) ? 1u : 0u; mine = (j == x) ? c : mine; }
        if (sum == G) break;
        __builtin_amdgcn_s_sleep(1);
        if ((++sp & 255u) == 0u) { if (xb_ld(&bar[XB_TMO])) break; if (sp > XB_SPIN_CAP) { atomicAdd(&bar[XB_TMO], 1u); break; } }
    }
    nloc = mine > 0u ? mine : 1u; nx = cnt > 0u ? cnt : 1u;
}
__device__ __forceinline__ void xcd_barrier(const XcdBarrier& b) {
    asm volatile("s_waitcnt vmcnt(0)" ::: "memory");
    __syncthreads();
    if (threadIdx.x == 0) {
        unsigned* bar = b.bar;
        __builtin_amdgcn_s_waitcnt(0);
        unsigned nloc = b.st[0], nx = b.st[1];
        if (nloc == 0u) { xcd_barrier_complete(bar, b.x, nloc, nx); b.st[0] = nloc; b.st[1] = nx; }
        const unsigned old = xb_add(&bar[XB_XSUB(b.x)], 1u);
        const unsigned gen = old / nloc;
        if (old + 1u == (gen + 1u) * nloc) {
            __builtin_amdgcn_fence(__ATOMIC_RELEASE, "agent");
            asm volatile("s_waitcnt vmcnt(0)" ::: "memory");
            const unsigned og = xb_add(&bar[XB_TOP], 1u);
            const unsigned tg = og / nx;
            if (og + 1u == (tg + 1u) * nx) xb_add(&bar[XB_TOPGEN], 1u);
            else XB_SPIN(xb_ld(&bar[XB_TOPGEN]) == tg, bar);
            __builtin_amdgcn_fence(__ATOMIC_ACQUIRE, "agent");
            xb_add(&bar[XB_XGEN(b.x)], 1u);
            asm volatile("s_waitcnt vmcnt(0)" ::: "memory");
        } else {
            XB_SPIN(xb_ld(&bar[XB_XGEN(b.x)]) == gen, bar);
            __builtin_amdgcn_fence(__ATOMIC_ACQUIRE, "agent");
            asm volatile("s_waitcnt vmcnt(0)" ::: "memory");
        }
    }
    __syncthreads();
}

__device__ __forceinline__ void tr_item(const float* W, int N, bf16* dst, int ldd, int k0, int n0, LAS float* scr, int lane) {
#pragma unroll 8
    for (int i = 0; i < 32; ++i) { const int kk = 2 * i + (lane >> 5); scr[kk * 33 + (lane & 31)] = W[(size_t)(k0 + kk) * N + n0 + (lane & 31)]; }
    asm volatile("s_waitcnt lgkmcnt(0)" ::: "memory");
    const int c = lane & 7;
#pragma unroll
    for (int j = 0; j < 4; ++j) { const int n = (lane >> 3) + 8 * j; const LAS float* s = scr + (8 * c) * 33 + n;
        u32x4 o; o.x = pk2(s[0 * 33], s[1 * 33]); o.y = pk2(s[2 * 33], s[3 * 33]); o.z = pk2(s[4 * 33], s[5 * 33]); o.w = pk2(s[6 * 33], s[7 * 33]);
        *(u32x4*)(dst + (size_t)n * ldd + k0 + 8 * c) = o; }
    asm volatile("s_waitcnt lgkmcnt(0)" ::: "memory");
}

__device__ __forceinline__ void tr_item8(const float* W, int N, unsigned char* dst, int ldd, int k0, int n0, LAS float* scr, int lane) {
#pragma unroll 8
    for (int i = 0; i < 32; ++i) { const int kk = 2 * i + (lane >> 5); scr[kk * 33 + (lane & 31)] = W[(size_t)(k0 + kk) * N + n0 + (lane & 31)]; }
    asm volatile("s_waitcnt lgkmcnt(0)" ::: "memory");
    const int n = lane >> 1, kh = (lane & 1) * 32; const LAS float* sp = scr + kh * 33 + n;
    u32x4 o[2];
#pragma unroll
    for (int q = 0; q < 8; ++q) { unsigned p = 0u;
        p = __builtin_amdgcn_cvt_pk_fp8_f32(sp[(4 * q) * 33] * W8SCALE, sp[(4 * q + 1) * 33] * W8SCALE, p, false);
        p = __builtin_amdgcn_cvt_pk_fp8_f32(sp[(4 * q + 2) * 33] * W8SCALE, sp[(4 * q + 3) * 33] * W8SCALE, p, true);
        o[q >> 2][q & 3] = p; }
    *(u32x4*)(dst + (size_t)n * ldd + k0 + kh) = o[0]; *(u32x4*)(dst + (size_t)n * ldd + k0 + kh + 16) = o[1];
    asm volatile("s_waitcnt lgkmcnt(0)" ::: "memory");
}

__device__ __forceinline__ float wave_max(float v) {
#pragma unroll
    for (int o = 1; o < 64; o <<= 1) v = fmaxf(v, __shfl_xor(v, o));
    return v;
}
template <int SAMPLE> __device__ __forceinline__ void absmax_tensor(const float* W, size_t n4, unsigned* slot, int gt, int NT, int lane) {
    float m = 0.f;
    for (size_t j = (size_t)gt; j < n4 / SAMPLE; j += (size_t)NT) { const size_t i = SAMPLE == 1 ? j : ((j >> 6) * SAMPLE << 6) + (j & 63); const f32x4 v = ((const f32x4*)W)[i]; m = fmaxf(m, fmaxf(fmaxf(fabsf(v[0]), fabsf(v[1])), fmaxf(fabsf(v[2]), fabsf(v[3])))); }
    m = wave_max(m);
    if (lane == 0) atomicMax(slot, __float_as_uint(m));
}
__device__ __forceinline__ void phase_absmax(const Args& a, int tid, int lane) {
    const int gt = blockIdx.x * 512 + tid, NT = gridDim.x * 512;
    unsigned* wm = (unsigned*)(a.ws + WS_CTL) + CW_WMAX;
    for (int l = 0; l < 2; ++l) {
        absmax_tensor<1>(a.in[9] + (size_t)l * 2048 * 3872, (size_t)2048 * 3872 / 4, wm + l, gt, NT, lane);
        absmax_tensor<8>(a.in[21] + (size_t)l * 4 * 2048 * 2048, (size_t)4 * 2048 * 2048 / 4, wm + 2 + l, gt, NT, lane);
        absmax_tensor<8>(a.in[22] + (size_t)l * 2048 * 2048, (size_t)2048 * 2048 / 4, wm + 68 + l, gt, NT, lane);
    }
    { const int wv = gt >> 6, NWV = NT >> 6;
        for (int w2 = wv; w2 < 2048; w2 += NWV) { const int t = w2 & 63, sub = w2 >> 6; const float* W = (t < 32 ? a.in[25] : a.in[26]) + (size_t)(t & 31) * 2048 * 1024; float m = 0.f;
#pragma unroll 8
            for (int k = 0; k < 32; ++k) { const f32x4 v = ((const f32x4*)(W + (size_t)(sub + 32 * k) * 8 * 256))[lane]; m = fmaxf(m, fmaxf(fmaxf(fabsf(v[0]), fabsf(v[1])), fmaxf(fabsf(v[2]), fabsf(v[3])))); }
            m = wave_max(m); if (lane == 0) atomicMax(wm + 4 + t, __float_as_uint(m)); } }
}
struct TrDesc { const float* W; bf16* dst; unsigned char* dst8; int N, ldd, ldd8, k0, n0, fp8, late; float qinv; };
constexpr int TR_C0 = 2 * 3872, TR_C1 = TR_C0 + 8 * 2048, TR_C2 = TR_C1 + 8 * 512, TR_C3 = TR_C2 + 2 * 2048, TR_C4 = TR_C3 + 32 * 1024, TR_C5 = TR_C4 + 32 * 1024, TR_C6 = TR_C5 + 32 * 1024, TR_ITEMS = TR_C6 + 8 * 8;
__device__ __forceinline__ void tr_desc(const Args& a, int it, TrDesc& d) {
    unsigned char* ws = a.ws; const float* W; int N, ii; bf16* dst; int ldd; int rowsel = 0; unsigned char* dst8 = nullptr; int ldd8 = 0, widx = -1;
    if (it < TR_C0) { const int m = it / 3872; ii = it % 3872; W = a.in[9] + (size_t)m * 2048 * 3872; N = 3872; dst = (bf16*)(ws + WS_WCAT) + (size_t)m * 4096 * 2048; ldd = 2048; dst8 = (unsigned char*)(ws + WS_WCAT8) + (size_t)m * 12288 * 2048; }
    else if (it < TR_C1) { const int r = it - TR_C0, m = r / 2048; ii = r % 2048; W = a.in[21] + (size_t)m * 2048 * 2048; N = 2048; dst = nullptr; ldd = 2048; dst8 = (unsigned char*)(ws + WS_WCAT8) + ((size_t)(m >> 2) * 12288 + 4096 + (size_t)(m & 3) * 2048) * 2048; }
    else if (it < TR_C2) { const int r = it - TR_C1, m = r / 512; ii = r % 512; W = a.in[20] + (size_t)m * 512 * 2048; N = 2048; dst = (bf16*)(ws + WS_WB) + (size_t)(m >> 2) * 2048 * 2048 + (size_t)(m & 3) * 512; ldd = 2048; }
    else if (it < TR_C3) { const int r = it - TR_C2, m = r / 2048; ii = r % 2048; W = a.in[22] + (size_t)m * 2048 * 2048; N = 2048; dst = (bf16*)(ws + WS_WO) + (size_t)m * 2048 * DP; ldd = DP; dst8 = (unsigned char*)(ws + WS_WO8) + (size_t)m * 2048 * 2048; ldd8 = 2048; widx = 68 + m; }
    else if (it < TR_C4) { const int r = it - TR_C3, m = r / 1024; ii = r % 1024; W = a.in[25] + (size_t)m * 2048 * 1024; N = 1024; dst = nullptr; dst8 = (unsigned char*)(ws + WS_WGU) + (size_t)m * 2048 * 2048; ldd = 2048; rowsel = 1; widx = 4 + m; }
    else if (it < TR_C5) { const int r = it - TR_C4, m = r / 1024; ii = r % 1024; W = a.in[26] + (size_t)m * 2048 * 1024; N = 1024; dst = nullptr; dst8 = (unsigned char*)(ws + WS_WGU) + (size_t)m * 2048 * 2048; ldd = 2048; rowsel = 2; widx = 36 + m; }
    else if (it < TR_C6) { const int r = it - TR_C5, m = r / 1024; ii = r % 1024; W = a.in[27] + (size_t)m * 1024 * 2048; N = 2048; dst = (bf16*)(ws + WS_WD) + (size_t)m * 2048 * 1024; ldd = 1024; }
    else { const int r = it - TR_C6, m = r / 8; ii = r % 8; W = a.in[11] + (size_t)m * 128 * 128; N = 128; dst = (bf16*)(ws + WS_PWT) + (size_t)m * 128 * 128; ldd = 128; }
    const int nblk = N / 32, pr = ii >> 1, kb = 2 * (pr / nblk) + (ii & 1), nb = pr % nblk, n0 = 32 * nb;
    int drow = n0; if (rowsel) drow = 256 * (n0 >> 7) + 128 * (rowsel - 1) + (n0 & 127);
    d.W = W; d.N = N; d.ldd = ldd; d.k0 = 64 * kb; d.n0 = n0; d.dst = dst ? dst + (size_t)drow * ldd : nullptr; d.dst8 = dst8 ? dst8 + (size_t)drow * (ldd8 ? ldd8 : ldd) : nullptr; d.ldd8 = ldd8 ? ldd8 : ldd;
    d.qinv = 0.f; d.fp8 = 0; d.late = (it >= TR_C3 && it < TR_C6);
    if (dst8) { const unsigned* wm = (const unsigned*)(ws + WS_CTL) + CW_WMAX; if (widx < 0) widx = it < TR_C0 ? it / 3872 : 2 + ((it - TR_C0) / 2048 >> 2);
        float amax = __uint_as_float(__hip_atomic_load(wm + widx, __ATOMIC_RELAXED, __HIP_MEMORY_SCOPE_AGENT)); if (widx >= 4 && widx < 68) amax *= EXPERT_MARGIN; d.fp8 = (it >= TR_C0 && it < TR_C3); if (ldd8 == 0) ldd8 = ldd; d.qinv = amax > 0.f ? (d.fp8 ? 128.f : 127.f) / amax : 0.f; }
}
__device__ __forceinline__ void tr_load(const TrDesc& d, int lane, f32x4 (&rv)[8]) {
    const float* p = d.W + (size_t)(d.k0 + (lane >> 3)) * d.N + d.n0 + 4 * (lane & 7);
#pragma unroll
    for (int i = 0; i < 8; ++i) rv[i] = __builtin_nontemporal_load((const f32x4*)(p + (size_t)(8 * i) * d.N));
}
__device__ __forceinline__ void tr_finish(const TrDesc& d, const f32x4 (&rv)[8], LAS float* scr, int lane) {
    constexpr int SK = 68;
    { const int kr = lane >> 3, n4 = lane & 7;
#pragma unroll
        for (int i = 0; i < 8; ++i)
#pragma unroll
            for (int e = 0; e < 4; ++e) scr[(4 * n4 + e) * SK + 8 * i + kr] = rv[i][e]; }
    asm volatile("s_waitcnt lgkmcnt(0)" ::: "memory");
    if (d.dst) { const int c = lane & 7;
#pragma unroll
        for (int j = 0; j < 4; ++j) { const int n = (lane >> 3) + 8 * j; const LAS float* sp = scr + n * SK + 8 * c; const f32x4 a0 = *(const LAS f32x4*)sp, a1 = *(const LAS f32x4*)(sp + 4);
            u32x4 o; o.x = pk2(a0[0], a0[1]); o.y = pk2(a0[2], a0[3]); o.z = pk2(a1[0], a1[1]); o.w = pk2(a1[2], a1[3]);
            if (d.late) __builtin_nontemporal_store(o, (u32x4*)(d.dst + (size_t)n * d.ldd + d.k0 + 8 * c)); else *(u32x4*)(d.dst + (size_t)n * d.ldd + d.k0 + 8 * c) = o; } }
    if (d.dst8) {
#pragma unroll
        for (int hh = 0; hh < 2; ++hh) { const int n = (lane >> 2) + 16 * hh, q4 = (lane & 3) * 16; const LAS float* sp = scr + n * SK + q4; u32x4 o;
#pragma unroll
            for (int q = 0; q < 4; ++q) { const f32x4 w = *(const LAS f32x4*)(sp + 4 * q); unsigned p = 0u;
                if (d.fp8) { p = __builtin_amdgcn_cvt_pk_fp8_f32(w[0] * d.qinv, w[1] * d.qinv, p, false); p = __builtin_amdgcn_cvt_pk_fp8_f32(w[2] * d.qinv, w[3] * d.qinv, p, true); }
                else {
                    const unsigned u0 = __float_as_uint(__builtin_amdgcn_fmed3f(w[0] * d.qinv, -127.f, 127.f) + 12582912.f), u1 = __float_as_uint(__builtin_amdgcn_fmed3f(w[1] * d.qinv, -127.f, 127.f) + 12582912.f);
                    const unsigned u2 = __float_as_uint(__builtin_amdgcn_fmed3f(w[2] * d.qinv, -127.f, 127.f) + 12582912.f), u3 = __float_as_uint(__builtin_amdgcn_fmed3f(w[3] * d.qinv, -127.f, 127.f) + 12582912.f);
                    p = __builtin_amdgcn_perm(u1, u0, 0x0c0c0400u) | __builtin_amdgcn_perm(u3, u2, 0x04000c0cu); }
                o[q] = p; }
            if (d.late) __builtin_nontemporal_store(o, (u32x4*)(d.dst8 + (size_t)n * d.ldd8 + d.k0 + q4));
            else *(u32x4*)(d.dst8 + (size_t)n * d.ldd8 + d.k0 + q4) = o; } }
    asm volatile("s_waitcnt lgkmcnt(0)" ::: "memory");
}
__device__ __forceinline__ void phase_prologue(const Args& a, LAS unsigned char* lds, int tid, int wave, int lane) {
    unsigned char* ws = a.ws;
    if (blockIdx.x < 192) {
        LAS float* sv = (LAS float*)lds;
        LAS float* red = (LAS float*)(lds + 24576);
        for (int i = tid; i < 3 * 2048; i += 512) { const int r = i >> 11, k = i & 2047; const float v = r < 2 ? a.in[1][r * 2048 + k] : a.in[3][k]; sv[i] = v / (1.f + __expf(-v)); }
        __syncthreads();
        const int l = blockIdx.x / 96, cc = blockIdx.x % 96, c4 = tid & 31, kg = tid >> 5;
        const float* wp = a.in[4] + (size_t)l * 2048 * 12288 + (size_t)(kg * 128) * 12288 + cc * 128 + c4 * 4;
        f32x4 acc0 = {0, 0, 0, 0}, acc1 = acc0, acc2 = acc0;
#pragma unroll 8
        for (int k = 0; k < 128; ++k) { const f32x4 w = __builtin_nontemporal_load((const f32x4*)(wp + (size_t)k * 12288)); const int kk = kg * 128 + k;
            acc0 += w * sv[kk]; acc1 += w * sv[2048 + kk]; acc2 += w * sv[4096 + kk]; }
#pragma unroll
        for (int e = 0; e < 4; ++e) { red[(kg * 3 + 0) * 128 + c4 * 4 + e] = acc0[e]; red[(kg * 3 + 1) * 128 + c4 * 4 + e] = acc1[e]; red[(kg * 3 + 2) * 128 + c4 * 4 + e] = acc2[e]; }
        __syncthreads();
        if (tid < 384) { const int r = tid >> 7, c = tid & 127; float s = a.in[5][l * 12288 + cc * 128 + c];
#pragma unroll
            for (int g = 0; g < 16; ++g) s += red[(g * 3 + r) * 128 + c];
            ((float*)(ws + WS_MOD))[(l * 3 + r) * 12288 + cc * 128 + c] = s; }
        __syncthreads();
    }
    {
        LAS float* scr = (LAS float*)(lds + wave * 16384);
        const int gw = blockIdx.x * 8 + wave, NGW = gridDim.x * 8;
        constexpr int NPRO = DEFER_CONV ? TR_C3 + (TR_ITEMS - TR_C6) : TR_ITEMS;
#define PRO_ITEM(i) (!DEFER_CONV ? (i) : (i) < TR_C3 ? (i) : (i) - TR_C3 + TR_C6)
        TrDesc cur; f32x4 rv[8];
        int it = gw;
        if (it < NPRO) { tr_desc(a, PRO_ITEM(it), cur); tr_load(cur, lane, rv); }
        while (it < NPRO) {
            const int nit = it + NGW; TrDesc nd = cur; f32x4 rn[8];
            if (nit < NPRO) { tr_desc(a, PRO_ITEM(nit), nd); tr_load(nd, lane, rn); }
            tr_finish(cur, rv, scr, lane);
#pragma unroll
            for (int i = 0; i < 8; ++i) rv[i] = rn[i];
            cur = nd; it = nit;
        }
#undef PRO_ITEM
    }
    {
        const int gt = blockIdx.x * 512 + tid, NT = gridDim.x * 512;
        for (int i = gt; i < 2 * 224 * 256; i += NT) { const int l = i / (224 * 256), r = i % (224 * 256); ((u32x4*)((bf16*)(ws + WS_WCAT) + ((size_t)l * 4096 + 3872) * 2048))[r] = (u32x4){0u, 0u, 0u, 0u}; }
        for (int i = gt; i < 2 * 224 * 128; i += NT) { const int l = i / (224 * 128), r = i % (224 * 128); ((u32x4*)((unsigned char*)(ws + WS_WCAT8) + ((size_t)l * 12288 + 3872) * 2048))[r] = (u32x4){0u, 0u, 0u, 0u}; }
        for (int i = gt; i < 131072; i += NT) ((bf16*)(ws + WS_WSB))[i] = (bf16)f2bf(a.in[15][i]);
        for (int i = gt; i < 2048; i += NT) { const int pos = i >> 4, f = i & 15; const float inv = exp2f(-(float)f * (13.287712379549449f / 16.f));
            float rev = (float)pos * inv * 0.15915494309189535f; rev -= floorf(rev);
            ((float*)(ws + WS_ROPE))[i] = __builtin_amdgcn_cosf(rev); ((float*)(ws + WS_ROPE))[2048 + i] = __builtin_amdgcn_sinf(rev); }
    }
}

constexpr int CONV_UNIT = 64, CONV_UNITS_PH = 3 * 16384 / CONV_UNIT / 2;
__device__ __forceinline__ void conv_finish2(const f32x4 (&ra)[8], const f32x4 (&rb)[8], LAS float* scr, int lane, bool down, bf16* dstb, unsigned char* dst8, float qinv) {
    constexpr int SK = 132;
    { const int kr = lane >> 3, n4 = lane & 7;
#pragma unroll
        for (int i = 0; i < 8; ++i)
#pragma unroll
            for (int e = 0; e < 4; ++e) { scr[(4 * n4 + e) * SK + 8 * i + kr] = ra[i][e]; scr[(4 * n4 + e) * SK + 64 + 8 * i + kr] = rb[i][e]; } }
    asm volatile("s_waitcnt lgkmcnt(0)" ::: "memory");
    if (down) { const int c = lane & 15;
#pragma unroll
        for (int j = 0; j < 8; ++j) { const int n = (lane >> 4) + 4 * j; const LAS float* sp = scr + n * SK + 8 * c; const f32x4 a0 = *(const LAS f32x4*)sp, a1 = *(const LAS f32x4*)(sp + 4);
            u32x4 o; o.x = pk2(a0[0], a0[1]); o.y = pk2(a0[2], a0[3]); o.z = pk2(a1[0], a1[1]); o.w = pk2(a1[2], a1[3]);
            *(u32x4*)(dstb + (size_t)n * 1024 + 8 * c) = o; } }
    else { const int c = lane & 7;
#pragma unroll
        for (int j = 0; j < 4; ++j) { const int n = (lane >> 3) + 8 * j; const LAS float* sp = scr + n * SK + 16 * c; u32x4 o;
#pragma unroll
            for (int q = 0; q < 4; ++q) { const f32x4 w = *(const LAS f32x4*)(sp + 4 * q);
                const unsigned u0 = __float_as_uint(__builtin_amdgcn_fmed3f(w[0] * qinv, -127.f, 127.f) + 12582912.f), u1 = __float_as_uint(__builtin_amdgcn_fmed3f(w[1] * qinv, -127.f, 127.f) + 12582912.f);
                const unsigned u2 = __float_as_uint(__builtin_amdgcn_fmed3f(w[2] * qinv, -127.f, 127.f) + 12582912.f), u3 = __float_as_uint(__builtin_amdgcn_fmed3f(w[3] * qinv, -127.f, 127.f) + 12582912.f);
                o[q] = __builtin_amdgcn_perm(u1, u0, 0x0c0c0400u) | __builtin_amdgcn_perm(u3, u2, 0x04000c0cu); }
            *(u32x4*)(dst8 + (size_t)n * 2048 + 16 * c) = o; } }
    asm volatile("s_waitcnt lgkmcnt(0)" ::: "memory");
}
__device__ __forceinline__ void conv_unit(const Args& a, int l, int half, int cu, LAS unsigned char* lds, int wave, int lane) {
    LAS float* scr = (LAS float*)(lds + wave * 17408);
    const int jb = (half * CONV_UNITS_PH + cu) * CONV_UNIT, tj = jb >> 14, r = l * 16384 + (jb & 16383), m = r >> 10, uin = (r & 1023) >> 6;
    const bool down = tj == 2;
    const int N = down ? 2048 : 1024, kbA = down ? 2 * (uin >> 1) : 2 * uin, nb0 = (down ? 32 * (uin & 1) : 0) + wave;
    float qinv = 0.f;
    if (!down) { const unsigned* wm = (const unsigned*)(a.ws + WS_CTL) + CW_WMAX; const float amax = __uint_as_float(__hip_atomic_load(wm + (tj == 0 ? 4 : 36) + m, __ATOMIC_RELAXED, __HIP_MEMORY_SCOPE_AGENT)) * EXPERT_MARGIN; qinv = amax > 0.f ? 127.f / amax : 0.f; }
    const float* W = (tj == 0 ? a.in[25] : tj == 1 ? a.in[26] : a.in[27]) + (size_t)m * 2048 * 1024;
    const float* lp = W + (size_t)(64 * kbA + (lane >> 3)) * N + 4 * (lane & 7);
#define CONV_LD2(p, RA, RB) do { const float* _p = lp + 32 * (nb0 + 8 * (p)); _Pragma("unroll") for (int _i = 0; _i < 8; ++_i) { RA[_i] = __builtin_nontemporal_load((const f32x4*)(_p + (size_t)(8 * _i) * N)); RB[_i] = __builtin_nontemporal_load((const f32x4*)(_p + (size_t)(64 + 8 * _i) * N)); } } while (0)
#define CONV_FIN2(p, RA, RB) do { const int _n0 = 32 * (nb0 + 8 * (p)); \
        conv_finish2(RA, RB, scr, lane, down, (bf16*)(a.ws + WS_WD) + (size_t)m * 2048 * 1024 + (size_t)_n0 * 1024 + 64 * kbA, \
                     (unsigned char*)(a.ws + WS_WGU) + (size_t)m * 2048 * 2048 + (size_t)(256 * (_n0 >> 7) + 128 * tj + (_n0 & 127)) * 2048 + 64 * kbA, qinv); } while (0)
    f32x4 a0[8], b0[8], a1[8], b1[8];
    CONV_LD2(0, a0, b0);
    CONV_LD2(1, a1, b1); CONV_FIN2(0, a0, b0);
    CONV_LD2(2, a0, b0); CONV_FIN2(1, a1, b1);
    CONV_LD2(3, a1, b1); CONV_FIN2(2, a0, b0);
    CONV_FIN2(3, a1, b1);
#undef CONV_LD2
#undef CONV_FIN2
}

template <int MODE> __device__ __forceinline__ void norm1_load(const Args& a, int r, int lane, const float* MODp, f32x4 (&v)[8]) {
    const int mr = r < ML ? (r >> 13) : 2;
    if (MODE == 0) { const float* src = r < ML ? a.in[0] + (size_t)r * D : a.in[2] + (size_t)(r - ML) * D;
#pragma unroll
        for (int j = 0; j < 8; ++j) v[j] = __builtin_nontemporal_load((const f32x4*)(src + 4 * lane + 256 * j)); }
    else { const bf16* xr = (const bf16*)(a.ws + WS_X) + (size_t)r * D; const bf16* y0 = (const bf16*)(a.ws + WS_Y) + (size_t)(2 * r) * D; const bf16* y1 = y0 + D; const float* g2 = MODp + mr * 12288 + 5 * 2048;
#pragma unroll
        for (int j = 0; j < 8; ++j) { const int c = 4 * lane + 256 * j; const u32x2 px = __builtin_nontemporal_load((const u32x2*)(xr + c)); f32x4 x = {bf2f(px.x & 0xffffu), bf2f(px.x >> 16), bf2f(px.y & 0xffffu), bf2f(px.y >> 16)}; const u32x2 p0 = __builtin_nontemporal_load((const u32x2*)(y0 + c)), p1 = __builtin_nontemporal_load((const u32x2*)(y1 + c)); const f32x4 g = *(const f32x4*)(g2 + c);
            x[0] += g[0] * (bf2f(p0.x & 0xffffu) + bf2f(p1.x & 0xffffu)); x[1] += g[1] * (bf2f(p0.x >> 16) + bf2f(p1.x >> 16));
            x[2] += g[2] * (bf2f(p0.y & 0xffffu) + bf2f(p1.y & 0xffffu)); x[3] += g[3] * (bf2f(p0.y >> 16) + bf2f(p1.y >> 16)); v[j] = x; } }
}
template <int MODE> __device__ __forceinline__ void norm1_finish(const Args& a, int l, int r, int lane, const float* MODl, f32x4 (&v)[8]) {
    const int mr = r < ML ? (r >> 13) : 2;
    if (MODE != 2) { bf16* xr = (bf16*)(a.ws + WS_X) + (size_t)r * D;
#pragma unroll
        for (int j = 0; j < 8; ++j) { u32x2 o; o.x = pk2(v[j][0], v[j][1]); o.y = pk2(v[j][2], v[j][3]); __builtin_nontemporal_store(o, (u32x2*)(xr + 4 * lane + 256 * j)); } }
    float ss = 0.f;
#pragma unroll
    for (int j = 0; j < 8; ++j) ss += (v[j][0] * v[j][0] + v[j][1] * v[j][1]) + (v[j][2] * v[j][2] + v[j][3] * v[j][3]);
    const float rstd = rsqrtf(wave_sum(ss) * (1.f / D) + 1e-6f);
    if (MODE == 2) { float* o = a.out + (size_t)r * D; const float* g = a.in[8];
#pragma unroll
        for (int j = 0; j < 8; ++j) { const int c = 4 * lane + 256 * j; const f32x4 gg = *(const f32x4*)(g + c); __builtin_nontemporal_store(v[j] * rstd * gg, (f32x4*)(o + c)); } }
    else { bf16* h = (bf16*)(a.ws + WS_H) + (size_t)r * D; unsigned char* h8 = (unsigned char*)(a.ws + WS_H8) + (size_t)r * D; unsigned char* h8i = (unsigned char*)(a.ws + WS_H8I) + (size_t)r * D; const float* g = a.in[6] + l * D; const float* sh = MODl + mr * 12288; const float* sc = sh + 2048;
        float am = 0.f;
#pragma unroll
        for (int j = 0; j < 8; ++j) { const int c = 4 * lane + 256 * j; const f32x4 gg = *(const f32x4*)(g + c), s1 = *(const f32x4*)(sh + c), s2 = *(const f32x4*)(sc + c);
            v[j] = (v[j] * rstd * gg) * (s2 + 1.f) + s1; am = fmaxf(am, fmaxf(fmaxf(fabsf(v[j][0]), fabsf(v[j][1])), fmaxf(fabsf(v[j][2]), fabsf(v[j][3])))); }
        am = wave_max(am);
        const float qinv = am > 0.f ? 127.f / am : 0.f;
        if (lane == 0) ((float*)(a.ws + WS_RS))[r] = am * (1.f / 127.f);
#pragma unroll
        for (int j = 0; j < 8; ++j) { const int c = 4 * lane + 256 * j; const f32x4 y = v[j];
            if (r >= ML) { u32x2 o; o.x = pk2(y[0], y[1]); o.y = pk2(y[2], y[3]); *(u32x2*)(h + c) = o; }
            *(unsigned*)(h8i + c) = q8pack(y[0] * qinv, y[1] * qinv, y[2] * qinv, y[3] * qinv);
            unsigned p8 = 0u; p8 = __builtin_amdgcn_cvt_pk_fp8_f32(y[0], y[1], p8, false); p8 = __builtin_amdgcn_cvt_pk_fp8_f32(y[2], y[3], p8, true); *(unsigned*)(h8 + c) = p8; } }
}
template <int MODE> __device__ __forceinline__ void phase_norm1(const Args& a, int l, int wave, int lane, int probe = 0) {
    const int gw = blockIdx.x * 8 + wave, NGW = gridDim.x * 8;
    const float* MODl = (const float*)(a.ws + WS_MOD) + (size_t)(l < 2 ? l : 1) * 3 * 12288;
    const float* MODp = (const float*)(a.ws + WS_MOD) + (size_t)(l > 0 ? l - 1 : 0) * 3 * 12288;
    const int nrows = (MODE == 2) ? ML : MT;
    for (int r = gw; r < nrows; r += 2 * NGW) {
        const int r2 = r + NGW; const bool has2 = r2 < nrows;
        f32x4 v[8], w[8];
        norm1_load<MODE>(a, r, lane, MODp, v);
        if (has2) norm1_load<MODE>(a, r2, lane, MODp, w);
        norm1_finish<MODE>(a, l, r, lane, MODl, v);
        if (has2) norm1_finish<MODE>(a, l, r2, lane, MODl, w);
    }
}

__device__ __forceinline__ void router_row_load(const Args& a, int r, int lane, u32x2 (&pxr)[8], u32x2 (&pmr)[8]) {
    const bf16* xr = (const bf16*)(a.ws + WS_X) + (size_t)r * D; const bf16* mx = (const bf16*)(a.ws + WS_MX) + (size_t)r * D;
#pragma unroll
    for (int j = 0; j < 8; ++j) { const int c = 4 * lane + 256 * j; pxr[j] = __builtin_nontemporal_load((const u32x2*)(xr + c)); pmr[j] = __builtin_nontemporal_load((const u32x2*)(mx + c)); }
}
__device__ __forceinline__ void router_row_norm(const Args& a, int l, int r, int lane, const float* MODl, const u32x2 (&pxr)[8], const u32x2 (&pmr)[8], f32x4 (&v)[8]) {
    const int mr = r < ML ? (r >> 13) : 2; bf16* xr = (bf16*)(a.ws + WS_X) + (size_t)r * D; float ss = 0.f;
    const float* g1 = MODl + mr * 12288 + 2 * 2048;
#pragma unroll
    for (int j = 0; j < 8; ++j) { const int c = 4 * lane + 256 * j; const u32x2 px = pxr[j]; f32x4 x = {bf2f(px.x & 0xffffu), bf2f(px.x >> 16), bf2f(px.y & 0xffffu), bf2f(px.y >> 16)}; const u32x2 pm = pmr[j]; const f32x4 gg = *(const f32x4*)(g1 + c);
        x[0] += gg[0] * bf2f(pm.x & 0xffffu); x[1] += gg[1] * bf2f(pm.x >> 16); x[2] += gg[2] * bf2f(pm.y & 0xffffu); x[3] += gg[3] * bf2f(pm.y >> 16);
        { u32x2 o; o.x = pk2(x[0], x[1]); o.y = pk2(x[2], x[3]); __builtin_nontemporal_store(o, (u32x2*)(xr + c)); } v[j] = x; ss += (x[0] * x[0] + x[1] * x[1]) + (x[2] * x[2] + x[3] * x[3]); }
    const float rstd = rsqrtf(wave_sum(ss) * (1.f / D) + 1e-6f);
    bf16* h = (bf16*)(a.ws + WS_H) + (size_t)r * D; const float* g = a.in[7] + l * D; const float* sh = MODl + mr * 12288 + 3 * 2048; const float* sc = sh + 2048;
    float am = 0.f;
#pragma unroll
    for (int j = 0; j < 8; ++j) { const int c = 4 * lane + 256 * j; const f32x4 gg = *(const f32x4*)(g + c), s1 = *(const f32x4*)(sh + c), s2 = *(const f32x4*)(sc + c);
        v[j] = (v[j] * rstd * gg) * (s2 + 1.f) + s1; am = fmaxf(am, fmaxf(fmaxf(fabsf(v[j][0]), fabsf(v[j][1])), fmaxf(fabsf(v[j][2]), fabsf(v[j][3])))); }
    am = wave_max(am); const float qinv = am > 0.f ? 127.f / am : 0.f;
    if (lane == 0) ((float*)(a.ws + WS_RS))[r] = am * (1.f / 127.f);
    unsigned char* h8i = (unsigned char*)(a.ws + WS_H8I) + (size_t)r * D; (void)h;
#pragma unroll
    for (int j = 0; j < 8; ++j) { const int c = 4 * lane + 256 * j; const f32x4 y = v[j];
        *(unsigned*)(h8i + c) = q8pack(y[0] * qinv, y[1] * qinv, y[2] * qinv, y[3] * qinv); }
}
typedef float f32x2v __attribute__((ext_vector_type(2)));
__device__ __forceinline__ void router_select(float (&p)[16], int lane, const float* rb, int rl, LAS int* SELE, LAS float* SELW) {
    { const bool up = (lane & 32) != 0;
#pragma unroll
        for (int c = 0; c < 8; ++c) { const float mine = up ? p[c + 8] : p[c], other = up ? p[c] : p[c + 8]; p[c] = mine + __shfl_xor(other, 32); } }
    { const bool up = (lane & 16) != 0;
#pragma unroll
        for (int c = 0; c < 4; ++c) { const float mine = up ? p[c + 4] : p[c], other = up ? p[c] : p[c + 4]; p[c] = mine + __shfl_xor(other, 16); } }
    { const bool up = (lane & 8) != 0;
#pragma unroll
        for (int c = 0; c < 2; ++c) { const float mine = up ? p[c + 2] : p[c], other = up ? p[c] : p[c + 2]; p[c] = mine + __shfl_xor(other, 8); } }
    { const bool up = (lane & 4) != 0; const float mine = up ? p[1] : p[0], other = up ? p[0] : p[1]; p[0] = mine + __shfl_xor(other, 4); }
    p[0] += __shfl_xor(p[0], 2); p[0] += __shfl_xor(p[0], 1);
    float lg[16];
#pragma unroll
    for (int c = 0; c < 16; ++c) { const int src = ((c >> 3) & 1) * 32 + ((c >> 2) & 1) * 16 + ((c >> 1) & 1) * 8 + (c & 1) * 4; lg[c] = __builtin_bit_cast(float, __builtin_amdgcn_readlane(__builtin_bit_cast(int, p[0]), src)); }
    int best = 0; float bestv = -3.0e38f;
    float c0 = 0, c1 = 0, c2 = 0, c3 = 0, t0 = 0, t1 = 0, t2 = 0, t3 = 0;
#pragma unroll
    for (int gI = 0; gI < 4; ++gI) {
        const float s0 = 1.f / (1.f + __expf(-lg[4 * gI])), s1 = 1.f / (1.f + __expf(-lg[4 * gI + 1])), s2 = 1.f / (1.f + __expf(-lg[4 * gI + 2])), s3 = 1.f / (1.f + __expf(-lg[4 * gI + 3]));
        const float b0 = s0 + rb[4 * gI], b1 = s1 + rb[4 * gI + 1], b2 = s2 + rb[4 * gI + 2], b3 = s3 + rb[4 * gI + 3];
        const float gs = fmaxf(fmaxf(fmaxf(b0 + b1, b0 + b2), fmaxf(b0 + b3, b1 + b2)), fmaxf(b1 + b3, b2 + b3));
        if (gs > bestv) { bestv = gs; best = gI; c0 = b0; c1 = b1; c2 = b2; c3 = b3; t0 = s0; t1 = s1; t2 = s2; t3 = s3; }
    }
    int i0 = 0; float m0 = c0; if (c1 > m0) { m0 = c1; i0 = 1; } if (c2 > m0) { m0 = c2; i0 = 2; } if (c3 > m0) { m0 = c3; i0 = 3; }
    int i1 = -1; float m1 = -3.0e38f;
    if (i0 != 0 && c0 > m1) { m1 = c0; i1 = 0; } if (i0 != 1 && c1 > m1) { m1 = c1; i1 = 1; } if (i0 != 2 && c2 > m1) { m1 = c2; i1 = 2; } if (i0 != 3 && c3 > m1) { m1 = c3; i1 = 3; }
    const float w0 = i0 == 0 ? t0 : i0 == 1 ? t1 : i0 == 2 ? t2 : t3, w1 = i1 == 0 ? t0 : i1 == 1 ? t1 : i1 == 2 ? t2 : t3;
    const float wsum = w0 + w1;
    if (lane == 0) { SELE[rl] = (4 * best + i0) | ((4 * best + i1) << 8); SELW[2 * rl] = w0 / wsum; SELW[2 * rl + 1] = w1 / wsum; }
}
__device__ __forceinline__ void phase_norm2_router(const Args& a, int l, LAS unsigned char* lds, int tid, int wave, int lane, int probe = 0) {
    constexpr int RWS = 2052;
    LAS float* RW = (LAS float*)lds;
    LAS int* SELE = (LAS int*)(lds + 131328);
    LAS float* SELW = (LAS float*)(lds + 131328 + 512);
    LAS int* SLOT = (LAS int*)(lds + 131328 + 1536);
    LAS int* BASE = (LAS int*)(lds + 131328 + 2560);
    for (int i = tid; i < 32768; i += 512) { const int k = i >> 4, c = i & 15; RW[c * RWS + k] = a.in[23][i]; }
    __syncthreads();
    const float* MODl = (const float*)(a.ws + WS_MOD) + (size_t)l * 3 * 12288;
    unsigned* cnt = (unsigned*)(a.ws + WS_CTL) + CW_CNT + 64 * 16 * l;
    int* LIST = (int*)(a.ws + WS_LIST); float* LISTW = (float*)(a.ws + WS_LISTW);
    const int nrows = (l == 0) ? MT : ML;
    const int R = (nrows + (int)gridDim.x - 1) / (int)gridDim.x, rbase = (int)blockIdx.x * R;
    const int HP = R >> 1;
    u32x2 pxa[8], pma[8], pxb[8], pmb[8];
    if (wave < HP) { router_row_load(a, rbase + wave, lane, pxa, pma); router_row_load(a, rbase + wave + HP, lane, pxb, pmb); }
    for (int rl = wave; rl < HP; rl += 8) {
        const int rl2 = rl + HP, r = rbase + rl, r2 = rbase + rl2;
        f32x4 v[8], w2[8];
        router_row_norm(a, l, r, lane, MODl, pxa, pma, v);
        router_row_norm(a, l, r2, lane, MODl, pxb, pmb, w2);
        if (rl + 8 < HP) { router_row_load(a, r + 8, lane, pxa, pma); router_row_load(a, r2 + 8, lane, pxb, pmb); }
        float p[16], q[16];
#pragma unroll
        for (int c = 0; c < 16; ++c) { f32x2v s12 = {0.f, 0.f};
#pragma unroll
            for (int j = 0; j < 8; ++j) { const f32x4 w = *(const LAS f32x4*)(RW + c * RWS + 4 * lane + 256 * j);
#pragma unroll
                for (int e = 0; e < 4; ++e) s12 = __builtin_elementwise_fma((f32x2v){v[j][e], w2[j][e]}, (f32x2v){w[e], w[e]}, s12); }
            p[c] = s12[0]; q[c] = s12[1]; asm volatile("" : "+v"(p[c]), "+v"(q[c]) :: "memory"); }
        router_select(p, lane, a.in[24], rl, SELE, SELW);
        router_select(q, lane, a.in[24], rl2, SELE, SELW);
    }
    __syncthreads();
    const int nloc = (nrows - rbase) < R ? (nrows - rbase > 0 ? nrows - rbase : 0) : R;
    if (tid < 16) { int c = 0;
        for (int rl = 0; rl < nloc; ++rl) { const int se = SELE[rl]; if ((se & 255) == tid) { SLOT[2 * rl] = c; ++c; } if ((se >> 8) == tid) { SLOT[2 * rl + 1] = c; ++c; } }
        BASE[tid] = c ? (int)atomicAdd(cnt + 64 * tid, (unsigned)c) : 0; }
    __syncthreads();
    if (tid < nloc) { const int se = SELE[tid], e0 = se & 255, e1 = se >> 8, r = rbase + tid;
        const int k0 = BASE[e0] + SLOT[2 * tid], k1 = BASE[e1] + SLOT[2 * tid + 1];
        LIST[e0 * CAP + k0] = 2 * r; LISTW[e0 * CAP + k0] = SELW[2 * tid]; LIST[e1 * CAP + k1] = 2 * r + 1; LISTW[e1 * CAP + k1] = SELW[2 * tid + 1]; }
}

namespace pg8 {
constexpr int BM = 256, BK = 64, HALF = 128, HTB = HALF * BK * 2, STAGE_BYTES = 8 * HTB, NXCD = 8, WGM = 8;
__device__ __forceinline__ int lds_byte(int r, int c) { const int st = (r >> 4) * 2 + (c >> 5), rr = r & 15, cc = c & 31, ob = rr * 64 + cc * 2; return st * 1024 + (ob ^ (((ob >> 9) & 1) << 5)); }
__device__ __forceinline__ void stage_rc(int b, int& R, int& C) { const int st = b / 1024, sb = b % 1024, swz = sb ^ (((sb >> 9) & 1) << 5); R = (st >> 1) * 16 + swz / 64; C = (st & 1) * 32 + (swz % 64) / 2; }
__device__ __forceinline__ int perm32(int rho) { const int n = rho >> 4, i = rho & 15; return 8 * (i >> 2) + 4 * n + (i & 3); }
typedef int i32x4v __attribute__((ext_vector_type(4)));
typedef int i32x8v __attribute__((ext_vector_type(8)));
__device__ __forceinline__ i32x4v lo4(i32x8v v) { return __builtin_shufflevector(v, v, 0, 1, 2, 3); }
__device__ __forceinline__ i32x4v hi4(i32x8v v) { return __builtin_shufflevector(v, v, 4, 5, 6, 7); }
__device__ __forceinline__ bf16x8 lo8(i32x8v v) { return __builtin_bit_cast(bf16x8, (i32x4v)__builtin_shufflevector(v, v, 0, 1, 2, 3)); }
__device__ __forceinline__ bf16x8 hi8(i32x8v v) { return __builtin_bit_cast(bf16x8, (i32x4v)__builtin_shufflevector(v, v, 4, 5, 6, 7)); }
__device__ __forceinline__ i32x8v cat8(bf16x8 lo, bf16x8 hi) { const i32x4v a = __builtin_bit_cast(i32x4v, lo), b = __builtin_bit_cast(i32x4v, hi); return __builtin_shufflevector(a, b, 0, 1, 2, 3, 4, 5, 6, 7); }
struct Unit { int pm, pn, e, cnt; };
__device__ __forceinline__ unsigned cvt_pk_bf16(float lo, float hi) { return pk2(lo, hi); }
__device__ __forceinline__ void static_tile(int L, int nM, int nN, int& pm, int& pn) {
    const int nwg = nM * nN; int wgid = L; { const int q = nwg / NXCD, r = nwg % NXCD, xcd = wgid % NXCD, off = wgid / NXCD; wgid = (xcd < r ? xcd * (q + 1) : r * (q + 1) + (xcd - r) * q) + off; }
    const int nig = WGM * nN, gid = wgid / nig, fm = gid * WGM, gsz = (nM - fm) < WGM ? (nM - fm) : WGM;
    pm = fm + ((wgid % nig) % gsz); pn = (wgid % nig) / gsz;
}
template <class Epi, bool KHOOK> struct HookState { struct type {}; };
template <class Epi> struct HookState<Epi, true> { typedef typename Epi::State type; };
template <class Epi, class Sched, bool KHOOK, int DT = 0>
__device__ __forceinline__ void gemm256(LAS unsigned char* lds, const char* Abase, const int Kb, const Sched& S, const Epi& E) {
    const int tid = fresh_tid(), wid = __builtin_amdgcn_readfirstlane(tid >> 6), lane = tid & 63, wr = wid >> 2, wc = wid & 3, fr = lane & 15, fq = lane >> 4;
    const int nt = Kb / 128;
    unsigned voffB[2];
#pragma unroll
    for (int i = 0; i < 2; ++i) { int R, C; stage_rc(tid * 16 + i * 8192, R, C); const int Rb = Epi::PERM ? ((R & ~31) + perm32(R & 31)) : R; voffB[i] = (unsigned)Rb * S.ldb_bytes() + (unsigned)(C * 2); }
#define PG8_RS(i) ({ int _R, _C; stage_rc(tid * 16 + (i) * 8192, _R, _C); _R; })
#define PG8_CS(i) ({ int _R, _C; stage_rc(tid * 16 + (i) * 8192, _R, _C); (unsigned)(_C * 2); })
    const unsigned kstep = 128u, hstepB = (unsigned)HALF * S.ldb_bytes();
    const __amdgpu_buffer_rsrc_t rA = __builtin_amdgcn_make_buffer_rsrc((void*)Abase, 0, 0x7fffffff, 0x00020000), rB = __builtin_amdgcn_make_buffer_rsrc((void*)S.wbase(), 0, 0x7fffffff, 0x00020000);
    const unsigned ldsw = (unsigned)wid * 1024u;
    const int aoff = lds_byte(wr * 64 + fr, fq * 8), boff = lds_byte(wc * 32 + fr, fq * 8);
#define PG8_SA(b, h) (((b) * 2 + (h)) * HTB)
#define PG8_SB(b, h) ((4 + (b) * 2 + (h)) * HTB)
#define PG8_STAGE(bufoff, rsrc, soff, voff) do { _Pragma("unroll") for (int _i = 0; _i < 2; ++_i) \
        __builtin_amdgcn_raw_ptr_buffer_load_lds(rsrc, (LAS void*)(lds + (bufoff) + ldsw + _i * 8192), 16, (int)(voff)[_i], (int)(soff), 0, 0); } while (0)
#define PG8_LDA(dst, b, h) do { _Pragma("unroll") for (int m = 0; m < 4; ++m) { const i32x4v _lo = *(const LAS i32x4v*)(lds + PG8_SA(b, h) + aoff + m * 2048), _hi = *(const LAS i32x4v*)(lds + PG8_SA(b, h) + aoff + m * 2048 + 1024); dst[m] = __builtin_shufflevector(_lo, _hi, 0, 1, 2, 3, 4, 5, 6, 7); } } while (0)
#define PG8_LDB(dst, b, h) do { _Pragma("unroll") for (int n = 0; n < 2; ++n) { const i32x4v _lo = *(const LAS i32x4v*)(lds + PG8_SB(b, h) + boff + n * 2048), _hi = *(const LAS i32x4v*)(lds + PG8_SB(b, h) + boff + n * 2048 + 1024); dst[n] = __builtin_shufflevector(_lo, _hi, 0, 1, 2, 3, 4, 5, 6, 7); } } while (0)
#define PG8_MMA(ai, bj, At, Bt) do { __builtin_amdgcn_s_setprio(1); _Pragma("unroll") for (int m = 0; m < 4; ++m) _Pragma("unroll") for (int n = 0; n < 2; ++n) { \
        if constexpr (DT == 0) { acc[ai][bj][m][n] = __builtin_amdgcn_mfma_f32_16x16x32_bf16(lo8(Bt[n]), lo8(At[m]), acc[ai][bj][m][n], 0, 0, 0); acc[ai][bj][m][n] = __builtin_amdgcn_mfma_f32_16x16x32_bf16(hi8(Bt[n]), hi8(At[m]), acc[ai][bj][m][n], 0, 0, 0); } \
        else if constexpr (DT == 1) { acc[ai][bj][m][n] = __builtin_amdgcn_mfma_scale_f32_16x16x128_f8f6f4(Bt[n], At[m], acc[ai][bj][m][n], 0, 0, 0, 0, 0, 0); } \
        else { i32x4v _c = __builtin_bit_cast(i32x4v, acc[ai][bj][m][n]); _c = __builtin_amdgcn_mfma_i32_16x16x64_i8(lo4(Bt[n]), lo4(At[m]), _c, 0, 0, 0); _c = __builtin_amdgcn_mfma_i32_16x16x64_i8(hi4(Bt[n]), hi4(At[m]), _c, 0, 0, 0); acc[ai][bj][m][n] = __builtin_bit_cast(f32x4, _c); } } \
        __builtin_amdgcn_s_setprio(0); } while (0)
#define PG8_WAIT_V(n) asm volatile("s_waitcnt vmcnt(" #n ")" ::: "memory")
#define PG8_WAIT_L(n) asm volatile("s_waitcnt lgkmcnt(" #n ")" ::: "memory")
#define PG8_BAR __builtin_amdgcn_s_barrier()
#define PG8_SCHED __builtin_amdgcn_sched_barrier(0)
    Unit cur, nxt; int ui = 0;
    if (!S.next(0, cur)) return;
    f32x4 acc[2][2][4][2];
#pragma unroll
    for (int a = 0; a < 2; ++a)
#pragma unroll
        for (int b = 0; b < 2; ++b)
#pragma unroll
            for (int m = 0; m < 4; ++m)
#pragma unroll
                for (int n = 0; n < 2; ++n) acc[a][b][m][n] = (f32x4){0.f, 0.f, 0.f, 0.f};
    i32x8v At[4], B0[2], B1[2];
    typename HookState<Epi, KHOOK>::type hst;
    unsigned vA0[2], vA1[2], nA0[2], nA1[2];
    unsigned cAs = 0u, nAs = 0u;
    const unsigned hA = Sched::GATHER ? 0u : (unsigned)HALF * S.lda_bytes();
    if constexpr (Sched::GATHER) {
#pragma unroll
        for (int i = 0; i < 2; ++i) { vA0[i] = S.arow_off(cur, PG8_RS(i)) + PG8_CS(i); vA1[i] = S.arow_off(cur, HALF + PG8_RS(i)) + PG8_CS(i); }
    } else {
#pragma unroll
        for (int i = 0; i < 2; ++i) { vA0[i] = (unsigned)PG8_RS(i) * S.lda_bytes() + PG8_CS(i); vA1[i] = vA0[i]; nA0[i] = vA0[i]; nA1[i] = vA0[i]; }
        cAs = S.aoff(cur);
    }
    unsigned cB = S.boff(cur);
    S.a_ready(cur);
    PG8_STAGE(PG8_SB(0, 0), rB, cB, voffB); PG8_STAGE(PG8_SB(0, 1), rB, cB + hstepB, voffB); PG8_STAGE(PG8_SA(0, 0), rA, cAs, vA0); PG8_STAGE(PG8_SA(0, 1), rA, cAs + hA, vA1);
    if (wr == 1) PG8_BAR;
    PG8_WAIT_V(2); PG8_BAR;
    PG8_STAGE(PG8_SB(1, 0), rB, cB + kstep, voffB); PG8_STAGE(PG8_SA(1, 0), rA, cAs + kstep, vA0); PG8_STAGE(PG8_SB(1, 1), rB, cB + hstepB + kstep, voffB);
    PG8_WAIT_V(6); PG8_BAR;
    for (;;) {
        const bool has_next = S.next(ui + 1, nxt);
        const unsigned nB = has_next ? S.boff(nxt) : cB;
        if constexpr (Sched::GATHER) {
#pragma unroll
            for (int i = 0; i < 2; ++i) { nA0[i] = has_next ? S.arow_off(nxt, PG8_RS(i)) + PG8_CS(i) : vA0[i]; nA1[i] = has_next ? S.arow_off(nxt, HALF + PG8_RS(i)) + PG8_CS(i) : vA1[i]; }
        } else nAs = has_next ? S.aoff(nxt) : cAs;
        for (int t = 0; t < nt; t += 2) {
            const bool last = (t == nt - 2);
            const unsigned a1 = cAs + (unsigned)(t + 1) * kstep;
            const unsigned a2 = last ? nAs : cAs + (unsigned)(t + 2) * kstep, b2 = last ? nB : cB + (unsigned)(t + 2) * kstep;
            const unsigned a3 = a2 + kstep, b3 = b2 + kstep;
            if (last && has_next) S.a_ready(nxt);
            unsigned w0[2], w1[2];
#pragma unroll
            for (int i = 0; i < 2; ++i) { w0[i] = (Sched::GATHER && last) ? nA0[i] : vA0[i]; w1[i] = (Sched::GATHER && last) ? nA1[i] : vA1[i]; }
            PG8_LDB(B0, 0, 0); PG8_LDB(B1, 0, 1); PG8_SCHED; PG8_LDA(At, 0, 0); PG8_STAGE(PG8_SA(1, 1), rA, a1 + hA, vA1);
            PG8_WAIT_V(8); PG8_WAIT_L(0); PG8_BAR; PG8_MMA(0, 0, At, B0); PG8_MMA(0, 1, At, B1); PG8_BAR; PG8_SCHED;
            PG8_LDA(At, 0, 1); PG8_STAGE(PG8_SB(0, 0), rB, b2, voffB); PG8_STAGE(PG8_SB(0, 1), rB, b2 + hstepB, voffB); PG8_STAGE(PG8_SA(0, 0), rA, a2, w0);
            PG8_WAIT_V(8); PG8_WAIT_L(0); PG8_BAR; PG8_MMA(1, 0, At, B0); PG8_MMA(1, 1, At, B1); PG8_BAR; PG8_SCHED;
            PG8_LDB(B0, 1, 0); PG8_LDB(B1, 1, 1); PG8_SCHED; PG8_LDA(At, 1, 0); PG8_STAGE(PG8_SA(0, 1), rA, a2 + hA, w1);
            PG8_WAIT_V(8); PG8_WAIT_L(0); PG8_BAR; PG8_MMA(0, 0, At, B0); PG8_MMA(0, 1, At, B1); PG8_BAR; PG8_SCHED;
            PG8_LDA(At, 1, 1); PG8_STAGE(PG8_SB(1, 0), rB, b3, voffB); PG8_STAGE(PG8_SB(1, 1), rB, b3 + hstepB, voffB); PG8_STAGE(PG8_SA(1, 0), rA, a3, w0);
            PG8_WAIT_V(8); PG8_WAIT_L(0); PG8_BAR; PG8_MMA(1, 0, At, B0); PG8_MMA(1, 1, At, B1); PG8_BAR; PG8_SCHED;
            if constexpr (KHOOK) { if (!last && ((t + 2) & 7) == 0) { int fr2 = fr, fq2 = fq; asm volatile("" : "+v"(fr2), "+v"(fq2)); E.khook(acc, hst, cur, ((t + 2) >> 3) - 1, wr, wc, fr2, fq2); } }
        }
        if (wr == 0) PG8_BAR;
        { int fr2 = fr, fq2 = fq; asm volatile("" : "+v"(fr2), "+v"(fq2)); if constexpr (KHOOK) E.fin(acc, hst, cur, wr, wc, fr2, fq2); else E(acc, cur, wr, wc, fr2, fq2); }
        S.done(cur);
        if (!has_next) break;
#pragma unroll
        for (int a = 0; a < 2; ++a)
#pragma unroll
            for (int b = 0; b < 2; ++b)
#pragma unroll
                for (int m = 0; m < 4; ++m)
#pragma unroll
                    for (int n = 0; n < 2; ++n) acc[a][b][m][n] = (f32x4){0.f, 0.f, 0.f, 0.f};
        cur = nxt; cB = nB; cAs = nAs; ++ui;
        if constexpr (Sched::GATHER) {
#pragma unroll
            for (int i = 0; i < 2; ++i) { vA0[i] = nA0[i]; vA1[i] = nA1[i]; } }
        if (wr == 1) PG8_BAR;
    }
    PG8_WAIT_V(0);
    PG8_BAR;
#undef PG8_RS
#undef PG8_CS
#undef PG8_SA
#undef PG8_SB
#undef PG8_STAGE
#undef PG8_LDA
#undef PG8_LDB
#undef PG8_MMA
#undef PG8_WAIT_V
#undef PG8_WAIT_L
#undef PG8_BAR
#undef PG8_SCHED
}
}

template <int UNR = 2> __device__ __forceinline__ void sgemm_k(f32x4 (&acc)[4][2][2], const bf16* (&pa)[4], const bf16* (&pb)[2][2], int K) {
#pragma unroll UNR
    for (int k = 0; k < K; k += 32) {
        bf16x8 af[4], bfr[2][2];
#pragma unroll
        for (int mi = 0; mi < 4; ++mi) af[mi] = *(const bf16x8*)(pa[mi] + k);
#pragma unroll
        for (int cp = 0; cp < 2; ++cp)
#pragma unroll
            for (int n = 0; n < 2; ++n) bfr[cp][n] = *(const bf16x8*)(pb[cp][n] + k);
#pragma unroll
        for (int mi = 0; mi < 4; ++mi)
#pragma unroll
            for (int cp = 0; cp < 2; ++cp)
#pragma unroll
                for (int n = 0; n < 2; ++n) acc[mi][cp][n] = MFMA16(bfr[cp][n], af[mi], acc[mi][cp][n]);
    }
}
#define ZERO_ACC(acc) do { _Pragma("unroll") for (int _a = 0; _a < 4; ++_a) _Pragma("unroll") for (int _b = 0; _b < 2; ++_b) _Pragma("unroll") for (int _c = 0; _c < 2; ++_c) acc[_a][_b][_c] = (f32x4){0.f, 0.f, 0.f, 0.f}; } while (0)

__device__ __forceinline__ void phase_proj(const Args& a, int l, int wave, int lane) {
    const bf16* H = (const bf16*)(a.ws + WS_H); const bf16* W = (const bf16*)(a.ws + WS_WCAT) + (size_t)l * 4096 * 2048; bf16* Z = (bf16*)(a.ws + WS_Z);
    const int fr = lane & 15, fq = lane >> 4, wr = wave >> 2, wc = wave & 3;
    for (int u = blockIdx.x; u < 132 * 48; u += gridDim.x) {
        const int pn = u % 48, pm = u / 48;
        if (l == 1 && pm >= 128 && pn >= 16) continue;
        const int r0 = 128 * pm + 64 * wr, c0 = 256 * pn + 64 * wc;
        const bf16* pa[4]; const bf16* pb[2][2];
#pragma unroll
        for (int mi = 0; mi < 4; ++mi) pa[mi] = H + (size_t)(r0 + 16 * mi + fr) * D + 8 * fq;
#pragma unroll
        for (int cp = 0; cp < 2; ++cp)
#pragma unroll
            for (int n = 0; n < 2; ++n) pb[cp][n] = W + (size_t)(c0 + 32 * cp + perm16(n, fr)) * D + 8 * fq;
        f32x4 acc[4][2][2]; ZERO_ACC(acc);
        sgemm_k(acc, pa, pb, D);
        const int act = (pn >= 5 && pn < 9) ? 1 : (pn >= 16 ? 2 : 0);
#pragma unroll
        for (int mi = 0; mi < 4; ++mi)
#pragma unroll
            for (int cp = 0; cp < 2; ++cp) { float o[8];
#pragma unroll
                for (int e = 0; e < 4; ++e) { o[e] = acc[mi][cp][0][e]; o[4 + e] = acc[mi][cp][1][e]; }
                if (act == 1) {
#pragma unroll
                    for (int e = 0; e < 8; ++e) o[e] = gelu_tanh(o[e]); }
                else if (act == 2) {
#pragma unroll
                    for (int e = 0; e < 8; ++e) o[e] = sigmoidf_(o[e]); }
                *(u32x4*)(Z + (size_t)(r0 + 16 * mi + fr) * ZS + c0 + 32 * cp + 8 * fq) = pack8(o); }
    }
}

__device__ __forceinline__ void phase_merge(const Args& a, int l, int wave, int lane) {
    const bf16* OB = (const bf16*)(a.ws + WS_O); const bf16* W = (const bf16*)(a.ws + WS_WB) + (size_t)l * 2048 * 2048; const bf16* Z = (const bf16*)(a.ws + WS_Z); bf16* ACC = (bf16*)(a.ws + WS_S);
    const int fr = lane & 15, fq = lane >> 4, wr = wave >> 2, wc = wave & 3;
    const int npm = (l == 0) ? 132 : 128;
    for (int u = blockIdx.x; u < npm * 8; u += gridDim.x) {
        const int pn = u & 7, pm = u >> 3;
        const int r0 = 128 * pm + 64 * wr, c0 = 256 * pn + 64 * wc;
        f32x4 tot[4][2][2]; ZERO_ACC(tot);
#pragma unroll 1
        for (int i = 0; i < 4; ++i) {
            const bf16* pa[4]; const bf16* pb[2][2];
#pragma unroll
            for (int mi = 0; mi < 4; ++mi) pa[mi] = OB + (size_t)(r0 + 16 * mi + fr) * D + 512 * i + 8 * fq;
#pragma unroll
            for (int cp = 0; cp < 2; ++cp)
#pragma unroll
                for (int n = 0; n < 2; ++n) pb[cp][n] = W + (size_t)(c0 + 32 * cp + perm16(n, fr)) * D + 512 * i + 8 * fq;
            f32x4 acc[4][2][2]; ZERO_ACC(acc);
            sgemm_k<1>(acc, pa, pb, 512);
#pragma unroll
            for (int mi = 0; mi < 4; ++mi)
#pragma unroll
                for (int cp = 0; cp < 2; ++cp) { float gt[8]; unpack8(*(const u32x4*)(Z + (size_t)(r0 + 16 * mi + fr) * ZS + ZGATE + 2048 * i + c0 + 32 * cp + 8 * fq), gt);
#pragma unroll
                    for (int e = 0; e < 4; ++e) { tot[mi][cp][0][e] += gt[e] * acc[mi][cp][0][e]; tot[mi][cp][1][e] += gt[4 + e] * acc[mi][cp][1][e]; } }
        }
#pragma unroll
        for (int mi = 0; mi < 4; ++mi)
#pragma unroll
            for (int cp = 0; cp < 2; ++cp) { float o[8];
#pragma unroll
                for (int e = 0; e < 4; ++e) { o[e] = tot[mi][cp][0][e]; o[4 + e] = tot[mi][cp][1][e]; }
                *(u32x4*)(ACC + (size_t)(r0 + 16 * mi + fr) * D + c0 + 32 * cp + 8 * fq) = pack8(o); }
    }
}

__device__ __forceinline__ void phase_outproj(const Args& a, int l, int wave, int lane) {
    const bf16* ACC = (const bf16*)(a.ws + WS_S); const bf16* W = (const bf16*)(a.ws + WS_WO) + (size_t)l * 2048 * 2048; float* X = (float*)(a.ws + WS_X);
    const float* MODl = (const float*)(a.ws + WS_MOD) + (size_t)l * 3 * 12288;
    const int fr = lane & 15, fq = lane >> 4, wr = wave >> 2, wc = wave & 3;
    const int npm = (l == 0) ? 132 : 128;
    for (int u = blockIdx.x; u < npm * 8; u += gridDim.x) {
        const int pn = u & 7, pm = u >> 3;
        const int r0 = 128 * pm + 64 * wr, c0 = 256 * pn + 64 * wc;
        const bf16* pa[4]; const bf16* pb[2][2];
#pragma unroll
        for (int mi = 0; mi < 4; ++mi) pa[mi] = ACC + (size_t)(r0 + 16 * mi + fr) * D + 8 * fq;
#pragma unroll
        for (int cp = 0; cp < 2; ++cp)
#pragma unroll
            for (int n = 0; n < 2; ++n) pb[cp][n] = W + (size_t)(c0 + 32 * cp + perm16(n, fr)) * D + 8 * fq;
        f32x4 acc[4][2][2]; ZERO_ACC(acc);
        sgemm_k(acc, pa, pb, D);
#pragma unroll
        for (int mi = 0; mi < 4; ++mi) { const int row = r0 + 16 * mi + fr; const int mr = row < ML ? (row >> 13) : 2;
#pragma unroll
            for (int cp = 0; cp < 2; ++cp) { const int col = c0 + 32 * cp + 8 * fq; const float* g1 = MODl + mr * 12288 + 2 * 2048 + col; float* xp = X + (size_t)row * D + col;
                const f32x4 ga = *(const f32x4*)g1, gb = *(const f32x4*)(g1 + 4); f32x4 xa = *(f32x4*)xp, xb = *(f32x4*)(xp + 4);
                xa += ga * acc[mi][cp][0]; xb += gb * acc[mi][cp][1]; *(f32x4*)xp = xa; *(f32x4*)(xp + 4) = xb; } }
    }
}

__device__ __forceinline__ void moe_table(const Args& a, int l, LAS int* tab, int tid) {
    __syncthreads();
    if (tid == 0) { const unsigned* cnt = (const unsigned*)(a.ws + WS_CTL) + CW_CNT + 64 * 16 * l; int acc = 0;
        for (int e = 0; e < 16; ++e) { const int c = (int)__hip_atomic_load(cnt + 64 * e, __ATOMIC_RELAXED, __HIP_MEMORY_SCOPE_AGENT); tab[e] = c; tab[16 + e] = acc; acc += (c + 255) >> 8; }
        tab[32] = acc; }
    __syncthreads();
}
__device__ __forceinline__ void phase_moe1(const Args& a, int l, LAS unsigned char* lds, int tid, int wave, int lane) {
    LAS int* tab = (LAS int*)lds; moe_table(a, l, tab, tid);
    const bf16* H = (const bf16*)(a.ws + WS_H); const bf16* Wl = (const bf16*)(a.ws + WS_WGU) + (size_t)l * 16 * 2048 * 2048; bf16* ACT = (bf16*)(a.ws + WS_ACT);
    const int* LIST = (const int*)(a.ws + WS_LIST);
    const int fr = lane & 15, fq = lane >> 4, wr = wave >> 2, wc = wave & 3;
    const int NTl = tab[32];
    for (int u = blockIdx.x; u < NTl * 16; u += gridDim.x) {
        const int j = u & 7, hh = (u >> 3) & 1, t = u >> 4;
        int e = 0;
#pragma unroll
        for (int q = 1; q < 16; ++q) if (t >= tab[16 + q]) e = q;
        const int cnt = tab[e], tbe = tab[16 + e], ri0 = 256 * (t - tbe) + 128 * hh + 64 * wr;
        const bf16* W = Wl + (size_t)e * 2048 * 2048;
        const bf16* pa[4]; const bf16* pb[2][2];
#pragma unroll
        for (int mi = 0; mi < 4; ++mi) { int ri = ri0 + 16 * mi + fr; ri = ri < cnt ? ri : cnt - 1; const int tok = LIST[e * CAP + ri] >> 1; pa[mi] = H + (size_t)tok * D + 8 * fq; }
#pragma unroll
        for (int cp = 0; cp < 2; ++cp)
#pragma unroll
            for (int n = 0; n < 2; ++n) pb[cp][n] = W + (size_t)(256 * j + 128 * cp + 32 * wc + perm16(n, fr)) * D + 8 * fq;
        f32x4 acc[4][2][2]; ZERO_ACC(acc);
        sgemm_k(acc, pa, pb, D);
#pragma unroll
        for (int mi = 0; mi < 4; ++mi) { float o[8];
#pragma unroll
            for (int e2 = 0; e2 < 4; ++e2) { const float g0 = acc[mi][0][0][e2], g1 = acc[mi][0][1][e2]; o[e2] = g0 * sigmoidf_(g0) * acc[mi][1][0][e2]; o[4 + e2] = g1 * sigmoidf_(g1) * acc[mi][1][1][e2]; }
            *(u32x4*)(ACT + (size_t)(tbe * 256 + ri0 + 16 * mi + fr) * 1024 + 128 * j + 32 * wc + 8 * fq) = pack8(o); }
    }
}
__device__ __forceinline__ void phase_moe2(const Args& a, int l, LAS unsigned char* lds, int tid, int wave, int lane) {
    LAS int* tab = (LAS int*)lds; moe_table(a, l, tab, tid);
    const bf16* ACT = (const bf16*)(a.ws + WS_ACT); const bf16* Wl = (const bf16*)(a.ws + WS_WD) + (size_t)l * 16 * 2048 * 1024; bf16* Y = (bf16*)(a.ws + WS_Y);
    const int* LIST = (const int*)(a.ws + WS_LIST); const float* LISTW = (const float*)(a.ws + WS_LISTW);
    const int fr = lane & 15, fq = lane >> 4, wr = wave >> 2, wc = wave & 3;
    const int NTl = tab[32];
    for (int u = blockIdx.x; u < NTl * 16; u += gridDim.x) {
        const int j = u & 7, hh = (u >> 3) & 1, t = u >> 4;
        int e = 0;
#pragma unroll
        for (int q = 1; q < 16; ++q) if (t >= tab[16 + q]) e = q;
        const int cnt = tab[e], tbe = tab[16 + e], ri0 = 256 * (t - tbe) + 128 * hh + 64 * wr;
        const bf16* W = Wl + (size_t)e * 2048 * 1024;
        const bf16* pa[4]; const bf16* pb[2][2];
#pragma unroll
        for (int mi = 0; mi < 4; ++mi) pa[mi] = ACT + (size_t)(tbe * 256 + ri0 + 16 * mi + fr) * 1024 + 8 * fq;
#pragma unroll
        for (int cp = 0; cp < 2; ++cp)
#pragma unroll
            for (int n = 0; n < 2; ++n) pb[cp][n] = W + (size_t)(256 * j + 64 * wc + 32 * cp + perm16(n, fr)) * 1024 + 8 * fq;
        f32x4 acc[4][2][2]; ZERO_ACC(acc);
        sgemm_k(acc, pa, pb, 1024);
#pragma unroll
        for (int mi = 0; mi < 4; ++mi) { const int ri = ri0 + 16 * mi + fr;
            if (ri < cnt) { const int tk = LIST[e * CAP + ri]; const float w = LISTW[e * CAP + ri];
#pragma unroll
                for (int cp = 0; cp < 2; ++cp) { float o[8];
#pragma unroll
                    for (int e2 = 0; e2 < 4; ++e2) { o[e2] = w * acc[mi][cp][0][e2]; o[4 + e2] = w * acc[mi][cp][1][e2]; }
                    *(u32x4*)(Y + (size_t)tk * D + 256 * j + 64 * wc + 32 * cp + 8 * fq) = pack8(o); } } }
    }
}


template <class Pre, class Epi>
__device__ __forceinline__ void sk_gemm_ctx(LAS unsigned char* lds, const bf16* A, int lda, const bf16* Bt, int ldb, int K, int N, const Pre& pre, const Epi& epi, int tid, int wave, int lane) {
    const int fr = lane & 15, fq = lane >> 4, ntn = N / 64, ks = K / 8;
    LAS float* P = (LAS float*)lds;
    for (int task = blockIdx.x; task < 8 * ntn; task += gridDim.x) {
        const int tm = task / ntn, tn = task % ntn, r0 = ML + 64 * tm, c0 = 64 * tn;
        const bf16* pa[4]; const bf16* pb[2][2];
#pragma unroll
        for (int mi = 0; mi < 4; ++mi) pa[mi] = A + (size_t)(r0 + 16 * mi + fr) * lda + wave * ks + 8 * fq;
#pragma unroll
        for (int cp = 0; cp < 2; ++cp)
#pragma unroll
            for (int n = 0; n < 2; ++n) pb[cp][n] = Bt + (size_t)(c0 + 32 * cp + perm16(n, fr)) * ldb + wave * ks + 8 * fq;
        f32x4 acc[4][2][2]; ZERO_ACC(acc);
        sgemm_k<4>(acc, pa, pb, ks);
        pre(acc, wave, r0, c0, fr, fq);
        __syncthreads();
#pragma unroll
        for (int mi = 0; mi < 4; ++mi)
#pragma unroll
            for (int cp = 0; cp < 2; ++cp)
#pragma unroll
                for (int n = 0; n < 2; ++n) *(LAS f32x4*)(P + wave * 4096 + (16 * mi + fr) * 64 + 32 * cp + 8 * fq + 4 * n) = acc[mi][cp][n];
        __syncthreads();
        { const int row = tid >> 3, c8 = (tid & 7) * 8; f32x4 s0 = {0.f, 0.f, 0.f, 0.f}, s1 = s0;
#pragma unroll
            for (int w = 0; w < 8; ++w) { s0 += *(const LAS f32x4*)(P + w * 4096 + row * 64 + c8); s1 += *(const LAS f32x4*)(P + w * 4096 + row * 64 + c8 + 4); }
            float v[8] = {s0[0], s0[1], s0[2], s0[3], s1[0], s1[1], s1[2], s1[3]};
            epi(r0 + row, c0 + c8, v); }
    }
    __syncthreads();
}
struct SkNoPre { __device__ __forceinline__ void operator()(f32x4 (&)[4][2][2], int, int, int, int, int) const {} };
struct SkPreMerge { const bf16* Z;
    __device__ __forceinline__ void operator()(f32x4 (&acc)[4][2][2], int w, int r0, int c0, int fr, int fq) const {
#pragma unroll
        for (int mi = 0; mi < 4; ++mi)
#pragma unroll
            for (int cp = 0; cp < 2; ++cp) { const int row = r0 + 16 * mi + fr, col = c0 + 32 * cp + 8 * fq, rr = row & 255, cc = col & 255;
                const u32x2 g8 = *(const u32x2*)((const unsigned char*)Z + g8_off(w >> 1, row >> 8, col >> 8, ((rr >> 6) & 1) * 4 + ((cc >> 5) & 3), rr >> 7, (rr >> 4) & 3, cc >> 7, ((cc >> 3) & 3) * 16 + (rr & 15)));
#pragma unroll
                for (int e = 0; e < 4; ++e) { acc[mi][cp][0][e] *= (float)((g8.x >> (8 * e)) & 255u) * (1.f / 255.f); acc[mi][cp][1][e] *= (float)((g8.y >> (8 * e)) & 255u) * (1.f / 255.f); } }
    }
};
struct SkEpiProj { bf16* Z;
    __device__ __forceinline__ void operator()(int row, int col, float (&v)[8]) const { const int pn = col >> 8;
        if (pn >= 5 && pn < 9) {
#pragma unroll
            for (int e = 0; e < 8; ++e) v[e] = gelu_tanh(v[e]); }
        *(u32x4*)(Z + (size_t)row * ZS + col) = pack8(v); }
};
struct SkEpiAcc { bf16* ACC; int ld; __device__ __forceinline__ void operator()(int row, int col, float (&v)[8]) const { *(u32x4*)(ACC + (size_t)row * ld + col) = pack8(v); } };
struct SkEpiOut { float* X; const float* g1;
    __device__ __forceinline__ void operator()(int row, int col, float (&v)[8]) const { float* xp = X + (size_t)row * D + col; const f32x4 ga = *(const f32x4*)(g1 + col), gb = *(const f32x4*)(g1 + col + 4);
        f32x4 xa = *(f32x4*)xp, xb = *(f32x4*)(xp + 4); xa += ga * (f32x4){v[0], v[1], v[2], v[3]}; xb += gb * (f32x4){v[4], v[5], v[6], v[7]}; *(f32x4*)xp = xa; *(f32x4*)(xp + 4) = xb; }
};

struct DenseOrder {            static constexpr bool GATHER = false;
    int nM, nN, exN, exCnt, exM0, G, c, lda2, K2; const char* Bt; int exPn0 = 0;
    __device__ __forceinline__ bool next(int i, pg8::Unit& u) const {
        const int L = i * G + c, nmain = nM * nN;
        if (L < nmain) { pg8::static_tile(L, nM, nN, u.pm, u.pn); }
        else { const int idx = L - nmain; if (idx >= exCnt) return false; u.pm = exM0 + idx / exN; u.pn = exPn0 + idx % exN; }
        u.e = 0; u.cnt = 256; return true;
    }
    __device__ __forceinline__ unsigned arow_off(const pg8::Unit& u, int r) const { return (unsigned)(u.pm * 256 + r) * (unsigned)lda2; }
    __device__ __forceinline__ void a_ready(const pg8::Unit&) const {}
    __device__ __forceinline__ void done(const pg8::Unit&) const {}
    __device__ __forceinline__ unsigned lda_bytes() const { return (unsigned)lda2; }
    __device__ __forceinline__ unsigned ldb_bytes() const { return (unsigned)K2; }
    __device__ __forceinline__ unsigned aoff(const pg8::Unit& u) const { return (unsigned)u.pm * 256u * (unsigned)lda2; }
    __device__ __forceinline__ const char* wbase() const { return Bt; }
    __device__ __forceinline__ unsigned boff(const pg8::Unit& u) const { return (unsigned)u.pn * 256u * (unsigned)K2; }
};
struct MoeOrder {              static constexpr bool GATHER = true;
    const LAS int* tab; int G, c, K2, gather; const int* LIST; const char* W; size_t wstride;
    int i0, base; unsigned* tcnt; unsigned* tmo;
    __device__ __forceinline__ void a_ready(const pg8::Unit& u) const {
        if (gather) return;
        if (threadIdx.x < 64) { unsigned spins = 0u;
            while ((unsigned)__builtin_amdgcn_readfirstlane(__hip_atomic_load(tcnt + 64 * u.pm, __ATOMIC_RELAXED, __HIP_MEMORY_SCOPE_AGENT)) < 64u) {
                __builtin_amdgcn_s_sleep(2);
                if ((++spins & 255u) == 0u) { if (__hip_atomic_load(tmo, __ATOMIC_RELAXED, __HIP_MEMORY_SCOPE_AGENT) != 0u) break; if (spins > (1u << 20)) { if (threadIdx.x == 0) __hip_atomic_store(tmo, 1u, __ATOMIC_RELAXED, __HIP_MEMORY_SCOPE_AGENT); break; } } }
            __builtin_amdgcn_fence(__ATOMIC_ACQUIRE, "agent");
            asm volatile("s_waitcnt vmcnt(0)" ::: "memory"); }
        asm volatile("" ::: "memory"); __builtin_amdgcn_s_barrier(); asm volatile("" ::: "memory");
    }
    __device__ __forceinline__ void done(const pg8::Unit& u) const {
        if (!gather) return;
        asm volatile("s_waitcnt vmcnt(0)" ::: "memory");
        if ((threadIdx.x & 63) == 0) __hip_atomic_fetch_add(tcnt + 64 * u.pm, 1u, __ATOMIC_RELAXED, __HIP_MEMORY_SCOPE_AGENT);
    }
    __device__ __forceinline__ bool next(int i, pg8::Unit& u) const {
        const int L = (i + i0) * G + c - base; if (L >= tab[32] * 8) return false;
        const int t = L >> 3; int e = 0;
#pragma unroll
        for (int q = 1; q < 16; ++q) if (t >= tab[16 + q]) e = q;
        u.pm = t; u.pn = L & 7; u.e = e; u.cnt = tab[e] - 256 * (t - tab[16 + e]);
        return true;
    }
    __device__ __forceinline__ unsigned arow_off(const pg8::Unit& u, int r) const {
        if (gather) { const int t0 = tab[16 + u.e]; int ri = 256 * (u.pm - t0) + r; const int last = tab[u.e] - 1; ri = ri < last ? ri : last; const int tok = LIST[u.e * CAP + ri] >> 1; return (unsigned)tok * 2048u; }
        return (unsigned)(u.pm * 256 + r) * 2048u;
    }
    __device__ __forceinline__ unsigned lda_bytes() const { return 0u; }
    __device__ __forceinline__ unsigned ldb_bytes() const { return (unsigned)K2; }
    __device__ __forceinline__ unsigned aoff(const pg8::Unit&) const { return 0u; }
    __device__ __forceinline__ const char* wbase() const { return W; }
    __device__ __forceinline__ unsigned boff(const pg8::Unit& u) const { return (unsigned)u.e * (unsigned)wstride + (unsigned)u.pn * 256u * (unsigned)K2; }
};
template <bool I8> struct EpiProjT { static constexpr bool PERM = true; bf16* Z; unsigned char* G8; int pn_off; float scale; const float* RS = nullptr; float scale_g = 0.f;
    __device__ __forceinline__ void operator()(const f32x4 (&acc)[2][2][4][2], const pg8::Unit& u0, int wr, int wc, int fr, int fq) const {
        pg8::Unit u = u0; u.pn += pn_off;
        const int act = (u.pn >= 5 && u.pn < 9) ? 1 : (u.pn >= 16 ? 2 : 0);
#pragma unroll
        for (int ai = 0; ai < 2; ++ai)
#pragma unroll
            for (int m = 0; m < 4; ++m) { bf16* rowp = Z + (size_t)(u.pm * 256 + ai * 128 + wr * 64 + m * 16 + fr) * ZS + u.pn * 256 + wc * 32 + 8 * fq;
#pragma unroll
                for (int bj = 0; bj < 2; ++bj) { f32x4 v0, v1;
                    if constexpr (I8) { const float sr = RS[u.pm * 256 + ai * 128 + wr * 64 + m * 16 + fr] * (act == 2 ? scale_g : scale); const i32x4q i0 = __builtin_bit_cast(i32x4q, acc[ai][bj][m][0]), i1 = __builtin_bit_cast(i32x4q, acc[ai][bj][m][1]);
#pragma unroll
                        for (int e = 0; e < 4; ++e) { v0[e] = (float)i0[e] * sr; v1[e] = (float)i1[e] * sr; } }
                    else { v0 = acc[ai][bj][m][0] * scale; v1 = acc[ai][bj][m][1] * scale; }
                    if (act == 1) {
#pragma unroll
                        for (int e = 0; e < 4; ++e) { v0[e] = gelu_tanh(v0[e]); v1[e] = gelu_tanh(v1[e]); } }
                    else if (act == 2) {
                        unsigned q[8];
#pragma unroll
                        for (int e = 0; e < 4; ++e) { q[e] = (unsigned)fmaxf(__builtin_rintf(255.f * sigmoidf_(v0[e])), 1.f); q[4 + e] = (unsigned)fmaxf(__builtin_rintf(255.f * sigmoidf_(v1[e])), 1.f); }
                        u32x2 w8; w8.x = q[0] | (q[1] << 8) | (q[2] << 16) | (q[3] << 24); w8.y = q[4] | (q[5] << 8) | (q[6] << 16) | (q[7] << 24);
                        *(u32x2*)(G8 + g8_off((u.pn - 16) >> 3, u.pm, (u.pn - 16) & 7, wr * 4 + wc, ai, m, bj, fq * 16 + fr)) = w8;
                        continue; }
                    u32x4 w; w.x = pg8::cvt_pk_bf16(v0[0], v0[1]); w.y = pg8::cvt_pk_bf16(v0[2], v0[3]); w.z = pg8::cvt_pk_bf16(v1[0], v1[1]); w.w = pg8::cvt_pk_bf16(v1[2], v1[3]);
                    *(u32x4*)(rowp + bj * 128) = w; } }
    }
};
typedef EpiProjT<false> EpiProj;
struct EpiMerge { static constexpr bool PERM = true; const bf16* Z; bf16* ACC;
    struct State { u32x2 g[2][4][2]; };
    __device__ __forceinline__ const unsigned char* gptr(const pg8::Unit& u, int i, int ai, int m, int bj, int wr, int wc, int fr, int fq) const {
        return (const unsigned char*)Z + g8_off(i, u.pm, u.pn, wr * 4 + wc, ai, m, bj, fq * 16 + fr); }
    __device__ __forceinline__ void khook(f32x4 (&acc)[2][2][4][2], State& st, const pg8::Unit& u, int i, int wr, int wc, int fr, int fq) const {
#pragma unroll
        for (int ai = 0; ai < 2; ++ai)
#pragma unroll
            for (int m = 0; m < 4; ++m) {
#pragma unroll
                for (int bj = 0; bj < 2; ++bj) { const u32x2 gn = *(const u32x2*)gptr(u, i + 1, ai, m, bj, wr, wc, fr, fq); const u32x2 gc = (i == 0) ? *(const u32x2*)gptr(u, 0, ai, m, bj, wr, wc, fr, fq) : st.g[ai][m][bj];
#pragma unroll
                    for (int e = 0; e < 4; ++e) { acc[ai][bj][m][0][e] *= (float)((gc.x >> (8 * e)) & 255u) * __builtin_amdgcn_rcpf((float)((gn.x >> (8 * e)) & 255u));
                                                  acc[ai][bj][m][1][e] *= (float)((gc.y >> (8 * e)) & 255u) * __builtin_amdgcn_rcpf((float)((gn.y >> (8 * e)) & 255u)); }
                    st.g[ai][m][bj] = gn; } }
    }
    __device__ __forceinline__ void fin(const f32x4 (&acc)[2][2][4][2], const State& st, const pg8::Unit& u, int wr, int wc, int fr, int fq) const {
#pragma unroll
        for (int ai = 0; ai < 2; ++ai)
#pragma unroll
            for (int m = 0; m < 4; ++m) { const size_t row = (size_t)(u.pm * 256 + ai * 128 + wr * 64 + m * 16 + fr); const int col = u.pn * 256 + wc * 32 + 8 * fq;
#pragma unroll
                for (int bj = 0; bj < 2; ++bj) { const u32x2 g3 = st.g[ai][m][bj]; float g[8];
#pragma unroll
                    for (int e = 0; e < 4; ++e) { g[e] = (float)((g3.x >> (8 * e)) & 255u) * (1.f / 255.f); g[4 + e] = (float)((g3.y >> (8 * e)) & 255u) * (1.f / 255.f); }
                    const f32x4 v0 = acc[ai][bj][m][0], v1 = acc[ai][bj][m][1];
                    u32x4 w; w.x = pg8::cvt_pk_bf16(v0[0] * g[0], v0[1] * g[1]); w.y = pg8::cvt_pk_bf16(v0[2] * g[2], v0[3] * g[3]); w.z = pg8::cvt_pk_bf16(v1[0] * g[4], v1[1] * g[5]); w.w = pg8::cvt_pk_bf16(v1[2] * g[6], v1[3] * g[7]);
                    (void)w;
                    u32x2 w8; unsigned p8 = 0u; p8 = __builtin_amdgcn_cvt_pk_fp8_f32(v0[0] * g[0], v0[1] * g[1], p8, false); p8 = __builtin_amdgcn_cvt_pk_fp8_f32(v0[2] * g[2], v0[3] * g[3], p8, true); w8.x = p8;
                    p8 = 0u; p8 = __builtin_amdgcn_cvt_pk_fp8_f32(v1[0] * g[4], v1[1] * g[5], p8, false); p8 = __builtin_amdgcn_cvt_pk_fp8_f32(v1[2] * g[6], v1[3] * g[7], p8, true); w8.y = p8;
                    *(u32x2*)((unsigned char*)ACC + row * 2048 + col + bj * 128) = w8; } }
    }
};
struct EpiOut { static constexpr bool PERM = true; bf16* MX; int nop; float scale;
    __device__ __forceinline__ void operator()(const f32x4 (&acc)[2][2][4][2], const pg8::Unit& u, int wr, int wc, int fr, int fq) const {
        if (nop && acc[0][0][0][0][0] != 1.2345e30f) return;
#pragma unroll
        for (int ai = 0; ai < 2; ++ai)
#pragma unroll
            for (int m = 0; m < 4; ++m) { bf16* rowp = MX + (size_t)(u.pm * 256 + ai * 128 + wr * 64 + m * 16 + fr) * D + u.pn * 256 + wc * 32 + 8 * fq;
#pragma unroll
                for (int bj = 0; bj < 2; ++bj) { const f32x4 v0 = acc[ai][bj][m][0] * scale, v1 = acc[ai][bj][m][1] * scale;
                    u32x4 w; w.x = pg8::cvt_pk_bf16(v0[0], v0[1]); w.y = pg8::cvt_pk_bf16(v0[2], v0[3]); w.z = pg8::cvt_pk_bf16(v1[0], v1[1]); w.w = pg8::cvt_pk_bf16(v1[2], v1[3]);
                    *(u32x4*)(rowp + bj * 128) = w; } }
    }
};
struct EpiMoe1 { static constexpr bool PERM = true; bf16* ACT; __amdgpu_buffer_rsrc_t rs; const float* RS; const int* LIST; const LAS int* tab; const unsigned* wm;
    __device__ __forceinline__ void operator()(const f32x4 (&acc)[2][2][4][2], const pg8::Unit& u, int wr, int wc, int fr, int fq) const {
#pragma unroll
        for (int ai = 0; ai < 2; ++ai)
#pragma unroll
            for (int m = 0; m < 4; ++m) { int ri = 256 * (u.pm - tab[16 + u.e]) + ai * 128 + wr * 64 + m * 16 + fr; const int lastr = tab[u.e] - 1; ri = ri < lastr ? ri : lastr;
                const float rsv = RS[LIST[u.e * CAP + ri] >> 1], sg = rsv * (__uint_as_float(wm[4 + u.e]) * (EXPERT_MARGIN / 127.f)), su = rsv * (__uint_as_float(wm[36 + u.e]) * (EXPERT_MARGIN / 127.f));
                const i32x4q ig0 = __builtin_bit_cast(i32x4q, acc[ai][0][m][0]), ig1 = __builtin_bit_cast(i32x4q, acc[ai][0][m][1]), iu0 = __builtin_bit_cast(i32x4q, acc[ai][1][m][0]), iu1 = __builtin_bit_cast(i32x4q, acc[ai][1][m][1]); float o[8];
#pragma unroll
                for (int e = 0; e < 4; ++e) { const float ga = (float)ig0[e] * sg, gb = (float)ig1[e] * sg; o[e] = ga * sigmoidf_(ga) * ((float)iu0[e] * su); o[4 + e] = gb * sigmoidf_(gb) * ((float)iu1[e] * su); }
                u32x4 w; w.x = pg8::cvt_pk_bf16(o[0], o[1]); w.y = pg8::cvt_pk_bf16(o[2], o[3]); w.z = pg8::cvt_pk_bf16(o[4], o[5]); w.w = pg8::cvt_pk_bf16(o[6], o[7]);
                __builtin_amdgcn_raw_buffer_store_b128(w, rs, (int)(((unsigned)(u.pm * 256 + ai * 128 + wr * 64 + m * 16 + fr) * 1024u + (unsigned)(u.pn * 128 + wc * 32 + 8 * fq)) * 2u), 0, 16); }
    }
};
struct EpiMoe2 { static constexpr bool PERM = true; bf16* Y; const int* LIST; const float* LISTW; const LAS int* tab;
    __device__ __forceinline__ void operator()(const f32x4 (&acc)[2][2][4][2], const pg8::Unit& u, int wr, int wc, int fr, int fq) const {
        const int ri0 = 256 * (u.pm - tab[16 + u.e]);
#pragma unroll
        for (int ai = 0; ai < 2; ++ai)
#pragma unroll
            for (int m = 0; m < 4; ++m) { const int rt = ai * 128 + wr * 64 + m * 16 + fr;
                if (rt < u.cnt) { const int tk = LIST[u.e * CAP + ri0 + rt]; const float wv = LISTW[u.e * CAP + ri0 + rt]; bf16* rowp = Y + (size_t)tk * D + u.pn * 256 + wc * 32 + 8 * fq;
#pragma unroll
                    for (int bj = 0; bj < 2; ++bj) { const f32x4 v0 = acc[ai][bj][m][0] * wv, v1 = acc[ai][bj][m][1] * wv;
                        u32x4 w; w.x = pg8::cvt_pk_bf16(v0[0], v0[1]); w.y = pg8::cvt_pk_bf16(v0[2], v0[3]); w.z = pg8::cvt_pk_bf16(v1[0], v1[1]); w.w = pg8::cvt_pk_bf16(v1[2], v1[3]);
                        *(u32x4*)(rowp + bj * 128) = w; } }
                __builtin_amdgcn_sched_barrier(0); }
    }
};
__device__ __forceinline__ void phase_proj2(const Args& a, int l, LAS unsigned char* lds) {
#if FP8Z
    const unsigned* wm = (const unsigned*)(a.ws + WS_CTL) + CW_WMAX;
    {
        const char* W = (const char*)(a.ws + WS_WCAT8) + (size_t)l * 12288 * 2048;
        DenseOrder S{64, 16, 16, 0, 64, (int)gridDim.x, (int)blockIdx.x, 2048, 2048, W};
        EpiProjT<true> E{(bf16*)(a.ws + WS_Z), (unsigned char*)(a.ws + WS_G8), 0, __uint_as_float(wm[l]) * (1.f / 127.f), (const float*)(a.ws + WS_RS), 0.f};
        pg8::gemm256<EpiProjT<true>, DenseOrder, false, 2>(lds, (const char*)(a.ws + WS_H8I), 2048, S, E);
        const char* Wz = (const char*)(a.ws + WS_WCAT) + (size_t)l * 4096 * 2048 * 2;
        sk_gemm_ctx(lds, (const bf16*)(a.ws + WS_H), 2048, (const bf16*)Wz, 2048, 2048, 4096, SkNoPre{}, SkEpiProj{(bf16*)(a.ws + WS_Z)}, (int)threadIdx.x, (int)(threadIdx.x >> 6), (int)(threadIdx.x & 63));
    }
    {
        const char* W = (const char*)(a.ws + WS_WCAT8) + ((size_t)l * 12288 + 4096) * 2048;
        DenseOrder S{64, 32, 32, l == 0 ? 64 : 0, 64, (int)gridDim.x, (int)blockIdx.x, 2048, 2048, W};
        EpiProj E{(bf16*)(a.ws + WS_Z), (unsigned char*)(a.ws + WS_G8), 16, __uint_as_float(wm[2 + l]) * (1.f / 128.f)};
        pg8::gemm256<EpiProj, DenseOrder, false, 1>(lds, (const char*)(a.ws + WS_H8), 2048, S, E);
    }
#if FP8Z == 2
    {
        const char* W = (const char*)(a.ws + WS_WCAT) + ((size_t)l * 4096 + 9 * 256) * 2048 * 2;
        DenseOrder S{64, 7, 7, 0, 64, (int)gridDim.x, (int)blockIdx.x, 4096, 4096, W};
        EpiProj E{(bf16*)(a.ws + WS_Z), (unsigned char*)(a.ws + WS_G8), 9, 1.f};
        pg8::gemm256<EpiProj, DenseOrder, false, 0>(lds, (const char*)(a.ws + WS_H), 4096, S, E);
    }
#elif FP8Z == 3
    {
        const char* W = (const char*)(a.ws + WS_WCAT) + ((size_t)l * 4096) * 2048 * 2;
        DenseOrder S{64, 9, 9, 0, 64, (int)gridDim.x, (int)blockIdx.x, 4096, 4096, W};
        EpiProj E{(bf16*)(a.ws + WS_Z), (unsigned char*)(a.ws + WS_G8), 0, 1.f};
        pg8::gemm256<EpiProj, DenseOrder, false, 0>(lds, (const char*)(a.ws + WS_H), 4096, S, E);
    }
#endif
#else
    {
        const char* W = (const char*)(a.ws + WS_WCAT) + (size_t)l * 4096 * 2048 * 2;
        DenseOrder S{64, 16, 16, 0, 64, (int)gridDim.x, (int)blockIdx.x, 4096, 4096, W};
        EpiProj E{(bf16*)(a.ws + WS_Z), (unsigned char*)(a.ws + WS_G8), 0, 1.f};
        pg8::gemm256<EpiProj, DenseOrder, false, 0>(lds, (const char*)(a.ws + WS_H), 4096, S, E);
        sk_gemm_ctx(lds, (const bf16*)(a.ws + WS_H), 2048, (const bf16*)W, 2048, 2048, 4096, SkNoPre{}, SkEpiProj{(bf16*)(a.ws + WS_Z)}, (int)threadIdx.x, (int)(threadIdx.x >> 6), (int)(threadIdx.x & 63));
    }
    {
        const char* W = (const char*)(a.ws + WS_WCAT8) + ((size_t)l * 12288 + 4096) * 2048;
        DenseOrder S{64, 32, 32, l == 0 ? 64 : 0, 64, (int)gridDim.x, (int)blockIdx.x, 2048, 2048, W};
        EpiProj E{(bf16*)(a.ws + WS_Z), (unsigned char*)(a.ws + WS_G8), 16, 1.f / W8SCALE};
        pg8::gemm256<EpiProj, DenseOrder, false, 1>(lds, (const char*)(a.ws + WS_H8), 2048, S, E);
    }
#endif
}
__device__ __forceinline__ void phase_merge2(const Args& a, int l, LAS unsigned char* lds) {
    const char* W = (const char*)(a.ws + WS_WB) + (size_t)l * 2048 * 2048 * 2;
    DenseOrder S{64, 8, 8, 0, 64, (int)gridDim.x, (int)blockIdx.x, 4096, 4096, W};
    EpiMerge E{(const bf16*)(a.ws + WS_G8), (bf16*)(a.ws + WS_ACC8)};
    pg8::gemm256<EpiMerge, DenseOrder, true>(lds, (const char*)(a.ws + WS_O), 4096, S, E);
    if (l == 0) sk_gemm_ctx(lds, (const bf16*)(a.ws + WS_O), 2048, (const bf16*)W, 2048, 2048, 2048, SkPreMerge{(const bf16*)(a.ws + WS_G8)}, SkEpiAcc{(bf16*)(a.ws + WS_ACC), DP}, (int)threadIdx.x, (int)(threadIdx.x >> 6), (int)(threadIdx.x & 63));
}
__device__ __forceinline__ void phase_outproj2(const Args& a, int l, LAS unsigned char* lds, int nop = 0) {
    const char* W = (const char*)(a.ws + WS_WO) + (size_t)l * 2048 * DP * 2;
    const char* W8 = (const char*)(a.ws + WS_WO8) + (size_t)l * 2048 * 2048;
    DenseOrder S{64, 8, 8, 0, 64, (int)gridDim.x, (int)blockIdx.x, 2048, 2048, W8};
    EpiOut E{(bf16*)(a.ws + WS_MX), nop, __uint_as_float(((const unsigned*)(a.ws + WS_CTL))[CW_WMAX + 68 + l]) * (1.f / 128.f)};
    pg8::gemm256<EpiOut, DenseOrder, false, 1>(lds, (const char*)(a.ws + WS_ACC8), 2048, S, E);
    if (l == 0 && !nop) sk_gemm_ctx(lds, (const bf16*)(a.ws + WS_ACC), DP, (const bf16*)W, DP, 2048, 2048, SkNoPre{}, SkEpiAcc{(bf16*)(a.ws + WS_MX), D}, (int)threadIdx.x, (int)(threadIdx.x >> 6), (int)(threadIdx.x & 63));
}
constexpr int CW_T2 = 16384;
__device__ __forceinline__ void phase_moe12(const Args& a, int l, LAS unsigned char* lds, int tid) {
    LAS int* tab = (LAS int*)(lds + pg8::STAGE_BYTES); moe_table(a, l, tab, tid);
    unsigned* tcnt = (unsigned*)(a.ws + WS_CTL) + CW_T2 + 64 * 160 * l; unsigned* tmo = (unsigned*)(a.ws + WS_CTL) + 8;
    const int G = (int)gridDim.x, c = (int)blockIdx.x, N1 = tab[32] * 8;
    {
        MoeOrder S{tab, G, c, 2048, 1, (const int*)(a.ws + WS_LIST), (const char*)(a.ws + WS_WGU) + (size_t)l * 16 * 2048 * 2048, (size_t)2048 * 2048, 0, 0, tcnt, tmo};
        EpiMoe1 E{(bf16*)(a.ws + WS_ACT), __builtin_amdgcn_make_buffer_rsrc((void*)(a.ws + WS_ACT), 0, 0x7fffffff, 0x00020000), (const float*)(a.ws + WS_RS), (const int*)(a.ws + WS_LIST), tab, (const unsigned*)(a.ws + WS_CTL) + CW_WMAX + 16 * l};
        pg8::gemm256<EpiMoe1, MoeOrder, false, 2>(lds, (const char*)(a.ws + WS_H8I), 2048, S, E);
    }
    {
        const int i0 = N1 > c ? (N1 - c + G - 1) / G : 0;
        MoeOrder S{tab, G, c, 2048, 0, (const int*)(a.ws + WS_LIST), (const char*)(a.ws + WS_WD) + (size_t)l * 16 * 2048 * 1024 * 2, (size_t)2048 * 1024 * 2, i0, N1, tcnt, tmo};
        EpiMoe2 E{(bf16*)(a.ws + WS_Y), (const int*)(a.ws + WS_LIST), (const float*)(a.ws + WS_LISTW), tab};
        pg8::gemm256<EpiMoe2, MoeOrder, false>(lds, (const char*)(a.ws + WS_ACT), 2048, S, E);
    }
}

__device__ __forceinline__ void attn_unit(const Args& a, int l, int u, LAS unsigned char* lds, int tid, int wave, int lane) {
    const bf16* Z = (const bf16*)(a.ws + WS_Z); bf16* OB = (bf16*)(a.ws + WS_O);
    const float* ROPEC = (const float*)(a.ws + WS_ROPE); const float* ROPES = ROPEC + 2048;
    LAS bf16* Ks = (LAS bf16*)lds;
    LAS bf16* VT = (LAS bf16*)(lds + 128 * 72 * 2);
    const int fr = lane & 15, fq = lane >> 4;
    {
        int b, kvh, nb; const bool isctx = u >= 256;
        if (!isctx) { b = u >> 7; kvh = (u >> 6) & 1; nb = u & 63; } else { const int v = u - 256; b = v >> 2; kvh = (v >> 1) & 1; nb = v & 1; }
        const int h = kvh * 4 + (wave >> 1), qs = (wave & 1) * 64;
        bf16x8 Qf[4][2];
#pragma unroll
        for (int qb = 0; qb < 4; ++qb) { const int tq = nb * 128 + qs + 16 * qb + fr; const size_t row = isctx ? (size_t)ML + b * 256 + tq : (size_t)b * SEQ + tq;
            const bf16* qp = Z + row * ZS + ZQ + h * 64;
#pragma unroll
            for (int ks = 0; ks < 2; ++ks) { float o[8]; unpack8(*(const u32x4*)(qp + 32 * ks + 8 * fq), o);
                if (!isctx) { float p[8]; unpack8(*(const u32x4*)(qp + 32 * ks + 8 * (fq ^ 2)), p); const int pos = ks == 0 ? (tq >> 6) : (tq & 63);
                    const float* cs = ROPEC + pos * 16 + 8 * (fq & 1); const float* sn = ROPES + pos * 16 + 8 * (fq & 1);
#pragma unroll
                    for (int e = 0; e < 8; ++e) o[e] = fq < 2 ? o[e] * cs[e] - p[e] * sn[e] : o[e] * cs[e] + p[e] * sn[e]; }
#pragma unroll
                for (int e = 0; e < 8; ++e) o[e] *= 0.125f * LOG2E;
                Qf[qb][ks] = __builtin_bit_cast(bf16x8, pack8(o)); } }
        float m[4], lsum[4]; f32x4 O[4][4];
        const float sinkv = a.in[10][l * 8 + h] * LOG2E;
#pragma unroll
        for (int qb = 0; qb < 4; ++qb) { m[qb] = sinkv; lsum[qb] = fq == 0 ? 1.f : 0.f;
#pragma unroll
            for (int db = 0; db < 4; ++db) O[qb][db] = (f32x4){0.f, 0.f, 0.f, 0.f}; }
        const int ntile = isctx ? 2 : 5;
#pragma unroll 1
        for (int kt = 0; kt < ntile; ++kt) {
            const bool isband = (!isctx && kt < 3);
            const int kblk = nb - 1 + kt;
            if (isband && (kblk < 0 || kblk > 63)) continue;
            const size_t krow0 = isband ? (size_t)b * SEQ + kblk * 128 : (size_t)ML + b * 256 + (isctx ? kt : kt - 3) * 128;
            __syncthreads();
            { const int key = tid >> 2, part = tid & 3, ks = part >> 1, sub = part & 1;
                const bf16* kp = Z + (krow0 + key) * ZS + ZK + kvh * 64 + 32 * ks + 8 * sub;
                float fa[8], fb[8]; unpack8(*(const u32x4*)kp, fa); unpack8(*(const u32x4*)(kp + 16), fb);
                if (isband) { const int tk = kblk * 128 + key; const int pos = ks == 0 ? (tk >> 6) : (tk & 63); const float* cs = ROPEC + pos * 16 + 8 * sub; const float* sn = ROPES + pos * 16 + 8 * sub;
#pragma unroll
                    for (int e = 0; e < 8; ++e) { const float x1 = fa[e], x2 = fb[e]; fa[e] = x1 * cs[e] - x2 * sn[e]; fb[e] = x2 * cs[e] + x1 * sn[e]; } }
                *(LAS u32x4*)(Ks + key * 72 + 32 * ks + 8 * sub) = pack8(fa); *(LAS u32x4*)(Ks + key * 72 + 32 * ks + 16 + 8 * sub) = pack8(fb);
                const bf16* vp = Z + (krow0 + key) * ZS + ZV + kvh * 64 + 16 * part;
                const u32x4 v0 = *(const u32x4*)vp, v1 = *(const u32x4*)(vp + 8);
                LAS bf16* vt = VT + (16 * part) * 136 + key;
                vt[0 * 136] = (bf16)(v0.x & 0xffffu); vt[1 * 136] = (bf16)(v0.x >> 16); vt[2 * 136] = (bf16)(v0.y & 0xffffu); vt[3 * 136] = (bf16)(v0.y >> 16);
                vt[4 * 136] = (bf16)(v0.z & 0xffffu); vt[5 * 136] = (bf16)(v0.z >> 16); vt[6 * 136] = (bf16)(v0.w & 0xffffu); vt[7 * 136] = (bf16)(v0.w >> 16);
                vt[8 * 136] = (bf16)(v1.x & 0xffffu); vt[9 * 136] = (bf16)(v1.x >> 16); vt[10 * 136] = (bf16)(v1.y & 0xffffu); vt[11 * 136] = (bf16)(v1.y >> 16);
                vt[12 * 136] = (bf16)(v1.z & 0xffffu); vt[13 * 136] = (bf16)(v1.z >> 16); vt[14 * 136] = (bf16)(v1.w & 0xffffu); vt[15 * 136] = (bf16)(v1.w >> 16); }
            __syncthreads();
#pragma unroll 1
            for (int kk = 0; kk < 4; ++kk) {
                bf16x8 Kf[2][2], Vf[4];
#pragma unroll
                for (int kb2 = 0; kb2 < 2; ++kb2)
#pragma unroll
                    for (int ks = 0; ks < 2; ++ks) Kf[kb2][ks] = *(const LAS bf16x8*)(Ks + (32 * kk + 16 * kb2 + fr) * 72 + 32 * ks + 8 * fq);
#pragma unroll
                for (int db = 0; db < 4; ++db) { const s16x4 lo = *(const LAS s16x4*)(VT + (16 * db + fr) * 136 + 32 * kk + 4 * fq), hi = *(const LAS s16x4*)(VT + (16 * db + fr) * 136 + 32 * kk + 16 + 4 * fq);
                    Vf[db] = (bf16x8){lo[0], lo[1], lo[2], lo[3], hi[0], hi[1], hi[2], hi[3]}; }
#pragma unroll
                for (int qb = 0; qb < 4; ++qb) {
                    f32x4 s0 = {0.f, 0.f, 0.f, 0.f}, s1 = s0;
                    s0 = MFMA16(Kf[0][0], Qf[qb][0], s0); s0 = MFMA16(Kf[0][1], Qf[qb][1], s0);
                    s1 = MFMA16(Kf[1][0], Qf[qb][0], s1); s1 = MFMA16(Kf[1][1], Qf[qb][1], s1);
                    if (isband && kt != 1) { const int tq = nb * 128 + qs + 16 * qb + fr;
#pragma unroll
                        for (int e = 0; e < 4; ++e) { const int d0 = kblk * 128 + 32 * kk + 4 * fq + e - tq, d1 = d0 + 16;
                            if (d0 > 128 || d0 < -128) s0[e] = -1e30f; if (d1 > 128 || d1 < -128) s1[e] = -1e30f; } }
                    float mx = fmaxf(fmaxf(fmaxf(s0[0], s0[1]), fmaxf(s0[2], s0[3])), fmaxf(fmaxf(s1[0], s1[1]), fmaxf(s1[2], s1[3])));
                    mx = fmaxf(mx, __shfl_xor(mx, 16)); mx = fmaxf(mx, __shfl_xor(mx, 32));
                    const float mn = fmaxf(m[qb], mx), alpha = __builtin_amdgcn_exp2f(m[qb] - mn); m[qb] = mn;
                    float p[8]; float ps = 0.f;
#pragma unroll
                    for (int e = 0; e < 4; ++e) { p[e] = __builtin_amdgcn_exp2f(s0[e] - mn); p[4 + e] = __builtin_amdgcn_exp2f(s1[e] - mn); ps += p[e] + p[4 + e]; }
                    lsum[qb] = lsum[qb] * alpha + ps;
                    const bf16x8 Pf = __builtin_bit_cast(bf16x8, pack8(p));
#pragma unroll
                    for (int db = 0; db < 4; ++db) { O[qb][db] = O[qb][db] * alpha; O[qb][db] = MFMA16(Vf[db], Pf, O[qb][db]); }
                    __builtin_amdgcn_sched_barrier(0);
                }
            }
        }
#pragma unroll
        for (int qb = 0; qb < 4; ++qb) { float ls = lsum[qb]; ls += __shfl_xor(ls, 16); ls += __shfl_xor(ls, 32); const float inv = 1.f / ls;
            const int tq = nb * 128 + qs + 16 * qb + fr; const size_t row = isctx ? (size_t)ML + b * 256 + tq : (size_t)b * SEQ + tq;
#pragma unroll
            for (int db = 0; db < 4; ++db) { u32x2 o; o.x = pk2(O[qb][db][0] * inv, O[qb][db][1] * inv); o.y = pk2(O[qb][db][2] * inv, O[qb][db][3] * inv);
                *(u32x2*)(OB + row * D + h * 64 + 16 * db + 4 * fq) = o; } }
    }
}


__device__ __forceinline__ void attn2_stage_k(LAS bf16* Ks, const bf16* Z, const float* ROPEC, const float* ROPES, size_t krow0, int kvh, int slot, bool rope, int kblk, int tid) {
    const int key = tid >> 2, part = tid & 3, ks = part >> 1, sub = part & 1;
    const bf16* kp = Z + (krow0 + key) * ZS + ZK + kvh * 64 + 32 * ks + 8 * sub;
    float fa[8], fb[8]; unpack8(*(const u32x4*)kp, fa); unpack8(*(const u32x4*)(kp + 16), fb);
    if (rope) { const int tk = kblk * 128 + key; const int pos = ks == 0 ? (tk >> 6) : (tk & 63); const float* cs = ROPEC + pos * 16 + 8 * sub; const float* sn = ROPES + pos * 16 + 8 * sub;
#pragma unroll
        for (int e = 0; e < 8; ++e) { const float x1 = fa[e], x2 = fb[e]; fa[e] = x1 * cs[e] - x2 * sn[e]; fb[e] = x2 * cs[e] + x1 * sn[e]; } }
    LAS bf16* kd = Ks + (slot * 128 + key) * 72 + 32 * ks + 8 * sub;
    *(LAS u32x4*)kd = pack8(fa); *(LAS u32x4*)(kd + 16) = pack8(fb);
}
__device__ __forceinline__ void attn2_load_v(const bf16* Z, size_t krow0, int kvh, int tid, u32x4& v0, u32x4& v1) {
    const bf16* vp = Z + (krow0 + (tid >> 2)) * ZS + ZV + kvh * 64 + 16 * (tid & 3); v0 = *(const u32x4*)vp; v1 = *(const u32x4*)(vp + 8);
}
__device__ __forceinline__ void attn2_write_vt(LAS bf16* VT, int tid, const u32x4 v0, const u32x4 v1) {
    LAS bf16* vt = VT + (16 * (tid & 3)) * 136 + (tid >> 2);
    vt[0 * 136] = (bf16)(v0.x & 0xffffu); vt[1 * 136] = (bf16)(v0.x >> 16); vt[2 * 136] = (bf16)(v0.y & 0xffffu); vt[3 * 136] = (bf16)(v0.y >> 16);
    vt[4 * 136] = (bf16)(v0.z & 0xffffu); vt[5 * 136] = (bf16)(v0.z >> 16); vt[6 * 136] = (bf16)(v0.w & 0xffffu); vt[7 * 136] = (bf16)(v0.w >> 16);
    vt[8 * 136] = (bf16)(v1.x & 0xffffu); vt[9 * 136] = (bf16)(v1.x >> 16); vt[10 * 136] = (bf16)(v1.y & 0xffffu); vt[11 * 136] = (bf16)(v1.y >> 16);
    vt[12 * 136] = (bf16)(v1.z & 0xffffu); vt[13 * 136] = (bf16)(v1.z >> 16); vt[14 * 136] = (bf16)(v1.w & 0xffffu); vt[15 * 136] = (bf16)(v1.w >> 16);
}
__device__ __forceinline__ void attn_unit2(const Args& a, int l, int u, LAS unsigned char* lds, int tid, int wave, int lane) {
    const bf16* Z = (const bf16*)(a.ws + WS_Z); bf16* OB = (bf16*)(a.ws + WS_O);
    const float* ROPEC = (const float*)(a.ws + WS_ROPE); const float* ROPES = ROPEC + 2048;
    LAS bf16* Ks = (LAS bf16*)lds;
    LAS bf16* VT0 = (LAS bf16*)(lds + 92160);
    const int fr = lane & 15, fq = lane >> 4;
    int b, kvh, nb; const bool isctx = u >= 256;
    if (!isctx) { b = u >> 7; kvh = (u >> 6) & 1; nb = u & 63; } else { const int v = u - 256; b = v >> 2; kvh = (v >> 1) & 1; nb = v & 1; }
    const int h = kvh * 4 + (wave >> 1), qs = (wave & 1) * 64;
    const int ntile = isctx ? 2 : 5;
    __syncthreads();
#pragma unroll
    for (int kt = 0; kt < 5; ++kt) {
        if (kt >= ntile) continue;
        const bool isband = (!isctx && kt < 3); const int kblk = nb - 1 + kt;
        if (isband && (kblk < 0 || kblk > 63)) continue;
        const size_t krow0 = isband ? (size_t)b * SEQ + kblk * 128 : (size_t)ML + b * 256 + (isctx ? kt : kt - 3) * 128;
        attn2_stage_k(Ks, Z, ROPEC, ROPES, krow0, kvh, kt, isband, kblk, tid);
    }
    bf16x8 Qf[4][2];
#pragma unroll
    for (int qb = 0; qb < 4; ++qb) { const int tq = nb * 128 + qs + 16 * qb + fr; const size_t row = isctx ? (size_t)ML + b * 256 + tq : (size_t)b * SEQ + tq;
        const bf16* qp = Z + row * ZS + ZQ + h * 64;
#pragma unroll
        for (int ks = 0; ks < 2; ++ks) { float o[8]; unpack8(*(const u32x4*)(qp + 32 * ks + 8 * fq), o);
            if (!isctx) { float p[8]; unpack8(*(const u32x4*)(qp + 32 * ks + 8 * (fq ^ 2)), p); const int pos = ks == 0 ? (tq >> 6) : (tq & 63);
                const float* cs = ROPEC + pos * 16 + 8 * (fq & 1); const float* sn = ROPES + pos * 16 + 8 * (fq & 1);
#pragma unroll
                for (int e = 0; e < 8; ++e) o[e] = fq < 2 ? o[e] * cs[e] - p[e] * sn[e] : o[e] * cs[e] + p[e] * sn[e]; }
#pragma unroll
            for (int e = 0; e < 8; ++e) o[e] *= 0.125f * LOG2E;
            Qf[qb][ks] = __builtin_bit_cast(bf16x8, pack8(o)); } }
    int first = 0; if (!isctx && nb == 0) first = 1;
    { const bool isband = (!isctx && first < 3); const int kblk = nb - 1 + first;
      const size_t krow0 = isband ? (size_t)b * SEQ + kblk * 128 : (size_t)ML + b * 256 + (isctx ? first : first - 3) * 128;
      u32x4 v0, v1; attn2_load_v(Z, krow0, kvh, tid, v0, v1); attn2_write_vt(VT0, tid, v0, v1); }
    __syncthreads();
    float mx[4]; const float sinkv = a.in[10][l * 8 + h] * LOG2E;
#pragma unroll
    for (int qb = 0; qb < 4; ++qb) mx[qb] = -3.0e38f;
#pragma unroll 1
    for (int kt = 0; kt < ntile; ++kt) {
        const bool isband = (!isctx && kt < 3); const int kblk = nb - 1 + kt;
        if (isband && (kblk < 0 || kblk > 63)) continue;
#pragma unroll 1
        for (int kk = 0; kk < 4; ++kk) {
            bf16x8 Kf[2][2];
#pragma unroll
            for (int kb2 = 0; kb2 < 2; ++kb2)
#pragma unroll
                for (int ks = 0; ks < 2; ++ks) Kf[kb2][ks] = *(const LAS bf16x8*)(Ks + (kt * 128 + 32 * kk + 16 * kb2 + fr) * 72 + 32 * ks + 8 * fq);
#pragma unroll
            for (int qb = 0; qb < 4; ++qb) {
                if (isband && ((kt == 0 && 32 * kk + 31 < qs + 16 * qb) || (kt == 2 && 32 * kk > qs + 16 * qb + 15))) continue;
                f32x4 s0 = {0.f, 0.f, 0.f, 0.f}, s1 = s0;
                s0 = MFMA16(Kf[0][0], Qf[qb][0], s0); s0 = MFMA16(Kf[0][1], Qf[qb][1], s0);
                s1 = MFMA16(Kf[1][0], Qf[qb][0], s1); s1 = MFMA16(Kf[1][1], Qf[qb][1], s1);
                if (isband && kt != 1) { const int tq = nb * 128 + qs + 16 * qb + fr;
#pragma unroll
                    for (int e = 0; e < 4; ++e) { const int d0 = kblk * 128 + 32 * kk + 4 * fq + e - tq, d1 = d0 + 16;
                        if (d0 > 128 || d0 < -128) s0[e] = -1e30f; if (d1 > 128 || d1 < -128) s1[e] = -1e30f; } }
                mx[qb] = fmaxf(mx[qb], fmaxf(fmaxf(fmaxf(s0[0], s0[1]), fmaxf(s0[2], s0[3])), fmaxf(fmaxf(s1[0], s1[1]), fmaxf(s1[2], s1[3]))));
            }
        }
    }
    float lsum[4]; f32x4 O[4][4]; float negm[4];
#pragma unroll
    for (int qb = 0; qb < 4; ++qb) { float m = mx[qb]; m = fmaxf(m, __shfl_xor(m, 16)); m = fmaxf(m, __shfl_xor(m, 32)); m = fmaxf(m, sinkv);
        negm[qb] = -m; lsum[qb] = fq == 0 ? __builtin_amdgcn_exp2f(sinkv - m) : 0.f;
#pragma unroll
        for (int db = 0; db < 4; ++db) O[qb][db] = (f32x4){0.f, 0.f, 0.f, 0.f}; }
    int buf = 0;
#pragma unroll 1
    for (int kt = first; kt < ntile; ++kt) {
        const bool isband = (!isctx && kt < 3); const int kblk = nb - 1 + kt;
        if (isband && (kblk < 0 || kblk > 63)) continue;
        int nk = kt + 1; if (!isctx && nk == 2 && nb == 63) nk = 3;
        const bool hasn = nk < ntile;
        u32x4 nv0 = {0u, 0u, 0u, 0u}, nv1 = nv0;
        if (hasn) { const bool nband = (!isctx && nk < 3); const size_t nrow0 = nband ? (size_t)b * SEQ + (nb - 1 + nk) * 128 : (size_t)ML + b * 256 + (isctx ? nk : nk - 3) * 128; attn2_load_v(Z, nrow0, kvh, tid, nv0, nv1); }
        LAS bf16* VT = VT0 + buf * (64 * 136);
#pragma unroll 1
        for (int kk = 0; kk < 4; ++kk) {
            bf16x8 Kf[2][2], Vf[4];
#pragma unroll
            for (int kb2 = 0; kb2 < 2; ++kb2)
#pragma unroll
                for (int ks = 0; ks < 2; ++ks) Kf[kb2][ks] = *(const LAS bf16x8*)(Ks + (kt * 128 + 32 * kk + 16 * kb2 + fr) * 72 + 32 * ks + 8 * fq);
#pragma unroll
            for (int db = 0; db < 4; ++db) { const s16x4 lo = *(const LAS s16x4*)(VT + (16 * db + fr) * 136 + 32 * kk + 4 * fq), hi = *(const LAS s16x4*)(VT + (16 * db + fr) * 136 + 32 * kk + 16 + 4 * fq);
                Vf[db] = (bf16x8){lo[0], lo[1], lo[2], lo[3], hi[0], hi[1], hi[2], hi[3]}; }
#pragma unroll
            for (int qb = 0; qb < 4; ++qb) {
                if (isband && ((kt == 0 && 32 * kk + 31 < qs + 16 * qb) || (kt == 2 && 32 * kk > qs + 16 * qb + 15))) continue;
                f32x4 s0 = {negm[qb], negm[qb], negm[qb], negm[qb]}, s1 = s0;
                s0 = MFMA16(Kf[0][0], Qf[qb][0], s0); s0 = MFMA16(Kf[0][1], Qf[qb][1], s0);
                s1 = MFMA16(Kf[1][0], Qf[qb][0], s1); s1 = MFMA16(Kf[1][1], Qf[qb][1], s1);
                if (isband && kt != 1) { const int tq = nb * 128 + qs + 16 * qb + fr;
#pragma unroll
                    for (int e = 0; e < 4; ++e) { const int d0 = kblk * 128 + 32 * kk + 4 * fq + e - tq, d1 = d0 + 16;
                        if (d0 > 128 || d0 < -128) s0[e] = -1e30f; if (d1 > 128 || d1 < -128) s1[e] = -1e30f; } }
                float p[8]; float ps = 0.f;
#pragma unroll
                for (int e = 0; e < 4; ++e) { p[e] = __builtin_amdgcn_exp2f(s0[e]); p[4 + e] = __builtin_amdgcn_exp2f(s1[e]); ps += p[e] + p[4 + e]; }
                lsum[qb] += ps;
                const bf16x8 Pf = __builtin_bit_cast(bf16x8, pack8(p));
#pragma unroll
                for (int db = 0; db < 4; ++db) O[qb][db] = MFMA16(Vf[db], Pf, O[qb][db]);
            }
        }
        if (hasn) attn2_write_vt(VT0 + (buf ^ 1) * (64 * 136), tid, nv0, nv1);
        __syncthreads();
        buf ^= 1;
    }
#pragma unroll
    for (int qb = 0; qb < 4; ++qb) { float ls = lsum[qb]; ls += __shfl_xor(ls, 16); ls += __shfl_xor(ls, 32); const float inv = 1.f / ls;
        const int tq = nb * 128 + qs + 16 * qb + fr; const size_t row = isctx ? (size_t)ML + b * 256 + tq : (size_t)b * SEQ + tq;
#pragma unroll
        for (int db = 0; db < 4; ++db) { u32x2 o; o.x = pk2(O[qb][db][0] * inv, O[qb][db][1] * inv); o.y = pk2(O[qb][db][2] * inv, O[qb][db][3] * inv);
            *(u32x2*)(OB + row * D + h * 64 + 16 * db + 4 * fq) = o; } }
}

__device__ __forceinline__ void phase_pool(const Args& a, int l, int wave, int lane) {
    const bf16* Z = (const bf16*)(a.ws + WS_Z); bf16* OB = (bf16*)(a.ws + WS_O);
    const bf16* PWT = (const bf16*)(a.ws + WS_PWT) + (size_t)l * 4 * 128 * 128; const float* pscale = a.in[12] + l * 512;
    const int fr = lane & 15, fq = lane >> 4;
    const int gw = blockIdx.x * 8 + wave, NGW = gridDim.x * 8;
    const int nblk = (l == 0 ? MT : ML) / 16;
    for (int task = gw; task < nblk * 4; task += NGW) {
        const int g = task & 3, tb = task >> 2;
        const int row = tb * 16 + fr;
        int t, n; if (row < ML) { t = row & 8191; n = SEQ; } else { t = (row - ML) & 255; n = CTXL; }
        const int seq0 = row - t, hw = 1 << g;
        const int lo = t - hw > 0 ? t - hw : 0, hi = t + hw < n ? t + hw : n;
        const float inv = 1.f / (float)(hi - lo);
        bf16x8 Af[4];
#pragma unroll
        for (int ks = 0; ks < 4; ++ks) { float s[8] = {0, 0, 0, 0, 0, 0, 0, 0}; const bf16* base = Z + ZP + g * 128 + 32 * ks + 8 * fq;
            for (int tt = lo; tt < hi; ++tt) { float x[8]; unpack8(*(const u32x4*)(base + (size_t)(seq0 + tt) * ZS), x);
#pragma unroll
                for (int e = 0; e < 8; ++e) s[e] += x[e]; }
            float own[8]; unpack8(*(const u32x4*)(base + (size_t)row * ZS), own);
#pragma unroll
            for (int e = 0; e < 8; ++e) s[e] = s[e] * inv - own[e];
            Af[ks] = __builtin_bit_cast(bf16x8, pack8(s)); }
        f32x4 acc[4][2];
#pragma unroll
        for (int cp = 0; cp < 4; ++cp) { acc[cp][0] = (f32x4){0.f, 0.f, 0.f, 0.f}; acc[cp][1] = acc[cp][0]; }
#pragma unroll
        for (int ks = 0; ks < 4; ++ks)
#pragma unroll
            for (int cp = 0; cp < 4; ++cp)
#pragma unroll
                for (int nn = 0; nn < 2; ++nn) { const bf16x8 Bf = *(const bf16x8*)(PWT + (size_t)(g * 128 + 32 * cp + perm16(nn, fr)) * 128 + 32 * ks + 8 * fq); acc[cp][nn] = MFMA16(Bf, Af[ks], acc[cp][nn]); }
#pragma unroll
        for (int cp = 0; cp < 4; ++cp) { const int ch = g * 128 + 32 * cp + 8 * fq; const f32x4 pa = *(const f32x4*)(pscale + ch), pb = *(const f32x4*)(pscale + ch + 4); float o[8];
#pragma unroll
            for (int e = 0; e < 4; ++e) { o[e] = acc[cp][0][e] * pa[e]; o[4 + e] = acc[cp][1][e] * pb[e]; }
            *(u32x4*)(OB + (size_t)row * D + 512 + ch) = pack8(o); }
    }
}

__device__ __forceinline__ void phase_cgate(const Args& a, int l, LAS unsigned char* lds, int tid, int wave, int lane) {
    const bf16* Z = (const bf16*)(a.ws + WS_Z); bf16* OB = (bf16*)(a.ws + WS_O);
    LAS bf16* VT = (LAS bf16*)lds;
    const bf16* WSB = (const bf16*)(a.ws + WS_WSB) + (size_t)l * 4 * 128 * 128;
    const float* lng = a.in[13] + l * 512; const float* lnb = a.in[14] + l * 512; const float* cbs = a.in[16] + l * 512;
    const int fr = lane & 15, fq = lane >> 4;
    const int nch = (l == 0) ? 132 : 128;
    for (int u = blockIdx.x; u < nch * 2; u += gridDim.x) {
        const int ch = u >> 1, gp = u & 1;
        const size_t row0 = (size_t)ch * 128;
        __syncthreads();
        for (int ti = 0; ti < 16; ++ti) {
            const int tok = 16 * wave + ti; float v[8]; unpack8(*(const u32x4*)(Z + (row0 + tok) * ZS + ZUV + 512 + 8 * lane), v);
            float s = 0.f;
#pragma unroll
            for (int e = 0; e < 8; ++e) s += v[e];
            const float mean = wave_sum(s) * (1.f / 512.f); float q = 0.f;
#pragma unroll
            for (int e = 0; e < 8; ++e) { v[e] -= mean; q += v[e] * v[e]; }
            const float rstd = rsqrtf(wave_sum(q) * (1.f / 512.f) + 1e-6f);
            if ((lane >> 5) == gp) { const int c0 = 8 * lane;
#pragma unroll
                for (int e = 0; e < 8; ++e) VT[(c0 - 256 * gp + e) * 136 + tok] = (bf16)f2bf(v[e] * rstd * lng[c0 + e] + lnb[c0 + e]); }
        }
        __syncthreads();
#pragma unroll
        for (int gl = 0; gl < 2; ++gl) { const int g = 2 * gp + gl;
            bf16x8 Vf[4];
#pragma unroll
            for (int ks = 0; ks < 4; ++ks) Vf[ks] = *(const LAS bf16x8*)(VT + (128 * gl + 16 * wave + fr) * 136 + 32 * ks + 8 * fq);
            for (int pb = 0; pb < 8; ++pb) { f32x4 acc = {0.f, 0.f, 0.f, 0.f};
#pragma unroll
                for (int ks = 0; ks < 4; ++ks) { const bf16x8 Wf = *(const bf16x8*)(WSB + (size_t)(g * 128 + 16 * pb + fr) * 128 + 32 * ks + 8 * fq); acc = MFMA16(Vf[ks], Wf, acc); }
                const int p = 16 * pb + fr; const float bsv = cbs[g * 128 + p];
                const u32x2 ur = *(const u32x2*)(Z + (row0 + p) * ZS + ZUV + g * 128 + 16 * wave + 4 * fq);
                u32x2 o; o.x = pk2(bf2f(ur.x & 0xffffu) * (acc[0] + bsv), bf2f(ur.x >> 16) * (acc[1] + bsv)); o.y = pk2(bf2f(ur.y & 0xffffu) * (acc[2] + bsv), bf2f(ur.y >> 16) * (acc[3] + bsv));
                *(u32x2*)(OB + (row0 + p) * D + 1024 + g * 128 + 16 * wave + 4 * fq) = o; } }
    }
}

__device__ __forceinline__ void gla_logg_cum(const Args& a, int l, LAS float* LG, const bf16* Z, size_t row0, int h, int tid) {
    const float* gw2 = a.in[17] + l * 2 * 16 * 256; const float* gb = a.in[18] + l * 2 * 256;
    for (int i = 0; i < 16; ++i) { const int idx = tid + 512 * i, dir = idx >> 12, tok = (idx >> 6) & 63, dk = idx & 63;
        const bf16* gl = Z + (row0 + tok) * ZS + ZGLR + dir * 16; float acc = gb[dir * 256 + h * 64 + dk];
        float ga[8], gc[8]; unpack8(*(const u32x4*)gl, ga); unpack8(*(const u32x4*)(gl + 8), gc);
#pragma unroll
        for (int r = 0; r < 8; ++r) acc += ga[r] * gw2[(dir * 16 + r) * 256 + h * 64 + dk] + gc[r] * gw2[(dir * 16 + 8 + r) * 256 + h * 64 + dk];
        const float ls = fminf(acc, 0.f) - __logf(1.f + __expf(-fabsf(acc)));
        LG[idx] = ls * (1.f / 16.f); }
    __syncthreads();
    if (tid < 128) { const int dir = tid >> 6, dk = tid & 63; float c = 0.f;
        if (dir == 0) { for (int tok = 0; tok < 64; ++tok) { c += LG[tok * 64 + dk]; LG[tok * 64 + dk] = c; } }
        else { for (int tok = 63; tok >= 0; --tok) { c += LG[4096 + tok * 64 + dk]; LG[4096 + tok * 64 + dk] = c; } } }
    __syncthreads();
}
__device__ __forceinline__ void gla_stage_vt(LAS bf16* VT, const bf16* Z, size_t row0, int h, int tid) {
    const int tok = tid >> 3, c8 = tid & 7;
    const bf16* vp = Z + (row0 + tok) * ZS + ZGV + h * 128 + 16 * c8;
    const u32x4 v0 = *(const u32x4*)vp, v1 = *(const u32x4*)(vp + 8);
    LAS bf16* vt = VT + (16 * c8) * 72 + tok;
    vt[0 * 72] = (bf16)(v0.x & 0xffffu); vt[1 * 72] = (bf16)(v0.x >> 16); vt[2 * 72] = (bf16)(v0.y & 0xffffu); vt[3 * 72] = (bf16)(v0.y >> 16);
    vt[4 * 72] = (bf16)(v0.z & 0xffffu); vt[5 * 72] = (bf16)(v0.z >> 16); vt[6 * 72] = (bf16)(v0.w & 0xffffu); vt[7 * 72] = (bf16)(v0.w >> 16);
    vt[8 * 72] = (bf16)(v1.x & 0xffffu); vt[9 * 72] = (bf16)(v1.x >> 16); vt[10 * 72] = (bf16)(v1.y & 0xffffu); vt[11 * 72] = (bf16)(v1.y >> 16);
    vt[12 * 72] = (bf16)(v1.z & 0xffffu); vt[13 * 72] = (bf16)(v1.z >> 16); vt[14 * 72] = (bf16)(v1.w & 0xffffu); vt[15 * 72] = (bf16)(v1.w >> 16);
}
__device__ __forceinline__ int gla_ci(int dir, int tile) { return dir == 0 ? tile : (tile < 4 ? 3 - tile : 4 + 127 - (tile - 4)); }

__device__ __forceinline__ void phase_gla1(const Args& a, int l, LAS unsigned char* lds, int tid, int wave, int lane) {
    const bf16* Z = (const bf16*)(a.ws + WS_Z);
    LAS float* LG = (LAS float*)lds; LAS bf16* KT = (LAS bf16*)(lds + 32768); LAS bf16* VT = (LAS bf16*)(lds + 32768 + 18432);
    float* S = (float*)(a.ws + WS_S); float* DEC = (float*)(a.ws + WS_DECAY);
    const int fr = lane & 15, fq = lane >> 4;
    for (int u = blockIdx.x; u < 1056; u += gridDim.x) {
        const int tile = u % 132, bh = u / 132, b = bh >> 2, h = bh & 3;
        const size_t row0 = tile < 4 ? (size_t)ML + b * 256 + tile * 64 : (size_t)b * SEQ + (tile - 4) * 64;
        __syncthreads();
        gla_logg_cum(a, l, LG, Z, row0, h, tid);
        if (tid < 128) { const int dir = tid >> 6, dk = tid & 63; const float tot = LG[dir * 4096 + (dir == 0 ? 63 : 0) * 64 + dk];
            DEC[((size_t)(bh * 2 + dir) * 132 + gla_ci(dir, tile)) * 64 + dk] = __expf(tot); }
        { const int tok = tid >> 3, c8 = tid & 7; float kv[8]; unpack8(*(const u32x4*)(Z + (row0 + tok) * ZS + ZGK + h * 64 + 8 * c8), kv);
#pragma unroll
            for (int dir = 0; dir < 2; ++dir)
#pragma unroll
                for (int e = 0; e < 8; ++e) { const int dk = 8 * c8 + e; const float f = __expf(LG[dir * 4096 + (dir == 0 ? 63 : 0) * 64 + dk] - LG[dir * 4096 + tok * 64 + dk]);
                    KT[(dir * 64 + dk) * 72 + tok] = (bf16)f2bf(kv[e] * f); } }
        gla_stage_vt(VT, Z, row0, h, tid);
        __syncthreads();
        { const int dir = wave >> 2, dkb = wave & 3; bf16x8 Kf[2];
#pragma unroll
            for (int ks = 0; ks < 2; ++ks) Kf[ks] = *(const LAS bf16x8*)(KT + (dir * 64 + 16 * dkb + fr) * 72 + 32 * ks + 8 * fq);
            float* Sd = S + ((size_t)(bh * 2 + dir) * 132 + gla_ci(dir, tile)) * 8192;
#pragma unroll
            for (int dvb = 0; dvb < 8; ++dvb) { f32x4 acc = {0.f, 0.f, 0.f, 0.f};
#pragma unroll
                for (int ks = 0; ks < 2; ++ks) { const bf16x8 Vf = *(const LAS bf16x8*)(VT + (16 * dvb + fr) * 72 + 32 * ks + 8 * fq); acc = MFMA16(Vf, Kf[ks], acc); }
#pragma unroll
                for (int e = 0; e < 4; ++e) Sd[(16 * dvb + 4 * fq + e) * 64 + 16 * dkb + fr] = acc[e]; } }
    }
}
__device__ __forceinline__ void phase_gla2(const Args& a, int tid) {
    float* S = (float*)(a.ws + WS_S); const float* DEC = (const float*)(a.ws + WS_DECAY);
    for (int el = blockIdx.x * 512 + tid; el < 131072; el += gridDim.x * 512) {
        const int seq = el >> 13, e = el & 8191, dk = e & 63;
        float* Sp = S + (size_t)seq * 132 * 8192 + e; const float* Dp = DEC + (size_t)seq * 132 * 64 + dk;
        float s = 0.f;
        for (int ci = 0; ci < 132; ci += 4) {
            const float d0 = Sp[(size_t)ci * 8192], d1 = Sp[(size_t)(ci + 1) * 8192], d2 = Sp[(size_t)(ci + 2) * 8192], d3 = Sp[(size_t)(ci + 3) * 8192];
            const float a0 = Dp[ci * 64], a1 = Dp[(ci + 1) * 64], a2 = Dp[(ci + 2) * 64], a3 = Dp[(ci + 3) * 64];
            Sp[(size_t)ci * 8192] = s; s = a0 * s + d0; Sp[(size_t)(ci + 1) * 8192] = s; s = a1 * s + d1; Sp[(size_t)(ci + 2) * 8192] = s; s = a2 * s + d2; Sp[(size_t)(ci + 3) * 8192] = s; s = a3 * s + d3;
        }
    }
}
__device__ __forceinline__ void phase_gla3(const Args& a, int l, LAS unsigned char* lds, int tid, int wave, int lane) {
    const bf16* Z = (const bf16*)(a.ws + WS_Z); bf16* OB = (bf16*)(a.ws + WS_O);
    LAS float* LG = (LAS float*)lds; LAS bf16* VT = (LAS bf16*)(lds + 32768); LAS float* OX = (LAS float*)(lds + 32768 + 18432);
    const float* S = (const float*)(a.ws + WS_S);
    const float* gn = a.in[19] + l * 512;
    const int fr = lane & 15, fq = lane >> 4;
    const int ntile = (l == 0) ? 132 : 128;
    for (int u = blockIdx.x; u < 8 * ntile; u += gridDim.x) {
        const int tile = (l == 0) ? u % 132 : 4 + u % 128, bh = u / ntile, b = bh >> 2, h = bh & 3;
        const size_t row0 = tile < 4 ? (size_t)ML + b * 256 + tile * 64 : (size_t)b * SEQ + (tile - 4) * 64;
        __syncthreads();
        gla_logg_cum(a, l, LG, Z, row0, h, tid);
        gla_stage_vt(VT, Z, row0, h, tid);
        __syncthreads();
        const int dir = wave >> 2, tb = wave & 3;
        bf16x8 Qf[2];
        { const int tok = 16 * tb + fr;
#pragma unroll
            for (int ks = 0; ks < 2; ++ks) { float q[8]; unpack8(*(const u32x4*)(Z + (row0 + tok) * ZS + ZGQ + h * 64 + 32 * ks + 8 * fq), q);
#pragma unroll
                for (int e = 0; e < 8; ++e) q[e] *= 0.125f * __expf(LG[dir * 4096 + tok * 64 + 32 * ks + 8 * fq + e]);
                Qf[ks] = __builtin_bit_cast(bf16x8, pack8(q)); } }
        f32x4 at[4];
#pragma unroll
        for (int kb = 0; kb < 4; ++kb) { const int key = 16 * kb + fr; f32x4 acc = {0.f, 0.f, 0.f, 0.f};
#pragma unroll
            for (int ks = 0; ks < 2; ++ks) { float k[8]; unpack8(*(const u32x4*)(Z + (row0 + key) * ZS + ZGK + h * 64 + 32 * ks + 8 * fq), k);
#pragma unroll
                for (int e = 0; e < 8; ++e) k[e] *= __expf(-LG[dir * 4096 + key * 64 + 32 * ks + 8 * fq + e]);
                acc = MFMA16(__builtin_bit_cast(bf16x8, pack8(k)), Qf[ks], acc); }
            const int tok = 16 * tb + fr;
#pragma unroll
            for (int e = 0; e < 4; ++e) { const int kj = 16 * kb + 4 * fq + e; const bool ok = dir == 0 ? (kj <= tok) : (kj >= tok); if (!ok) acc[e] = 0.f; }
            at[kb] = acc; }
        bf16x8 Pf[2];
#pragma unroll
        for (int kk = 0; kk < 2; ++kk) { float p[8];
#pragma unroll
            for (int e = 0; e < 4; ++e) { p[e] = at[2 * kk][e]; p[4 + e] = at[2 * kk + 1][e]; }
            Pf[kk] = __builtin_bit_cast(bf16x8, pack8(p)); }
        const float* Sp = S + ((size_t)(bh * 2 + dir) * 132 + gla_ci(dir, tile)) * 8192;
        f32x4 O[8];
#pragma unroll
        for (int dvb = 0; dvb < 8; ++dvb) { f32x4 o = {0.f, 0.f, 0.f, 0.f};
#pragma unroll
            for (int kk = 0; kk < 2; ++kk) { const s16x4 lo = *(const LAS s16x4*)(VT + (16 * dvb + fr) * 72 + 32 * kk + 4 * fq), hi = *(const LAS s16x4*)(VT + (16 * dvb + fr) * 72 + 32 * kk + 16 + 4 * fq);
                const bf16x8 Vf = (bf16x8){lo[0], lo[1], lo[2], lo[3], hi[0], hi[1], hi[2], hi[3]}; o = MFMA16(Vf, Pf[kk], o); }
#pragma unroll
            for (int ks = 0; ks < 2; ++ks) { const float* sp = Sp + (16 * dvb + fr) * 64 + 32 * ks + 8 * fq; const f32x4 s0 = *(const f32x4*)sp, s1 = *(const f32x4*)(sp + 4);
                float sv[8] = {s0[0], s0[1], s0[2], s0[3], s1[0], s1[1], s1[2], s1[3]}; o = MFMA16(__builtin_bit_cast(bf16x8, pack8(sv)), Qf[ks], o); }
            O[dvb] = o; }
        if (dir == 1) {
#pragma unroll
            for (int dvb = 0; dvb < 8; ++dvb) *(LAS f32x4*)(OX + (tb * 16 + fr) * 132 + 16 * dvb + 4 * fq) = O[dvb]; }
        __syncthreads();
        if (dir == 0) { float ss = 0.f;
#pragma unroll
            for (int dvb = 0; dvb < 8; ++dvb) { O[dvb] += *(const LAS f32x4*)(OX + (tb * 16 + fr) * 132 + 16 * dvb + 4 * fq); ss += (O[dvb][0] * O[dvb][0] + O[dvb][1] * O[dvb][1]) + (O[dvb][2] * O[dvb][2] + O[dvb][3] * O[dvb][3]); }
            ss += __shfl_xor(ss, 16); ss += __shfl_xor(ss, 32);
            const float rstd = rsqrtf(ss * (1.f / 128.f) + 1e-6f);
            const size_t row = row0 + 16 * tb + fr;
#pragma unroll
            for (int dvb = 0; dvb < 8; ++dvb) { const int c = h * 128 + 16 * dvb + 4 * fq; const f32x4 g = *(const f32x4*)(gn + c); const u32x2 rr = *(const u32x2*)(Z + row * ZS + ZGR + c);
                const float r0 = bf2f(rr.x & 0xffffu), r1 = bf2f(rr.x >> 16), r2 = bf2f(rr.y & 0xffffu), r3 = bf2f(rr.y >> 16);
                u32x2 o; o.x = pk2(O[dvb][0] * rstd * g[0] * r0 * sigmoidf_(r0), O[dvb][1] * rstd * g[1] * r1 * sigmoidf_(r1)); o.y = pk2(O[dvb][2] * rstd * g[2] * r2 * sigmoidf_(r2), O[dvb][3] * rstd * g[3] * r3 * sigmoidf_(r3));
                *(u32x2*)(OB + row * D + 1536 + c) = o; } }
    }
}


template <int G> __device__ __forceinline__ void pool_task(const bf16* Z, bf16* OB, const bf16* PWT, const float* pscale, int tb, int fr, int fq) {
    constexpr int HW = 1 << G;
    const int row = tb * 16 + fr;
    int t, n; if (row < ML) { t = row & 8191; n = SEQ; } else { t = (row - ML) & 255; n = CTXL; }
    const int seq0 = row - t;
    const int lo = t - HW > 0 ? t - HW : 0, hi = t + HW < n ? t + HW : n;
    const float inv = 1.f / (float)(hi - lo);
    f32x4 acc[4][2];
#pragma unroll
    for (int cp = 0; cp < 4; ++cp) { acc[cp][0] = (f32x4){0.f, 0.f, 0.f, 0.f}; acc[cp][1] = acc[cp][0]; }
#pragma unroll 1
    for (int ks = 0; ks < 4; ++ks) { const bf16* base = Z + ZP + G * 128 + 32 * ks + 8 * fq;
        bf16x8 Bf[4][2];
#pragma unroll
        for (int cp = 0; cp < 4; ++cp)
#pragma unroll
            for (int nn = 0; nn < 2; ++nn) Bf[cp][nn] = *(const bf16x8*)(PWT + (size_t)(G * 128 + 32 * cp + perm16(nn, fr)) * 128 + 32 * ks + 8 * fq);
        float s[8] = {0, 0, 0, 0, 0, 0, 0, 0}, own[8];
        constexpr int CH = (2 * HW < 8) ? 2 * HW : 8;
#pragma unroll
        for (int j0 = 0; j0 < 2 * HW; j0 += CH) {
            u32x4 raw[CH];
#pragma unroll
            for (int j = 0; j < CH; ++j) { int tt = t - HW + j0 + j; tt = tt < 0 ? 0 : (tt > n - 1 ? n - 1 : tt); raw[j] = *(const u32x4*)(base + (size_t)(seq0 + tt) * ZS); }
#pragma unroll
            for (int j = 0; j < CH; ++j) { const int tt = t - HW + j0 + j; const bool ok = tt >= 0 && tt < n; float x[8]; unpack8(raw[j], x);
#pragma unroll
                for (int e = 0; e < 8; ++e) { s[e] += ok ? x[e] : 0.f; if (j0 + j == HW) own[e] = x[e]; } }
            __builtin_amdgcn_sched_barrier(0);
        }
#pragma unroll
        for (int e = 0; e < 8; ++e) s[e] = s[e] * inv - own[e];
        const bf16x8 Af = __builtin_bit_cast(bf16x8, pack8(s));
#pragma unroll
        for (int cp = 0; cp < 4; ++cp)
#pragma unroll
            for (int nn = 0; nn < 2; ++nn) acc[cp][nn] = MFMA16(Bf[cp][nn], Af, acc[cp][nn]); }
#pragma unroll
    for (int cp = 0; cp < 4; ++cp) { const int ch = G * 128 + 32 * cp + 8 * fq; const f32x4 pa = *(const f32x4*)(pscale + ch), pb = *(const f32x4*)(pscale + ch + 4); float o[8];
#pragma unroll
        for (int e = 0; e < 4; ++e) { o[e] = acc[cp][0][e] * pa[e]; o[4 + e] = acc[cp][1][e] * pb[e]; }
        *(u32x4*)(OB + (size_t)row * D + 512 + ch) = pack8(o); }
}
__device__ __forceinline__ void pool_unit(const Args& a, int l, int pu, int wave, int lane) {
    const bf16* Z = (const bf16*)(a.ws + WS_Z); bf16* OB = (bf16*)(a.ws + WS_O);
    const bf16* PWT = (const bf16*)(a.ws + WS_PWT) + (size_t)l * 4 * 128 * 128; const float* pscale = a.in[12] + l * 512;
    const int fr = lane & 15, fq = lane >> 4, g = wave & 3, tb = 2 * pu + (wave >> 2);
    if (g == 0) pool_task<0>(Z, OB, PWT, pscale, tb, fr, fq); else if (g == 1) pool_task<1>(Z, OB, PWT, pscale, tb, fr, fq);
    else if (g == 2) pool_task<2>(Z, OB, PWT, pscale, tb, fr, fq); else pool_task<3>(Z, OB, PWT, pscale, tb, fr, fq);
}
__device__ __forceinline__ void cgate_unit(const Args& a, int l, int u, LAS unsigned char* lds, int tid, int wave, int lane) {
    const bf16* Z = (const bf16*)(a.ws + WS_Z); bf16* OB = (bf16*)(a.ws + WS_O);
    LAS bf16* VT = (LAS bf16*)lds;
    LAS bf16* WS = (LAS bf16*)(lds + 69632);
    const bf16* WSB = (const bf16*)(a.ws + WS_WSB) + (size_t)l * 4 * 128 * 128;
    const float* lng = a.in[13] + l * 512; const float* lnb = a.in[14] + l * 512; const float* cbs = a.in[16] + l * 512;
    const int fr = lane & 15, fq = lane >> 4;
    const int ch = u >> 1, gp = u & 1;
    const size_t row0 = (size_t)ch * 128;
    __syncthreads();
    u32x4 raw[16];
#pragma unroll
    for (int ti = 0; ti < 16; ++ti) raw[ti] = *(const u32x4*)(Z + (row0 + 16 * wave + ti) * ZS + ZUV + 512 + 8 * lane);
#pragma unroll
    for (int i = 0; i < 8; ++i) { const int p = tid + 512 * i, gl = p >> 11, r = (p >> 4) & 127, c16 = p & 15;
        *(LAS u32x4*)(WS + (gl * 128 + r) * 136 + 8 * c16) = *(const u32x4*)(WSB + (size_t)((2 * gp + gl) * 128 + r) * 128 + 8 * c16); }
    float gv[8], bv[8];
    { const int c0 = 8 * lane;
#pragma unroll
        for (int e = 0; e < 8; ++e) { gv[e] = lng[c0 + e]; bv[e] = lnb[c0 + e]; } }
#pragma unroll
    for (int ti = 0; ti < 16; ++ti) {
        const int tok = 16 * wave + ti; float v[8]; unpack8(raw[ti], v);
        float sm = 0.f;
#pragma unroll
        for (int e = 0; e < 8; ++e) sm += v[e];
        const float mean = wave_sum(sm) * (1.f / 512.f); float q = 0.f;
#pragma unroll
        for (int e = 0; e < 8; ++e) { v[e] -= mean; q += v[e] * v[e]; }
        const float rstd = rsqrtf(wave_sum(q) * (1.f / 512.f) + 1e-6f);
        if ((lane >> 5) == gp) { const int c0 = 8 * lane - 256 * gp;
#pragma unroll
            for (int e = 0; e < 8; ++e) VT[(c0 + e) * 136 + tok] = (bf16)f2bf(v[e] * rstd * gv[e] + bv[e]); }
    }
    __syncthreads();
#pragma unroll
    for (int gl = 0; gl < 2; ++gl) { const int g = 2 * gp + gl;
        bf16x8 Vf[4];
#pragma unroll
        for (int ks = 0; ks < 4; ++ks) Vf[ks] = *(const LAS bf16x8*)(VT + (128 * gl + 16 * wave + fr) * 136 + 32 * ks + 8 * fq);
        u32x2 ur[8]; float bsv[8];
#pragma unroll
        for (int pb = 0; pb < 8; ++pb) { const int p = 16 * pb + fr; ur[pb] = *(const u32x2*)(Z + (row0 + p) * ZS + ZUV + g * 128 + 16 * wave + 4 * fq); bsv[pb] = cbs[g * 128 + p]; }
#pragma unroll
        for (int pb = 0; pb < 8; ++pb) { f32x4 acc = {0.f, 0.f, 0.f, 0.f};
#pragma unroll
            for (int ks = 0; ks < 4; ++ks) { const bf16x8 Wf = *(const LAS bf16x8*)(WS + (gl * 128 + 16 * pb + fr) * 136 + 32 * ks + 8 * fq); acc = MFMA16(Vf[ks], Wf, acc); }
            const int p = 16 * pb + fr;
            u32x2 o; o.x = pk2(bf2f(ur[pb].x & 0xffffu) * (acc[0] + bsv[pb]), bf2f(ur[pb].x >> 16) * (acc[1] + bsv[pb])); o.y = pk2(bf2f(ur[pb].y & 0xffffu) * (acc[2] + bsv[pb]), bf2f(ur[pb].y >> 16) * (acc[3] + bsv[pb]));
            *(u32x2*)(OB + (row0 + p) * D + 1024 + g * 128 + 16 * wave + 4 * fq) = o; } }
}

__device__ __forceinline__ void gla_cum2(const Args& a, int l, LAS unsigned char* lds, const bf16* Z, size_t row0, int h, int tid) {
    LAS float* CUM = (LAS float*)lds; LAS float* GLR = (LAS float*)(lds + 32768); LAS float* QT = (LAS float*)(lds + 40960);
    const float* gw2 = a.in[17] + l * 2 * 16 * 256; const float* gb = a.in[18] + l * 2 * 256;
    if (tid < 256) { const int tok = tid >> 2, part = tid & 3; float g[8]; unpack8(*(const u32x4*)(Z + (row0 + tok) * ZS + ZGLR + 8 * part), g);
        *(LAS f32x4*)(GLR + tok * 32 + 8 * part) = (f32x4){g[0], g[1], g[2], g[3]}; *(LAS f32x4*)(GLR + tok * 32 + 8 * part + 4) = (f32x4){g[4], g[5], g[6], g[7]}; }
    const int dir = tid >> 8, q = (tid >> 6) & 3, dk = tid & 63;
    float w[16];
#pragma unroll
    for (int r = 0; r < 16; ++r) w[r] = gw2[(dir * 16 + r) * 256 + h * 64 + dk];
    const float bias = gb[dir * 256 + h * 64 + dk];
    __syncthreads();
    float run = 0.f;
#pragma unroll 4
    for (int i = 0; i < 16; ++i) { const int tok = dir == 0 ? 16 * q + i : 16 * q + 15 - i;
        const LAS float* gp = GLR + tok * 32 + dir * 16; const f32x4 g0 = *(const LAS f32x4*)gp, g1 = *(const LAS f32x4*)(gp + 4), g2 = *(const LAS f32x4*)(gp + 8), g3 = *(const LAS f32x4*)(gp + 12);
        float acc = bias;
#pragma unroll
        for (int e = 0; e < 4; ++e) acc += g0[e] * w[e] + g1[e] * w[4 + e] + g2[e] * w[8 + e] + g3[e] * w[12 + e];
        const float ls = fminf(acc, 0.f) - __logf(1.f + __expf(-fabsf(acc)));
        run += ls * (1.f / 16.f); CUM[dir * 4096 + tok * 64 + dk] = run; }
    QT[(dir * 4 + q) * 64 + dk] = run;
    __syncthreads();
    float off = 0.f;
#pragma unroll
    for (int qq = 0; qq < 4; ++qq) { const float v = QT[(dir * 4 + qq) * 64 + dk]; if (dir == 0 ? qq < q : qq > q) off += v; }
#pragma unroll
    for (int i = 0; i < 16; ++i) CUM[dir * 4096 + (16 * q + i) * 64 + dk] += off;
    __syncthreads();
}
__device__ __forceinline__ void gla1_unit(const Args& a, int l, int u, LAS unsigned char* lds, int tid, int wave, int lane) {
    const bf16* Z = (const bf16*)(a.ws + WS_Z);
    LAS float* CUM = (LAS float*)lds; LAS bf16* KT = (LAS bf16*)(lds + 43008); LAS bf16* VT = (LAS bf16*)(lds + 43008 + 18432);
    bf16* S = (bf16*)(a.ws + WS_S); float* DEC = (float*)(a.ws + WS_DECAY);
    const int fr = lane & 15, fq = lane >> 4;
    const int tile = u % 132, bh = u / 132, b = bh >> 2, h = bh & 3;
    const size_t row0 = tile < 4 ? (size_t)ML + b * 256 + tile * 64 : (size_t)b * SEQ + (tile - 4) * 64;
    const int tok = tid >> 3, c8 = tid & 7;
    const u32x4 kraw = *(const u32x4*)(Z + (row0 + tok) * ZS + ZGK + h * 64 + 8 * c8);
    const bf16* vp = Z + (row0 + tok) * ZS + ZGV + h * 128 + 16 * c8;
    const u32x4 v0 = *(const u32x4*)vp, v1 = *(const u32x4*)(vp + 8);
    __syncthreads();
    gla_cum2(a, l, lds, Z, row0, h, tid);
    if (tid < 128) { const int dir = tid >> 6, dk = tid & 63; DEC[((size_t)(bh * 2 + dir) * 132 + gla_ci(dir, tile)) * 64 + dk] = __expf(CUM[dir * 4096 + (dir == 0 ? 63 : 0) * 64 + dk]); }
    { float kv[8]; unpack8(kraw, kv);
#pragma unroll
        for (int dir = 0; dir < 2; ++dir)
#pragma unroll
            for (int e = 0; e < 8; ++e) { const int dk = 8 * c8 + e; const float f = __expf(CUM[dir * 4096 + (dir == 0 ? 63 : 0) * 64 + dk] - CUM[dir * 4096 + tok * 64 + dk]);
                KT[(dir * 64 + dk) * 72 + tok] = (bf16)f2bf(kv[e] * f); }
        LAS bf16* vt = VT + (16 * c8) * 72 + tok;
        vt[0 * 72] = (bf16)(v0.x & 0xffffu); vt[1 * 72] = (bf16)(v0.x >> 16); vt[2 * 72] = (bf16)(v0.y & 0xffffu); vt[3 * 72] = (bf16)(v0.y >> 16);
        vt[4 * 72] = (bf16)(v0.z & 0xffffu); vt[5 * 72] = (bf16)(v0.z >> 16); vt[6 * 72] = (bf16)(v0.w & 0xffffu); vt[7 * 72] = (bf16)(v0.w >> 16);
        vt[8 * 72] = (bf16)(v1.x & 0xffffu); vt[9 * 72] = (bf16)(v1.x >> 16); vt[10 * 72] = (bf16)(v1.y & 0xffffu); vt[11 * 72] = (bf16)(v1.y >> 16);
        vt[12 * 72] = (bf16)(v1.z & 0xffffu); vt[13 * 72] = (bf16)(v1.z >> 16); vt[14 * 72] = (bf16)(v1.w & 0xffffu); vt[15 * 72] = (bf16)(v1.w >> 16); }
    __syncthreads();
    { const int dir = wave >> 2, dkb = wave & 3; bf16x8 Kf[2];
#pragma unroll
        for (int ks = 0; ks < 2; ++ks) Kf[ks] = *(const LAS bf16x8*)(KT + (dir * 64 + 16 * dkb + fr) * 72 + 32 * ks + 8 * fq);
        bf16* Sd = S + ((size_t)(bh * 2 + dir) * 132 + gla_ci(dir, tile)) * 8192;
#pragma unroll
        for (int dvb = 0; dvb < 8; ++dvb) { f32x4 acc = {0.f, 0.f, 0.f, 0.f};
#pragma unroll
            for (int ks = 0; ks < 2; ++ks) { const bf16x8 Vf = *(const LAS bf16x8*)(VT + (16 * dvb + fr) * 72 + 32 * ks + 8 * fq); acc = MFMA16(Kf[ks], Vf, acc); }
            { u32x2 o; o.x = pk2(acc[0], acc[1]); o.y = pk2(acc[2], acc[3]); *(u32x2*)(Sd + (16 * dvb + fr) * 64 + 16 * dkb + 4 * fq) = o; } } }
}
__device__ __forceinline__ void phase_gla2b(const Args& a, int tid) {
    const bf16* S = (const bf16*)(a.ws + WS_S); const float* DEC = (const float*)(a.ws + WS_DECAY); bf16* SB = (bf16*)(a.ws + WS_SB);
    for (int el = blockIdx.x * 512 + tid; el < 131072; el += gridDim.x * 512) {
        const int seq = el >> 13, e = el & 8191, dk = e & 63;
        const bf16* Sp = S + (size_t)seq * 132 * 8192 + e; const float* Dp = DEC + (size_t)seq * 132 * 64 + dk; bf16* Bp = SB + (size_t)seq * 132 * 8192 + e;
        float s = 0.f;
#pragma unroll 1
        for (int ci = 0; ci < 132; ci += 33) { float d[33], dc[33];
#pragma unroll
            for (int j = 0; j < 33; ++j) { d[j] = bf2f((unsigned)__builtin_nontemporal_load(Sp + (size_t)(ci + j) * 8192)); dc[j] = Dp[(ci + j) * 64]; }
#pragma unroll
            for (int j = 0; j < 33; ++j) { Bp[(size_t)(ci + j) * 8192] = (bf16)f2bf(s); s = dc[j] * s + d[j]; } }
    }
}
__device__ __forceinline__ void gla3_unit(const Args& a, int l, int u, LAS unsigned char* lds, int tid, int wave, int lane) {
    const bf16* Z = (const bf16*)(a.ws + WS_Z); bf16* OB = (bf16*)(a.ws + WS_O);
    LAS float* CUM = (LAS float*)lds; LAS bf16* QS = (LAS bf16*)(lds + 43008); LAS bf16* KS = (LAS bf16*)(lds + 43008 + 18432); LAS bf16* VT = (LAS bf16*)(lds + 43008 + 36864);
    LAS float* OX = (LAS float*)(lds + 43008 + 36864 + 18432);
    const bf16* SB = (const bf16*)(a.ws + WS_SB);
    const float* gn = a.in[19] + l * 512;
    const int fr = lane & 15, fq = lane >> 4;
    const int ntile = (l == 0) ? 132 : 128;
    const int tile = (l == 0) ? u % 132 : 4 + u % 128, bh = u / ntile, b = bh >> 2, h = bh & 3;
    const size_t row0 = tile < 4 ? (size_t)ML + b * 256 + tile * 64 : (size_t)b * SEQ + (tile - 4) * 64;
    const int tok = tid >> 3, c8 = tid & 7;
    const u32x4 qraw = *(const u32x4*)(Z + (row0 + tok) * ZS + ZGQ + h * 64 + 8 * c8), kraw = *(const u32x4*)(Z + (row0 + tok) * ZS + ZGK + h * 64 + 8 * c8);
    const bf16* vp = Z + (row0 + tok) * ZS + ZGV + h * 128 + 16 * c8;
    const u32x4 v0 = *(const u32x4*)vp, v1 = *(const u32x4*)(vp + 8);
    __syncthreads();
    gla_cum2(a, l, lds, Z, row0, h, tid);
    { float qv[8], kv[8]; unpack8(qraw, qv); unpack8(kraw, kv);
#pragma unroll
        for (int dir = 0; dir < 2; ++dir) { float qo[8], ko[8];
#pragma unroll
            for (int e = 0; e < 8; ++e) { const float c = CUM[dir * 4096 + tok * 64 + 8 * c8 + e]; qo[e] = qv[e] * 0.125f * __expf(c); ko[e] = kv[e] * __expf(-c); }
            *(LAS u32x4*)(QS + (dir * 64 + tok) * 72 + 8 * c8) = pack8(qo); *(LAS u32x4*)(KS + (dir * 64 + tok) * 72 + 8 * c8) = pack8(ko); }
        LAS bf16* vt = VT + (16 * c8) * 72 + tok;
        vt[0 * 72] = (bf16)(v0.x & 0xffffu); vt[1 * 72] = (bf16)(v0.x >> 16); vt[2 * 72] = (bf16)(v0.y & 0xffffu); vt[3 * 72] = (bf16)(v0.y >> 16);
        vt[4 * 72] = (bf16)(v0.z & 0xffffu); vt[5 * 72] = (bf16)(v0.z >> 16); vt[6 * 72] = (bf16)(v0.w & 0xffffu); vt[7 * 72] = (bf16)(v0.w >> 16);
        vt[8 * 72] = (bf16)(v1.x & 0xffffu); vt[9 * 72] = (bf16)(v1.x >> 16); vt[10 * 72] = (bf16)(v1.y & 0xffffu); vt[11 * 72] = (bf16)(v1.y >> 16);
        vt[12 * 72] = (bf16)(v1.z & 0xffffu); vt[13 * 72] = (bf16)(v1.z >> 16); vt[14 * 72] = (bf16)(v1.w & 0xffffu); vt[15 * 72] = (bf16)(v1.w >> 16); }
    const int dir = wave >> 2, tb = wave & 3;
    const bf16* Sp = SB + ((size_t)(bh * 2 + dir) * 132 + gla_ci(dir, tile)) * 8192;
    bf16x8 Sf[8][2];
#pragma unroll
    for (int dvb = 0; dvb < 8; ++dvb)
#pragma unroll
        for (int ks = 0; ks < 2; ++ks) Sf[dvb][ks] = *(const bf16x8*)(Sp + (16 * dvb + fr) * 64 + 32 * ks + 8 * fq);
    __syncthreads();
    bf16x8 Qf[2];
#pragma unroll
    for (int ks = 0; ks < 2; ++ks) Qf[ks] = *(const LAS bf16x8*)(QS + (dir * 64 + 16 * tb + fr) * 72 + 32 * ks + 8 * fq);
    f32x4 at[4];
#pragma unroll
    for (int kb = 0; kb < 4; ++kb) { f32x4 acc = {0.f, 0.f, 0.f, 0.f};
        const bool need = dir == 0 ? (kb <= tb) : (kb >= tb);
        if (need) {
#pragma unroll
            for (int ks = 0; ks < 2; ++ks) { const bf16x8 Kf = *(const LAS bf16x8*)(KS + (dir * 64 + 16 * kb + fr) * 72 + 32 * ks + 8 * fq); acc = MFMA16(Kf, Qf[ks], acc); }
            const int tq = 16 * tb + fr;
#pragma unroll
            for (int e = 0; e < 4; ++e) { const int kj = 16 * kb + 4 * fq + e; const bool ok = dir == 0 ? (kj <= tq) : (kj >= tq); if (!ok) acc[e] = 0.f; } }
        at[kb] = acc; }
    bf16x8 Pf[2];
#pragma unroll
    for (int kk = 0; kk < 2; ++kk) { float p[8];
#pragma unroll
        for (int e = 0; e < 4; ++e) { p[e] = at[2 * kk][e]; p[4 + e] = at[2 * kk + 1][e]; }
        Pf[kk] = __builtin_bit_cast(bf16x8, pack8(p)); }
    f32x4 O[8];
#pragma unroll
    for (int dvb = 0; dvb < 8; ++dvb) { f32x4 o = {0.f, 0.f, 0.f, 0.f};
#pragma unroll
        for (int kk = 0; kk < 2; ++kk) { const s16x4 lo = *(const LAS s16x4*)(VT + (16 * dvb + fr) * 72 + 32 * kk + 4 * fq), hi = *(const LAS s16x4*)(VT + (16 * dvb + fr) * 72 + 32 * kk + 16 + 4 * fq);
            const bf16x8 Vf = (bf16x8){lo[0], lo[1], lo[2], lo[3], hi[0], hi[1], hi[2], hi[3]}; o = MFMA16(Vf, Pf[kk], o); }
#pragma unroll
        for (int ks = 0; ks < 2; ++ks) o = MFMA16(Sf[dvb][ks], Qf[ks], o);
        O[dvb] = o; }
    if (dir == 1) {
#pragma unroll
        for (int dvb = 0; dvb < 8; ++dvb) *(LAS f32x4*)(OX + (tb * 16 + fr) * 132 + 16 * dvb + 4 * fq) = O[dvb]; }
    __syncthreads();
    if (dir == 0) { float ss = 0.f;
#pragma unroll
        for (int dvb = 0; dvb < 8; ++dvb) { O[dvb] += *(const LAS f32x4*)(OX + (tb * 16 + fr) * 132 + 16 * dvb + 4 * fq); ss += (O[dvb][0] * O[dvb][0] + O[dvb][1] * O[dvb][1]) + (O[dvb][2] * O[dvb][2] + O[dvb][3] * O[dvb][3]); }
        ss += __shfl_xor(ss, 16); ss += __shfl_xor(ss, 32);
        const float rstd = rsqrtf(ss * (1.f / 128.f) + 1e-6f);
        const size_t row = row0 + 16 * tb + fr;
#pragma unroll
        for (int dvb = 0; dvb < 8; ++dvb) { const int c = h * 128 + 16 * dvb + 4 * fq; const f32x4 g = *(const f32x4*)(gn + c); const u32x2 rr = *(const u32x2*)(Z + row * ZS + ZGR + c);
            const float r0 = bf2f(rr.x & 0xffffu), r1 = bf2f(rr.x >> 16), r2 = bf2f(rr.y & 0xffffu), r3 = bf2f(rr.y >> 16);
            u32x2 o; o.x = pk2(O[dvb][0] * rstd * g[0] * r0 * sigmoidf_(r0), O[dvb][1] * rstd * g[1] * r1 * sigmoidf_(r1)); o.y = pk2(O[dvb][2] * rstd * g[2] * r2 * sigmoidf_(r2), O[dvb][3] * rstd * g[3] * r3 * sigmoidf_(r3));
            *(u32x2*)(OB + row * D + 1536 + c) = o; } }
}
__device__ __forceinline__ void phase_pool2(const Args& a, int l, int wave, int lane) { const int npu = (l == 0 ? MT : ML) / 32; for (int u = blockIdx.x; u < npu; u += gridDim.x) pool_unit(a, l, u, wave, lane); }
__device__ __forceinline__ void phase_cgate2(const Args& a, int l, LAS unsigned char* lds, int tid, int wave, int lane) { const int n = (l == 0 ? 132 : 128) * 2; for (int u = blockIdx.x; u < n; u += gridDim.x) cgate_unit(a, l, u, lds, tid, wave, lane); }
__device__ __forceinline__ void phase_gla1b(const Args& a, int l, LAS unsigned char* lds, int tid, int wave, int lane) { for (int u = blockIdx.x; u < 1056; u += gridDim.x) gla1_unit(a, l, u, lds, tid, wave, lane); }
__device__ __forceinline__ void phase_gla3b(const Args& a, int l, LAS unsigned char* lds, int tid, int wave, int lane) { const int n = 8 * (l == 0 ? 132 : 128); for (int u = blockIdx.x; u < n; u += gridDim.x) gla3_unit(a, l, u, lds, tid, wave, lane); }


constexpr int CW_Q = 6144;
__device__ __forceinline__ void phase_attn(const Args& a, int l, LAS unsigned char* lds, int tid, int wave, int lane) { const int n = 256 + (l == 0 ? 8 : 0); for (int u = blockIdx.x; u < n; u += gridDim.x) attn_unit(a, l, u, lds, tid, wave, lane); }
#define DYN_BEGIN(ctrword) unsigned* _ctr = (unsigned*)(a.ws + WS_CTL) + (ctrword); volatile LAS int* _qs = (volatile LAS int*)(lds + LDS_BYTES - 32); int u; \
        { if (threadIdx.x == 0) _qs[0] = (int)atomicAdd(_ctr, 1u); __syncthreads(); u = _qs[0]; __syncthreads(); }
#define DYN_SEG(hi, BODY) while (u < (hi)) { unsigned _nx = 0u; if (threadIdx.x == 0) _nx = atomicAdd(_ctr, 1u); \
        BODY; \
        if (threadIdx.x == 0) _qs[0] = (int)_nx; \
        __syncthreads(); u = _qs[0]; }
__device__ __forceinline__ void conv_queue(const Args& a, int l, int half, LAS unsigned char* lds) {
    unsigned* c2 = (unsigned*)(a.ws + WS_CTL) + CW_Q + 64 * (8 + 2 * l + half); volatile LAS int* q2 = (volatile LAS int*)(lds + LDS_BYTES - 64);
    if (threadIdx.x == 0) q2[0] = (int)atomicAdd(c2, 1u);
    __syncthreads(); int cu = q2[0]; __syncthreads();
    while (cu < CONV_UNITS_PH) { unsigned n2 = 0u; if (threadIdx.x == 0) n2 = atomicAdd(c2, 1u);
        { const int t2 = fresh_tid(); conv_unit(a, l, half, cu, lds, __builtin_amdgcn_readfirstlane(t2 >> 6), t2 & 63); }
        __syncthreads(); if (threadIdx.x == 0) q2[0] = (int)n2; __syncthreads(); cu = q2[0]; }
    __syncthreads();
}
__device__ __forceinline__ void phase_mix_a(const Args& a, int l, LAS unsigned char* lds, int tid, int wave, int lane, int qoff = 0) {
    const int natt = 256, total = natt + 1056;
    const bool conv_first = ((blockIdx.x >> 3) & 3) == 0;
    if (DEFER_CONV && conv_first && qoff == 0) conv_queue(a, l, 0, lds);
    {
        DYN_BEGIN(CW_Q + 64 * (2 * l + qoff));
        DYN_SEG(natt, { const int t2 = fresh_tid(); if (ATTN2) attn_unit2(a, l, u, lds, t2, __builtin_amdgcn_readfirstlane(t2 >> 6), t2 & 63); else attn_unit(a, l, u, lds, t2, __builtin_amdgcn_readfirstlane(t2 >> 6), t2 & 63); });
        DYN_SEG(total, { const int t2 = fresh_tid(); gla1_unit(a, l, u - natt, lds, t2, __builtin_amdgcn_readfirstlane(t2 >> 6), t2 & 63); });
        __syncthreads();
    }
    if (DEFER_CONV && !conv_first && qoff == 0) conv_queue(a, l, 0, lds);
}
__device__ __forceinline__ void phase_mix_b(const Args& a, int l, LAS unsigned char* lds, int tid, int wave, int lane, int qoff = 0) {
    const int nat = (l == 0 ? 8 : 0), ncg = nat + (l == 0 ? 132 : 128) * 2, ng3 = 8 * (l == 0 ? 132 : 128), npu = (l == 0 ? MT : ML) / 32, total = ncg + ng3 + npu;
    const bool conv_first = ((blockIdx.x >> 3) & 3) == 0;
    if (DEFER_CONV && conv_first && qoff == 0) conv_queue(a, l, 1, lds);
    {
        DYN_BEGIN(CW_Q + 64 * (2 * l + 1 + qoff));
        if (l == 0) { DYN_SEG(nat, { const int t2 = fresh_tid(); attn_unit2(a, l, 256 + u, lds, t2, __builtin_amdgcn_readfirstlane(t2 >> 6), t2 & 63); }); }
        DYN_SEG(ncg, { const int t2 = fresh_tid(); cgate_unit(a, l, u - nat, lds, t2, __builtin_amdgcn_readfirstlane(t2 >> 6), t2 & 63); });
        DYN_SEG(ncg + npu, { const int t2 = fresh_tid(); __syncthreads(); pool_unit(a, l, u - ncg, __builtin_amdgcn_readfirstlane(t2 >> 6), t2 & 63); });
        DYN_SEG(total, { const int t2 = fresh_tid(); gla3_unit(a, l, u - ncg - npu, lds, t2, __builtin_amdgcn_readfirstlane(t2 >> 6), t2 & 63); });
        __syncthreads();
    }
    if (DEFER_CONV && !conv_first && qoff == 0) conv_queue(a, l, 1, lds);
}

__global__ void __launch_bounds__(512, 2) mk_fwd(Args a_formal) {
    const Args& a = *(const Args*)(const __attribute__((address_space(4))) Args*)__builtin_amdgcn_kernarg_segment_ptr();
    extern __shared__ __attribute__((aligned(16))) unsigned char lds_raw[];
    LAS unsigned char* lds = (LAS unsigned char*)lds_raw;
    const int lo = a.ph_lo, hi = a.ph_hi;
#define tid fresh_tid()
#define lane (fresh_tid() & 63)
#define wave __builtin_amdgcn_readfirstlane(fresh_tid() >> 6)
#if N_LAUNCH_MODE == 1
    volatile LAS unsigned* xbw = (volatile LAS unsigned*)(lds + LDS_BYTES - 16);
    if (threadIdx.x == 0) { xbw[0] = 0u; xbw[1] = 0u; }
    __syncthreads();
    XcdBarrier bar = xcd_barrier_post((unsigned*)(a.ws + WS_CTL) + CW_BAR, xbw);
#define GRID_BAR() xcd_barrier(bar)
#else
#define GRID_BAR() do { } while (0)
#endif
#ifdef ONLY_PHASE
#define IN(k) ((k) % 10 == ONLY_PHASE % 10 && ((k) == 0) == (ONLY_PHASE == 0) && ((k) == 21) == (ONLY_PHASE == 21) && lo <= (k) && (k) < hi)
#else
#define IN(k) (lo <= (k) && (k) < hi)
#endif
#define SEAM(k) do { if (hi > (k) + 1) GRID_BAR(); } while (0)
#define RPT(code, call) do { call; if (REPEAT == (code)) { __syncthreads(); call; } } while (0)
    if (IN(0)) { phase_absmax(a, tid, lane); GRID_BAR(); RPT(0, phase_prologue(a, lds, tid, wave, lane)); SEAM(0); }
#define LAYER_PHASES(l) do { constexpr int pb = 1 + 10 * (l); \
        if (IN(pb + 0)) { if (l == 0) phase_norm1<0>(a, l, wave, lane); else phase_norm1<1>(a, l, wave, lane); SEAM(pb + 0); } \
        if (IN(pb + 1)) { if (USE_G256 & 1) RPT(2, phase_proj2(a, l, lds)); else phase_proj(a, l, wave, lane); SEAM(pb + 1); } \
        if (IN(pb + 2)) { if (DYNQ) { phase_mix_a(a, l, lds, tid, wave, lane); if (REPEAT == 33) { __syncthreads(); phase_mix_a(a, l, lds, tid, wave, lane, 4); } } else { RPT(31, phase_gla1b(a, l, lds, tid, wave, lane)); RPT(32, phase_attn(a, l, lds, tid, wave, lane)); } SEAM(pb + 2); } \
        if (IN(pb + 3)) { RPT(41, phase_gla2b(a, tid)); if (!DYNQ) { RPT(42, phase_pool2(a, l, wave, lane)); RPT(43, phase_cgate2(a, l, lds, tid, wave, lane)); } SEAM(pb + 3); } \
        if (IN(pb + 4)) { if (DYNQ) { phase_mix_b(a, l, lds, tid, wave, lane); if (REPEAT == 35) { __syncthreads(); phase_mix_b(a, l, lds, tid, wave, lane, 4); } } else RPT(5, phase_gla3b(a, l, lds, tid, wave, lane)); SEAM(pb + 4); } \
        if (IN(pb + 5)) { if (USE_G256 & 2) RPT(6, phase_merge2(a, l, lds)); else phase_merge(a, l, wave, lane); SEAM(pb + 5); } \
        if (IN(pb + 6)) { if (USE_G256 & 4) { RPT(7, phase_outproj2(a, l, lds)); if (REPEAT == 107) { __syncthreads(); phase_outproj2(a, l, lds, 1); } } else phase_outproj(a, l, wave, lane); SEAM(pb + 6); } \
        if (IN(pb + 7)) { phase_norm2_router(a, l, lds, tid, wave, lane); SEAM(pb + 7); } \
        if (IN(pb + 8)) { RPT(9, phase_moe12(a, l, lds, tid)); SEAM(pb + 8); } \
        if (IN(pb + 9)) {   if (N_LAUNCH_MODE == 0) { SEAM(pb + 9); } } \
    } while (0)
    LAYER_PHASES(0);
    LAYER_PHASES(1);
    if (IN(21)) RPT(21, phase_norm1<2>(a, 2, wave, lane));
#undef tid
#undef lane
#undef wave
}

extern "C" void kernel_launch(void* const* d_in, const int* in_sizes, int n_in, void* d_out, int out_size, void* d_ws, size_t ws_size, hipStream_t stream) {
    static int grid = 0;
    if (grid == 0) {
        if (n_in != 28 || ws_size < WS_END) { fprintf(stderr, "kernel_launch: unexpected n_in %d / ws %zu (need %zu)\n", n_in, ws_size, (size_t)WS_END); grid = -1; return; }
        int dev = 0, cus = 0;
        if (hipGetDevice(&dev) != hipSuccess || hipDeviceGetAttribute(&cus, hipDeviceAttributeMultiprocessorCount, dev) != hipSuccess) { grid = -1; return; }
        if (hipFuncSetAttribute((const void*)mk_fwd, hipFuncAttributeMaxDynamicSharedMemorySize, LDS_BYTES) != hipSuccess) { grid = -1; return; }
        int per_cu = 0;
        if (hipOccupancyMaxActiveBlocksPerMultiprocessor(&per_cu, (const void*)mk_fwd, 512, LDS_BYTES) != hipSuccess || per_cu < 1) fprintf(stderr, "kernel_launch: occupancy query says %d\n", per_cu);
        (void)hipGetLastError();
        grid = cus;
    }
    if (grid < 0) return;
    (void)hipMemsetAsync((char*)d_ws + WS_CTL, 0, CTL_ZERO_BYTES, stream);
    Args a{};
    for (int i = 0; i < 28; ++i) a.in[i] = (const float*)d_in[i];
    a.out = (float*)d_out; a.ws = (unsigned char*)d_ws;
#if N_LAUNCH_MODE == 1
    a.ph_lo = 0; a.ph_hi = NPH;
    hipLaunchKernelGGL(mk_fwd, dim3(grid), dim3(512), LDS_BYTES, stream, a);
#else
    for (int p = 0; p < NPH; ++p) { a.ph_lo = p; a.ph_hi = p + 1; hipLaunchKernelGGL(mk_fwd, dim3(grid), dim3(512), LDS_BYTES, stream, a); }
#endif
}
```

```cpp
#include <hip/hip_runtime.h>
#include <cstdio>
#include <cstdint>

#define GAS __attribute__((address_space(1)))
#define LAS __attribute__((address_space(3)))
typedef unsigned short bf16;
typedef short bf16x8 __attribute__((ext_vector_type(8)));
typedef short s16x4 __attribute__((ext_vector_type(4)));
typedef float f32x4 __attribute__((ext_vector_type(4)));
typedef float f32x2 __attribute__((ext_vector_type(2)));
typedef unsigned u32x4 __attribute__((ext_vector_type(4)));
typedef unsigned u32x2 __attribute__((ext_vector_type(2)));
typedef int i32x4q __attribute__((ext_vector_type(4)));

#ifndef USE_G256
#define USE_G256 31
#endif
#ifndef ATTN2
#define ATTN2 1
#endif
#ifndef DYNQ
#define DEFER_CONV 1
#define DYNQ 1
#endif
#ifndef FP8Z
#define FP8Z 1
#endif
#ifndef MIX2
#define MIX2 7
#endif
#ifndef REPEAT
#define REPEAT -1
#endif
#ifndef N_LAUNCH_MODE
#define N_LAUNCH_MODE 1
#endif

constexpr int LDS_BYTES = 147456;
constexpr int D = 2048, SEQ = 8192, CTXL = 256, ML = 16384, MT = 16896;
constexpr int ZS = 4224;
constexpr int DP = 2176;
constexpr int ZQ = 0, ZK = 512, ZV = 640, ZP = 768, ZUV = 1280, ZGQ = 2304, ZGK = 2560, ZGV = 2816, ZGR = 3328, ZGLR = 3840, ZGATE = 4096;
constexpr int NPH = 22;
constexpr int CAP = 16896;
constexpr float LOG2E = 1.4426950408889634f;

constexpr size_t MiB = 1u << 20;
constexpr size_t WS_CTL = 0, CTL_ZERO_BYTES = 1 * MiB;
constexpr size_t WS_MOD = 1 * MiB;
constexpr size_t WS_ROPE = 1 * MiB + 512 * 1024;
constexpr size_t WS_PWT = 2 * MiB;
constexpr size_t WS_WSB = 2 * MiB + 512 * 1024;
constexpr size_t WS_LIST = 3 * MiB;
constexpr size_t WS_LISTW = 5 * MiB;
constexpr size_t WS_DECAY = 7 * MiB;
constexpr size_t WS_WCAT = 8 * MiB;
constexpr size_t WS_WCAT8 = 40 * MiB;
constexpr size_t WS_H8 = 88 * MiB;
constexpr size_t WS_WB = 122 * MiB;
constexpr size_t WS_WO = 138 * MiB;
constexpr size_t WS_WGU = 156 * MiB;
constexpr size_t WS_WD = 412 * MiB;
constexpr size_t WS_X = 540 * MiB;
constexpr size_t WS_H = 672 * MiB;
constexpr size_t WS_O = 738 * MiB;
constexpr size_t WS_S = 804 * MiB;
constexpr size_t WS_Z = 870 * MiB;
constexpr size_t WS_G8 = 1008 * MiB;
constexpr size_t WS_MX = 870 * MiB;
constexpr size_t WS_ACT = 870 * MiB;
constexpr size_t WS_Y = 944 * MiB;
constexpr size_t WS_SB = 1140 * MiB;
constexpr size_t WS_ACC = 1173 * MiB;
constexpr size_t WS_RS = 1244 * MiB;
constexpr size_t WS_H8I = 1245 * MiB;
constexpr size_t WS_ACC8 = 1279 * MiB;
constexpr size_t WS_WO8 = 1311 * MiB;
constexpr size_t WS_END = 1319 * MiB;
constexpr float EXPERT_MARGIN = 1.25f;
constexpr float W8SCALE = 64.f;
constexpr int CW_CNT = 64;
constexpr int CW_BAR = 8192;
constexpr int CW_WMAX = 12288;

__device__ __forceinline__ int fresh_tid() { int t; asm volatile("v_mov_b32 %0, %1" : "=v"(t) : "v"((int)threadIdx.x)); return t; }
__device__ __forceinline__ float bf2f(unsigned b) { return __uint_as_float(b << 16); }
__device__ __forceinline__ unsigned f2bf(float f) { return (unsigned)__builtin_bit_cast(unsigned short, (__bf16)f); }
typedef __bf16 bf16x2n __attribute__((ext_vector_type(2)));
typedef float f32x2n __attribute__((ext_vector_type(2)));
__device__ __forceinline__ unsigned pk2(float lo, float hi) { return __builtin_bit_cast(unsigned, __builtin_convertvector((f32x2n){lo, hi}, bf16x2n)); }
__device__ __forceinline__ unsigned q8pack(float a, float b, float c, float d) {
    const unsigned u0 = __float_as_uint(a + 12582912.f), u1 = __float_as_uint(b + 12582912.f), u2 = __float_as_uint(c + 12582912.f), u3 = __float_as_uint(d + 12582912.f);
    return __builtin_amdgcn_perm(u1, u0, 0x0c0c0400u) | __builtin_amdgcn_perm(u3, u2, 0x04000c0cu); }
__device__ __forceinline__ void unpack8(const u32x4 r, float (&o)[8]) {
    o[0] = __uint_as_float(r.x << 16); o[1] = __uint_as_float(r.x & 0xffff0000u); o[2] = __uint_as_float(r.y << 16); o[3] = __uint_as_float(r.y & 0xffff0000u);
    o[4] = __uint_as_float(r.z << 16); o[5] = __uint_as_float(r.z & 0xffff0000u); o[6] = __uint_as_float(r.w << 16); o[7] = __uint_as_float(r.w & 0xffff0000u);
}
__device__ __forceinline__ u32x4 pack8(const float (&o)[8]) { u32x4 r; r.x = pk2(o[0], o[1]); r.y = pk2(o[2], o[3]); r.z = pk2(o[4], o[5]); r.w = pk2(o[6], o[7]); return r; }
__device__ __forceinline__ float wave_sum(float v) {
#pragma unroll
    for (int o = 1; o < 64; o <<= 1) v += __shfl_xor(v, o);
    return v;
}
__device__ __forceinline__ int perm16(int n, int i) { return 8 * (i >> 2) + 4 * n + (i & 3); }
__device__ __forceinline__ float sigmoidf_(float x) { return __builtin_amdgcn_rcpf(1.f + __builtin_amdgcn_exp2f(-1.4426950408889634f * x)); }
__device__ __forceinline__ float gelu_tanh(float x) { const float u = x * (2.302208198f + 0.1029432397f * x * x); return x * __builtin_amdgcn_rcpf(1.f + __builtin_amdgcn_exp2f(-u)); }
#define MFMA16(a, b, c) __builtin_amdgcn_mfma_f32_16x16x32_bf16((a), (b), (c), 0, 0, 0)

__device__ __forceinline__ size_t g8_off(int i, int pm, int pn, int wv, int ai, int m, int bj, int ln) { return ((size_t)((i * 66 + pm) * 8 + pn) << 16) + (size_t)((((wv * 2 + ai) * 4 + m) * 2 + bj) * 64 + ln) * 8; }
struct Args { const float* in[28]; float* out; unsigned char* ws; int ph_lo, ph_hi; };

#define XB_TMO      128
#define XB_XCNT(j)  (256  + 64 * (j))
#define XB_XSUB(j)  (1280 + 64 * (j))
#define XB_XGEN(j)  (2304 + 64 * (j))
#define XB_TOP      3328
#define XB_TOPGEN   3392
#define XCD_BAR_WORDS 3456
#define XB_SPIN_CAP (1u << 18)
__device__ __forceinline__ unsigned xb_ld(unsigned* p)              { return __hip_atomic_load(p, __ATOMIC_RELAXED, __HIP_MEMORY_SCOPE_AGENT); }
__device__ __forceinline__ unsigned xb_add(unsigned* p, unsigned v) { return __hip_atomic_fetch_add(p, v, __ATOMIC_RELAXED, __HIP_MEMORY_SCOPE_AGENT); }
__device__ __forceinline__ unsigned xb_xcc_id() { return (unsigned)__builtin_amdgcn_s_getreg((3 << 11) | 20) & 0xFu; }
#define XB_SPIN(cond, bar) do { unsigned _sp = 0; while (cond) { __builtin_amdgcn_s_sleep(1); \
    if ((++_sp & 255u) == 0u) { if (xb_ld(&(bar)[XB_TMO])) break; if (_sp > XB_SPIN_CAP) { atomicAdd(&(bar)[XB_TMO], 1u); break; } } } } while (0)
struct XcdBarrier { unsigned* bar; unsigned x; volatile LAS unsigned* st; };
__device__ __forceinline__ XcdBarrier xcd_barrier_post(unsigned* bar, volatile LAS unsigned* st) {
    XcdBarrier b; b.bar = bar; b.x = xb_xcc_id(); b.st = st;
    if (threadIdx.x == 0) (void)xb_add(&bar[XB_XCNT(b.x)], 1u);
    return b;
}
__device__ __forceinline__ void xcd_barrier_complete(unsigned* bar, unsigned x, unsigned& nloc, unsigned& nx) {
    const unsigned G = gridDim.x * gridDim.y * gridDim.z;
    unsigned sum, cnt, mine, sp = 0u;
    for (;;) {
        sum = 0u; cnt = 0u; mine = 0u;
#pragma unroll
        for (unsigned j = 0; j < 16; ++j) { const unsigned c = xb_ld(&bar[XB_XCNT(j)]); sum += c; cnt += (c > 0u) ? 1u : 0u; mine = (j == x) ? c : mine; }
        if (sum == G) break;
        __builtin_amdgcn_s_sleep(1);
        if ((++sp & 255u) == 0u) { if (xb_ld(&bar[XB_TMO])) break; if (sp > XB_SPIN_CAP) { atomicAdd(&bar[XB_TMO], 1u); break; } }
    }
    nloc = mine > 0u ? mine : 1u; nx = cnt > 0u ? cnt : 1u;
}
__device__ __forceinline__ void xcd_barrier(const XcdBarrier& b) {
    asm volatile("s_waitcnt vmcnt(0)" ::: "memory");
    __syncthreads();
    if (threadIdx.x == 0) {
        unsigned* bar = b.bar;
        __builtin_amdgcn_s_waitcnt(0);
        unsigned nloc = b.st[0], nx = b.st[1];
        if (nloc == 0u) { xcd_barrier_complete(bar, b.x, nloc, nx); b.st[0] = nloc; b.st[1] = nx; }
        const unsigned old = xb_add(&bar[XB_XSUB(b.x)], 1u);
        const unsigned gen = old / nloc;
        if (old + 1u == (gen + 1u) * nloc) {
            __builtin_amdgcn_fence(__ATOMIC_RELEASE, "agent");
            asm volatile("s_waitcnt vmcnt(0)" ::: "memory");
            const unsigned og = xb_add(&bar[XB_TOP], 1u);
            const unsigned tg = og / nx;
            if (og + 1u == (tg + 1u) * nx) xb_add(&bar[XB_TOPGEN], 1u);
            else XB_SPIN(xb_ld(&bar[XB_TOPGEN]) == tg, bar);
            __builtin_amdgcn_fence(__ATOMIC_ACQUIRE, "agent");
            xb_add(&bar[XB_XGEN(b.x)], 1u);
            asm volatile("s_waitcnt vmcnt(0)" ::: "memory");
        } else {
            XB_SPIN(xb_ld(&bar[XB_XGEN(b.x)]) == gen, bar);
            __builtin_amdgcn_fence(__ATOMIC_ACQUIRE, "agent");
            asm volatile("s_waitcnt vmcnt(0)" ::: "memory");
        }
    }
    __syncthreads();
}

__device__ __forceinline__ void tr_item(const float* W, int N, bf16* dst, int ldd, int k0, int n0, LAS float* scr, int lane) {
#pragma unroll 8
    for (int i = 0; i < 32; ++i) { const int kk = 2 * i + (lane >> 5); scr[kk * 33 + (lane & 31)] = W[(size_t)(k0 + kk) * N + n0 + (lane & 31)]; }
    asm volatile("s_waitcnt lgkmcnt(0)" ::: "memory");
    const int c = lane & 7;
#pragma unroll
    for (int j = 0; j < 4; ++j) { const int n = (lane >> 3) + 8 * j; const LAS float* s = scr + (8 * c) * 33 + n;
        u32x4 o; o.x = pk2(s[0 * 33], s[1 * 33]); o.y = pk2(s[2 * 33], s[3 * 33]); o.z = pk2(s[4 * 33], s[5 * 33]); o.w = pk2(s[6 * 33], s[7 * 33]);
        *(u32x4*)(dst + (size_t)n * ldd + k0 + 8 * c) = o; }
    asm volatile("s_waitcnt lgkmcnt(0)" ::: "memory");
}

__device__ __forceinline__ void tr_item8(const float* W, int N, unsigned char* dst, int ldd, int k0, int n0, LAS float* scr, int lane) {
#pragma unroll 8
    for (int i = 0; i < 32; ++i) { const int kk = 2 * i + (lane >> 5); scr[kk * 33 + (lane & 31)] = W[(size_t)(k0 + kk) * N + n0 + (lane & 31)]; }
    asm volatile("s_waitcnt lgkmcnt(0)" ::: "memory");
    const int n = lane >> 1, kh = (lane & 1) * 32; const LAS float* sp = scr + kh * 33 + n;
    u32x4 o[2];
#pragma unroll
    for (int q = 0; q < 8; ++q) { unsigned p = 0u;
        p = __builtin_amdgcn_cvt_pk_fp8_f32(sp[(4 * q) * 33] * W8SCALE, sp[(4 * q + 1) * 33] * W8SCALE, p, false);
        p = __builtin_amdgcn_cvt_pk_fp8_f32(sp[(4 * q + 2) * 33] * W8SCALE, sp[(4 * q + 3) * 33] * W8SCALE, p, true);
        o[q >> 2][q & 3] = p; }
    *(u32x4*)(dst + (size_t)n * ldd + k0 + kh) = o[0]; *(u32x4*)(dst + (size_t)n * ldd + k0 + kh + 16) = o[1];
    asm volatile("s_waitcnt lgkmcnt(0)" ::: "memory");
}

__device__ __forceinline__ float wave_max(float v) {
#pragma unroll
    for (int o = 1; o < 64; o <<= 1) v = fmaxf(v, __shfl_xor(v, o));
    return v;
}
template <int SAMPLE> __device__ __forceinline__ void absmax_tensor(const float* W, size_t n4, unsigned* slot, int gt, int NT, int lane) {
    float m = 0.f;
    for (size_t j = (size_t)gt; j < n4 / SAMPLE; j += (size_t)NT) { const size_t i = SAMPLE == 1 ? j : ((j >> 6) * SAMPLE << 6) + (j & 63); const f32x4 v = ((const f32x4*)W)[i]; m = fmaxf(m, fmaxf(fmaxf(fabsf(v[0]), fabsf(v[1])), fmaxf(fabsf(v[2]), fabsf(v[3])))); }
    m = wave_max(m);
    if (lane == 0) atomicMax(slot, __float_as_uint(m));
}
__device__ __forceinline__ void phase_absmax(const Args& a, int tid, int lane) {
    const int gt = blockIdx.x * 512 + tid, NT = gridDim.x * 512;
    unsigned* wm = (unsigned*)(a.ws + WS_CTL) + CW_WMAX;
    for (int l = 0; l < 2; ++l) {
        absmax_tensor<1>(a.in[9] + (size_t)l * 2048 * 3872, (size_t)2048 * 3872 / 4, wm + l, gt, NT, lane);
        absmax_tensor<8>(a.in[21] + (size_t)l * 4 * 2048 * 2048, (size_t)4 * 2048 * 2048 / 4, wm + 2 + l, gt, NT, lane);
        absmax_tensor<8>(a.in[22] + (size_t)l * 2048 * 2048, (size_t)2048 * 2048 / 4, wm + 68 + l, gt, NT, lane);
    }
    { const int wv = gt >> 6, NWV = NT >> 6;
        for (int w2 = wv; w2 < 2048; w2 += NWV) { const int t = w2 & 63, sub = w2 >> 6; const float* W = (t < 32 ? a.in[25] : a.in[26]) + (size_t)(t & 31) * 2048 * 1024; float m = 0.f;
#pragma unroll 8
            for (int k = 0; k < 32; ++k) { const f32x4 v = ((const f32x4*)(W + (size_t)(sub + 32 * k) * 8 * 256))[lane]; m = fmaxf(m, fmaxf(fmaxf(fabsf(v[0]), fabsf(v[1])), fmaxf(fabsf(v[2]), fabsf(v[3])))); }
            m = wave_max(m); if (lane == 0) atomicMax(wm + 4 + t, __float_as_uint(m)); } }
}
struct TrDesc { const float* W; bf16* dst; unsigned char* dst8; int N, ldd, ldd8, k0, n0, fp8, late; float qinv; };
constexpr int TR_C0 = 2 * 3872, TR_C1 = TR_C0 + 8 * 2048, TR_C2 = TR_C1 + 8 * 512, TR_C3 = TR_C2 + 2 * 2048, TR_C4 = TR_C3 + 32 * 1024, TR_C5 = TR_C4 + 32 * 1024, TR_C6 = TR_C5 + 32 * 1024, TR_ITEMS = TR_C6 + 8 * 8;
__device__ __forceinline__ void tr_desc(const Args& a, int it, TrDesc& d) {
    unsigned char* ws = a.ws; const float* W; int N, ii; bf16* dst; int ldd; int rowsel = 0; unsigned char* dst8 = nullptr; int ldd8 = 0, widx = -1;
    if (it < TR_C0) { const int m = it / 3872; ii = it % 3872; W = a.in[9] + (size_t)m * 2048 * 3872; N = 3872; dst = (bf16*)(ws + WS_WCAT) + (size_t)m * 4096 * 2048; ldd = 2048; dst8 = (unsigned char*)(ws + WS_WCAT8) + (size_t)m * 12288 * 2048; }
    else if (it < TR_C1) { const int r = it - TR_C0, m = r / 2048; ii = r % 2048; W = a.in[21] + (size_t)m * 2048 * 2048; N = 2048; dst = nullptr; ldd = 2048; dst8 = (unsigned char*)(ws + WS_WCAT8) + ((size_t)(m >> 2) * 12288 + 4096 + (size_t)(m & 3) * 2048) * 2048; }
    else if (it < TR_C2) { const int r = it - TR_C1, m = r / 512; ii = r % 512; W = a.in[20] + (size_t)m * 512 * 2048; N = 2048; dst = (bf16*)(ws + WS_WB) + (size_t)(m >> 2) * 2048 * 2048 + (size_t)(m & 3) * 512; ldd = 2048; }
    else if (it < TR_C3) { const int r = it - TR_C2, m = r / 2048; ii = r % 2048; W = a.in[22] + (size_t)m * 2048 * 2048; N = 2048; dst = (bf16*)(ws + WS_WO) + (size_t)m * 2048 * DP; ldd = DP; dst8 = (unsigned char*)(ws + WS_WO8) + (size_t)m * 2048 * 2048; ldd8 = 2048; widx = 68 + m; }
    else if (it < TR_C4) { const int r = it - TR_C3, m = r / 1024; ii = r % 1024; W = a.in[25] + (size_t)m * 2048 * 1024; N = 1024; dst = nullptr; dst8 = (unsigned char*)(ws + WS_WGU) + (size_t)m * 2048 * 2048; ldd = 2048; rowsel = 1; widx = 4 + m; }
    else if (it < TR_C5) { const int r = it - TR_C4, m = r / 1024; ii = r % 1024; W = a.in[26] + (size_t)m * 2048 * 1024; N = 1024; dst = nullptr; dst8 = (unsigned char*)(ws + WS_WGU) + (size_t)m * 2048 * 2048; ldd = 2048; rowsel = 2; widx = 36 + m; }
    else if (it < TR_C6) { const int r = it - TR_C5, m = r / 1024; ii = r % 1024; W = a.in[27] + (size_t)m * 1024 * 2048; N = 2048; dst = (bf16*)(ws + WS_WD) + (size_t)m * 2048 * 1024; ldd = 1024; }
    else { const int r = it - TR_C6, m = r / 8; ii = r % 8; W = a.in[11] + (size_t)m * 128 * 128; N = 128; dst = (bf16*)(ws + WS_PWT) + (size_t)m * 128 * 128; ldd = 128; }
    const int nblk = N / 32, pr = ii >> 1, kb = 2 * (pr / nblk) + (ii & 1), nb = pr % nblk, n0 = 32 * nb;
    int drow = n0; if (rowsel) drow = 256 * (n0 >> 7) + 128 * (rowsel - 1) + (n0 & 127);
    d.W = W; d.N = N; d.ldd = ldd; d.k0 = 64 * kb; d.n0 = n0; d.dst = dst ? dst + (size_t)drow * ldd : nullptr; d.dst8 = dst8 ? dst8 + (size_t)drow * (ldd8 ? ldd8 : ldd) : nullptr; d.ldd8 = ldd8 ? ldd8 : ldd;
    d.qinv = 0.f; d.fp8 = 0; d.late = (it >= TR_C3 && it < TR_C6);
    if (dst8) { const unsigned* wm = (const unsigned*)(ws + WS_CTL) + CW_WMAX; if (widx < 0) widx = it < TR_C0 ? it / 3872 : 2 + ((it - TR_C0) / 2048 >> 2);
        float amax = __uint_as_float(__hip_atomic_load(wm + widx, __ATOMIC_RELAXED, __HIP_MEMORY_SCOPE_AGENT)); if (widx >= 4 && widx < 68) amax *= EXPERT_MARGIN; d.fp8 = (it >= TR_C0 && it < TR_C3); if (ldd8 == 0) ldd8 = ldd; d.qinv = amax > 0.f ? (d.fp8 ? 128.f : 127.f) / amax : 0.f; }
}
__device__ __forceinline__ void tr_load(const TrDesc& d, int lane, f32x4 (&rv)[8]) {
    const float* p = d.W + (size_t)(d.k0 + (lane >> 3)) * d.N + d.n0 + 4 * (lane & 7);
#pragma unroll
    for (int i = 0; i < 8; ++i) rv[i] = __builtin_nontemporal_load((const f32x4*)(p + (size_t)(8 * i) * d.N));
}
__device__ __forceinline__ void tr_finish(const TrDesc& d, const f32x4 (&rv)[8], LAS float* scr, int lane) {
    constexpr int SK = 68;
    { const int kr = lane >> 3, n4 = lane & 7;
#pragma unroll
        for (int i = 0; i < 8; ++i)
#pragma unroll
            for (int e = 0; e < 4; ++e) scr[(4 * n4 + e) * SK + 8 * i + kr] = rv[i][e]; }
    asm volatile("s_waitcnt lgkmcnt(0)" ::: "memory");
    if (d.dst) { const int c = lane & 7;
#pragma unroll
        for (int j = 0; j < 4; ++j) { const int n = (lane >> 3) + 8 * j; const LAS float* sp = scr + n * SK + 8 * c; const f32x4 a0 = *(const LAS f32x4*)sp, a1 = *(const LAS f32x4*)(sp + 4);
            u32x4 o; o.x = pk2(a0[0], a0[1]); o.y = pk2(a0[2], a0[3]); o.z = pk2(a1[0], a1[1]); o.w = pk2(a1[2], a1[3]);
            if (d.late) __builtin_nontemporal_store(o, (u32x4*)(d.dst + (size_t)n * d.ldd + d.k0 + 8 * c)); else *(u32x4*)(d.dst + (size_t)n * d.ldd + d.k0 + 8 * c) = o; } }
    if (d.dst8) {
#pragma unroll
        for (int hh = 0; hh < 2; ++hh) { const int n = (lane >> 2) + 16 * hh, q4 = (lane & 3) * 16; const LAS float* sp = scr + n * SK + q4; u32x4 o;
#pragma unroll
            for (int q = 0; q < 4; ++q) { const f32x4 w = *(const LAS f32x4*)(sp + 4 * q); unsigned p = 0u;
                if (d.fp8) { p = __builtin_amdgcn_cvt_pk_fp8_f32(w[0] * d.qinv, w[1] * d.qinv, p, false); p = __builtin_amdgcn_cvt_pk_fp8_f32(w[2] * d.qinv, w[3] * d.qinv, p, true); }
                else {
                    const unsigned u0 = __float_as_uint(__builtin_amdgcn_fmed3f(w[0] * d.qinv, -127.f, 127.f) + 12582912.f), u1 = __float_as_uint(__builtin_amdgcn_fmed3f(w[1] * d.qinv, -127.f, 127.f) + 12582912.f);
                    const unsigned u2 = __float_as_uint(__builtin_amdgcn_fmed3f(w[2] * d.qinv, -127.f, 127.f) + 12582912.f), u3 = __float_as_uint(__builtin_amdgcn_fmed3f(w[3] * d.qinv, -127.f, 127.f) + 12582912.f);
                    p = __builtin_amdgcn_perm(u1, u0, 0x0c0c0400u) | __builtin_amdgcn_perm(u3, u2, 0x04000c0cu); }
                o[q] = p; }
            if (d.late) __builtin_nontemporal_store(o, (u32x4*)(d.dst8 + (size_t)n * d.ldd8 + d.k0 + q4));
            else *(u32x4*)(d.dst8 + (size_t)n * d.ldd8 + d.k0 + q4) = o; } }
    asm volatile("s_waitcnt lgkmcnt(0)" ::: "memory");
}
__device__ __forceinline__ void phase_prologue(const Args& a, LAS unsigned char* lds, int tid, int wave, int lane) {
    unsigned char* ws = a.ws;
    if (blockIdx.x < 192) {
        LAS float* sv = (LAS float*)lds;
        LAS float* red = (LAS float*)(lds + 24576);
        for (int i = tid; i < 3 * 2048; i += 512) { const int r = i >> 11, k = i & 2047; const float v = r < 2 ? a.in[1][r * 2048 + k] : a.in[3][k]; sv[i] = v / (1.f + __expf(-v)); }
        __syncthreads();
        const int l = blockIdx.x / 96, cc = blockIdx.x % 96, c4 = tid & 31, kg = tid >> 5;
        const float* wp = a.in[4] + (size_t)l * 2048 * 12288 + (size_t)(kg * 128) * 12288 + cc * 128 + c4 * 4;
        f32x4 acc0 = {0, 0, 0, 0}, acc1 = acc0, acc2 = acc0;
#pragma unroll 8
        for (int k = 0; k < 128; ++k) { const f32x4 w = __builtin_nontemporal_load((const f32x4*)(wp + (size_t)k * 12288)); const int kk = kg * 128 + k;
            acc0 += w * sv[kk]; acc1 += w * sv[2048 + kk]; acc2 += w * sv[4096 + kk]; }
#pragma unroll
        for (int e = 0; e < 4; ++e) { red[(kg * 3 + 0) * 128 + c4 * 4 + e] = acc0[e]; red[(kg * 3 + 1) * 128 + c4 * 4 + e] = acc1[e]; red[(kg * 3 + 2) * 128 + c4 * 4 + e] = acc2[e]; }
        __syncthreads();
        if (tid < 384) { const int r = tid >> 7, c = tid & 127; float s = a.in[5][l * 12288 + cc * 128 + c];
#pragma unroll
            for (int g = 0; g < 16; ++g) s += red[(g * 3 + r) * 128 + c];
            ((float*)(ws + WS_MOD))[(l * 3 + r) * 12288 + cc * 128 + c] = s; }
        __syncthreads();
    }
    {
        LAS float* scr = (LAS float*)(lds + wave * 16384);
        const int gw = blockIdx.x * 8 + wave, NGW = gridDim.x * 8;
        constexpr int NPRO = DEFER_CONV ? TR_C3 + (TR_ITEMS - TR_C6) : TR_ITEMS;
#define PRO_ITEM(i) (!DEFER_CONV ? (i) : (i) < TR_C3 ? (i) : (i) - TR_C3 + TR_C6)
        TrDesc cur; f32x4 rv[8];
        int it = gw;
        if (it < NPRO) { tr_desc(a, PRO_ITEM(it), cur); tr_load(cur, lane, rv); }
        while (it < NPRO) {
            const int nit = it + NGW; TrDesc nd = cur; f32x4 rn[8];
            if (nit < NPRO) { tr_desc(a, PRO_ITEM(nit), nd); tr_load(nd, lane, rn); }
            tr_finish(cur, rv, scr, lane);
#pragma unroll
            for (int i = 0; i < 8; ++i) rv[i] = rn[i];
            cur = nd; it = nit;
        }
#undef PRO_ITEM
    }
    {
        const int gt = blockIdx.x * 512 + tid, NT = gridDim.x * 512;
        for (int i = gt; i < 2 * 224 * 256; i += NT) { const int l = i / (224 * 256), r = i % (224 * 256); ((u32x4*)((bf16*)(ws + WS_WCAT) + ((size_t)l * 4096 + 3872) * 2048))[r] = (u32x4){0u, 0u, 0u, 0u}; }
        for (int i = gt; i < 2 * 224 * 128; i += NT) { const int l = i / (224 * 128), r = i % (224 * 128); ((u32x4*)((unsigned char*)(ws + WS_WCAT8) + ((size_t)l * 12288 + 3872) * 2048))[r] = (u32x4){0u, 0u, 0u, 0u}; }
        for (int i = gt; i < 131072; i += NT) ((bf16*)(ws + WS_WSB))[i] = (bf16)f2bf(a.in[15][i]);
        for (int i = gt; i < 2048; i += NT) { const int pos = i >> 4, f = i & 15; const float inv = exp2f(-(float)f * (13.287712379549449f / 16.f));
            float rev = (float)pos * inv * 0.15915494309189535f; rev -= floorf(rev);
            ((float*)(ws + WS_ROPE))[i] = __builtin_amdgcn_cosf(rev); ((float*)(ws + WS_ROPE))[2048 + i] = __builtin_amdgcn_sinf(rev); }
    }
}

constexpr int CONV_UNIT = 64, CONV_UNITS_PH = 3 * 16384 / CONV_UNIT / 2;
__device__ __forceinline__ void conv_finish2(const f32x4 (&ra)[8], const f32x4 (&rb)[8], LAS float* scr, int lane, bool down, bf16* dstb, unsigned char* dst8, float qinv) {
    constexpr int SK = 132;
    { const int kr = lane >> 3, n4 = lane & 7;
#pragma unroll
        for (int i = 0; i < 8; ++i)
#pragma unroll
            for (int e = 0; e < 4; ++e) { scr[(4 * n4 + e) * SK + 8 * i + kr] = ra[i][e]; scr[(4 * n4 + e) * SK + 64 + 8 * i + kr] = rb[i][e]; } }
    asm volatile("s_waitcnt lgkmcnt(0)" ::: "memory");
    if (down) { const int c = lane & 15;
#pragma unroll
        for (int j = 0; j < 8; ++j) { const int n = (lane >> 4) + 4 * j; const LAS float* sp = scr + n * SK + 8 * c; const f32x4 a0 = *(const LAS f32x4*)sp, a1 = *(const LAS f32x4*)(sp + 4);
            u32x4 o; o.x = pk2(a0[0], a0[1]); o.y = pk2(a0[2], a0[3]); o.z = pk2(a1[0], a1[1]); o.w = pk2(a1[2], a1[3]);
            __builtin_nontemporal_store(o, (u32x4*)(dstb + (size_t)n * 1024 + 8 * c)); } }
    else { const int c = lane & 7;
#pragma unroll
        for (int j = 0; j < 4; ++j) { const int n = (lane >> 3) + 8 * j; const LAS float* sp = scr + n * SK + 16 * c; u32x4 o;
#pragma unroll
            for (int q = 0; q < 4; ++q) { const f32x4 w = *(const LAS f32x4*)(sp + 4 * q);
                const unsigned u0 = __float_as_uint(__builtin_amdgcn_fmed3f(w[0] * qinv, -127.f, 127.f) + 12582912.f), u1 = __float_as_uint(__builtin_amdgcn_fmed3f(w[1] * qinv, -127.f, 127.f) + 12582912.f);
                const unsigned u2 = __float_as_uint(__builtin_amdgcn_fmed3f(w[2] * qinv, -127.f, 127.f) + 12582912.f), u3 = __float_as_uint(__builtin_amdgcn_fmed3f(w[3] * qinv, -127.f, 127.f) + 12582912.f);
                o[q] = __builtin_amdgcn_perm(u1, u0, 0x0c0c0400u) | __builtin_amdgcn_perm(u3, u2, 0x04000c0cu); }
            __builtin_nontemporal_store(o, (u32x4*)(dst8 + (size_t)n * 2048 + 16 * c)); } }
    asm volatile("s_waitcnt lgkmcnt(0)" ::: "memory");
}
__device__ __forceinline__ void conv_unit(const Args& a, int l, int half, int cu, LAS unsigned char* lds, int wave, int lane) {
    LAS float* scr = (LAS float*)(lds + wave * 17408);
    const int jb = (half * CONV_UNITS_PH + cu) * CONV_UNIT, tj = jb >> 14, r = l * 16384 + (jb & 16383), m = r >> 10, uin = (r & 1023) >> 6;
    const bool down = tj == 2;
    const int N = down ? 2048 : 1024, kbA = down ? 2 * (uin >> 1) : 2 * uin, nb0 = (down ? 32 * (uin & 1) : 0) + wave;
    float qinv = 0.f;
    if (!down) { const unsigned* wm = (const unsigned*)(a.ws + WS_CTL) + CW_WMAX; const float amax = __uint_as_float(__hip_atomic_load(wm + (tj == 0 ? 4 : 36) + m, __ATOMIC_RELAXED, __HIP_MEMORY_SCOPE_AGENT)) * EXPERT_MARGIN; qinv = amax > 0.f ? 127.f / amax : 0.f; }
    const float* W = (tj == 0 ? a.in[25] : tj == 1 ? a.in[26] : a.in[27]) + (size_t)m * 2048 * 1024;
    const float* lp = W + (size_t)(64 * kbA + (lane >> 3)) * N + 4 * (lane & 7);
#define CONV_LD2(p, RA, RB) do { const float* _p = lp + 32 * (nb0 + 8 * (p)); _Pragma("unroll") for (int _i = 0; _i < 8; ++_i) { RA[_i] = __builtin_nontemporal_load((const f32x4*)(_p + (size_t)(8 * _i) * N)); RB[_i] = __builtin_nontemporal_load((const f32x4*)(_p + (size_t)(64 + 8 * _i) * N)); } } while (0)
#define CONV_FIN2(p, RA, RB) do { const int _n0 = 32 * (nb0 + 8 * (p)); \
        conv_finish2(RA, RB, scr, lane, down, (bf16*)(a.ws + WS_WD) + (size_t)m * 2048 * 1024 + (size_t)_n0 * 1024 + 64 * kbA, \
                     (unsigned char*)(a.ws + WS_WGU) + (size_t)m * 2048 * 2048 + (size_t)(256 * (_n0 >> 7) + 128 * tj + (_n0 & 127)) * 2048 + 64 * kbA, qinv); } while (0)
    f32x4 a0[8], b0[8], a1[8], b1[8];
    CONV_LD2(0, a0, b0);
    CONV_LD2(1, a1, b1); CONV_FIN2(0, a0, b0);
    CONV_LD2(2, a0, b0); CONV_FIN2(1, a1, b1);
    CONV_LD2(3, a1, b1); CONV_FIN2(2, a0, b0);
    CONV_FIN2(3, a1, b1);
#undef CONV_LD2
#undef CONV_FIN2
}

template <int MODE> __device__ __forceinline__ void norm1_load(const Args& a, int r, int lane, const float* MODp, f32x4 (&v)[8]) {
    const int mr = r < ML ? (r >> 13) : 2;
    if (MODE == 0) { const float* src = r < ML ? a.in[0] + (size_t)r * D : a.in[2] + (size_t)(r - ML) * D;
#pragma unroll
        for (int j = 0; j < 8; ++j) v[j] = __builtin_nontemporal_load((const f32x4*)(src + 4 * lane + 256 * j)); }
    else { const bf16* xr = (const bf16*)(a.ws + WS_X) + (size_t)r * D; const bf16* y0 = (const bf16*)(a.ws + WS_Y) + (size_t)(2 * r) * D; const bf16* y1 = y0 + D; const float* g2 = MODp + mr * 12288 + 5 * 2048;
#pragma unroll
        for (int j = 0; j < 8; ++j) { const int c = 4 * lane + 256 * j; const u32x2 px = __builtin_nontemporal_load((const u32x2*)(xr + c)); f32x4 x = {bf2f(px.x & 0xffffu), bf2f(px.x >> 16), bf2f(px.y & 0xffffu), bf2f(px.y >> 16)}; const u32x2 p0 = __builtin_nontemporal_load((const u32x2*)(y0 + c)), p1 = __builtin_nontemporal_load((const u32x2*)(y1 + c)); const f32x4 g = *(const f32x4*)(g2 + c);
            x[0] += g[0] * (bf2f(p0.x & 0xffffu) + bf2f(p1.x & 0xffffu)); x[1] += g[1] * (bf2f(p0.x >> 16) + bf2f(p1.x >> 16));
            x[2] += g[2] * (bf2f(p0.y & 0xffffu) + bf2f(p1.y & 0xffffu)); x[3] += g[3] * (bf2f(p0.y >> 16) + bf2f(p1.y >> 16)); v[j] = x; } }
}
template <int MODE> __device__ __forceinline__ void norm1_finish(const Args& a, int l, int r, int lane, const float* MODl, f32x4 (&v)[8]) {
    const int mr = r < ML ? (r >> 13) : 2;
    if (MODE != 2) { bf16* xr = (bf16*)(a.ws + WS_X) + (size_t)r * D;
#pragma unroll
        for (int j = 0; j < 8; ++j) { u32x2 o; o.x = pk2(v[j][0], v[j][1]); o.y = pk2(v[j][2], v[j][3]); __builtin_nontemporal_store(o, (u32x2*)(xr + 4 * lane + 256 * j)); } }
    float ss = 0.f;
#pragma unroll
    for (int j = 0; j < 8; ++j) ss += (v[j][0] * v[j][0] + v[j][1] * v[j][1]) + (v[j][2] * v[j][2] + v[j][3] * v[j][3]);
    const float rstd = rsqrtf(wave_sum(ss) * (1.f / D) + 1e-6f);
    if (MODE == 2) { float* o = a.out + (size_t)r * D; const float* g = a.in[8];
#pragma unroll
        for (int j = 0; j < 8; ++j) { const int c = 4 * lane + 256 * j; const f32x4 gg = *(const f32x4*)(g + c); __builtin_nontemporal_store(v[j] * rstd * gg, (f32x4*)(o + c)); } }
    else { bf16* h = (bf16*)(a.ws + WS_H) + (size_t)r * D; unsigned char* h8 = (unsigned char*)(a.ws + WS_H8) + (size_t)r * D; unsigned char* h8i = (unsigned char*)(a.ws + WS_H8I) + (size_t)r * D; const float* g = a.in[6] + l * D; const float* sh = MODl + mr * 12288; const float* sc = sh + 2048;
        float am = 0.f;
#pragma unroll
        for (int j = 0; j < 8; ++j) { const int c = 4 * lane + 256 * j; const f32x4 gg = *(const f32x4*)(g + c), s1 = *(const f32x4*)(sh + c), s2 = *(const f32x4*)(sc + c);
            v[j] = (v[j] * rstd * gg) * (s2 + 1.f) + s1; am = fmaxf(am, fmaxf(fmaxf(fabsf(v[j][0]), fabsf(v[j][1])), fmaxf(fabsf(v[j][2]), fabsf(v[j][3])))); }
        am = wave_max(am);
        const float qinv = am > 0.f ? 127.f / am : 0.f;
        if (lane == 0) ((float*)(a.ws + WS_RS))[r] = am * (1.f / 127.f);
#pragma unroll
        for (int j = 0; j < 8; ++j) { const int c = 4 * lane + 256 * j; const f32x4 y = v[j];
            if (r >= ML) { u32x2 o; o.x = pk2(y[0], y[1]); o.y = pk2(y[2], y[3]); *(u32x2*)(h + c) = o; }
            *(unsigned*)(h8i + c) = q8pack(y[0] * qinv, y[1] * qinv, y[2] * qinv, y[3] * qinv);
            unsigned p8 = 0u; p8 = __builtin_amdgcn_cvt_pk_fp8_f32(y[0], y[1], p8, false); p8 = __builtin_amdgcn_cvt_pk_fp8_f32(y[2], y[3], p8, true); *(unsigned*)(h8 + c) = p8; } }
}
template <int MODE> __device__ __forceinline__ void phase_norm1(const Args& a, int l, int wave, int lane, int probe = 0) {
    const int gw = blockIdx.x * 8 + wave, NGW = gridDim.x * 8;
    const float* MODl = (const float*)(a.ws + WS_MOD) + (size_t)(l < 2 ? l : 1) * 3 * 12288;
    const float* MODp = (const float*)(a.ws + WS_MOD) + (size_t)(l > 0 ? l - 1 : 0) * 3 * 12288;
    const int nrows = (MODE == 2) ? ML : MT;
    for (int r = gw; r < nrows; r += 2 * NGW) {
        const int r2 = r + NGW; const bool has2 = r2 < nrows;
        f32x4 v[8], w[8];
        norm1_load<MODE>(a, r, lane, MODp, v);
        if (has2) norm1_load<MODE>(a, r2, lane, MODp, w);
        norm1_finish<MODE>(a, l, r, lane, MODl, v);
        if (has2) norm1_finish<MODE>(a, l, r2, lane, MODl, w);
    }
}

__device__ __forceinline__ void router_row_load(const Args& a, int r, int lane, u32x2 (&pxr)[8], u32x2 (&pmr)[8]) {
    const bf16* xr = (const bf16*)(a.ws + WS_X) + (size_t)r * D; const bf16* mx = (const bf16*)(a.ws + WS_MX) + (size_t)r * D;
#pragma unroll
    for (int j = 0; j < 8; ++j) { const int c = 4 * lane + 256 * j; pxr[j] = __builtin_nontemporal_load((const u32x2*)(xr + c)); pmr[j] = __builtin_nontemporal_load((const u32x2*)(mx + c)); }
}
__device__ __forceinline__ void router_row_norm(const Args& a, int l, int r, int lane, const float* MODl, const u32x2 (&pxr)[8], const u32x2 (&pmr)[8], f32x4 (&v)[8]) {
    const int mr = r < ML ? (r >> 13) : 2; bf16* xr = (bf16*)(a.ws + WS_X) + (size_t)r * D; float ss = 0.f;
    const float* g1 = MODl + mr * 12288 + 2 * 2048;
#pragma unroll
    for (int j = 0; j < 8; ++j) { const int c = 4 * lane + 256 * j; const u32x2 px = pxr[j]; f32x4 x = {bf2f(px.x & 0xffffu), bf2f(px.x >> 16), bf2f(px.y & 0xffffu), bf2f(px.y >> 16)}; const u32x2 pm = pmr[j]; const f32x4 gg = *(const f32x4*)(g1 + c);
        x[0] += gg[0] * bf2f(pm.x & 0xffffu); x[1] += gg[1] * bf2f(pm.x >> 16); x[2] += gg[2] * bf2f(pm.y & 0xffffu); x[3] += gg[3] * bf2f(pm.y >> 16);
        { u32x2 o; o.x = pk2(x[0], x[1]); o.y = pk2(x[2], x[3]); __builtin_nontemporal_store(o, (u32x2*)(xr + c)); } v[j] = x; ss += (x[0] * x[0] + x[1] * x[1]) + (x[2] * x[2] + x[3] * x[3]); }
    const float rstd = rsqrtf(wave_sum(ss) * (1.f / D) + 1e-6f);
    bf16* h = (bf16*)(a.ws + WS_H) + (size_t)r * D; const float* g = a.in[7] + l * D; const float* sh = MODl + mr * 12288 + 3 * 2048; const float* sc = sh + 2048;
    float am = 0.f;
#pragma unroll
    for (int j = 0; j < 8; ++j) { const int c = 4 * lane + 256 * j; const f32x4 gg = *(const f32x4*)(g + c), s1 = *(const f32x4*)(sh + c), s2 = *(const f32x4*)(sc + c);
        v[j] = (v[j] * rstd * gg) * (s2 + 1.f) + s1; am = fmaxf(am, fmaxf(fmaxf(fabsf(v[j][0]), fabsf(v[j][1])), fmaxf(fabsf(v[j][2]), fabsf(v[j][3])))); }
    am = wave_max(am); const float qinv = am > 0.f ? 127.f / am : 0.f;
    if (lane == 0) ((float*)(a.ws + WS_RS))[r] = am * (1.f / 127.f);
    unsigned char* h8i = (unsigned char*)(a.ws + WS_H8I) + (size_t)r * D; (void)h;
#pragma unroll
    for (int j = 0; j < 8; ++j) { const int c = 4 * lane + 256 * j; const f32x4 y = v[j];
        *(unsigned*)(h8i + c) = q8pack(y[0] * qinv, y[1] * qinv, y[2] * qinv, y[3] * qinv); }
}
typedef float f32x2v __attribute__((ext_vector_type(2)));
__device__ __forceinline__ void router_select(float (&p)[16], int lane, const float* rb, int rl, LAS int* SELE, LAS float* SELW) {
    { const bool up = (lane & 32) != 0;
#pragma unroll
        for (int c = 0; c < 8; ++c) { const float mine = up ? p[c + 8] : p[c], other = up ? p[c] : p[c + 8]; p[c] = mine + __shfl_xor(other, 32); } }
    { const bool up = (lane & 16) != 0;
#pragma unroll
        for (int c = 0; c < 4; ++c) { const float mine = up ? p[c + 4] : p[c], other = up ? p[c] : p[c + 4]; p[c] = mine + __shfl_xor(other, 16); } }
    { const bool up = (lane & 8) != 0;
#pragma unroll
        for (int c = 0; c < 2; ++c) { const float mine = up ? p[c + 2] : p[c], other = up ? p[c] : p[c + 2]; p[c] = mine + __shfl_xor(other, 8); } }
    { const bool up = (lane & 4) != 0; const float mine = up ? p[1] : p[0], other = up ? p[0] : p[1]; p[0] = mine + __shfl_xor(other, 4); }
    p[0] += __shfl_xor(p[0], 2); p[0] += __shfl_xor(p[0], 1);
    float lg[16];
#pragma unroll
    for (int c = 0; c < 16; ++c) { const int src = ((c >> 3) & 1) * 32 + ((c >> 2) & 1) * 16 + ((c >> 1) & 1) * 8 + (c & 1) * 4; lg[c] = __builtin_bit_cast(float, __builtin_amdgcn_readlane(__builtin_bit_cast(int, p[0]), src)); }
    int best = 0; float bestv = -3.0e38f;
    float c0 = 0, c1 = 0, c2 = 0, c3 = 0, t0 = 0, t1 = 0, t2 = 0, t3 = 0;
#pragma unroll
    for (int gI = 0; gI < 4; ++gI) {
        const float s0 = 1.f / (1.f + __expf(-lg[4 * gI])), s1 = 1.f / (1.f + __expf(-lg[4 * gI + 1])), s2 = 1.f / (1.f + __expf(-lg[4 * gI + 2])), s3 = 1.f / (1.f + __expf(-lg[4 * gI + 3]));
        const float b0 = s0 + rb[4 * gI], b1 = s1 + rb[4 * gI + 1], b2 = s2 + rb[4 * gI + 2], b3 = s3 + rb[4 * gI + 3];
        const float gs = fmaxf(fmaxf(fmaxf(b0 + b1, b0 + b2), fmaxf(b0 + b3, b1 + b2)), fmaxf(b1 + b3, b2 + b3));
        if (gs > bestv) { bestv = gs; best = gI; c0 = b0; c1 = b1; c2 = b2; c3 = b3; t0 = s0; t1 = s1; t2 = s2; t3 = s3; }
    }
    int i0 = 0; float m0 = c0; if (c1 > m0) { m0 = c1; i0 = 1; } if (c2 > m0) { m0 = c2; i0 = 2; } if (c3 > m0) { m0 = c3; i0 = 3; }
    int i1 = -1; float m1 = -3.0e38f;
    if (i0 != 0 && c0 > m1) { m1 = c0; i1 = 0; } if (i0 != 1 && c1 > m1) { m1 = c1; i1 = 1; } if (i0 != 2 && c2 > m1) { m1 = c2; i1 = 2; } if (i0 != 3 && c3 > m1) { m1 = c3; i1 = 3; }
    const float w0 = i0 == 0 ? t0 : i0 == 1 ? t1 : i0 == 2 ? t2 : t3, w1 = i1 == 0 ? t0 : i1 == 1 ? t1 : i1 == 2 ? t2 : t3;
    const float wsum = w0 + w1;
    if (lane == 0) { SELE[rl] = (4 * best + i0) | ((4 * best + i1) << 8); SELW[2 * rl] = w0 / wsum; SELW[2 * rl + 1] = w1 / wsum; }
}
__device__ __forceinline__ void phase_norm2_router(const Args& a, int l, LAS unsigned char* lds, int tid, int wave, int lane, int probe = 0) {
    constexpr int RWS = 2052;
    LAS float* RW = (LAS float*)lds;
    LAS int* SELE = (LAS int*)(lds + 131328);
    LAS float* SELW = (LAS float*)(lds + 131328 + 512);
    LAS int* SLOT = (LAS int*)(lds + 131328 + 1536);
    LAS int* BASE = (LAS int*)(lds + 131328 + 2560);
    for (int i = tid; i < 32768; i += 512) { const int k = i >> 4, c = i & 15; RW[c * RWS + k] = a.in[23][i]; }
    __syncthreads();
    const float* MODl = (const float*)(a.ws + WS_MOD) + (size_t)l * 3 * 12288;
    unsigned* cnt = (unsigned*)(a.ws + WS_CTL) + CW_CNT + 64 * 16 * l;
    int* LIST = (int*)(a.ws + WS_LIST); float* LISTW = (float*)(a.ws + WS_LISTW);
    const int nrows = (l == 0) ? MT : ML;
    const int R = (nrows + (int)gridDim.x - 1) / (int)gridDim.x, rbase = (int)blockIdx.x * R;
    const int HP = R >> 1;
    u32x2 pxa[8], pma[8], pxb[8], pmb[8];
    if (wave < HP) { router_row_load(a, rbase + wave, lane, pxa, pma); router_row_load(a, rbase + wave + HP, lane, pxb, pmb); }
    for (int rl = wave; rl < HP; rl += 8) {
        const int rl2 = rl + HP, r = rbase + rl, r2 = rbase + rl2;
        f32x4 v[8], w2[8];
        router_row_norm(a, l, r, lane, MODl, pxa, pma, v);
        router_row_norm(a, l, r2, lane, MODl, pxb, pmb, w2);
        if (rl + 8 < HP) { router_row_load(a, r + 8, lane, pxa, pma); router_row_load(a, r2 + 8, lane, pxb, pmb); }
        float p[16], q[16];
#pragma unroll
        for (int c = 0; c < 16; ++c) { f32x2v s12 = {0.f, 0.f};
#pragma unroll
            for (int j = 0; j < 8; ++j) { const f32x4 w = *(const LAS f32x4*)(RW + c * RWS + 4 * lane + 256 * j);
#pragma unroll
                for (int e = 0; e < 4; ++e) s12 = __builtin_elementwise_fma((f32x2v){v[j][e], w2[j][e]}, (f32x2v){w[e], w[e]}, s12); }
            p[c] = s12[0]; q[c] = s12[1]; asm volatile("" : "+v"(p[c]), "+v"(q[c]) :: "memory"); }
        router_select(p, lane, a.in[24], rl, SELE, SELW);
        router_select(q, lane, a.in[24], rl2, SELE, SELW);
    }
    __syncthreads();
    const int nloc = (nrows - rbase) < R ? (nrows - rbase > 0 ? nrows - rbase : 0) : R;
    if (tid < 16) { int c = 0;
        for (int rl = 0; rl < nloc; ++rl) { const int se = SELE[rl]; if ((se & 255) == tid) { SLOT[2 * rl] = c; ++c; } if ((se >> 8) == tid) { SLOT[2 * rl + 1] = c; ++c; } }
        BASE[tid] = c ? (int)atomicAdd(cnt + 64 * tid, (unsigned)c) : 0; }
    __syncthreads();
    if (tid < nloc) { const int se = SELE[tid], e0 = se & 255, e1 = se >> 8, r = rbase + tid;
        const int k0 = BASE[e0] + SLOT[2 * tid], k1 = BASE[e1] + SLOT[2 * tid + 1];
        LIST[e0 * CAP + k0] = 2 * r; LISTW[e0 * CAP + k0] = SELW[2 * tid]; LIST[e1 * CAP + k1] = 2 * r + 1; LISTW[e1 * CAP + k1] = SELW[2 * tid + 1]; }
}

namespace pg8 {
constexpr int BM = 256, BK = 64, HALF = 128, HTB = HALF * BK * 2, STAGE_BYTES = 8 * HTB, NXCD = 8, WGM = 8;
__device__ __forceinline__ int lds_byte(int r, int c) { const int st = (r >> 4) * 2 + (c >> 5), rr = r & 15, cc = c & 31, ob = rr * 64 + cc * 2; return st * 1024 + (ob ^ (((ob >> 9) & 1) << 5)); }
__device__ __forceinline__ void stage_rc(int b, int& R, int& C) { const int st = b / 1024, sb = b % 1024, swz = sb ^ (((sb >> 9) & 1) << 5); R = (st >> 1) * 16 + swz / 64; C = (st & 1) * 32 + (swz % 64) / 2; }
__device__ __forceinline__ int perm32(int rho) { const int n = rho >> 4, i = rho & 15; return 8 * (i >> 2) + 4 * n + (i & 3); }
typedef int i32x4v __attribute__((ext_vector_type(4)));
typedef int i32x8v __attribute__((ext_vector_type(8)));
__device__ __forceinline__ i32x4v lo4(i32x8v v) { return __builtin_shufflevector(v, v, 0, 1, 2, 3); }
__device__ __forceinline__ i32x4v hi4(i32x8v v) { return __builtin_shufflevector(v, v, 4, 5, 6, 7); }
__device__ __forceinline__ bf16x8 lo8(i32x8v v) { return __builtin_bit_cast(bf16x8, (i32x4v)__builtin_shufflevector(v, v, 0, 1, 2, 3)); }
__device__ __forceinline__ bf16x8 hi8(i32x8v v) { return __builtin_bit_cast(bf16x8, (i32x4v)__builtin_shufflevector(v, v, 4, 5, 6, 7)); }
__device__ __forceinline__ i32x8v cat8(bf16x8 lo, bf16x8 hi) { const i32x4v a = __builtin_bit_cast(i32x4v, lo), b = __builtin_bit_cast(i32x4v, hi); return __builtin_shufflevector(a, b, 0, 1, 2, 3, 4, 5, 6, 7); }
struct Unit { int pm, pn, e, cnt; };
__device__ __forceinline__ unsigned cvt_pk_bf16(float lo, float hi) { return pk2(lo, hi); }
__device__ __forceinline__ void static_tile(int L, int nM, int nN, int& pm, int& pn) {
    const int nwg = nM * nN; int wgid = L; { const int q = nwg / NXCD, r = nwg % NXCD, xcd = wgid % NXCD, off = wgid / NXCD; wgid = (xcd < r ? xcd * (q + 1) : r * (q + 1) + (xcd - r) * q) + off; }
    const int nig = WGM * nN, gid = wgid / nig, fm = gid * WGM, gsz = (nM - fm) < WGM ? (nM - fm) : WGM;
    pm = fm + ((wgid % nig) % gsz); pn = (wgid % nig) / gsz;
}
template <class Epi, bool KHOOK> struct HookState { struct type {}; };
template <class Epi> struct HookState<Epi, true> { typedef typename Epi::State type; };
template <class Epi, class Sched, bool KHOOK, int DT = 0>
__device__ __forceinline__ void gemm256(LAS unsigned char* lds, const char* Abase, const int Kb, const Sched& S, const Epi& E) {
    const int tid = fresh_tid(), wid = __builtin_amdgcn_readfirstlane(tid >> 6), lane = tid & 63, wr = wid >> 2, wc = wid & 3, fr = lane & 15, fq = lane >> 4;
    const int nt = Kb / 128;
    unsigned voffB[2];
#pragma unroll
    for (int i = 0; i < 2; ++i) { int R, C; stage_rc(tid * 16 + i * 8192, R, C); const int Rb = Epi::PERM ? ((R & ~31) + perm32(R & 31)) : R; voffB[i] = (unsigned)Rb * S.ldb_bytes() + (unsigned)(C * 2); }
#define PG8_RS(i) ({ int _R, _C; stage_rc(tid * 16 + (i) * 8192, _R, _C); _R; })
#define PG8_CS(i) ({ int _R, _C; stage_rc(tid * 16 + (i) * 8192, _R, _C); (unsigned)(_C * 2); })
    const unsigned kstep = 128u, hstepB = (unsigned)HALF * S.ldb_bytes();
    const __amdgpu_buffer_rsrc_t rA = __builtin_amdgcn_make_buffer_rsrc((void*)Abase, 0, 0x7fffffff, 0x00020000), rB = __builtin_amdgcn_make_buffer_rsrc((void*)S.wbase(), 0, 0x7fffffff, 0x00020000);
    const unsigned ldsw = (unsigned)wid * 1024u;
    const int aoff = lds_byte(wr * 64 + fr, fq * 8), boff = lds_byte(wc * 32 + fr, fq * 8);
#define PG8_SA(b, h) (((b) * 2 + (h)) * HTB)
#define PG8_SB(b, h) ((4 + (b) * 2 + (h)) * HTB)
#define PG8_STAGE(bufoff, rsrc, soff, voff) do { _Pragma("unroll") for (int _i = 0; _i < 2; ++_i) \
        __builtin_amdgcn_raw_ptr_buffer_load_lds(rsrc, (LAS void*)(lds + (bufoff) + ldsw + _i * 8192), 16, (int)(voff)[_i], (int)(soff), 0, 0); } while (0)
#define PG8_LDA(dst, b, h) do { _Pragma("unroll") for (int m = 0; m < 4; ++m) { const i32x4v _lo = *(const LAS i32x4v*)(lds + PG8_SA(b, h) + aoff + m * 2048), _hi = *(const LAS i32x4v*)(lds + PG8_SA(b, h) + aoff + m * 2048 + 1024); dst[m] = __builtin_shufflevector(_lo, _hi, 0, 1, 2, 3, 4, 5, 6, 7); } } while (0)
#define PG8_LDB(dst, b, h) do { _Pragma("unroll") for (int n = 0; n < 2; ++n) { const i32x4v _lo = *(const LAS i32x4v*)(lds + PG8_SB(b, h) + boff + n * 2048), _hi = *(const LAS i32x4v*)(lds + PG8_SB(b, h) + boff + n * 2048 + 1024); dst[n] = __builtin_shufflevector(_lo, _hi, 0, 1, 2, 3, 4, 5, 6, 7); } } while (0)
#define PG8_MMA(ai, bj, At, Bt) do { __builtin_amdgcn_s_setprio(1); _Pragma("unroll") for (int m = 0; m < 4; ++m) _Pragma("unroll") for (int n = 0; n < 2; ++n) { \
        if constexpr (DT == 0) { acc[ai][bj][m][n] = __builtin_amdgcn_mfma_f32_16x16x32_bf16(lo8(Bt[n]), lo8(At[m]), acc[ai][bj][m][n], 0, 0, 0); acc[ai][bj][m][n] = __builtin_amdgcn_mfma_f32_16x16x32_bf16(hi8(Bt[n]), hi8(At[m]), acc[ai][bj][m][n], 0, 0, 0); } \
        else if constexpr (DT == 1) { acc[ai][bj][m][n] = __builtin_amdgcn_mfma_scale_f32_16x16x128_f8f6f4(Bt[n], At[m], acc[ai][bj][m][n], 0, 0, 0, 0, 0, 0); } \
        else { i32x4v _c = __builtin_bit_cast(i32x4v, acc[ai][bj][m][n]); _c = __builtin_amdgcn_mfma_i32_16x16x64_i8(lo4(Bt[n]), lo4(At[m]), _c, 0, 0, 0); _c = __builtin_amdgcn_mfma_i32_16x16x64_i8(hi4(Bt[n]), hi4(At[m]), _c, 0, 0, 0); acc[ai][bj][m][n] = __builtin_bit_cast(f32x4, _c); } } \
        __builtin_amdgcn_s_setprio(0); } while (0)
#define PG8_WAIT_V(n) asm volatile("s_waitcnt vmcnt(" #n ")" ::: "memory")
#define PG8_WAIT_L(n) asm volatile("s_waitcnt lgkmcnt(" #n ")" ::: "memory")
#define PG8_BAR __builtin_amdgcn_s_barrier()
#define PG8_SCHED __builtin_amdgcn_sched_barrier(0)
    Unit cur, nxt; int ui = 0;
    if (!S.next(0, cur)) return;
    f32x4 acc[2][2][4][2];
#pragma unroll
    for (int a = 0; a < 2; ++a)
#pragma unroll
        for (int b = 0; b < 2; ++b)
#pragma unroll
            for (int m = 0; m < 4; ++m)
#pragma unroll
                for (int n = 0; n < 2; ++n) acc[a][b][m][n] = (f32x4){0.f, 0.f, 0.f, 0.f};
    i32x8v At[4], B0[2], B1[2];
    typename HookState<Epi, KHOOK>::type hst;
    unsigned vA0[2], vA1[2], nA0[2], nA1[2];
    unsigned cAs = 0u, nAs = 0u;
    const unsigned hA = Sched::GATHER ? 0u : (unsigned)HALF * S.lda_bytes();
    if constexpr (Sched::GATHER) {
#pragma unroll
        for (int i = 0; i < 2; ++i) { vA0[i] = S.arow_off(cur, PG8_RS(i)) + PG8_CS(i); vA1[i] = S.arow_off(cur, HALF + PG8_RS(i)) + PG8_CS(i); }
    } else {
#pragma unroll
        for (int i = 0; i < 2; ++i) { vA0[i] = (unsigned)PG8_RS(i) * S.lda_bytes() + PG8_CS(i); vA1[i] = vA0[i]; nA0[i] = vA0[i]; nA1[i] = vA0[i]; }
        cAs = S.aoff(cur);
    }
    unsigned cB = S.boff(cur);
    S.a_ready(cur);
    PG8_STAGE(PG8_SB(0, 0), rB, cB, voffB); PG8_STAGE(PG8_SB(0, 1), rB, cB + hstepB, voffB); PG8_STAGE(PG8_SA(0, 0), rA, cAs, vA0); PG8_STAGE(PG8_SA(0, 1), rA, cAs + hA, vA1);
    if (wr == 1) PG8_BAR;
    PG8_WAIT_V(2); PG8_BAR;
    PG8_STAGE(PG8_SB(1, 0), rB, cB + kstep, voffB); PG8_STAGE(PG8_SA(1, 0), rA, cAs + kstep, vA0); PG8_STAGE(PG8_SB(1, 1), rB, cB + hstepB + kstep, voffB);
    PG8_WAIT_V(6); PG8_BAR;
    for (;;) {
        const bool has_next = S.next(ui + 1, nxt);
        const unsigned nB = has_next ? S.boff(nxt) : cB;
        if constexpr (Sched::GATHER) {
#pragma unroll
            for (int i = 0; i < 2; ++i) { nA0[i] = has_next ? S.arow_off(nxt, PG8_RS(i)) + PG8_CS(i) : vA0[i]; nA1[i] = has_next ? S.arow_off(nxt, HALF + PG8_RS(i)) + PG8_CS(i) : vA1[i]; }
        } else nAs = has_next ? S.aoff(nxt) : cAs;
        for (int t = 0; t < nt; t += 2) {
            const bool last = (t == nt - 2);
            const unsigned a1 = cAs + (unsigned)(t + 1) * kstep;
            const unsigned a2 = last ? nAs : cAs + (unsigned)(t + 2) * kstep, b2 = last ? nB : cB + (unsigned)(t + 2) * kstep;
            const unsigned a3 = a2 + kstep, b3 = b2 + kstep;
            if (last && has_next) S.a_ready(nxt);
            unsigned w0[2], w1[2];
#pragma unroll
            for (int i = 0; i < 2; ++i) { w0[i] = (Sched::GATHER && last) ? nA0[i] : vA0[i]; w1[i] = (Sched::GATHER && last) ? nA1[i] : vA1[i]; }
            PG8_LDB(B0, 0, 0); PG8_LDB(B1, 0, 1); PG8_SCHED; PG8_LDA(At, 0, 0); PG8_STAGE(PG8_SA(1, 1), rA, a1 + hA, vA1);
            PG8_WAIT_V(8); PG8_WAIT_L(0); PG8_BAR; PG8_MMA(0, 0, At, B0); PG8_MMA(0, 1, At, B1); PG8_BAR; PG8_SCHED;
            PG8_LDA(At, 0, 1); PG8_STAGE(PG8_SB(0, 0), rB, b2, voffB); PG8_STAGE(PG8_SB(0, 1), rB, b2 + hstepB, voffB); PG8_STAGE(PG8_SA(0, 0), rA, a2, w0);
            PG8_WAIT_V(8); PG8_WAIT_L(0); PG8_BAR; PG8_MMA(1, 0, At, B0); PG8_MMA(1, 1, At, B1); PG8_BAR; PG8_SCHED;
            PG8_LDB(B0, 1, 0); PG8_LDB(B1, 1, 1); PG8_SCHED; PG8_LDA(At, 1, 0); PG8_STAGE(PG8_SA(0, 1), rA, a2 + hA, w1);
            PG8_WAIT_V(8); PG8_WAIT_L(0); PG8_BAR; PG8_MMA(0, 0, At, B0); PG8_MMA(0, 1, At, B1); PG8_BAR; PG8_SCHED;
            PG8_LDA(At, 1, 1); PG8_STAGE(PG8_SB(1, 0), rB, b3, voffB); PG8_STAGE(PG8_SB(1, 1), rB, b3 + hstepB, voffB); PG8_STAGE(PG8_SA(1, 0), rA, a3, w0);
            PG8_WAIT_V(8); PG8_WAIT_L(0); PG8_BAR; PG8_MMA(1, 0, At, B0); PG8_MMA(1, 1, At, B1); PG8_BAR; PG8_SCHED;
            if constexpr (KHOOK) { if (!last && ((t + 2) & 7) == 0) { int fr2 = fr, fq2 = fq; asm volatile("" : "+v"(fr2), "+v"(fq2)); E.khook(acc, hst, cur, ((t + 2) >> 3) - 1, wr, wc, fr2, fq2); } }
        }
        if (wr == 0) PG8_BAR;
        { int fr2 = fr, fq2 = fq; asm volatile("" : "+v"(fr2), "+v"(fq2)); if constexpr (KHOOK) E.fin(acc, hst, cur, wr, wc, fr2, fq2); else E(acc, cur, wr, wc, fr2, fq2); }
        S.done(cur);
        if (!has_next) break;
#pragma unroll
        for (int a = 0; a < 2; ++a)
#pragma unroll
            for (int b = 0; b < 2; ++b)
#pragma unroll
                for (int m = 0; m < 4; ++m)
#pragma unroll
                    for (int n = 0; n < 2; ++n) acc[a][b][m][n] = (f32x4){0.f, 0.f, 0.f, 0.f};
        cur = nxt; cB = nB; cAs = nAs; ++ui;
        if constexpr (Sched::GATHER) {
#pragma unroll
            for (int i = 0; i < 2; ++i) { vA0[i] = nA0[i]; vA1[i] = nA1[i]; } }
        if (wr == 1) PG8_BAR;
    }
    PG8_WAIT_V(0);
    PG8_BAR;
#undef PG8_RS
#undef PG8_CS
#undef PG8_SA
#undef PG8_SB
#undef PG8_STAGE
#undef PG8_LDA
#undef PG8_LDB
#undef PG8_MMA
#undef PG8_WAIT_V
#undef PG8_WAIT_L
#undef PG8_BAR
#undef PG8_SCHED
}
}

template <int UNR = 2> __device__ __forceinline__ void sgemm_k(f32x4 (&acc)[4][2][2], const bf16* (&pa)[4], const bf16* (&pb)[2][2], int K) {
#pragma unroll UNR
    for (int k = 0; k < K; k += 32) {
        bf16x8 af[4], bfr[2][2];
#pragma unroll
        for (int mi = 0; mi < 4; ++mi) af[mi] = *(const bf16x8*)(pa[mi] + k);
#pragma unroll
        for (int cp = 0; cp < 2; ++cp)
#pragma unroll
            for (int n = 0; n < 2; ++n) bfr[cp][n] = *(const bf16x8*)(pb[cp][n] + k);
#pragma unroll
        for (int mi = 0; mi < 4; ++mi)
#pragma unroll
            for (int cp = 0; cp < 2; ++cp)
#pragma unroll
                for (int n = 0; n < 2; ++n) acc[mi][cp][n] = MFMA16(bfr[cp][n], af[mi], acc[mi][cp][n]);
    }
}
#define ZERO_ACC(acc) do { _Pragma("unroll") for (int _a = 0; _a < 4; ++_a) _Pragma("unroll") for (int _b = 0; _b < 2; ++_b) _Pragma("unroll") for (int _c = 0; _c < 2; ++_c) acc[_a][_b][_c] = (f32x4){0.f, 0.f, 0.f, 0.f}; } while (0)

__device__ __forceinline__ void phase_proj(const Args& a, int l, int wave, int lane) {
    const bf16* H = (const bf16*)(a.ws + WS_H); const bf16* W = (const bf16*)(a.ws + WS_WCAT) + (size_t)l * 4096 * 2048; bf16* Z = (bf16*)(a.ws + WS_Z);
    const int fr = lane & 15, fq = lane >> 4, wr = wave >> 2, wc = wave & 3;
    for (int u = blockIdx.x; u < 132 * 48; u += gridDim.x) {
        const int pn = u % 48, pm = u / 48;
        if (l == 1 && pm >= 128 && pn >= 16) continue;
        const int r0 = 128 * pm + 64 * wr, c0 = 256 * pn + 64 * wc;
        const bf16* pa[4]; const bf16* pb[2][2];
#pragma unroll
        for (int mi = 0; mi < 4; ++mi) pa[mi] = H + (size_t)(r0 + 16 * mi + fr) * D + 8 * fq;
#pragma unroll
        for (int cp = 0; cp < 2; ++cp)
#pragma unroll
            for (int n = 0; n < 2; ++n) pb[cp][n] = W + (size_t)(c0 + 32 * cp + perm16(n, fr)) * D + 8 * fq;
        f32x4 acc[4][2][2]; ZERO_ACC(acc);
        sgemm_k(acc, pa, pb, D);
        const int act = (pn >= 5 && pn < 9) ? 1 : (pn >= 16 ? 2 : 0);
#pragma unroll
        for (int mi = 0; mi < 4; ++mi)
#pragma unroll
            for (int cp = 0; cp < 2; ++cp) { float o[8];
#pragma unroll
                for (int e = 0; e < 4; ++e) { o[e] = acc[mi][cp][0][e]; o[4 + e] = acc[mi][cp][1][e]; }
                if (act == 1) {
#pragma unroll
                    for (int e = 0; e < 8; ++e) o[e] = gelu_tanh(o[e]); }
                else if (act == 2) {
#pragma unroll
                    for (int e = 0; e < 8; ++e) o[e] = sigmoidf_(o[e]); }
                *(u32x4*)(Z + (size_t)(r0 + 16 * mi + fr) * ZS + c0 + 32 * cp + 8 * fq) = pack8(o); }
    }
}

__device__ __forceinline__ void phase_merge(const Args& a, int l, int wave, int lane) {
    const bf16* OB = (const bf16*)(a.ws + WS_O); const bf16* W = (const bf16*)(a.ws + WS_WB) + (size_t)l * 2048 * 2048; const bf16* Z = (const bf16*)(a.ws + WS_Z); bf16* ACC = (bf16*)(a.ws + WS_S);
    const int fr = lane & 15, fq = lane >> 4, wr = wave >> 2, wc = wave & 3;
    const int npm = (l == 0) ? 132 : 128;
    for (int u = blockIdx.x; u < npm * 8; u += gridDim.x) {
        const int pn = u & 7, pm = u >> 3;
        const int r0 = 128 * pm + 64 * wr, c0 = 256 * pn + 64 * wc;
        f32x4 tot[4][2][2]; ZERO_ACC(tot);
#pragma unroll 1
        for (int i = 0; i < 4; ++i) {
            const bf16* pa[4]; const bf16* pb[2][2];
#pragma unroll
            for (int mi = 0; mi < 4; ++mi) pa[mi] = OB + (size_t)(r0 + 16 * mi + fr) * D + 512 * i + 8 * fq;
#pragma unroll
            for (int cp = 0; cp < 2; ++cp)
#pragma unroll
                for (int n = 0; n < 2; ++n) pb[cp][n] = W + (size_t)(c0 + 32 * cp + perm16(n, fr)) * D + 512 * i + 8 * fq;
            f32x4 acc[4][2][2]; ZERO_ACC(acc);
            sgemm_k<1>(acc, pa, pb, 512);
#pragma unroll
            for (int mi = 0; mi < 4; ++mi)
#pragma unroll
                for (int cp = 0; cp < 2; ++cp) { float gt[8]; unpack8(*(const u32x4*)(Z + (size_t)(r0 + 16 * mi + fr) * ZS + ZGATE + 2048 * i + c0 + 32 * cp + 8 * fq), gt);
#pragma unroll
                    for (int e = 0; e < 4; ++e) { tot[mi][cp][0][e] += gt[e] * acc[mi][cp][0][e]; tot[mi][cp][1][e] += gt[4 + e] * acc[mi][cp][1][e]; } }
        }
#pragma unroll
        for (int mi = 0; mi < 4; ++mi)
#pragma unroll
            for (int cp = 0; cp < 2; ++cp) { float o[8];
#pragma unroll
                for (int e = 0; e < 4; ++e) { o[e] = tot[mi][cp][0][e]; o[4 + e] = tot[mi][cp][1][e]; }
                *(u32x4*)(ACC + (size_t)(r0 + 16 * mi + fr) * D + c0 + 32 * cp + 8 * fq) = pack8(o); }
    }
}

__device__ __forceinline__ void phase_outproj(const Args& a, int l, int wave, int lane) {
    const bf16* ACC = (const bf16*)(a.ws + WS_S); const bf16* W = (const bf16*)(a.ws + WS_WO) + (size_t)l * 2048 * 2048; float* X = (float*)(a.ws + WS_X);
    const float* MODl = (const float*)(a.ws + WS_MOD) + (size_t)l * 3 * 12288;
    const int fr = lane & 15, fq = lane >> 4, wr = wave >> 2, wc = wave & 3;
    const int npm = (l == 0) ? 132 : 128;
    for (int u = blockIdx.x; u < npm * 8; u += gridDim.x) {
        const int pn = u & 7, pm = u >> 3;
        const int r0 = 128 * pm + 64 * wr, c0 = 256 * pn + 64 * wc;
        const bf16* pa[4]; const bf16* pb[2][2];
#pragma unroll
        for (int mi = 0; mi < 4; ++mi) pa[mi] = ACC + (size_t)(r0 + 16 * mi + fr) * D + 8 * fq;
#pragma unroll
        for (int cp = 0; cp < 2; ++cp)
#pragma unroll
            for (int n = 0; n < 2; ++n) pb[cp][n] = W + (size_t)(c0 + 32 * cp + perm16(n, fr)) * D + 8 * fq;
        f32x4 acc[4][2][2]; ZERO_ACC(acc);
        sgemm_k(acc, pa, pb, D);
#pragma unroll
        for (int mi = 0; mi < 4; ++mi) { const int row = r0 + 16 * mi + fr; const int mr = row < ML ? (row >> 13) : 2;
#pragma unroll
            for (int cp = 0; cp < 2; ++cp) { const int col = c0 + 32 * cp + 8 * fq; const float* g1 = MODl + mr * 12288 + 2 * 2048 + col; float* xp = X + (size_t)row * D + col;
                const f32x4 ga = *(const f32x4*)g1, gb = *(const f32x4*)(g1 + 4); f32x4 xa = *(f32x4*)xp, xb = *(f32x4*)(xp + 4);
                xa += ga * acc[mi][cp][0]; xb += gb * acc[mi][cp][1]; *(f32x4*)xp = xa; *(f32x4*)(xp + 4) = xb; } }
    }
}

__device__ __forceinline__ void moe_table(const Args& a, int l, LAS int* tab, int tid) {
    __syncthreads();
    if (tid == 0) { const unsigned* cnt = (const unsigned*)(a.ws + WS_CTL) + CW_CNT + 64 * 16 * l; int acc = 0;
        for (int e = 0; e < 16; ++e) { const int c = (int)__hip_atomic_load(cnt + 64 * e, __ATOMIC_RELAXED, __HIP_MEMORY_SCOPE_AGENT); tab[e] = c; tab[16 + e] = acc; acc += (c + 255) >> 8; }
        tab[32] = acc; }
    __syncthreads();
}
__device__ __forceinline__ void phase_moe1(const Args& a, int l, LAS unsigned char* lds, int tid, int wave, int lane) {
    LAS int* tab = (LAS int*)lds; moe_table(a, l, tab, tid);
    const bf16* H = (const bf16*)(a.ws + WS_H); const bf16* Wl = (const bf16*)(a.ws + WS_WGU) + (size_t)l * 16 * 2048 * 2048; bf16* ACT = (bf16*)(a.ws + WS_ACT);
    const int* LIST = (const int*)(a.ws + WS_LIST);
    const int fr = lane & 15, fq = lane >> 4, wr = wave >> 2, wc = wave & 3;
    const int NTl = tab[32];
    for (int u = blockIdx.x; u < NTl * 16; u += gridDim.x) {
        const int j = u & 7, hh = (u >> 3) & 1, t = u >> 4;
        int e = 0;
#pragma unroll
        for (int q = 1; q < 16; ++q) if (t >= tab[16 + q]) e = q;
        const int cnt = tab[e], tbe = tab[16 + e], ri0 = 256 * (t - tbe) + 128 * hh + 64 * wr;
        const bf16* W = Wl + (size_t)e * 2048 * 2048;
        const bf16* pa[4]; const bf16* pb[2][2];
#pragma unroll
        for (int mi = 0; mi < 4; ++mi) { int ri = ri0 + 16 * mi + fr; ri = ri < cnt ? ri : cnt - 1; const int tok = LIST[e * CAP + ri] >> 1; pa[mi] = H + (size_t)tok * D + 8 * fq; }
#pragma unroll
        for (int cp = 0; cp < 2; ++cp)
#pragma unroll
            for (int n = 0; n < 2; ++n) pb[cp][n] = W + (size_t)(256 * j + 128 * cp + 32 * wc + perm16(n, fr)) * D + 8 * fq;
        f32x4 acc[4][2][2]; ZERO_ACC(acc);
        sgemm_k(acc, pa, pb, D);
#pragma unroll
        for (int mi = 0; mi < 4; ++mi) { float o[8];
#pragma unroll
            for (int e2 = 0; e2 < 4; ++e2) { const float g0 = acc[mi][0][0][e2], g1 = acc[mi][0][1][e2]; o[e2] = g0 * sigmoidf_(g0) * acc[mi][1][0][e2]; o[4 + e2] = g1 * sigmoidf_(g1) * acc[mi][1][1][e2]; }
            *(u32x4*)(ACT + (size_t)(tbe * 256 + ri0 + 16 * mi + fr) * 1024 + 128 * j + 32 * wc + 8 * fq) = pack8(o); }
    }
}
__device__ __forceinline__ void phase_moe2(const Args& a, int l, LAS unsigned char* lds, int tid, int wave, int lane) {
    LAS int* tab = (LAS int*)lds; moe_table(a, l, tab, tid);
    const bf16* ACT = (const bf16*)(a.ws + WS_ACT); const bf16* Wl = (const bf16*)(a.ws + WS_WD) + (size_t)l * 16 * 2048 * 1024; bf16* Y = (bf16*)(a.ws + WS_Y);
    const int* LIST = (const int*)(a.ws + WS_LIST); const float* LISTW = (const float*)(a.ws + WS_LISTW);
    const int fr = lane & 15, fq = lane >> 4, wr = wave >> 2, wc = wave & 3;
    const int NTl = tab[32];
    for (int u = blockIdx.x; u < NTl * 16; u += gridDim.x) {
        const int j = u & 7, hh = (u >> 3) & 1, t = u >> 4;
        int e = 0;
#pragma unroll
        for (int q = 1; q < 16; ++q) if (t >= tab[16 + q]) e = q;
        const int cnt = tab[e], tbe = tab[16 + e], ri0 = 256 * (t - tbe) + 128 * hh + 64 * wr;
        const bf16* W = Wl + (size_t)e * 2048 * 1024;
        const bf16* pa[4]; const bf16* pb[2][2];
#pragma unroll
        for (int mi = 0; mi < 4; ++mi) pa[mi] = ACT + (size_t)(tbe * 256 + ri0 + 16 * mi + fr) * 1024 + 8 * fq;
#pragma unroll
        for (int cp = 0; cp < 2; ++cp)
#pragma unroll
            for (int n = 0; n < 2; ++n) pb[cp][n] = W + (size_t)(256 * j + 64 * wc + 32 * cp + perm16(n, fr)) * 1024 + 8 * fq;
        f32x4 acc[4][2][2]; ZERO_ACC(acc);
        sgemm_k(acc, pa, pb, 1024);
#pragma unroll
        for (int mi = 0; mi < 4; ++mi) { const int ri = ri0 + 16 * mi + fr;
            if (ri < cnt) { const int tk = LIST[e * CAP + ri]; const float w = LISTW[e * CAP + ri];
#pragma unroll
                for (int cp = 0; cp < 2; ++cp) { float o[8];
#pragma unroll
                    for (int e2 = 0; e2 < 4; ++e2) { o[e2] = w * acc[mi][cp][0][e2]; o[4 + e2] = w * acc[mi][cp][1][e2]; }
                    *(u32x4*)(Y + (size_t)tk * D + 256 * j + 64 * wc + 32 * cp + 8 * fq) = pack8(o); } } }
    }
}


template <class Pre, class Epi>
__device__ __forceinline__ void sk_gemm_ctx(LAS unsigned char* lds, const bf16* A, int lda, const bf16* Bt, int ldb, int K, int N, const Pre& pre, const Epi& epi, int tid, int wave, int lane) {
    const int fr = lane & 15, fq = lane >> 4, ntn = N / 64, ks = K / 8;
    LAS float* P = (LAS float*)lds;
    for (int task = blockIdx.x; task < 8 * ntn; task += gridDim.x) {
        const int tm = task / ntn, tn = task % ntn, r0 = ML + 64 * tm, c0 = 64 * tn;
        const bf16* pa[4]; const bf16* pb[2][2];
#pragma unroll
        for (int mi = 0; mi < 4; ++mi) pa[mi] = A + (size_t)(r0 + 16 * mi + fr) * lda + wave * ks + 8 * fq;
#pragma unroll
        for (int cp = 0; cp < 2; ++cp)
#pragma unroll
            for (int n = 0; n < 2; ++n) pb[cp][n] = Bt + (size_t)(c0 + 32 * cp + perm16(n, fr)) * ldb + wave * ks + 8 * fq;
        f32x4 acc[4][2][2]; ZERO_ACC(acc);
        sgemm_k<4>(acc, pa, pb, ks);
        pre(acc, wave, r0, c0, fr, fq);
        __syncthreads();
#pragma unroll
        for (int mi = 0; mi < 4; ++mi)
#pragma unroll
            for (int cp = 0; cp < 2; ++cp)
#pragma unroll
                for (int n = 0; n < 2; ++n) *(LAS f32x4*)(P + wave * 4096 + (16 * mi + fr) * 64 + 32 * cp + 8 * fq + 4 * n) = acc[mi][cp][n];
        __syncthreads();
        { const int row = tid >> 3, c8 = (tid & 7) * 8; f32x4 s0 = {0.f, 0.f, 0.f, 0.f}, s1 = s0;
#pragma unroll
            for (int w = 0; w < 8; ++w) { s0 += *(const LAS f32x4*)(P + w * 4096 + row * 64 + c8); s1 += *(const LAS f32x4*)(P + w * 4096 + row * 64 + c8 + 4); }
            float v[8] = {s0[0], s0[1], s0[2], s0[3], s1[0], s1[1], s1[2], s1[3]};
            epi(r0 + row, c0 + c8, v); }
    }
    __syncthreads();
}
struct SkNoPre { __device__ __forceinline__ void operator()(f32x4 (&)[4][2][2], int, int, int, int, int) const {} };
struct SkPreMerge { const bf16* Z;
    __device__ __forceinline__ void operator()(f32x4 (&acc)[4][2][2], int w, int r0, int c0, int fr, int fq) const {
#pragma unroll
        for (int mi = 0; mi < 4; ++mi)
#pragma unroll
            for (int cp = 0; cp < 2; ++cp) { const int row = r0 + 16 * mi + fr, col = c0 + 32 * cp + 8 * fq, rr = row & 255, cc = col & 255;
                const u32x2 g8 = *(const u32x2*)((const unsigned char*)Z + g8_off(w >> 1, row >> 8, col >> 8, ((rr >> 6) & 1) * 4 + ((cc >> 5) & 3), rr >> 7, (rr >> 4) & 3, cc >> 7, ((cc >> 3) & 3) * 16 + (rr & 15)));
#pragma unroll
                for (int e = 0; e < 4; ++e) { acc[mi][cp][0][e] *= (float)((g8.x >> (8 * e)) & 255u) * (1.f / 255.f); acc[mi][cp][1][e] *= (float)((g8.y >> (8 * e)) & 255u) * (1.f / 255.f); } }
    }
};
struct SkEpiProj { bf16* Z;
    __device__ __forceinline__ void operator()(int row, int col, float (&v)[8]) const { const int pn = col >> 8;
        if (pn >= 5 && pn < 9) {
#pragma unroll
            for (int e = 0; e < 8; ++e) v[e] = gelu_tanh(v[e]); }
        *(u32x4*)(Z + (size_t)row * ZS + col) = pack8(v); }
};
struct SkEpiAcc { bf16* ACC; int ld; __device__ __forceinline__ void operator()(int row, int col, float (&v)[8]) const { *(u32x4*)(ACC + (size_t)row * ld + col) = pack8(v); } };
struct SkEpiOut { float* X; const float* g1;
    __device__ __forceinline__ void operator()(int row, int col, float (&v)[8]) const { float* xp = X + (size_t)row * D + col; const f32x4 ga = *(const f32x4*)(g1 + col), gb = *(const f32x4*)(g1 + col + 4);
        f32x4 xa = *(f32x4*)xp, xb = *(f32x4*)(xp + 4); xa += ga * (f32x4){v[0], v[1], v[2], v[3]}; xb += gb * (f32x4){v[4], v[5], v[6], v[7]}; *(f32x4*)xp = xa; *(f32x4*)(xp + 4) = xb; }
};

struct DenseOrder {            static constexpr bool GATHER = false;
    int nM, nN, exN, exCnt, exM0, G, c, lda2, K2; const char* Bt; int exPn0 = 0;
    __device__ __forceinline__ bool next(int i, pg8::Unit& u) const {
        const int L = i * G + c, nmain = nM * nN;
        if (L < nmain) { pg8::static_tile(L, nM, nN, u.pm, u.pn); }
        else { const int idx = L - nmain; if (idx >= exCnt) return false; u.pm = exM0 + idx / exN; u.pn = exPn0 + idx % exN; }
        u.e = 0; u.cnt = 256; return true;
    }
    __device__ __forceinline__ unsigned arow_off(const pg8::Unit& u, int r) const { return (unsigned)(u.pm * 256 + r) * (unsigned)lda2; }
    __device__ __forceinline__ void a_ready(const pg8::Unit&) const {}
    __device__ __forceinline__ void done(const pg8::Unit&) const {}
    __device__ __forceinline__ unsigned lda_bytes() const { return (unsigned)lda2; }
    __device__ __forceinline__ unsigned ldb_bytes() const { return (unsigned)K2; }
    __device__ __forceinline__ unsigned aoff(const pg8::Unit& u) const { return (unsigned)u.pm * 256u * (unsigned)lda2; }
    __device__ __forceinline__ const char* wbase() const { return Bt; }
    __device__ __forceinline__ unsigned boff(const pg8::Unit& u) const { return (unsigned)u.pn * 256u * (unsigned)K2; }
};
struct MoeOrder {              static constexpr bool GATHER = true;
    const LAS int* tab; int G, c, K2, gather; const int* LIST; const char* W; size_t wstride;
    int i0, base; unsigned* tcnt; unsigned* tmo;
    __device__ __forceinline__ void a_ready(const pg8::Unit& u) const {
        if (gather) return;
        if (threadIdx.x < 64) { unsigned spins = 0u;
            while ((unsigned)__builtin_amdgcn_readfirstlane(__hip_atomic_load(tcnt + 64 * u.pm, __ATOMIC_RELAXED, __HIP_MEMORY_SCOPE_AGENT)) < 64u) {
                __builtin_amdgcn_s_sleep(2);
                if ((++spins & 255u) == 0u) { if (__hip_atomic_load(tmo, __ATOMIC_RELAXED, __HIP_MEMORY_SCOPE_AGENT) != 0u) break; if (spins > (1u << 20)) { if (threadIdx.x == 0) __hip_atomic_store(tmo, 1u, __ATOMIC_RELAXED, __HIP_MEMORY_SCOPE_AGENT); break; } } }
            __builtin_amdgcn_fence(__ATOMIC_ACQUIRE, "agent");
            asm volatile("s_waitcnt vmcnt(0)" ::: "memory"); }
        asm volatile("" ::: "memory"); __builtin_amdgcn_s_barrier(); asm volatile("" ::: "memory");
    }
    __device__ __forceinline__ void done(const pg8::Unit& u) const {
        if (!gather) return;
        asm volatile("s_waitcnt vmcnt(0)" ::: "memory");
        if ((threadIdx.x & 63) == 0) __hip_atomic_fetch_add(tcnt + 64 * u.pm, 1u, __ATOMIC_RELAXED, __HIP_MEMORY_SCOPE_AGENT);
    }
    __device__ __forceinline__ bool next(int i, pg8::Unit& u) const {
        const int L = (i + i0) * G + c - base; if (L >= tab[32] * 8) return false;
        const int t = L >> 3; int e = 0;
#pragma unroll
        for (int q = 1; q < 16; ++q) if (t >= tab[16 + q]) e = q;
        u.pm = t; u.pn = L & 7; u.e = e; u.cnt = tab[e] - 256 * (t - tab[16 + e]);
        return true;
    }
    __device__ __forceinline__ unsigned arow_off(const pg8::Unit& u, int r) const {
        if (gather) { const int t0 = tab[16 + u.e]; int ri = 256 * (u.pm - t0) + r; const int last = tab[u.e] - 1; ri = ri < last ? ri : last; const int tok = LIST[u.e * CAP + ri] >> 1; return (unsigned)tok * 2048u; }
        return (unsigned)(u.pm * 256 + r) * 2048u;
    }
    __device__ __forceinline__ unsigned lda_bytes() const { return 0u; }
    __device__ __forceinline__ unsigned ldb_bytes() const { return (unsigned)K2; }
    __device__ __forceinline__ unsigned aoff(const pg8::Unit&) const { return 0u; }
    __device__ __forceinline__ const char* wbase() const { return W; }
    __device__ __forceinline__ unsigned boff(const pg8::Unit& u) const { return (unsigned)u.e * (unsigned)wstride + (unsigned)u.pn * 256u * (unsigned)K2; }
};
template <bool I8> struct EpiProjT { static constexpr bool PERM = true; bf16* Z; unsigned char* G8; int pn_off; float scale; const float* RS = nullptr; float scale_g = 0.f;
    __device__ __forceinline__ void operator()(const f32x4 (&acc)[2][2][4][2], const pg8::Unit& u0, int wr, int wc, int fr, int fq) const {
        pg8::Unit u = u0; u.pn += pn_off;
        const int act = (u.pn >= 5 && u.pn < 9) ? 1 : (u.pn >= 16 ? 2 : 0);
#pragma unroll
        for (int ai = 0; ai < 2; ++ai)
#pragma unroll
            for (int m = 0; m < 4; ++m) { bf16* rowp = Z + (size_t)(u.pm * 256 + ai * 128 + wr * 64 + m * 16 + fr) * ZS + u.pn * 256 + wc * 32 + 8 * fq;
#pragma unroll
                for (int bj = 0; bj < 2; ++bj) { f32x4 v0, v1;
                    if constexpr (I8) { const float sr = RS[u.pm * 256 + ai * 128 + wr * 64 + m * 16 + fr] * (act == 2 ? scale_g : scale); const i32x4q i0 = __builtin_bit_cast(i32x4q, acc[ai][bj][m][0]), i1 = __builtin_bit_cast(i32x4q, acc[ai][bj][m][1]);
#pragma unroll
                        for (int e = 0; e < 4; ++e) { v0[e] = (float)i0[e] * sr; v1[e] = (float)i1[e] * sr; } }
                    else { v0 = acc[ai][bj][m][0] * scale; v1 = acc[ai][bj][m][1] * scale; }
                    if (act == 1) {
#pragma unroll
                        for (int e = 0; e < 4; ++e) { v0[e] = gelu_tanh(v0[e]); v1[e] = gelu_tanh(v1[e]); } }
                    else if (act == 2) {
                        unsigned q[8];
#pragma unroll
                        for (int e = 0; e < 4; ++e) { q[e] = (unsigned)fmaxf(__builtin_rintf(255.f * sigmoidf_(v0[e])), 1.f); q[4 + e] = (unsigned)fmaxf(__builtin_rintf(255.f * sigmoidf_(v1[e])), 1.f); }
                        u32x2 w8; w8.x = q[0] | (q[1] << 8) | (q[2] << 16) | (q[3] << 24); w8.y = q[4] | (q[5] << 8) | (q[6] << 16) | (q[7] << 24);
                        *(u32x2*)(G8 + g8_off((u.pn - 16) >> 3, u.pm, (u.pn - 16) & 7, wr * 4 + wc, ai, m, bj, fq * 16 + fr)) = w8;
                        continue; }
                    u32x4 w; w.x = pg8::cvt_pk_bf16(v0[0], v0[1]); w.y = pg8::cvt_pk_bf16(v0[2], v0[3]); w.z = pg8::cvt_pk_bf16(v1[0], v1[1]); w.w = pg8::cvt_pk_bf16(v1[2], v1[3]);
                    *(u32x4*)(rowp + bj * 128) = w; } }
    }
};
typedef EpiProjT<false> EpiProj;
struct EpiMerge { static constexpr bool PERM = true; const bf16* Z; bf16* ACC;
    struct State { u32x2 g[2][4][2]; };
    __device__ __forceinline__ const unsigned char* gptr(const pg8::Unit& u, int i, int ai, int m, int bj, int wr, int wc, int fr, int fq) const {
        return (const unsigned char*)Z + g8_off(i, u.pm, u.pn, wr * 4 + wc, ai, m, bj, fq * 16 + fr); }
    __device__ __forceinline__ void khook(f32x4 (&acc)[2][2][4][2], State& st, const pg8::Unit& u, int i, int wr, int wc, int fr, int fq) const {
#pragma unroll
        for (int ai = 0; ai < 2; ++ai)
#pragma unroll
            for (int m = 0; m < 4; ++m) {
#pragma unroll
                for (int bj = 0; bj < 2; ++bj) { const u32x2 gn = *(const u32x2*)gptr(u, i + 1, ai, m, bj, wr, wc, fr, fq); const u32x2 gc = (i == 0) ? *(const u32x2*)gptr(u, 0, ai, m, bj, wr, wc, fr, fq) : st.g[ai][m][bj];
#pragma unroll
                    for (int e = 0; e < 4; ++e) { acc[ai][bj][m][0][e] *= (float)((gc.x >> (8 * e)) & 255u) * __builtin_amdgcn_rcpf((float)((gn.x >> (8 * e)) & 255u));
                                                  acc[ai][bj][m][1][e] *= (float)((gc.y >> (8 * e)) & 255u) * __builtin_amdgcn_rcpf((float)((gn.y >> (8 * e)) & 255u)); }
                    st.g[ai][m][bj] = gn; } }
    }
    __device__ __forceinline__ void fin(const f32x4 (&acc)[2][2][4][2], const State& st, const pg8::Unit& u, int wr, int wc, int fr, int fq) const {
#pragma unroll
        for (int ai = 0; ai < 2; ++ai)
#pragma unroll
            for (int m = 0; m < 4; ++m) { const size_t row = (size_t)(u.pm * 256 + ai * 128 + wr * 64 + m * 16 + fr); const int col = u.pn * 256 + wc * 32 + 8 * fq;
#pragma unroll
                for (int bj = 0; bj < 2; ++bj) { const u32x2 g3 = st.g[ai][m][bj]; float g[8];
#pragma unroll
                    for (int e = 0; e < 4; ++e) { g[e] = (float)((g3.x >> (8 * e)) & 255u) * (1.f / 255.f); g[4 + e] = (float)((g3.y >> (8 * e)) & 255u) * (1.f / 255.f); }
                    const f32x4 v0 = acc[ai][bj][m][0], v1 = acc[ai][bj][m][1];
                    u32x4 w; w.x = pg8::cvt_pk_bf16(v0[0] * g[0], v0[1] * g[1]); w.y = pg8::cvt_pk_bf16(v0[2] * g[2], v0[3] * g[3]); w.z = pg8::cvt_pk_bf16(v1[0] * g[4], v1[1] * g[5]); w.w = pg8::cvt_pk_bf16(v1[2] * g[6], v1[3] * g[7]);
                    (void)w;
                    u32x2 w8; unsigned p8 = 0u; p8 = __builtin_amdgcn_cvt_pk_fp8_f32(v0[0] * g[0], v0[1] * g[1], p8, false); p8 = __builtin_amdgcn_cvt_pk_fp8_f32(v0[2] * g[2], v0[3] * g[3], p8, true); w8.x = p8;
                    p8 = 0u; p8 = __builtin_amdgcn_cvt_pk_fp8_f32(v1[0] * g[4], v1[1] * g[5], p8, false); p8 = __builtin_amdgcn_cvt_pk_fp8_f32(v1[2] * g[6], v1[3] * g[7], p8, true); w8.y = p8;
                    *(u32x2*)((unsigned char*)ACC + row * 2048 + col + bj * 128) = w8; } }
    }
};
struct EpiOut { static constexpr bool PERM = true; bf16* MX; int nop; float scale;
    __device__ __forceinline__ void operator()(const f32x4 (&acc)[2][2][4][2], const pg8::Unit& u, int wr, int wc, int fr, int fq) const {
        if (nop && acc[0][0][0][0][0] != 1.2345e30f) return;
#pragma unroll
        for (int ai = 0; ai < 2; ++ai)
#pragma unroll
            for (int m = 0; m < 4; ++m) { bf16* rowp = MX + (size_t)(u.pm * 256 + ai * 128 + wr * 64 + m * 16 + fr) * D + u.pn * 256 + wc * 32 + 8 * fq;
#pragma unroll
                for (int bj = 0; bj < 2; ++bj) { const f32x4 v0 = acc[ai][bj][m][0] * scale, v1 = acc[ai][bj][m][1] * scale;
                    u32x4 w; w.x = pg8::cvt_pk_bf16(v0[0], v0[1]); w.y = pg8::cvt_pk_bf16(v0[2], v0[3]); w.z = pg8::cvt_pk_bf16(v1[0], v1[1]); w.w = pg8::cvt_pk_bf16(v1[2], v1[3]);
                    *(u32x4*)(rowp + bj * 128) = w; } }
    }
};
struct EpiMoe1 { static constexpr bool PERM = true; bf16* ACT; __amdgpu_buffer_rsrc_t rs; const float* RS; const int* LIST; const LAS int* tab; const unsigned* wm;
    __device__ __forceinline__ void operator()(const f32x4 (&acc)[2][2][4][2], const pg8::Unit& u, int wr, int wc, int fr, int fq) const {
#pragma unroll
        for (int ai = 0; ai < 2; ++ai)
#pragma unroll
            for (int m = 0; m < 4; ++m) { int ri = 256 * (u.pm - tab[16 + u.e]) + ai * 128 + wr * 64 + m * 16 + fr; const int lastr = tab[u.e] - 1; ri = ri < lastr ? ri : lastr;
                const float rsv = RS[LIST[u.e * CAP + ri] >> 1], sg = rsv * (__uint_as_float(wm[4 + u.e]) * (EXPERT_MARGIN / 127.f)), su = rsv * (__uint_as_float(wm[36 + u.e]) * (EXPERT_MARGIN / 127.f));
                const i32x4q ig0 = __builtin_bit_cast(i32x4q, acc[ai][0][m][0]), ig1 = __builtin_bit_cast(i32x4q, acc[ai][0][m][1]), iu0 = __builtin_bit_cast(i32x4q, acc[ai][1][m][0]), iu1 = __builtin_bit_cast(i32x4q, acc[ai][1][m][1]); float o[8];
#pragma unroll
                for (int e = 0; e < 4; ++e) { const float ga = (float)ig0[e] * sg, gb = (float)ig1[e] * sg; o[e] = ga * sigmoidf_(ga) * ((float)iu0[e] * su); o[4 + e] = gb * sigmoidf_(gb) * ((float)iu1[e] * su); }
                u32x4 w; w.x = pg8::cvt_pk_bf16(o[0], o[1]); w.y = pg8::cvt_pk_bf16(o[2], o[3]); w.z = pg8::cvt_pk_bf16(o[4], o[5]); w.w = pg8::cvt_pk_bf16(o[6], o[7]);
                __builtin_amdgcn_raw_buffer_store_b128(w, rs, (int)(((unsigned)(u.pm * 256 + ai * 128 + wr * 64 + m * 16 + fr) * 1024u + (unsigned)(u.pn * 128 + wc * 32 + 8 * fq)) * 2u), 0, 16); }
    }
};
struct EpiMoe2 { static constexpr bool PERM = true; bf16* Y; const int* LIST; const float* LISTW; const LAS int* tab;
    __device__ __forceinline__ void operator()(const f32x4 (&acc)[2][2][4][2], const pg8::Unit& u, int wr, int wc, int fr, int fq) const {
        const int ri0 = 256 * (u.pm - tab[16 + u.e]);
#pragma unroll
        for (int ai = 0; ai < 2; ++ai)
#pragma unroll
            for (int m = 0; m < 4; ++m) { const int rt = ai * 128 + wr * 64 + m * 16 + fr;
                if (rt < u.cnt) { const int tk = LIST[u.e * CAP + ri0 + rt]; const float wv = LISTW[u.e * CAP + ri0 + rt]; bf16* rowp = Y + (size_t)tk * D + u.pn * 256 + wc * 32 + 8 * fq;
#pragma unroll
                    for (int bj = 0; bj < 2; ++bj) { const f32x4 v0 = acc[ai][bj][m][0] * wv, v1 = acc[ai][bj][m][1] * wv;
                        u32x4 w; w.x = pg8::cvt_pk_bf16(v0[0], v0[1]); w.y = pg8::cvt_pk_bf16(v0[2], v0[3]); w.z = pg8::cvt_pk_bf16(v1[0], v1[1]); w.w = pg8::cvt_pk_bf16(v1[2], v1[3]);
                        *(u32x4*)(rowp + bj * 128) = w; } }
                __builtin_amdgcn_sched_barrier(0); }
    }
};
__device__ __forceinline__ void phase_proj2(const Args& a, int l, LAS unsigned char* lds) {
#if FP8Z
    const unsigned* wm = (const unsigned*)(a.ws + WS_CTL) + CW_WMAX;
    {
        const char* W = (const char*)(a.ws + WS_WCAT8) + (size_t)l * 12288 * 2048;
        DenseOrder S{64, 16, 16, 0, 64, (int)gridDim.x, (int)blockIdx.x, 2048, 2048, W};
        EpiProjT<true> E{(bf16*)(a.ws + WS_Z), (unsigned char*)(a.ws + WS_G8), 0, __uint_as_float(wm[l]) * (1.f / 127.f), (const float*)(a.ws + WS_RS), 0.f};
        pg8::gemm256<EpiProjT<true>, DenseOrder, false, 2>(lds, (const char*)(a.ws + WS_H8I), 2048, S, E);
        const char* Wz = (const char*)(a.ws + WS_WCAT) + (size_t)l * 4096 * 2048 * 2;
        sk_gemm_ctx(lds, (const bf16*)(a.ws + WS_H), 2048, (const bf16*)Wz, 2048, 2048, 4096, SkNoPre{}, SkEpiProj{(bf16*)(a.ws + WS_Z)}, (int)threadIdx.x, (int)(threadIdx.x >> 6), (int)(threadIdx.x & 63));
    }
    {
        const char* W = (const char*)(a.ws + WS_WCAT8) + ((size_t)l * 12288 + 4096) * 2048;
        DenseOrder S{64, 32, 32, l == 0 ? 64 : 0, 64, (int)gridDim.x, (int)blockIdx.x, 2048, 2048, W};
        EpiProj E{(bf16*)(a.ws + WS_Z), (unsigned char*)(a.ws + WS_G8), 16, __uint_as_float(wm[2 + l]) * (1.f / 128.f)};
        pg8::gemm256<EpiProj, DenseOrder, false, 1>(lds, (const char*)(a.ws + WS_H8), 2048, S, E);
    }
#if FP8Z == 2
    {
        const char* W = (const char*)(a.ws + WS_WCAT) + ((size_t)l * 4096 + 9 * 256) * 2048 * 2;
        DenseOrder S{64, 7, 7, 0, 64, (int)gridDim.x, (int)blockIdx.x, 4096, 4096, W};
        EpiProj E{(bf16*)(a.ws + WS_Z), (unsigned char*)(a.ws + WS_G8), 9, 1.f};
        pg8::gemm256<EpiProj, DenseOrder, false, 0>(lds, (const char*)(a.ws + WS_H), 4096, S, E);
    }
#elif FP8Z == 3
    {
        const char* W = (const char*)(a.ws + WS_WCAT) + ((size_t)l * 4096) * 2048 * 2;
        DenseOrder S{64, 9, 9, 0, 64, (int)gridDim.x, (int)blockIdx.x, 4096, 4096, W};
        EpiProj E{(bf16*)(a.ws + WS_Z), (unsigned char*)(a.ws + WS_G8), 0, 1.f};
        pg8::gemm256<EpiProj, DenseOrder, false, 0>(lds, (const char*)(a.ws + WS_H), 4096, S, E);
    }
#endif
#else
    {
        const char* W = (const char*)(a.ws + WS_WCAT) + (size_t)l * 4096 * 2048 * 2;
        DenseOrder S{64, 16, 16, 0, 64, (int)gridDim.x, (int)blockIdx.x, 4096, 4096, W};
        EpiProj E{(bf16*)(a.ws + WS_Z), (unsigned char*)(a.ws + WS_G8), 0, 1.f};
        pg8::gemm256<EpiProj, DenseOrder, false, 0>(lds, (const char*)(a.ws + WS_H), 4096, S, E);
        sk_gemm_ctx(lds, (const bf16*)(a.ws + WS_H), 2048, (const bf16*)W, 2048, 2048, 4096, SkNoPre{}, SkEpiProj{(bf16*)(a.ws + WS_Z)}, (int)threadIdx.x, (int)(threadIdx.x >> 6), (int)(threadIdx.x & 63));
    }
    {
        const char* W = (const char*)(a.ws + WS_WCAT8) + ((size_t)l * 12288 + 4096) * 2048;
        DenseOrder S{64, 32, 32, l == 0 ? 64 : 0, 64, (int)gridDim.x, (int)blockIdx.x, 2048, 2048, W};
        EpiProj E{(bf16*)(a.ws + WS_Z), (unsigned char*)(a.ws + WS_G8), 16, 1.f / W8SCALE};
        pg8::gemm256<EpiProj, DenseOrder, false, 1>(lds, (const char*)(a.ws + WS_H8), 2048, S, E);
    }
#endif
}
__device__ __forceinline__ void phase_merge2(const Args& a, int l, LAS unsigned char* lds) {
    const char* W = (const char*)(a.ws + WS_WB) + (size_t)l * 2048 * 2048 * 2;
    DenseOrder S{64, 8, 8, 0, 64, (int)gridDim.x, (int)blockIdx.x, 4096, 4096, W};
    EpiMerge E{(const bf16*)(a.ws + WS_G8), (bf16*)(a.ws + WS_ACC8)};
    pg8::gemm256<EpiMerge, DenseOrder, true>(lds, (const char*)(a.ws + WS_O), 4096, S, E);
    if (l == 0) sk_gemm_ctx(lds, (const bf16*)(a.ws + WS_O), 2048, (const bf16*)W, 2048, 2048, 2048, SkPreMerge{(const bf16*)(a.ws + WS_G8)}, SkEpiAcc{(bf16*)(a.ws + WS_ACC), DP}, (int)threadIdx.x, (int)(threadIdx.x >> 6), (int)(threadIdx.x & 63));
}
__device__ __forceinline__ void phase_outproj2(const Args& a, int l, LAS unsigned char* lds, int nop = 0) {
    const char* W = (const char*)(a.ws + WS_WO) + (size_t)l * 2048 * DP * 2;
    const char* W8 = (const char*)(a.ws + WS_WO8) + (size_t)l * 2048 * 2048;
    DenseOrder S{64, 8, 8, 0, 64, (int)gridDim.x, (int)blockIdx.x, 2048, 2048, W8};
    EpiOut E{(bf16*)(a.ws + WS_MX), nop, __uint_as_float(((const unsigned*)(a.ws + WS_CTL))[CW_WMAX + 68 + l]) * (1.f / 128.f)};
    pg8::gemm256<EpiOut, DenseOrder, false, 1>(lds, (const char*)(a.ws + WS_ACC8), 2048, S, E);
    if (l == 0 && !nop) sk_gemm_ctx(lds, (const bf16*)(a.ws + WS_ACC), DP, (const bf16*)W, DP, 2048, 2048, SkNoPre{}, SkEpiAcc{(bf16*)(a.ws + WS_MX), D}, (int)threadIdx.x, (int)(threadIdx.x >> 6), (int)(threadIdx.x & 63));
}
constexpr int CW_T2 = 16384;
__device__ __forceinline__ void phase_moe12(const Args& a, int l, LAS unsigned char* lds, int tid) {
    LAS int* tab = (LAS int*)(lds + pg8::STAGE_BYTES); moe_table(a, l, tab, tid);
    unsigned* tcnt = (unsigned*)(a.ws + WS_CTL) + CW_T2 + 64 * 160 * l; unsigned* tmo = (unsigned*)(a.ws + WS_CTL) + 8;
    const int G = (int)gridDim.x, c = (int)blockIdx.x, N1 = tab[32] * 8;
    {
        MoeOrder S{tab, G, c, 2048, 1, (const int*)(a.ws + WS_LIST), (const char*)(a.ws + WS_WGU) + (size_t)l * 16 * 2048 * 2048, (size_t)2048 * 2048, 0, 0, tcnt, tmo};
        EpiMoe1 E{(bf16*)(a.ws + WS_ACT), __builtin_amdgcn_make_buffer_rsrc((void*)(a.ws + WS_ACT), 0, 0x7fffffff, 0x00020000), (const float*)(a.ws + WS_RS), (const int*)(a.ws + WS_LIST), tab, (const unsigned*)(a.ws + WS_CTL) + CW_WMAX + 16 * l};
        pg8::gemm256<EpiMoe1, MoeOrder, false, 2>(lds, (const char*)(a.ws + WS_H8I), 2048, S, E);
    }
    {
        const int i0 = N1 > c ? (N1 - c + G - 1) / G : 0;
        MoeOrder S{tab, G, c, 2048, 0, (const int*)(a.ws + WS_LIST), (const char*)(a.ws + WS_WD) + (size_t)l * 16 * 2048 * 1024 * 2, (size_t)2048 * 1024 * 2, i0, N1, tcnt, tmo};
        EpiMoe2 E{(bf16*)(a.ws + WS_Y), (const int*)(a.ws + WS_LIST), (const float*)(a.ws + WS_LISTW), tab};
        pg8::gemm256<EpiMoe2, MoeOrder, false>(lds, (const char*)(a.ws + WS_ACT), 2048, S, E);
    }
}

__device__ __forceinline__ void attn_unit(const Args& a, int l, int u, LAS unsigned char* lds, int tid, int wave, int lane) {
    const bf16* Z = (const bf16*)(a.ws + WS_Z); bf16* OB = (bf16*)(a.ws + WS_O);
    const float* ROPEC = (const float*)(a.ws + WS_ROPE); const float* ROPES = ROPEC + 2048;
    LAS bf16* Ks = (LAS bf16*)lds;
    LAS bf16* VT = (LAS bf16*)(lds + 128 * 72 * 2);
    const int fr = lane & 15, fq = lane >> 4;
    {
        int b, kvh, nb; const bool isctx = u >= 256;
        if (!isctx) { b = u >> 7; kvh = (u >> 6) & 1; nb = u & 63; } else { const int v = u - 256; b = v >> 2; kvh = (v >> 1) & 1; nb = v & 1; }
        const int h = kvh * 4 + (wave >> 1), qs = (wave & 1) * 64;
        bf16x8 Qf[4][2];
#pragma unroll
        for (int qb = 0; qb < 4; ++qb) { const int tq = nb * 128 + qs + 16 * qb + fr; const size_t row = isctx ? (size_t)ML + b * 256 + tq : (size_t)b * SEQ + tq;
            const bf16* qp = Z + row * ZS + ZQ + h * 64;
#pragma unroll
            for (int ks = 0; ks < 2; ++ks) { float o[8]; unpack8(*(const u32x4*)(qp + 32 * ks + 8 * fq), o);
                if (!isctx) { float p[8]; unpack8(*(const u32x4*)(qp + 32 * ks + 8 * (fq ^ 2)), p); const int pos = ks == 0 ? (tq >> 6) : (tq & 63);
                    const float* cs = ROPEC + pos * 16 + 8 * (fq & 1); const float* sn = ROPES + pos * 16 + 8 * (fq & 1);
#pragma unroll
                    for (int e = 0; e < 8; ++e) o[e] = fq < 2 ? o[e] * cs[e] - p[e] * sn[e] : o[e] * cs[e] + p[e] * sn[e]; }
#pragma unroll
                for (int e = 0; e < 8; ++e) o[e] *= 0.125f * LOG2E;
                Qf[qb][ks] = __builtin_bit_cast(bf16x8, pack8(o)); } }
        float m[4], lsum[4]; f32x4 O[4][4];
        const float sinkv = a.in[10][l * 8 + h] * LOG2E;
#pragma unroll
        for (int qb = 0; qb < 4; ++qb) { m[qb] = sinkv; lsum[qb] = fq == 0 ? 1.f : 0.f;
#pragma unroll
            for (int db = 0; db < 4; ++db) O[qb][db] = (f32x4){0.f, 0.f, 0.f, 0.f}; }
        const int ntile = isctx ? 2 : 5;
#pragma unroll 1
        for (int kt = 0; kt < ntile; ++kt) {
            const bool isband = (!isctx && kt < 3);
            const int kblk = nb - 1 + kt;
            if (isband && (kblk < 0 || kblk > 63)) continue;
            const size_t krow0 = isband ? (size_t)b * SEQ + kblk * 128 : (size_t)ML + b * 256 + (isctx ? kt : kt - 3) * 128;
            __syncthreads();
            { const int key = tid >> 2, part = tid & 3, ks = part >> 1, sub = part & 1;
                const bf16* kp = Z + (krow0 + key) * ZS + ZK + kvh * 64 + 32 * ks + 8 * sub;
                float fa[8], fb[8]; unpack8(*(const u32x4*)kp, fa); unpack8(*(const u32x4*)(kp + 16), fb);
                if (isband) { const int tk = kblk * 128 + key; const int pos = ks == 0 ? (tk >> 6) : (tk & 63); const float* cs = ROPEC + pos * 16 + 8 * sub; const float* sn = ROPES + pos * 16 + 8 * sub;
#pragma unroll
                    for (int e = 0; e < 8; ++e) { const float x1 = fa[e], x2 = fb[e]; fa[e] = x1 * cs[e] - x2 * sn[e]; fb[e] = x2 * cs[e] + x1 * sn[e]; } }
                *(LAS u32x4*)(Ks + key * 72 + 32 * ks + 8 * sub) = pack8(fa); *(LAS u32x4*)(Ks + key * 72 + 32 * ks + 16 + 8 * sub) = pack8(fb);
                const bf16* vp = Z + (krow0 + key) * ZS + ZV + kvh * 64 + 16 * part;
                const u32x4 v0 = *(const u32x4*)vp, v1 = *(const u32x4*)(vp + 8);
                LAS bf16* vt = VT + (16 * part) * 136 + key;
                vt[0 * 136] = (bf16)(v0.x & 0xffffu); vt[1 * 136] = (bf16)(v0.x >> 16); vt[2 * 136] = (bf16)(v0.y & 0xffffu); vt[3 * 136] = (bf16)(v0.y >> 16);
                vt[4 * 136] = (bf16)(v0.z & 0xffffu); vt[5 * 136] = (bf16)(v0.z >> 16); vt[6 * 136] = (bf16)(v0.w & 0xffffu); vt[7 * 136] = (bf16)(v0.w >> 16);
                vt[8 * 136] = (bf16)(v1.x & 0xffffu); vt[9 * 136] = (bf16)(v1.x >> 16); vt[10 * 136] = (bf16)(v1.y & 0xffffu); vt[11 * 136] = (bf16)(v1.y >> 16);
                vt[12 * 136] = (bf16)(v1.z & 0xffffu); vt[13 * 136] = (bf16)(v1.z >> 16); vt[14 * 136] = (bf16)(v1.w & 0xffffu); vt[15 * 136] = (bf16)(v1.w >> 16); }
            __syncthreads();
#pragma unroll 1
            for (int kk = 0; kk < 4; ++kk) {
                bf16x8 Kf[2][2], Vf[4];
#pragma unroll
                for (int kb2 = 0; kb2 < 2; ++kb2)
#pragma unroll
                    for (int ks = 0; ks < 2; ++ks) Kf[kb2][ks] = *(const LAS bf16x8*)(Ks + (32 * kk + 16 * kb2 + fr) * 72 + 32 * ks + 8 * fq);
#pragma unroll
                for (int db = 0; db < 4; ++db) { const s16x4 lo = *(const LAS s16x4*)(VT + (16 * db + fr) * 136 + 32 * kk + 4 * fq), hi = *(const LAS s16x4*)(VT + (16 * db + fr) * 136 + 32 * kk + 16 + 4 * fq);
                    Vf[db] = (bf16x8){lo[0], lo[1], lo[2], lo[3], hi[0], hi[1], hi[2], hi[3]}; }
#pragma unroll
                for (int qb = 0; qb < 4; ++qb) {
                    f32x4 s0 = {0.f, 0.f, 0.f, 0.f}, s1 = s0;
                    s0 = MFMA16(Kf[0][0], Qf[qb][0], s0); s0 = MFMA16(Kf[0][1], Qf[qb][1], s0);
                    s1 = MFMA16(Kf[1][0], Qf[qb][0], s1); s1 = MFMA16(Kf[1][1], Qf[qb][1], s1);
                    if (isband && kt != 1) { const int tq = nb * 128 + qs + 16 * qb + fr;
#pragma unroll
                        for (int e = 0; e < 4; ++e) { const int d0 = kblk * 128 + 32 * kk + 4 * fq + e - tq, d1 = d0 + 16;
                            if (d0 > 128 || d0 < -128) s0[e] = -1e30f; if (d1 > 128 || d1 < -128) s1[e] = -1e30f; } }
                    float mx = fmaxf(fmaxf(fmaxf(s0[0], s0[1]), fmaxf(s0[2], s0[3])), fmaxf(fmaxf(s1[0], s1[1]), fmaxf(s1[2], s1[3])));
                    mx = fmaxf(mx, __shfl_xor(mx, 16)); mx = fmaxf(mx, __shfl_xor(mx, 32));
                    const float mn = fmaxf(m[qb], mx), alpha = __builtin_amdgcn_exp2f(m[qb] - mn); m[qb] = mn;
                    float p[8]; float ps = 0.f;
#pragma unroll
                    for (int e = 0; e < 4; ++e) { p[e] = __builtin_amdgcn_exp2f(s0[e] - mn); p[4 + e] = __builtin_amdgcn_exp2f(s1[e] - mn); ps += p[e] + p[4 + e]; }
                    lsum[qb] = lsum[qb] * alpha + ps;
                    const bf16x8 Pf = __builtin_bit_cast(bf16x8, pack8(p));
#pragma unroll
                    for (int db = 0; db < 4; ++db) { O[qb][db] = O[qb][db] * alpha; O[qb][db] = MFMA16(Vf[db], Pf, O[qb][db]); }
                    __builtin_amdgcn_sched_barrier(0);
                }
            }
        }
#pragma unroll
        for (int qb = 0; qb < 4; ++qb) { float ls = lsum[qb]; ls += __shfl_xor(ls, 16); ls += __shfl_xor(ls, 32); const float inv = 1.f / ls;
            const int tq = nb * 128 + qs + 16 * qb + fr; const size_t row = isctx ? (size_t)ML + b * 256 + tq : (size_t)b * SEQ + tq;
#pragma unroll
            for (int db = 0; db < 4; ++db) { u32x2 o; o.x = pk2(O[qb][db][0] * inv, O[qb][db][1] * inv); o.y = pk2(O[qb][db][2] * inv, O[qb][db][3] * inv);
                *(u32x2*)(OB + row * D + h * 64 + 16 * db + 4 * fq) = o; } }
    }
}


__device__ __forceinline__ void attn2_stage_k(LAS bf16* Ks, const bf16* Z, const float* ROPEC, const float* ROPES, size_t krow0, int kvh, int slot, bool rope, int kblk, int tid) {
    const int key = tid >> 2, part = tid & 3, ks = part >> 1, sub = part & 1;
    const bf16* kp = Z + (krow0 + key) * ZS + ZK + kvh * 64 + 32 * ks + 8 * sub;
    float fa[8], fb[8]; unpack8(*(const u32x4*)kp, fa); unpack8(*(const u32x4*)(kp + 16), fb);
    if (rope) { const int tk = kblk * 128 + key; const int pos = ks == 0 ? (tk >> 6) : (tk & 63); const float* cs = ROPEC + pos * 16 + 8 * sub; const float* sn = ROPES + pos * 16 + 8 * sub;
#pragma unroll
        for (int e = 0; e < 8; ++e) { const float x1 = fa[e], x2 = fb[e]; fa[e] = x1 * cs[e] - x2 * sn[e]; fb[e] = x2 * cs[e] + x1 * sn[e]; } }
    LAS bf16* kd = Ks + (slot * 128 + key) * 72 + 32 * ks + 8 * sub;
    *(LAS u32x4*)kd = pack8(fa); *(LAS u32x4*)(kd + 16) = pack8(fb);
}
__device__ __forceinline__ void attn2_load_v(const bf16* Z, size_t krow0, int kvh, int tid, u32x4& v0, u32x4& v1) {
    const bf16* vp = Z + (krow0 + (tid >> 2)) * ZS + ZV + kvh * 64 + 16 * (tid & 3); v0 = *(const u32x4*)vp; v1 = *(const u32x4*)(vp + 8);
}
__device__ __forceinline__ void attn2_write_vt(LAS bf16* VT, int tid, const u32x4 v0, const u32x4 v1) {
    LAS bf16* vt = VT + (16 * (tid & 3)) * 136 + (tid >> 2);
    vt[0 * 136] = (bf16)(v0.x & 0xffffu); vt[1 * 136] = (bf16)(v0.x >> 16); vt[2 * 136] = (bf16)(v0.y & 0xffffu); vt[3 * 136] = (bf16)(v0.y >> 16);
    vt[4 * 136] = (bf16)(v0.z & 0xffffu); vt[5 * 136] = (bf16)(v0.z >> 16); vt[6 * 136] = (bf16)(v0.w & 0xffffu); vt[7 * 136] = (bf16)(v0.w >> 16);
    vt[8 * 136] = (bf16)(v1.x & 0xffffu); vt[9 * 136] = (bf16)(v1.x >> 16); vt[10 * 136] = (bf16)(v1.y & 0xffffu); vt[11 * 136] = (bf16)(v1.y >> 16);
    vt[12 * 136] = (bf16)(v1.z & 0xffffu); vt[13 * 136] = (bf16)(v1.z >> 16); vt[14 * 136] = (bf16)(v1.w & 0xffffu); vt[15 * 136] = (bf16)(v1.w >> 16);
}
__device__ __forceinline__ void attn_unit2(const Args& a, int l, int u, LAS unsigned char* lds, int tid, int wave, int lane) {
    const bf16* Z = (const bf16*)(a.ws + WS_Z); bf16* OB = (bf16*)(a.ws + WS_O);
    const float* ROPEC = (const float*)(a.ws + WS_ROPE); const float* ROPES = ROPEC + 2048;
    LAS bf16* Ks = (LAS bf16*)lds;
    LAS bf16* VT0 = (LAS bf16*)(lds + 92160);
    const int fr = lane & 15, fq = lane >> 4;
    int b, kvh, nb; const bool isctx = u >= 256;
    if (!isctx) { b = u >> 7; kvh = (u >> 6) & 1; nb = u & 63; } else { const int v = u - 256; b = v >> 2; kvh = (v >> 1) & 1; nb = v & 1; }
    const int h = kvh * 4 + (wave >> 1), qs = (wave & 1) * 64;
    const int ntile = isctx ? 2 : 5;
    __syncthreads();
#pragma unroll
    for (int kt = 0; kt < 5; ++kt) {
        if (kt >= ntile) continue;
        const bool isband = (!isctx && kt < 3); const int kblk = nb - 1 + kt;
        if (isband && (kblk < 0 || kblk > 63)) continue;
        const size_t krow0 = isband ? (size_t)b * SEQ + kblk * 128 : (size_t)ML + b * 256 + (isctx ? kt : kt - 3) * 128;
        attn2_stage_k(Ks, Z, ROPEC, ROPES, krow0, kvh, kt, isband, kblk, tid);
    }
    bf16x8 Qf[4][2];
#pragma unroll
    for (int qb = 0; qb < 4; ++qb) { const int tq = nb * 128 + qs + 16 * qb + fr; const size_t row = isctx ? (size_t)ML + b * 256 + tq : (size_t)b * SEQ + tq;
        const bf16* qp = Z + row * ZS + ZQ + h * 64;
#pragma unroll
        for (int ks = 0; ks < 2; ++ks) { float o[8]; unpack8(*(const u32x4*)(qp + 32 * ks + 8 * fq), o);
            if (!isctx) { float p[8]; unpack8(*(const u32x4*)(qp + 32 * ks + 8 * (fq ^ 2)), p); const int pos = ks == 0 ? (tq >> 6) : (tq & 63);
                const float* cs = ROPEC + pos * 16 + 8 * (fq & 1); const float* sn = ROPES + pos * 16 + 8 * (fq & 1);
#pragma unroll
                for (int e = 0; e < 8; ++e) o[e] = fq < 2 ? o[e] * cs[e] - p[e] * sn[e] : o[e] * cs[e] + p[e] * sn[e]; }
#pragma unroll
            for (int e = 0; e < 8; ++e) o[e] *= 0.125f * LOG2E;
            Qf[qb][ks] = __builtin_bit_cast(bf16x8, pack8(o)); } }
    int first = 0; if (!isctx && nb == 0) first = 1;
    { const bool isband = (!isctx && first < 3); const int kblk = nb - 1 + first;
      const size_t krow0 = isband ? (size_t)b * SEQ + kblk * 128 : (size_t)ML + b * 256 + (isctx ? first : first - 3) * 128;
      u32x4 v0, v1; attn2_load_v(Z, krow0, kvh, tid, v0, v1); attn2_write_vt(VT0, tid, v0, v1); }
    __syncthreads();
    float mx[4]; const float sinkv = a.in[10][l * 8 + h] * LOG2E;
#pragma unroll
    for (int qb = 0; qb < 4; ++qb) mx[qb] = -3.0e38f;
#pragma unroll 1
    for (int kt = 0; kt < ntile; ++kt) {
        const bool isband = (!isctx && kt < 3); const int kblk = nb - 1 + kt;
        if (isband && (kblk < 0 || kblk > 63)) continue;
#pragma unroll 1
        for (int kk = 0; kk < 4; ++kk) {
            bf16x8 Kf[2][2];
#pragma unroll
            for (int kb2 = 0; kb2 < 2; ++kb2)
#pragma unroll
                for (int ks = 0; ks < 2; ++ks) Kf[kb2][ks] = *(const LAS bf16x8*)(Ks + (kt * 128 + 32 * kk + 16 * kb2 + fr) * 72 + 32 * ks + 8 * fq);
#pragma unroll
            for (int qb = 0; qb < 4; ++qb) {
                if (isband && ((kt == 0 && 32 * kk + 31 < qs + 16 * qb) || (kt == 2 && 32 * kk > qs + 16 * qb + 15))) continue;
                f32x4 s0 = {0.f, 0.f, 0.f, 0.f}, s1 = s0;
                s0 = MFMA16(Kf[0][0], Qf[qb][0], s0); s0 = MFMA16(Kf[0][1], Qf[qb][1], s0);
                s1 = MFMA16(Kf[1][0], Qf[qb][0], s1); s1 = MFMA16(Kf[1][1], Qf[qb][1], s1);
                if (isband && kt != 1) { const int tq = nb * 128 + qs + 16 * qb + fr;
#pragma unroll
                    for (int e = 0; e < 4; ++e) { const int d0 = kblk * 128 + 32 * kk + 4 * fq + e - tq, d1 = d0 + 16;
                        if (d0 > 128 || d0 < -128) s0[e] = -1e30f; if (d1 > 128 || d1 < -128) s1[e] = -1e30f; } }
                mx[qb] = fmaxf(mx[qb], fmaxf(fmaxf(fmaxf(s0[0], s0[1]), fmaxf(s0[2], s0[3])), fmaxf(fmaxf(s1[0], s1[1]), fmaxf(s1[2], s1[3]))));
            }
        }
    }
    float lsum[4]; f32x4 O[4][4]; float negm[4];
#pragma unroll
    for (int qb = 0; qb < 4; ++qb) { float m = mx[qb]; m = fmaxf(m, __shfl_xor(m, 16)); m = fmaxf(m, __shfl_xor(m, 32)); m = fmaxf(m, sinkv);
        negm[qb] = -m; lsum[qb] = fq == 0 ? __builtin_amdgcn_exp2f(sinkv - m) : 0.f;
#pragma unroll
        for (int db = 0; db < 4; ++db) O[qb][db] = (f32x4){0.f, 0.f, 0.f, 0.f}; }
    int buf = 0;
#pragma unroll 1
    for (int kt = first; kt < ntile; ++kt) {
        const bool isband = (!isctx && kt < 3); const int kblk = nb - 1 + kt;
        if (isband && (kblk < 0 || kblk > 63)) continue;
        int nk = kt + 1; if (!isctx && nk == 2 && nb == 63) nk = 3;
        const bool hasn = nk < ntile;
        u32x4 nv0 = {0u, 0u, 0u, 0u}, nv1 = nv0;
        if (hasn) { const bool nband = (!isctx && nk < 3); const size_t nrow0 = nband ? (size_t)b * SEQ + (nb - 1 + nk) * 128 : (size_t)ML + b * 256 + (isctx ? nk : nk - 3) * 128; attn2_load_v(Z, nrow0, kvh, tid, nv0, nv1); }
        LAS bf16* VT = VT0 + buf * (64 * 136);
#pragma unroll 1
        for (int kk = 0; kk < 4; ++kk) {
            bf16x8 Kf[2][2], Vf[4];
#pragma unroll
            for (int kb2 = 0; kb2 < 2; ++kb2)
#pragma unroll
                for (int ks = 0; ks < 2; ++ks) Kf[kb2][ks] = *(const LAS bf16x8*)(Ks + (kt * 128 + 32 * kk + 16 * kb2 + fr) * 72 + 32 * ks + 8 * fq);
#pragma unroll
            for (int db = 0; db < 4; ++db) { const s16x4 lo = *(const LAS s16x4*)(VT + (16 * db + fr) * 136 + 32 * kk + 4 * fq), hi = *(const LAS s16x4*)(VT + (16 * db + fr) * 136 + 32 * kk + 16 + 4 * fq);
                Vf[db] = (bf16x8){lo[0], lo[1], lo[2], lo[3], hi[0], hi[1], hi[2], hi[3]}; }
#pragma unroll
            for (int qb = 0; qb < 4; ++qb) {
                if (isband && ((kt == 0 && 32 * kk + 31 < qs + 16 * qb) || (kt == 2 && 32 * kk > qs + 16 * qb + 15))) continue;
                f32x4 s0 = {negm[qb], negm[qb], negm[qb], negm[qb]}, s1 = s0;
                s0 = MFMA16(Kf[0][0], Qf[qb][0], s0); s0 = MFMA16(Kf[0][1], Qf[qb][1], s0);
                s1 = MFMA16(Kf[1][0], Qf[qb][0], s1); s1 = MFMA16(Kf[1][1], Qf[qb][1], s1);
                if (isband && kt != 1) { const int tq = nb * 128 + qs + 16 * qb + fr;
#pragma unroll
                    for (int e = 0; e < 4; ++e) { const int d0 = kblk * 128 + 32 * kk + 4 * fq + e - tq, d1 = d0 + 16;
                        if (d0 > 128 || d0 < -128) s0[e] = -1e30f; if (d1 > 128 || d1 < -128) s1[e] = -1e30f; } }
                float p[8]; float ps = 0.f;
#pragma unroll
                for (int e = 0; e < 4; ++e) { p[e] = __builtin_amdgcn_exp2f(s0[e]); p[4 + e] = __builtin_amdgcn_exp2f(s1[e]); ps += p[e] + p[4 + e]; }
                lsum[qb] += ps;
                const bf16x8 Pf = __builtin_bit_cast(bf16x8, pack8(p));
#pragma unroll
                for (int db = 0; db < 4; ++db) O[qb][db] = MFMA16(Vf[db], Pf, O[qb][db]);
            }
        }
        if (hasn) attn2_write_vt(VT0 + (buf ^ 1) * (64 * 136), tid, nv0, nv1);
        __syncthreads();
        buf ^= 1;
    }
#pragma unroll
    for (int qb = 0; qb < 4; ++qb) { float ls = lsum[qb]; ls += __shfl_xor(ls, 16); ls += __shfl_xor(ls, 32); const float inv = 1.f / ls;
        const int tq = nb * 128 + qs + 16 * qb + fr; const size_t row = isctx ? (size_t)ML + b * 256 + tq : (size_t)b * SEQ + tq;
#pragma unroll
        for (int db = 0; db < 4; ++db) { u32x2 o; o.x = pk2(O[qb][db][0] * inv, O[qb][db][1] * inv); o.y = pk2(O[qb][db][2] * inv, O[qb][db][3] * inv);
            *(u32x2*)(OB + row * D + h * 64 + 16 * db + 4 * fq) = o; } }
}

__device__ __forceinline__ void phase_pool(const Args& a, int l, int wave, int lane) {
    const bf16* Z = (const bf16*)(a.ws + WS_Z); bf16* OB = (bf16*)(a.ws + WS_O);
    const bf16* PWT = (const bf16*)(a.ws + WS_PWT) + (size_t)l * 4 * 128 * 128; const float* pscale = a.in[12] + l * 512;
    const int fr = lane & 15, fq = lane >> 4;
    const int gw = blockIdx.x * 8 + wave, NGW = gridDim.x * 8;
    const int nblk = (l == 0 ? MT : ML) / 16;
    for (int task = gw; task < nblk * 4; task += NGW) {
        const int g = task & 3, tb = task >> 2;
        const int row = tb * 16 + fr;
        int t, n; if (row < ML) { t = row & 8191; n = SEQ; } else { t = (row - ML) & 255; n = CTXL; }
        const int seq0 = row - t, hw = 1 << g;
        const int lo = t - hw > 0 ? t - hw : 0, hi = t + hw < n ? t + hw : n;
        const float inv = 1.f / (float)(hi - lo);
        bf16x8 Af[4];
#pragma unroll
        for (int ks = 0; ks < 4; ++ks) { float s[8] = {0, 0, 0, 0, 0, 0, 0, 0}; const bf16* base = Z + ZP + g * 128 + 32 * ks + 8 * fq;
            for (int tt = lo; tt < hi; ++tt) { float x[8]; unpack8(*(const u32x4*)(base + (size_t)(seq0 + tt) * ZS), x);
#pragma unroll
                for (int e = 0; e < 8; ++e) s[e] += x[e]; }
            float own[8]; unpack8(*(const u32x4*)(base + (size_t)row * ZS), own);
#pragma unroll
            for (int e = 0; e < 8; ++e) s[e] = s[e] * inv - own[e];
            Af[ks] = __builtin_bit_cast(bf16x8, pack8(s)); }
        f32x4 acc[4][2];
#pragma unroll
        for (int cp = 0; cp < 4; ++cp) { acc[cp][0] = (f32x4){0.f, 0.f, 0.f, 0.f}; acc[cp][1] = acc[cp][0]; }
#pragma unroll
        for (int ks = 0; ks < 4; ++ks)
#pragma unroll
            for (int cp = 0; cp < 4; ++cp)
#pragma unroll
                for (int nn = 0; nn < 2; ++nn) { const bf16x8 Bf = *(const bf16x8*)(PWT + (size_t)(g * 128 + 32 * cp + perm16(nn, fr)) * 128 + 32 * ks + 8 * fq); acc[cp][nn] = MFMA16(Bf, Af[ks], acc[cp][nn]); }
#pragma unroll
        for (int cp = 0; cp < 4; ++cp) { const int ch = g * 128 + 32 * cp + 8 * fq; const f32x4 pa = *(const f32x4*)(pscale + ch), pb = *(const f32x4*)(pscale + ch + 4); float o[8];
#pragma unroll
            for (int e = 0; e < 4; ++e) { o[e] = acc[cp][0][e] * pa[e]; o[4 + e] = acc[cp][1][e] * pb[e]; }
            *(u32x4*)(OB + (size_t)row * D + 512 + ch) = pack8(o); }
    }
}

__device__ __forceinline__ void phase_cgate(const Args& a, int l, LAS unsigned char* lds, int tid, int wave, int lane) {
    const bf16* Z = (const bf16*)(a.ws + WS_Z); bf16* OB = (bf16*)(a.ws + WS_O);
    LAS bf16* VT = (LAS bf16*)lds;
    const bf16* WSB = (const bf16*)(a.ws + WS_WSB) + (size_t)l * 4 * 128 * 128;
    const float* lng = a.in[13] + l * 512; const float* lnb = a.in[14] + l * 512; const float* cbs = a.in[16] + l * 512;
    const int fr = lane & 15, fq = lane >> 4;
    const int nch = (l == 0) ? 132 : 128;
    for (int u = blockIdx.x; u < nch * 2; u += gridDim.x) {
        const int ch = u >> 1, gp = u & 1;
        const size_t row0 = (size_t)ch * 128;
        __syncthreads();
        for (int ti = 0; ti < 16; ++ti) {
            const int tok = 16 * wave + ti; float v[8]; unpack8(*(const u32x4*)(Z + (row0 + tok) * ZS + ZUV + 512 + 8 * lane), v);
            float s = 0.f;
#pragma unroll
            for (int e = 0; e < 8; ++e) s += v[e];
            const float mean = wave_sum(s) * (1.f / 512.f); float q = 0.f;
#pragma unroll
            for (int e = 0; e < 8; ++e) { v[e] -= mean; q += v[e] * v[e]; }
            const float rstd = rsqrtf(wave_sum(q) * (1.f / 512.f) + 1e-6f);
            if ((lane >> 5) == gp) { const int c0 = 8 * lane;
#pragma unroll
                for (int e = 0; e < 8; ++e) VT[(c0 - 256 * gp + e) * 136 + tok] = (bf16)f2bf(v[e] * rstd * lng[c0 + e] + lnb[c0 + e]); }
        }
        __syncthreads();
#pragma unroll
        for (int gl = 0; gl < 2; ++gl) { const int g = 2 * gp + gl;
            bf16x8 Vf[4];
#pragma unroll
            for (int ks = 0; ks < 4; ++ks) Vf[ks] = *(const LAS bf16x8*)(VT + (128 * gl + 16 * wave + fr) * 136 + 32 * ks + 8 * fq);
            for (int pb = 0; pb < 8; ++pb) { f32x4 acc = {0.f, 0.f, 0.f, 0.f};
#pragma unroll
                for (int ks = 0; ks < 4; ++ks) { const bf16x8 Wf = *(const bf16x8*)(WSB + (size_t)(g * 128 + 16 * pb + fr) * 128 + 32 * ks + 8 * fq); acc = MFMA16(Vf[ks], Wf, acc); }
                const int p = 16 * pb + fr; const float bsv = cbs[g * 128 + p];
                const u32x2 ur = *(const u32x2*)(Z + (row0 + p) * ZS + ZUV + g * 128 + 16 * wave + 4 * fq);
                u32x2 o; o.x = pk2(bf2f(ur.x & 0xffffu) * (acc[0] + bsv), bf2f(ur.x >> 16) * (acc[1] + bsv)); o.y = pk2(bf2f(ur.y & 0xffffu) * (acc[2] + bsv), bf2f(ur.y >> 16) * (acc[3] + bsv));
                *(u32x2*)(OB + (row0 + p) * D + 1024 + g * 128 + 16 * wave + 4 * fq) = o; } }
    }
}

__device__ __forceinline__ void gla_logg_cum(const Args& a, int l, LAS float* LG, const bf16* Z, size_t row0, int h, int tid) {
    const float* gw2 = a.in[17] + l * 2 * 16 * 256; const float* gb = a.in[18] + l * 2 * 256;
    for (int i = 0; i < 16; ++i) { const int idx = tid + 512 * i, dir = idx >> 12, tok = (idx >> 6) & 63, dk = idx & 63;
        const bf16* gl = Z + (row0 + tok) * ZS + ZGLR + dir * 16; float acc = gb[dir * 256 + h * 64 + dk];
        float ga[8], gc[8]; unpack8(*(const u32x4*)gl, ga); unpack8(*(const u32x4*)(gl + 8), gc);
#pragma unroll
        for (int r = 0; r < 8; ++r) acc += ga[r] * gw2[(dir * 16 + r) * 256 + h * 64 + dk] + gc[r] * gw2[(dir * 16 + 8 + r) * 256 + h * 64 + dk];
        const float ls = fminf(acc, 0.f) - __logf(1.f + __expf(-fabsf(acc)));
        LG[idx] = ls * (1.f / 16.f); }
    __syncthreads();
    if (tid < 128) { const int dir = tid >> 6, dk = tid & 63; float c = 0.f;
        if (dir == 0) { for (int tok = 0; tok < 64; ++tok) { c += LG[tok * 64 + dk]; LG[tok * 64 + dk] = c; } }
        else { for (int tok = 63; tok >= 0; --tok) { c += LG[4096 + tok * 64 + dk]; LG[4096 + tok * 64 + dk] = c; } } }
    __syncthreads();
}
__device__ __forceinline__ void gla_stage_vt(LAS bf16* VT, const bf16* Z, size_t row0, int h, int tid) {
    const int tok = tid >> 3, c8 = tid & 7;
    const bf16* vp = Z + (row0 + tok) * ZS + ZGV + h * 128 + 16 * c8;
    const u32x4 v0 = *(const u32x4*)vp, v1 = *(const u32x4*)(vp + 8);
    LAS bf16* vt = VT + (16 * c8) * 72 + tok;
    vt[0 * 72] = (bf16)(v0.x & 0xffffu); vt[1 * 72] = (bf16)(v0.x >> 16); vt[2 * 72] = (bf16)(v0.y & 0xffffu); vt[3 * 72] = (bf16)(v0.y >> 16);
    vt[4 * 72] = (bf16)(v0.z & 0xffffu); vt[5 * 72] = (bf16)(v0.z >> 16); vt[6 * 72] = (bf16)(v0.w & 0xffffu); vt[7 * 72] = (bf16)(v0.w >> 16);
    vt[8 * 72] = (bf16)(v1.x & 0xffffu); vt[9 * 72] = (bf16)(v1.x >> 16); vt[10 * 72] = (bf16)(v1.y & 0xffffu); vt[11 * 72] = (bf16)(v1.y >> 16);
    vt[12 * 72] = (bf16)(v1.z & 0xffffu); vt[13 * 72] = (bf16)(v1.z >> 16); vt[14 * 72] = (bf16)(v1.w & 0xffffu); vt[15 * 72] = (bf16)(v1.w >> 16);
}
__device__ __forceinline__ int gla_ci(int dir, int tile) { return dir == 0 ? tile : (tile < 4 ? 3 - tile : 4 + 127 - (tile - 4)); }

__device__ __forceinline__ void phase_gla1(const Args& a, int l, LAS unsigned char* lds, int tid, int wave, int lane) {
    const bf16* Z = (const bf16*)(a.ws + WS_Z);
    LAS float* LG = (LAS float*)lds; LAS bf16* KT = (LAS bf16*)(lds + 32768); LAS bf16* VT = (LAS bf16*)(lds + 32768 + 18432);
    float* S = (float*)(a.ws + WS_S); float* DEC = (float*)(a.ws + WS_DECAY);
    const int fr = lane & 15, fq = lane >> 4;
    for (int u = blockIdx.x; u < 1056; u += gridDim.x) {
        const int tile = u % 132, bh = u / 132, b = bh >> 2, h = bh & 3;
        const size_t row0 = tile < 4 ? (size_t)ML + b * 256 + tile * 64 : (size_t)b * SEQ + (tile - 4) * 64;
        __syncthreads();
        gla_logg_cum(a, l, LG, Z, row0, h, tid);
        if (tid < 128) { const int dir = tid >> 6, dk = tid & 63; const float tot = LG[dir * 4096 + (dir == 0 ? 63 : 0) * 64 + dk];
            DEC[((size_t)(bh * 2 + dir) * 132 + gla_ci(dir, tile)) * 64 + dk] = __expf(tot); }
        { const int tok = tid >> 3, c8 = tid & 7; float kv[8]; unpack8(*(const u32x4*)(Z + (row0 + tok) * ZS + ZGK + h * 64 + 8 * c8), kv);
#pragma unroll
            for (int dir = 0; dir < 2; ++dir)
#pragma unroll
                for (int e = 0; e < 8; ++e) { const int dk = 8 * c8 + e; const float f = __expf(LG[dir * 4096 + (dir == 0 ? 63 : 0) * 64 + dk] - LG[dir * 4096 + tok * 64 + dk]);
                    KT[(dir * 64 + dk) * 72 + tok] = (bf16)f2bf(kv[e] * f); } }
        gla_stage_vt(VT, Z, row0, h, tid);
        __syncthreads();
        { const int dir = wave >> 2, dkb = wave & 3; bf16x8 Kf[2];
#pragma unroll
            for (int ks = 0; ks < 2; ++ks) Kf[ks] = *(const LAS bf16x8*)(KT + (dir * 64 + 16 * dkb + fr) * 72 + 32 * ks + 8 * fq);
            float* Sd = S + ((size_t)(bh * 2 + dir) * 132 + gla_ci(dir, tile)) * 8192;
#pragma unroll
            for (int dvb = 0; dvb < 8; ++dvb) { f32x4 acc = {0.f, 0.f, 0.f, 0.f};
#pragma unroll
                for (int ks = 0; ks < 2; ++ks) { const bf16x8 Vf = *(const LAS bf16x8*)(VT + (16 * dvb + fr) * 72 + 32 * ks + 8 * fq); acc = MFMA16(Vf, Kf[ks], acc); }
#pragma unroll
                for (int e = 0; e < 4; ++e) Sd[(16 * dvb + 4 * fq + e) * 64 + 16 * dkb + fr] = acc[e]; } }
    }
}
__device__ __forceinline__ void phase_gla2(const Args& a, int tid) {
    float* S = (float*)(a.ws + WS_S); const float* DEC = (const float*)(a.ws + WS_DECAY);
    for (int el = blockIdx.x * 512 + tid; el < 131072; el += gridDim.x * 512) {
        const int seq = el >> 13, e = el & 8191, dk = e & 63;
        float* Sp = S + (size_t)seq * 132 * 8192 + e; const float* Dp = DEC + (size_t)seq * 132 * 64 + dk;
        float s = 0.f;
        for (int ci = 0; ci < 132; ci += 4) {
            const float d0 = Sp[(size_t)ci * 8192], d1 = Sp[(size_t)(ci + 1) * 8192], d2 = Sp[(size_t)(ci + 2) * 8192], d3 = Sp[(size_t)(ci + 3) * 8192];
            const float a0 = Dp[ci * 64], a1 = Dp[(ci + 1) * 64], a2 = Dp[(ci + 2) * 64], a3 = Dp[(ci + 3) * 64];
            Sp[(size_t)ci * 8192] = s; s = a0 * s + d0; Sp[(size_t)(ci + 1) * 8192] = s; s = a1 * s + d1; Sp[(size_t)(ci + 2) * 8192] = s; s = a2 * s + d2; Sp[(size_t)(ci + 3) * 8192] = s; s = a3 * s + d3;
        }
    }
}
__device__ __forceinline__ void phase_gla3(const Args& a, int l, LAS unsigned char* lds, int tid, int wave, int lane) {
    const bf16* Z = (const bf16*)(a.ws + WS_Z); bf16* OB = (bf16*)(a.ws + WS_O);
    LAS float* LG = (LAS float*)lds; LAS bf16* VT = (LAS bf16*)(lds + 32768); LAS float* OX = (LAS float*)(lds + 32768 + 18432);
    const float* S = (const float*)(a.ws + WS_S);
    const float* gn = a.in[19] + l * 512;
    const int fr = lane & 15, fq = lane >> 4;
    const int ntile = (l == 0) ? 132 : 128;
    for (int u = blockIdx.x; u < 8 * ntile; u += gridDim.x) {
        const int tile = (l == 0) ? u % 132 : 4 + u % 128, bh = u / ntile, b = bh >> 2, h = bh & 3;
        const size_t row0 = tile < 4 ? (size_t)ML + b * 256 + tile * 64 : (size_t)b * SEQ + (tile - 4) * 64;
        __syncthreads();
        gla_logg_cum(a, l, LG, Z, row0, h, tid);
        gla_stage_vt(VT, Z, row0, h, tid);
        __syncthreads();
        const int dir = wave >> 2, tb = wave & 3;
        bf16x8 Qf[2];
        { const int tok = 16 * tb + fr;
#pragma unroll
            for (int ks = 0; ks < 2; ++ks) { float q[8]; unpack8(*(const u32x4*)(Z + (row0 + tok) * ZS + ZGQ + h * 64 + 32 * ks + 8 * fq), q);
#pragma unroll
                for (int e = 0; e < 8; ++e) q[e] *= 0.125f * __expf(LG[dir * 4096 + tok * 64 + 32 * ks + 8 * fq + e]);
                Qf[ks] = __builtin_bit_cast(bf16x8, pack8(q)); } }
        f32x4 at[4];
#pragma unroll
        for (int kb = 0; kb < 4; ++kb) { const int key = 16 * kb + fr; f32x4 acc = {0.f, 0.f, 0.f, 0.f};
#pragma unroll
            for (int ks = 0; ks < 2; ++ks) { float k[8]; unpack8(*(const u32x4*)(Z + (row0 + key) * ZS + ZGK + h * 64 + 32 * ks + 8 * fq), k);
#pragma unroll
                for (int e = 0; e < 8; ++e) k[e] *= __expf(-LG[dir * 4096 + key * 64 + 32 * ks + 8 * fq + e]);
                acc = MFMA16(__builtin_bit_cast(bf16x8, pack8(k)), Qf[ks], acc); }
            const int tok = 16 * tb + fr;
#pragma unroll
            for (int e = 0; e < 4; ++e) { const int kj = 16 * kb + 4 * fq + e; const bool ok = dir == 0 ? (kj <= tok) : (kj >= tok); if (!ok) acc[e] = 0.f; }
            at[kb] = acc; }
        bf16x8 Pf[2];
#pragma unroll
        for (int kk = 0; kk < 2; ++kk) { float p[8];
#pragma unroll
            for (int e = 0; e < 4; ++e) { p[e] = at[2 * kk][e]; p[4 + e] = at[2 * kk + 1][e]; }
            Pf[kk] = __builtin_bit_cast(bf16x8, pack8(p)); }
        const float* Sp = S + ((size_t)(bh * 2 + dir) * 132 + gla_ci(dir, tile)) * 8192;
        f32x4 O[8];
#pragma unroll
        for (int dvb = 0; dvb < 8; ++dvb) { f32x4 o = {0.f, 0.f, 0.f, 0.f};
#pragma unroll
            for (int kk = 0; kk < 2; ++kk) { const s16x4 lo = *(const LAS s16x4*)(VT + (16 * dvb + fr) * 72 + 32 * kk + 4 * fq), hi = *(const LAS s16x4*)(VT + (16 * dvb + fr) * 72 + 32 * kk + 16 + 4 * fq);
                const bf16x8 Vf = (bf16x8){lo[0], lo[1], lo[2], lo[3], hi[0], hi[1], hi[2], hi[3]}; o = MFMA16(Vf, Pf[kk], o); }
#pragma unroll
            for (int ks = 0; ks < 2; ++ks) { const float* sp = Sp + (16 * dvb + fr) * 64 + 32 * ks + 8 * fq; const f32x4 s0 = *(const f32x4*)sp, s1 = *(const f32x4*)(sp + 4);
                float sv[8] = {s0[0], s0[1], s0[2], s0[3], s1[0], s1[1], s1[2], s1[3]}; o = MFMA16(__builtin_bit_cast(bf16x8, pack8(sv)), Qf[ks], o); }
            O[dvb] = o; }
        if (dir == 1) {
#pragma unroll
            for (int dvb = 0; dvb < 8; ++dvb) *(LAS f32x4*)(OX + (tb * 16 + fr) * 132 + 16 * dvb + 4 * fq) = O[dvb]; }
        __syncthreads();
        if (dir == 0) { float ss = 0.f;
#pragma unroll
            for (int dvb = 0; dvb < 8; ++dvb) { O[dvb] += *(const LAS f32x4*)(OX + (tb * 16 + fr) * 132 + 16 * dvb + 4 * fq); ss += (O[dvb][0] * O[dvb][0] + O[dvb][1] * O[dvb][1]) + (O[dvb][2] * O[dvb][2] + O[dvb][3] * O[dvb][3]); }
            ss += __shfl_xor(ss, 16); ss += __shfl_xor(ss, 32);
            const float rstd = rsqrtf(ss * (1.f / 128.f) + 1e-6f);
            const size_t row = row0 + 16 * tb + fr;
#pragma unroll
            for (int dvb = 0; dvb < 8; ++dvb) { const int c = h * 128 + 16 * dvb + 4 * fq; const f32x4 g = *(const f32x4*)(gn + c); const u32x2 rr = *(const u32x2*)(Z + row * ZS + ZGR + c);
                const float r0 = bf2f(rr.x & 0xffffu), r1 = bf2f(rr.x >> 16), r2 = bf2f(rr.y & 0xffffu), r3 = bf2f(rr.y >> 16);
                u32x2 o; o.x = pk2(O[dvb][0] * rstd * g[0] * r0 * sigmoidf_(r0), O[dvb][1] * rstd * g[1] * r1 * sigmoidf_(r1)); o.y = pk2(O[dvb][2] * rstd * g[2] * r2 * sigmoidf_(r2), O[dvb][3] * rstd * g[3] * r3 * sigmoidf_(r3));
                *(u32x2*)(OB + row * D + 1536 + c) = o; } }
    }
}


template <int G> __device__ __forceinline__ void pool_task(const bf16* Z, bf16* OB, const bf16* PWT, const float* pscale, int tb, int fr, int fq) {
    constexpr int HW = 1 << G;
    const int row = tb * 16 + fr;
    int t, n; if (row < ML) { t = row & 8191; n = SEQ; } else { t = (row - ML) & 255; n = CTXL; }
    const int seq0 = row - t;
    const int lo = t - HW > 0 ? t - HW : 0, hi = t + HW < n ? t + HW : n;
    const float inv = 1.f / (float)(hi - lo);
    f32x4 acc[4][2];
#pragma unroll
    for (int cp = 0; cp < 4; ++cp) { acc[cp][0] = (f32x4){0.f, 0.f, 0.f, 0.f}; acc[cp][1] = acc[cp][0]; }
#pragma unroll 1
    for (int ks = 0; ks < 4; ++ks) { const bf16* base = Z + ZP + G * 128 + 32 * ks + 8 * fq;
        bf16x8 Bf[4][2];
#pragma unroll
        for (int cp = 0; cp < 4; ++cp)
#pragma unroll
            for (int nn = 0; nn < 2; ++nn) Bf[cp][nn] = *(const bf16x8*)(PWT + (size_t)(G * 128 + 32 * cp + perm16(nn, fr)) * 128 + 32 * ks + 8 * fq);
        float s[8] = {0, 0, 0, 0, 0, 0, 0, 0}, own[8];
        constexpr int CH = (2 * HW < 8) ? 2 * HW : 8;
#pragma unroll
        for (int j0 = 0; j0 < 2 * HW; j0 += CH) {
            u32x4 raw[CH];
#pragma unroll
            for (int j = 0; j < CH; ++j) { int tt = t - HW + j0 + j; tt = tt < 0 ? 0 : (tt > n - 1 ? n - 1 : tt); raw[j] = *(const u32x4*)(base + (size_t)(seq0 + tt) * ZS); }
#pragma unroll
            for (int j = 0; j < CH; ++j) { const int tt = t - HW + j0 + j; const bool ok = tt >= 0 && tt < n; float x[8]; unpack8(raw[j], x);
#pragma unroll
                for (int e = 0; e < 8; ++e) { s[e] += ok ? x[e] : 0.f; if (j0 + j == HW) own[e] = x[e]; } }
            __builtin_amdgcn_sched_barrier(0);
        }
#pragma unroll
        for (int e = 0; e < 8; ++e) s[e] = s[e] * inv - own[e];
        const bf16x8 Af = __builtin_bit_cast(bf16x8, pack8(s));
#pragma unroll
        for (int cp = 0; cp < 4; ++cp)
#pragma unroll
            for (int nn = 0; nn < 2; ++nn) acc[cp][nn] = MFMA16(Bf[cp][nn], Af, acc[cp][nn]); }
#pragma unroll
    for (int cp = 0; cp < 4; ++cp) { const int ch = G * 128 + 32 * cp + 8 * fq; const f32x4 pa = *(const f32x4*)(pscale + ch), pb = *(const f32x4*)(pscale + ch + 4); float o[8];
#pragma unroll
        for (int e = 0; e < 4; ++e) { o[e] = acc[cp][0][e] * pa[e]; o[4 + e] = acc[cp][1][e] * pb[e]; }
        *(u32x4*)(OB + (size_t)row * D + 512 + ch) = pack8(o); }
}
__device__ __forceinline__ void pool_unit(const Args& a, int l, int pu, int wave, int lane) {
    const bf16* Z = (const bf16*)(a.ws + WS_Z); bf16* OB = (bf16*)(a.ws + WS_O);
    const bf16* PWT = (const bf16*)(a.ws + WS_PWT) + (size_t)l * 4 * 128 * 128; const float* pscale = a.in[12] + l * 512;
    const int fr = lane & 15, fq = lane >> 4, g = wave & 3, tb = 2 * pu + (wave >> 2);
    if (g == 0) pool_task<0>(Z, OB, PWT, pscale, tb, fr, fq); else if (g == 1) pool_task<1>(Z, OB, PWT, pscale, tb, fr, fq);
    else if (g == 2) pool_task<2>(Z, OB, PWT, pscale, tb, fr, fq); else pool_task<3>(Z, OB, PWT, pscale, tb, fr, fq);
}
__device__ __forceinline__ void cgate_unit(const Args& a, int l, int u, LAS unsigned char* lds, int tid, int wave, int lane) {
    const bf16* Z = (const bf16*)(a.ws + WS_Z); bf16* OB = (bf16*)(a.ws + WS_O);
    LAS bf16* VT = (LAS bf16*)lds;
    LAS bf16* WS = (LAS bf16*)(lds + 69632);
    const bf16* WSB = (const bf16*)(a.ws + WS_WSB) + (size_t)l * 4 * 128 * 128;
    const float* lng = a.in[13] + l * 512; const float* lnb = a.in[14] + l * 512; const float* cbs = a.in[16] + l * 512;
    const int fr = lane & 15, fq = lane >> 4;
    const int ch = u >> 1, gp = u & 1;
    const size_t row0 = (size_t)ch * 128;
    __syncthreads();
    u32x4 raw[16];
#pragma unroll
    for (int ti = 0; ti < 16; ++ti) raw[ti] = *(const u32x4*)(Z + (row0 + 16 * wave + ti) * ZS + ZUV + 512 + 8 * lane);
#pragma unroll
    for (int i = 0; i < 8; ++i) { const int p = tid + 512 * i, gl = p >> 11, r = (p >> 4) & 127, c16 = p & 15;
        *(LAS u32x4*)(WS + (gl * 128 + r) * 136 + 8 * c16) = *(const u32x4*)(WSB + (size_t)((2 * gp + gl) * 128 + r) * 128 + 8 * c16); }
    float gv[8], bv[8];
    { const int c0 = 8 * lane;
#pragma unroll
        for (int e = 0; e < 8; ++e) { gv[e] = lng[c0 + e]; bv[e] = lnb[c0 + e]; } }
#pragma unroll
    for (int ti = 0; ti < 16; ++ti) {
        const int tok = 16 * wave + ti; float v[8]; unpack8(raw[ti], v);
        float sm = 0.f;
#pragma unroll
        for (int e = 0; e < 8; ++e) sm += v[e];
        const float mean = wave_sum(sm) * (1.f / 512.f); float q = 0.f;
#pragma unroll
        for (int e = 0; e < 8; ++e) { v[e] -= mean; q += v[e] * v[e]; }
        const float rstd = rsqrtf(wave_sum(q) * (1.f / 512.f) + 1e-6f);
        if ((lane >> 5) == gp) { const int c0 = 8 * lane - 256 * gp;
#pragma unroll
            for (int e = 0; e < 8; ++e) VT[(c0 + e) * 136 + tok] = (bf16)f2bf(v[e] * rstd * gv[e] + bv[e]); }
    }
    __syncthreads();
#pragma unroll
    for (int gl = 0; gl < 2; ++gl) { const int g = 2 * gp + gl;
        bf16x8 Vf[4];
#pragma unroll
        for (int ks = 0; ks < 4; ++ks) Vf[ks] = *(const LAS bf16x8*)(VT + (128 * gl + 16 * wave + fr) * 136 + 32 * ks + 8 * fq);
        u32x2 ur[8]; float bsv[8];
#pragma unroll
        for (int pb = 0; pb < 8; ++pb) { const int p = 16 * pb + fr; ur[pb] = *(const u32x2*)(Z + (row0 + p) * ZS + ZUV + g * 128 + 16 * wave + 4 * fq); bsv[pb] = cbs[g * 128 + p]; }
#pragma unroll
        for (int pb = 0; pb < 8; ++pb) { f32x4 acc = {0.f, 0.f, 0.f, 0.f};
#pragma unroll
            for (int ks = 0; ks < 4; ++ks) { const bf16x8 Wf = *(const LAS bf16x8*)(WS + (gl * 128 + 16 * pb + fr) * 136 + 32 * ks + 8 * fq); acc = MFMA16(Vf[ks], Wf, acc); }
            const int p = 16 * pb + fr;
            u32x2 o; o.x = pk2(bf2f(ur[pb].x & 0xffffu) * (acc[0] + bsv[pb]), bf2f(ur[pb].x >> 16) * (acc[1] + bsv[pb])); o.y = pk2(bf2f(ur[pb].y & 0xffffu) * (acc[2] + bsv[pb]), bf2f(ur[pb].y >> 16) * (acc[3] + bsv[pb]));
            *(u32x2*)(OB + (row0 + p) * D + 1024 + g * 128 + 16 * wave + 4 * fq) = o; } }
}

__device__ __forceinline__ void gla_cum2(const Args& a, int l, LAS unsigned char* lds, const bf16* Z, size_t row0, int h, int tid) {
    LAS float* CUM = (LAS float*)lds; LAS float* GLR = (LAS float*)(lds + 32768); LAS float* QT = (LAS float*)(lds + 40960);
    const float* gw2 = a.in[17] + l * 2 * 16 * 256; const float* gb = a.in[18] + l * 2 * 256;
    if (tid < 256) { const int tok = tid >> 2, part = tid & 3; float g[8]; unpack8(*(const u32x4*)(Z + (row0 + tok) * ZS + ZGLR + 8 * part), g);
        *(LAS f32x4*)(GLR + tok * 32 + 8 * part) = (f32x4){g[0], g[1], g[2], g[3]}; *(LAS f32x4*)(GLR + tok * 32 + 8 * part + 4) = (f32x4){g[4], g[5], g[6], g[7]}; }
    const int dir = tid >> 8, q = (tid >> 6) & 3, dk = tid & 63;
    float w[16];
#pragma unroll
    for (int r = 0; r < 16; ++r) w[r] = gw2[(dir * 16 + r) * 256 + h * 64 + dk];
    const float bias = gb[dir * 256 + h * 64 + dk];
    __syncthreads();
    float run = 0.f;
#pragma unroll 4
    for (int i = 0; i < 16; ++i) { const int tok = dir == 0 ? 16 * q + i : 16 * q + 15 - i;
        const LAS float* gp = GLR + tok * 32 + dir * 16; const f32x4 g0 = *(const LAS f32x4*)gp, g1 = *(const LAS f32x4*)(gp + 4), g2 = *(const LAS f32x4*)(gp + 8), g3 = *(const LAS f32x4*)(gp + 12);
        float acc = bias;
#pragma unroll
        for (int e = 0; e < 4; ++e) acc += g0[e] * w[e] + g1[e] * w[4 + e] + g2[e] * w[8 + e] + g3[e] * w[12 + e];
        const float ls = fminf(acc, 0.f) - __logf(1.f + __expf(-fabsf(acc)));
        run += ls * (1.f / 16.f); CUM[dir * 4096 + tok * 64 + dk] = run; }
    QT[(dir * 4 + q) * 64 + dk] = run;
    __syncthreads();
    float off = 0.f;
#pragma unroll
    for (int qq = 0; qq < 4; ++qq) { const float v = QT[(dir * 4 + qq) * 64 + dk]; if (dir == 0 ? qq < q : qq > q) off += v; }
#pragma unroll
    for (int i = 0; i < 16; ++i) CUM[dir * 4096 + (16 * q + i) * 64 + dk] += off;
    __syncthreads();
}
__device__ __forceinline__ void gla1_unit(const Args& a, int l, int u, LAS unsigned char* lds, int tid, int wave, int lane) {
    const bf16* Z = (const bf16*)(a.ws + WS_Z);
    LAS float* CUM = (LAS float*)lds; LAS bf16* KT = (LAS bf16*)(lds + 43008); LAS bf16* VT = (LAS bf16*)(lds + 43008 + 18432);
    bf16* S = (bf16*)(a.ws + WS_S); float* DEC = (float*)(a.ws + WS_DECAY);
    const int fr = lane & 15, fq = lane >> 4;
    const int tile = u % 132, bh = u / 132, b = bh >> 2, h = bh & 3;
    const size_t row0 = tile < 4 ? (size_t)ML + b * 256 + tile * 64 : (size_t)b * SEQ + (tile - 4) * 64;
    const int tok = tid >> 3, c8 = tid & 7;
    const u32x4 kraw = *(const u32x4*)(Z + (row0 + tok) * ZS + ZGK + h * 64 + 8 * c8);
    const bf16* vp = Z + (row0 + tok) * ZS + ZGV + h * 128 + 16 * c8;
    const u32x4 v0 = *(const u32x4*)vp, v1 = *(const u32x4*)(vp + 8);
    __syncthreads();
    gla_cum2(a, l, lds, Z, row0, h, tid);
    if (tid < 128) { const int dir = tid >> 6, dk = tid & 63; DEC[((size_t)(bh * 2 + dir) * 132 + gla_ci(dir, tile)) * 64 + dk] = __expf(CUM[dir * 4096 + (dir == 0 ? 63 : 0) * 64 + dk]); }
    { float kv[8]; unpack8(kraw, kv);
#pragma unroll
        for (int dir = 0; dir < 2; ++dir)
#pragma unroll
            for (int e = 0; e < 8; ++e) { const int dk = 8 * c8 + e; const float f = __expf(CUM[dir * 4096 + (dir == 0 ? 63 : 0) * 64 + dk] - CUM[dir * 4096 + tok * 64 + dk]);
                KT[(dir * 64 + dk) * 72 + tok] = (bf16)f2bf(kv[e] * f); }
        LAS bf16* vt = VT + (16 * c8) * 72 + tok;
        vt[0 * 72] = (bf16)(v0.x & 0xffffu); vt[1 * 72] = (bf16)(v0.x >> 16); vt[2 * 72] = (bf16)(v0.y & 0xffffu); vt[3 * 72] = (bf16)(v0.y >> 16);
        vt[4 * 72] = (bf16)(v0.z & 0xffffu); vt[5 * 72] = (bf16)(v0.z >> 16); vt[6 * 72] = (bf16)(v0.w & 0xffffu); vt[7 * 72] = (bf16)(v0.w >> 16);
        vt[8 * 72] = (bf16)(v1.x & 0xffffu); vt[9 * 72] = (bf16)(v1.x >> 16); vt[10 * 72] = (bf16)(v1.y & 0xffffu); vt[11 * 72] = (bf16)(v1.y >> 16);
        vt[12 * 72] = (bf16)(v1.z & 0xffffu); vt[13 * 72] = (bf16)(v1.z >> 16); vt[14 * 72] = (bf16)(v1.w & 0xffffu); vt[15 * 72] = (bf16)(v1.w >> 16); }
    __syncthreads();
    { const int dir = wave >> 2, dkb = wave & 3; bf16x8 Kf[2];
#pragma unroll
        for (int ks = 0; ks < 2; ++ks) Kf[ks] = *(const LAS bf16x8*)(KT + (dir * 64 + 16 * dkb + fr) * 72 + 32 * ks + 8 * fq);
        bf16* Sd = S + ((size_t)(bh * 2 + dir) * 132 + gla_ci(dir, tile)) * 8192;
#pragma unroll
        for (int dvb = 0; dvb < 8; ++dvb) { f32x4 acc = {0.f, 0.f, 0.f, 0.f};
#pragma unroll
            for (int ks = 0; ks < 2; ++ks) { const bf16x8 Vf = *(const LAS bf16x8*)(VT + (16 * dvb + fr) * 72 + 32 * ks + 8 * fq); acc = MFMA16(Kf[ks], Vf, acc); }
            { u32x2 o; o.x = pk2(acc[0], acc[1]); o.y = pk2(acc[2], acc[3]); *(u32x2*)(Sd + (16 * dvb + fr) * 64 + 16 * dkb + 4 * fq) = o; } } }
}
__device__ __forceinline__ void phase_gla2b(const Args& a, int tid) {
    const bf16* S = (const bf16*)(a.ws + WS_S); const float* DEC = (const float*)(a.ws + WS_DECAY); bf16* SB = (bf16*)(a.ws + WS_SB);
    for (int el = blockIdx.x * 512 + tid; el < 131072; el += gridDim.x * 512) {
        const int seq = el >> 13, e = el & 8191, dk = e & 63;
        const bf16* Sp = S + (size_t)seq * 132 * 8192 + e; const float* Dp = DEC + (size_t)seq * 132 * 64 + dk; bf16* Bp = SB + (size_t)seq * 132 * 8192 + e;
        float s = 0.f;
#pragma unroll 1
        for (int ci = 0; ci < 132; ci += 33) { float d[33], dc[33];
#pragma unroll
            for (int j = 0; j < 33; ++j) { d[j] = bf2f((unsigned)__builtin_nontemporal_load(Sp + (size_t)(ci + j) * 8192)); dc[j] = Dp[(ci + j) * 64]; }
#pragma unroll
            for (int j = 0; j < 33; ++j) { Bp[(size_t)(ci + j) * 8192] = (bf16)f2bf(s); s = dc[j] * s + d[j]; } }
    }
}
__device__ __forceinline__ void gla3_unit(const Args& a, int l, int u, LAS unsigned char* lds, int tid, int wave, int lane) {
    const bf16* Z = (const bf16*)(a.ws + WS_Z); bf16* OB = (bf16*)(a.ws + WS_O);
    LAS float* CUM = (LAS float*)lds; LAS bf16* QS = (LAS bf16*)(lds + 43008); LAS bf16* KS = (LAS bf16*)(lds + 43008 + 18432); LAS bf16* VT = (LAS bf16*)(lds + 43008 + 36864);
    LAS float* OX = (LAS float*)(lds + 43008 + 36864 + 18432);
    const bf16* SB = (const bf16*)(a.ws + WS_SB);
    const float* gn = a.in[19] + l * 512;
    const int fr = lane & 15, fq = lane >> 4;
    const int ntile = (l == 0) ? 132 : 128;
    const int tile = (l == 0) ? u % 132 : 4 + u % 128, bh = u / ntile, b = bh >> 2, h = bh & 3;
    const size_t row0 = tile < 4 ? (size_t)ML + b * 256 + tile * 64 : (size_t)b * SEQ + (tile - 4) * 64;
    const int tok = tid >> 3, c8 = tid & 7;
    const u32x4 qraw = *(const u32x4*)(Z + (row0 + tok) * ZS + ZGQ + h * 64 + 8 * c8), kraw = *(const u32x4*)(Z + (row0 + tok) * ZS + ZGK + h * 64 + 8 * c8);
    const bf16* vp = Z + (row0 + tok) * ZS + ZGV + h * 128 + 16 * c8;
    const u32x4 v0 = *(const u32x4*)vp, v1 = *(const u32x4*)(vp + 8);
    __syncthreads();
    gla_cum2(a, l, lds, Z, row0, h, tid);
    { float qv[8], kv[8]; unpack8(qraw, qv); unpack8(kraw, kv);
#pragma unroll
        for (int dir = 0; dir < 2; ++dir) { float qo[8], ko[8];
#pragma unroll
            for (int e = 0; e < 8; ++e) { const float c = CUM[dir * 4096 + tok * 64 + 8 * c8 + e]; qo[e] = qv[e] * 0.125f * __expf(c); ko[e] = kv[e] * __expf(-c); }
            *(LAS u32x4*)(QS + (dir * 64 + tok) * 72 + 8 * c8) = pack8(qo); *(LAS u32x4*)(KS + (dir * 64 + tok) * 72 + 8 * c8) = pack8(ko); }
        LAS bf16* vt = VT + (16 * c8) * 72 + tok;
        vt[0 * 72] = (bf16)(v0.x & 0xffffu); vt[1 * 72] = (bf16)(v0.x >> 16); vt[2 * 72] = (bf16)(v0.y & 0xffffu); vt[3 * 72] = (bf16)(v0.y >> 16);
        vt[4 * 72] = (bf16)(v0.z & 0xffffu); vt[5 * 72] = (bf16)(v0.z >> 16); vt[6 * 72] = (bf16)(v0.w & 0xffffu); vt[7 * 72] = (bf16)(v0.w >> 16);
        vt[8 * 72] = (bf16)(v1.x & 0xffffu); vt[9 * 72] = (bf16)(v1.x >> 16); vt[10 * 72] = (bf16)(v1.y & 0xffffu); vt[11 * 72] = (bf16)(v1.y >> 16);
        vt[12 * 72] = (bf16)(v1.z & 0xffffu); vt[13 * 72] = (bf16)(v1.z >> 16); vt[14 * 72] = (bf16)(v1.w & 0xffffu); vt[15 * 72] = (bf16)(v1.w >> 16); }
    const int dir = wave >> 2, tb = wave & 3;
    const bf16* Sp = SB + ((size_t)(bh * 2 + dir) * 132 + gla_ci(dir, tile)) * 8192;
    bf16x8 Sf[8][2];
#pragma unroll
    for (int dvb = 0; dvb < 8; ++dvb)
#pragma unroll
        for (int ks = 0; ks < 2; ++ks) Sf[dvb][ks] = *(const bf16x8*)(Sp + (16 * dvb + fr) * 64 + 32 * ks + 8 * fq);
    __syncthreads();
    bf16x8 Qf[2];
#pragma unroll
    for (int ks = 0; ks < 2; ++ks) Qf[ks] = *(const LAS bf16x8*)(QS + (dir * 64 + 16 * tb + fr) * 72 + 32 * ks + 8 * fq);
    f32x4 at[4];
#pragma unroll
    for (int kb = 0; kb < 4; ++kb) { f32x4 acc = {0.f, 0.f, 0.f, 0.f};
        const bool need = dir == 0 ? (kb <= tb) : (kb >= tb);
        if (need) {
#pragma unroll
            for (int ks = 0; ks < 2; ++ks) { const bf16x8 Kf = *(const LAS bf16x8*)(KS + (dir * 64 + 16 * kb + fr) * 72 + 32 * ks + 8 * fq); acc = MFMA16(Kf, Qf[ks], acc); }
            const int tq = 16 * tb + fr;
#pragma unroll
            for (int e = 0; e < 4; ++e) { const int kj = 16 * kb + 4 * fq + e; const bool ok = dir == 0 ? (kj <= tq) : (kj >= tq); if (!ok) acc[e] = 0.f; } }
        at[kb] = acc; }
    bf16x8 Pf[2];
#pragma unroll
    for (int kk = 0; kk < 2; ++kk) { float p[8];
#pragma unroll
        for (int e = 0; e < 4; ++e) { p[e] = at[2 * kk][e]; p[4 + e] = at[2 * kk + 1][e]; }
        Pf[kk] = __builtin_bit_cast(bf16x8, pack8(p)); }
    f32x4 O[8];
#pragma unroll
    for (int dvb = 0; dvb < 8; ++dvb) { f32x4 o = {0.f, 0.f, 0.f, 0.f};
#pragma unroll
        for (int kk = 0; kk < 2; ++kk) { const s16x4 lo = *(const LAS s16x4*)(VT + (16 * dvb + fr) * 72 + 32 * kk + 4 * fq), hi = *(const LAS s16x4*)(VT + (16 * dvb + fr) * 72 + 32 * kk + 16 + 4 * fq);
            const bf16x8 Vf = (bf16x8){lo[0], lo[1], lo[2], lo[3], hi[0], hi[1], hi[2], hi[3]}; o = MFMA16(Vf, Pf[kk], o); }
#pragma unroll
        for (int ks = 0; ks < 2; ++ks) o = MFMA16(Sf[dvb][ks], Qf[ks], o);
        O[dvb] = o; }
    if (dir == 1) {
#pragma unroll
        for (int dvb = 0; dvb < 8; ++dvb) *(LAS f32x4*)(OX + (tb * 16 + fr) * 132 + 16 * dvb + 4 * fq) = O[dvb]; }
    __syncthreads();
    if (dir == 0) { float ss = 0.f;
#pragma unroll
        for (int dvb = 0; dvb < 8; ++dvb) { O[dvb] += *(const LAS f32x4*)(OX + (tb * 16 + fr) * 132 + 16 * dvb + 4 * fq); ss += (O[dvb][0] * O[dvb][0] + O[dvb][1] * O[dvb][1]) + (O[dvb][2] * O[dvb][2] + O[dvb][3] * O[dvb][3]); }
        ss += __shfl_xor(ss, 16); ss += __shfl_xor(ss, 32);
        const float rstd = rsqrtf(ss * (1.f / 128.f) + 1e-6f);
        const size_t row = row0 + 16 * tb + fr;
#pragma unroll
        for (int dvb = 0; dvb < 8; ++dvb) { const int c = h * 128 + 16 * dvb + 4 * fq; const f32x4 g = *(const f32x4*)(gn + c); const u32x2 rr = *(const u32x2*)(Z + row * ZS + ZGR + c);
            const float r0 = bf2f(rr.x & 0xffffu), r1 = bf2f(rr.x >> 16), r2 = bf2f(rr.y & 0xffffu), r3 = bf2f(rr.y >> 16);
            u32x2 o; o.x = pk2(O[dvb][0] * rstd * g[0] * r0 * sigmoidf_(r0), O[dvb][1] * rstd * g[1] * r1 * sigmoidf_(r1)); o.y = pk2(O[dvb][2] * rstd * g[2] * r2 * sigmoidf_(r2), O[dvb][3] * rstd * g[3] * r3 * sigmoidf_(r3));
            *(u32x2*)(OB + row * D + 1536 + c) = o; } }
}
__device__ __forceinline__ void phase_pool2(const Args& a, int l, int wave, int lane) { const int npu = (l == 0 ? MT : ML) / 32; for (int u = blockIdx.x; u < npu; u += gridDim.x) pool_unit(a, l, u, wave, lane); }
__device__ __forceinline__ void phase_cgate2(const Args& a, int l, LAS unsigned char* lds, int tid, int wave, int lane) { const int n = (l == 0 ? 132 : 128) * 2; for (int u = blockIdx.x; u < n; u += gridDim.x) cgate_unit(a, l, u, lds, tid, wave, lane); }
__device__ __forceinline__ void phase_gla1b(const Args& a, int l, LAS unsigned char* lds, int tid, int wave, int lane) { for (int u = blockIdx.x; u < 1056; u += gridDim.x) gla1_unit(a, l, u, lds, tid, wave, lane); }
__device__ __forceinline__ void phase_gla3b(const Args& a, int l, LAS unsigned char* lds, int tid, int wave, int lane) { const int n = 8 * (l == 0 ? 132 : 128); for (int u = blockIdx.x; u < n; u += gridDim.x) gla3_unit(a, l, u, lds, tid, wave, lane); }


constexpr int CW_Q = 6144;
__device__ __forceinline__ void phase_attn(const Args& a, int l, LAS unsigned char* lds, int tid, int wave, int lane) { const int n = 256 + (l == 0 ? 8 : 0); for (int u = blockIdx.x; u < n; u += gridDim.x) attn_unit(a, l, u, lds, tid, wave, lane); }
#define DYN_BEGIN(ctrword) unsigned* _ctr = (unsigned*)(a.ws + WS_CTL) + (ctrword); volatile LAS int* _qs = (volatile LAS int*)(lds + LDS_BYTES - 32); int u; \
        { if (threadIdx.x == 0) _qs[0] = (int)atomicAdd(_ctr, 1u); __syncthreads(); u = _qs[0]; __syncthreads(); }
#define DYN_SEG(hi, BODY) while (u < (hi)) { unsigned _nx = 0u; if (threadIdx.x == 0) _nx = atomicAdd(_ctr, 1u); \
        BODY; \
        if (threadIdx.x == 0) _qs[0] = (int)_nx; \
        __syncthreads(); u = _qs[0]; }
__device__ __forceinline__ void conv_queue(const Args& a, int l, int half, LAS unsigned char* lds) {
    unsigned* c2 = (unsigned*)(a.ws + WS_CTL) + CW_Q + 64 * (8 + 2 * l + half); volatile LAS int* q2 = (volatile LAS int*)(lds + LDS_BYTES - 64);
    if (threadIdx.x == 0) q2[0] = (int)atomicAdd(c2, 1u);
    __syncthreads(); int cu = q2[0]; __syncthreads();
    while (cu < CONV_UNITS_PH) { unsigned n2 = 0u; if (threadIdx.x == 0) n2 = atomicAdd(c2, 1u);
        { const int t2 = fresh_tid(); conv_unit(a, l, half, cu, lds, __builtin_amdgcn_readfirstlane(t2 >> 6), t2 & 63); }
        __syncthreads(); if (threadIdx.x == 0) q2[0] = (int)n2; __syncthreads(); cu = q2[0]; }
    __syncthreads();
}
__device__ __forceinline__ void phase_mix_a(const Args& a, int l, LAS unsigned char* lds, int tid, int wave, int lane, int qoff = 0) {
    const int natt = 256, total = natt + 1056;
    const bool conv_first = ((blockIdx.x >> 3) & 7) < 3;
    if (DEFER_CONV && conv_first && qoff == 0) conv_queue(a, l, 0, lds);
    {
        DYN_BEGIN(CW_Q + 64 * (2 * l + qoff));
        DYN_SEG(natt, { const int t2 = fresh_tid(); if (ATTN2) attn_unit2(a, l, u, lds, t2, __builtin_amdgcn_readfirstlane(t2 >> 6), t2 & 63); else attn_unit(a, l, u, lds, t2, __builtin_amdgcn_readfirstlane(t2 >> 6), t2 & 63); });
        DYN_SEG(total, { const int t2 = fresh_tid(); gla1_unit(a, l, u - natt, lds, t2, __builtin_amdgcn_readfirstlane(t2 >> 6), t2 & 63); });
        __syncthreads();
    }
    if (DEFER_CONV && !conv_first && qoff == 0) conv_queue(a, l, 0, lds);
}
__device__ __forceinline__ void phase_mix_b(const Args& a, int l, LAS unsigned char* lds, int tid, int wave, int lane, int qoff = 0) {
    const int nat = (l == 0 ? 8 : 0), ncg = nat + (l == 0 ? 132 : 128) * 2, ng3 = 8 * (l == 0 ? 132 : 128), npu = (l == 0 ? MT : ML) / 32, total = ncg + ng3 + npu;
    const bool conv_first = ((blockIdx.x >> 3) & 7) < 3;
    if (DEFER_CONV && conv_first && qoff == 0) conv_queue(a, l, 1, lds);
    {
        DYN_BEGIN(CW_Q + 64 * (2 * l + 1 + qoff));
        if (l == 0) { DYN_SEG(nat, { const int t2 = fresh_tid(); attn_unit2(a, l, 256 + u, lds, t2, __builtin_amdgcn_readfirstlane(t2 >> 6), t2 & 63); }); }
        DYN_SEG(ncg, { const int t2 = fresh_tid(); cgate_unit(a, l, u - nat, lds, t2, __builtin_amdgcn_readfirstlane(t2 >> 6), t2 & 63); });
        DYN_SEG(ncg + npu, { const int t2 = fresh_tid(); __syncthreads(); pool_unit(a, l, u - ncg, __builtin_amdgcn_readfirstlane(t2 >> 6), t2 & 63); });
        DYN_SEG(total, { const int t2 = fresh_tid(); gla3_unit(a, l, u - ncg - npu, lds, t2, __builtin_amdgcn_readfirstlane(t2 >> 6), t2 & 63); });
        __syncthreads();
    }
    if (DEFER_CONV && !conv_first && qoff == 0) conv_queue(a, l, 1, lds);
}

__global__ void __launch_bounds__(512, 2) mk_fwd(Args a_formal) {
    const Args& a = *(const Args*)(const __attribute__((address_space(4))) Args*)__builtin_amdgcn_kernarg_segment_ptr();
    extern __shared__ __attribute__((aligned(16))) unsigned char lds_raw[];
    LAS unsigned char* lds = (LAS unsigned char*)lds_raw;
    const int lo = a.ph_lo, hi = a.ph_hi;
#define tid fresh_tid()
#define lane (fresh_tid() & 63)
#define wave __builtin_amdgcn_readfirstlane(fresh_tid() >> 6)
#if N_LAUNCH_MODE == 1
    volatile LAS unsigned* xbw = (volatile LAS unsigned*)(lds + LDS_BYTES - 16);
    if (threadIdx.x == 0) { xbw[0] = 0u; xbw[1] = 0u; }
    __syncthreads();
    XcdBarrier bar = xcd_barrier_post((unsigned*)(a.ws + WS_CTL) + CW_BAR, xbw);
#define GRID_BAR() xcd_barrier(bar)
#else
#define GRID_BAR() do { } while (0)
#endif
#ifdef ONLY_PHASE
#define IN(k) ((k) % 10 == ONLY_PHASE % 10 && ((k) == 0) == (ONLY_PHASE == 0) && ((k) == 21) == (ONLY_PHASE == 21) && lo <= (k) && (k) < hi)
#else
#define IN(k) (lo <= (k) && (k) < hi)
#endif
#define SEAM(k) do { if (hi > (k) + 1) GRID_BAR(); } while (0)
#define RPT(code, call) do { call; if (REPEAT == (code)) { __syncthreads(); call; } } while (0)
    if (IN(0)) { phase_absmax(a, tid, lane); GRID_BAR(); RPT(0, phase_prologue(a, lds, tid, wave, lane)); SEAM(0); }
#define LAYER_PHASES(l) do { constexpr int pb = 1 + 10 * (l); \
        if (IN(pb + 0)) { if (l == 0) phase_norm1<0>(a, l, wave, lane); else phase_norm1<1>(a, l, wave, lane); SEAM(pb + 0); } \
        if (IN(pb + 1)) { if (USE_G256 & 1) RPT(2, phase_proj2(a, l, lds)); else phase_proj(a, l, wave, lane); SEAM(pb + 1); } \
        if (IN(pb + 2)) { if (DYNQ) { phase_mix_a(a, l, lds, tid, wave, lane); if (REPEAT == 33) { __syncthreads(); phase_mix_a(a, l, lds, tid, wave, lane, 4); } } else { RPT(31, phase_gla1b(a, l, lds, tid, wave, lane)); RPT(32, phase_attn(a, l, lds, tid, wave, lane)); } SEAM(pb + 2); } \
        if (IN(pb + 3)) { RPT(41, phase_gla2b(a, tid)); if (!DYNQ) { RPT(42, phase_pool2(a, l, wave, lane)); RPT(43, phase_cgate2(a, l, lds, tid, wave, lane)); } SEAM(pb + 3); } \
        if (IN(pb + 4)) { if (DYNQ) { phase_mix_b(a, l, lds, tid, wave, lane); if (REPEAT == 35) { __syncthreads(); phase_mix_b(a, l, lds, tid, wave, lane, 4); } } else RPT(5, phase_gla3b(a, l, lds, tid, wave, lane)); SEAM(pb + 4); } \
        if (IN(pb + 5)) { if (USE_G256 & 2) RPT(6, phase_merge2(a, l, lds)); else phase_merge(a, l, wave, lane); SEAM(pb + 5); } \
        if (IN(pb + 6)) { if (USE_G256 & 4) { RPT(7, phase_outproj2(a, l, lds)); if (REPEAT == 107) { __syncthreads(); phase_outproj2(a, l, lds, 1); } } else phase_outproj(a, l, wave, lane); SEAM(pb + 6); } \
        if (IN(pb + 7)) { phase_norm2_router(a, l, lds, tid, wave, lane); SEAM(pb + 7); } \
        if (IN(pb + 8)) { RPT(9, phase_moe12(a, l, lds, tid)); SEAM(pb + 8); } \
        if (IN(pb + 9)) {   if (N_LAUNCH_MODE == 0) { SEAM(pb + 9); } } \
    } while (0)
    LAYER_PHASES(0);
    LAYER_PHASES(1);
    if (IN(21)) RPT(21, phase_norm1<2>(a, 2, wave, lane));
#undef tid
#undef lane
#undef wave
}

extern "C" void kernel_launch(void* const* d_in, const int* in_sizes, int n_in, void* d_out, int out_size, void* d_ws, size_t ws_size, hipStream_t stream) {
    static int grid = 0;
    if (grid == 0) {
        if (n_in != 28 || ws_size < WS_END) { fprintf(stderr, "kernel_launch: unexpected n_in %d / ws %zu (need %zu)\n", n_in, ws_size, (size_t)WS_END); grid = -1; return; }
        int dev = 0, cus = 0;
        if (hipGetDevice(&dev) != hipSuccess || hipDeviceGetAttribute(&cus, hipDeviceAttributeMultiprocessorCount, dev) != hipSuccess) { grid = -1; return; }
        if (hipFuncSetAttribute((const void*)mk_fwd, hipFuncAttributeMaxDynamicSharedMemorySize, LDS_BYTES) != hipSuccess) { grid = -1; return; }
        int per_cu = 0;
        if (hipOccupancyMaxActiveBlocksPerMultiprocessor(&per_cu, (const void*)mk_fwd, 512, LDS_BYTES) != hipSuccess || per_cu < 1) fprintf(stderr, "kernel_launch: occupancy query says %d\n", per_cu);
        (void)hipGetLastError();
        grid = cus;
    }
    if (grid < 0) return;
    (void)hipMemsetAsync((char*)d_ws + WS_CTL, 0, CTL_ZERO_BYTES, stream);
    Args a{};
    for (int i = 0; i < 28; ++i) a.in[i] = (const float*)d_in[i];
    a.out = (float*)d_out; a.ws = (unsigned char*)d_ws;
#if N_LAUNCH_MODE == 1
    a.ph_lo = 0; a.ph_hi = NPH;
    hipLaunchKernelGGL(mk_fwd, dim3(grid), dim3(512), LDS_BYTES, stream, a);
#else
    for (int p = 0; p < NPH; ++p) { a.ph_lo = p; a.ph_hi = p + 1; hipLaunchKernelGGL(mk_fwd, dim3(grid), dim3(512), LDS_BYTES, stream, a); }
#endif
}
```

```cpp
#include <hip/hip_runtime.h>
#include <cstdio>
#include <cstdint>

#define GAS __attribute__((address_space(1)))
#define LAS __attribute__((address_space(3)))
typedef unsigned short bf16;
typedef short bf16x8 __attribute__((ext_vector_type(8)));
typedef short s16x4 __attribute__((ext_vector_type(4)));
typedef float f32x4 __attribute__((ext_vector_type(4)));
typedef float f32x2 __attribute__((ext_vector_type(2)));
typedef unsigned u32x4 __attribute__((ext_vector_type(4)));
typedef unsigned u32x2 __attribute__((ext_vector_type(2)));
typedef int i32x4q __attribute__((ext_vector_type(4)));

#ifndef USE_G256
#define USE_G256 31
#endif
#ifndef ATTN2
#define ATTN2 1
#endif
#ifndef DYNQ
#define DEFER_CONV 1
#define DYNQ 1
#endif
#ifndef FP8Z
#define FP8Z 1
#endif
#ifndef MIX2
#define MIX2 7
#endif
#ifndef REPEAT
#define REPEAT -1
#endif
#ifndef N_LAUNCH_MODE
#define N_LAUNCH_MODE 1
#endif

constexpr int LDS_BYTES = 147456;
constexpr int D = 2048, SEQ = 8192, CTXL = 256, ML = 16384, MT = 16896;
constexpr int ZS = 4224;
constexpr int DP = 2176;
constexpr int ZQ = 0, ZK = 512, ZV = 640, ZP = 768, ZUV = 1280, ZGQ = 2304, ZGK = 2560, ZGV = 2816, ZGR = 3328, ZGLR = 3840, ZGATE = 4096;
constexpr int NPH = 22;
constexpr int CAP = 16896;
constexpr float LOG2E = 1.4426950408889634f;

constexpr size_t MiB = 1u << 20;
constexpr size_t WS_CTL = 0, CTL_ZERO_BYTES = 1 * MiB;
constexpr size_t WS_MOD = 1 * MiB;
constexpr size_t WS_ROPE = 1 * MiB + 512 * 1024;
constexpr size_t WS_PWT = 2 * MiB;
constexpr size_t WS_WSB = 2 * MiB + 512 * 1024;
constexpr size_t WS_LIST = 3 * MiB;
constexpr size_t WS_LISTW = 5 * MiB;
constexpr size_t WS_DECAY = 7 * MiB;
constexpr size_t WS_WCAT = 8 * MiB;
constexpr size_t WS_WCAT8 = 40 * MiB;
constexpr size_t WS_H8 = 88 * MiB;
constexpr size_t WS_WB = 122 * MiB;
constexpr size_t WS_WO = 138 * MiB;
constexpr size_t WS_WGU = 156 * MiB;
constexpr size_t WS_WD = 412 * MiB;
constexpr size_t WS_X = 540 * MiB;
constexpr size_t WS_H = 672 * MiB;
constexpr size_t WS_O = 738 * MiB;
constexpr size_t WS_S = 804 * MiB;
constexpr size_t WS_Z = 870 * MiB;
constexpr size_t WS_G8 = 1008 * MiB;
constexpr size_t WS_MX = 870 * MiB;
constexpr size_t WS_ACT = 870 * MiB;
constexpr size_t WS_Y = 944 * MiB;
constexpr size_t WS_SB = 1140 * MiB;
constexpr size_t WS_ACC = 1173 * MiB;
constexpr size_t WS_RS = 1244 * MiB;
constexpr size_t WS_H8I = 1245 * MiB;
constexpr size_t WS_ACC8 = 1279 * MiB;
constexpr size_t WS_WO8 = 1311 * MiB;
constexpr size_t WS_END = 1319 * MiB;
constexpr float EXPERT_MARGIN = 1.25f;
constexpr float W8SCALE = 64.f;
constexpr int CW_CNT = 64;
constexpr int CW_BAR = 8192;
constexpr int CW_WMAX = 12288;

__device__ __forceinline__ int fresh_tid() { int t; asm volatile("v_mov_b32 %0, %1" : "=v"(t) : "v"((int)threadIdx.x)); return t; }
__device__ __forceinline__ float bf2f(unsigned b) { return __uint_as_float(b << 16); }
__device__ __forceinline__ unsigned f2bf(float f) { return (unsigned)__builtin_bit_cast(unsigned short, (__bf16)f); }
typedef __bf16 bf16x2n __attribute__((ext_vector_type(2)));
typedef float f32x2n __attribute__((ext_vector_type(2)));
__device__ __forceinline__ unsigned pk2(float lo, float hi) { return __builtin_bit_cast(unsigned, __builtin_convertvector((f32x2n){lo, hi}, bf16x2n)); }
__device__ __forceinline__ unsigned q8pack(float a, float b, float c, float d) {
    const unsigned u0 = __float_as_uint(a + 12582912.f), u1 = __float_as_uint(b + 12582912.f), u2 = __float_as_uint(c + 12582912.f), u3 = __float_as_uint(d + 12582912.f);
    return __builtin_amdgcn_perm(u1, u0, 0x0c0c0400u) | __builtin_amdgcn_perm(u3, u2, 0x04000c0cu); }
__device__ __forceinline__ void unpack8(const u32x4 r, float (&o)[8]) {
    o[0] = __uint_as_float(r.x << 16); o[1] = __uint_as_float(r.x & 0xffff0000u); o[2] = __uint_as_float(r.y << 16); o[3] = __uint_as_float(r.y & 0xffff0000u);
    o[4] = __uint_as_float(r.z << 16); o[5] = __uint_as_float(r.z & 0xffff0000u); o[6] = __uint_as_float(r.w << 16); o[7] = __uint_as_float(r.w & 0xffff0000u);
}
__device__ __forceinline__ u32x4 pack8(const float (&o)[8]) { u32x4 r; r.x = pk2(o[0], o[1]); r.y = pk2(o[2], o[3]); r.z = pk2(o[4], o[5]); r.w = pk2(o[6], o[7]); return r; }
__device__ __forceinline__ float wave_sum(float v) {
#pragma unroll
    for (int o = 1; o < 64; o <<= 1) v += __shfl_xor(v, o);
    return v;
}
__device__ __forceinline__ int perm16(int n, int i) { return 8 * (i >> 2) + 4 * n + (i & 3); }
__device__ __forceinline__ float sigmoidf_(float x) { return __builtin_amdgcn_rcpf(1.f + __builtin_amdgcn_exp2f(-1.4426950408889634f * x)); }
__device__ __forceinline__ float gelu_tanh(float x) { const float u = x * (2.302208198f + 0.1029432397f * x * x); return x * __builtin_amdgcn_rcpf(1.f + __builtin_amdgcn_exp2f(-u)); }
#define MFMA16(a, b, c) __builtin_amdgcn_mfma_f32_16x16x32_bf16((a), (b), (c), 0, 0, 0)

__device__ __forceinline__ size_t g8_off(int i, int pm, int pn, int wv, int ai, int m, int bj, int ln) { return ((size_t)((i * 66 + pm) * 8 + pn) << 16) + (size_t)((((wv * 2 + ai) * 4 + m) * 2 + bj) * 64 + ln) * 8; }
struct Args { const float* in[28]; float* out; unsigned char* ws; int ph_lo, ph_hi; };

#define XB_TMO      128
#define XB_XCNT(j)  (256  + 64 * (j))
#define XB_XSUB(j)  (1280 + 64 * (j))
#define XB_XGEN(j)  (2304 + 64 * (j))
#define XB_TOP      3328
#define XB_TOPGEN   3392
#define XCD_BAR_WORDS 3456
#define XB_SPIN_CAP (1u << 18)
__device__ __forceinline__ unsigned xb_ld(unsigned* p)              { return __hip_atomic_load(p, __ATOMIC_RELAXED, __HIP_MEMORY_SCOPE_AGENT); }
__device__ __forceinline__ unsigned xb_add(unsigned* p, unsigned v) { return __hip_atomic_fetch_add(p, v, __ATOMIC_RELAXED, __HIP_MEMORY_SCOPE_AGENT); }
__device__ __forceinline__ unsigned xb_xcc_id() { return (unsigned)__builtin_amdgcn_s_getreg((3 << 11) | 20) & 0xFu; }
#define XB_SPIN(cond, bar) do { unsigned _sp = 0; while (cond) { __builtin_amdgcn_s_sleep(1); \
    if ((++_sp & 255u) == 0u) { if (xb_ld(&(bar)[XB_TMO])) break; if (_sp > XB_SPIN_CAP) { atomicAdd(&(bar)[XB_TMO], 1u); break; } } } } while (0)
struct XcdBarrier { unsigned* bar; unsigned x; volatile LAS unsigned* st; };
__device__ __forceinline__ XcdBarrier xcd_barrier_post(unsigned* bar, volatile LAS unsigned* st) {
    XcdBarrier b; b.bar = bar; b.x = xb_xcc_id(); b.st = st;
    if (threadIdx.x == 0) (void)xb_add(&bar[XB_XCNT(b.x)], 1u);
    return b;
}
__device__ __forceinline__ void xcd_barrier_complete(unsigned* bar, unsigned x, unsigned& nloc, unsigned& nx) {
    const unsigned G = gridDim.x * gridDim.y * gridDim.z;
    unsigned sum, cnt, mine, sp = 0u;
    for (;;) {
        sum = 0u; cnt = 0u; mine = 0u;
#pragma unroll
        for (unsigned j = 0; j < 16; ++j) { const unsigned c = xb_ld(&bar[XB_XCNT(j)]); sum += c; cnt += (c > 0u) ? 1u : 0u; mine = (j == x) ? c : mine; }
        if (sum == G) break;
        __builtin_amdgcn_s_sleep(1);
        if ((++sp & 255u) == 0u) { if (xb_ld(&bar[XB_TMO])) break; if (sp > XB_SPIN_CAP) { atomicAdd(&bar[XB_TMO], 1u); break; } }
    }
    nloc = mine > 0u ? mine : 1u; nx = cnt > 0u ? cnt : 1u;
}
__device__ __forceinline__ void xcd_barrier(const XcdBarrier& b) {
    asm volatile("s_waitcnt vmcnt(0)" ::: "memory");
    __syncthreads();
    if (threadIdx.x == 0) {
        unsigned* bar = b.bar;
        __builtin_amdgcn_s_waitcnt(0);
        unsigned nloc = b.st[0], nx = b.st[1];
        if (nloc == 0u) { xcd_barrier_complete(bar, b.x, nloc, nx); b.st[0] = nloc; b.st[1] = nx; }
        const unsigned old = xb_add(&bar[XB_XSUB(b.x)], 1u);
        const unsigned gen = old / nloc;
        if (old + 1u == (gen + 1u) * nloc) {
            __builtin_amdgcn_fence(__ATOMIC_RELEASE, "agent");
            asm volatile("s_waitcnt vmcnt(0)" ::: "memory");
            const unsigned og = xb_add(&bar[XB_TOP], 1u);
            const unsigned tg = og / nx;
            if (og + 1u == (tg + 1u) * nx) xb_add(&bar[XB_TOPGEN], 1u);
            else XB_SPIN(xb_ld(&bar[XB_TOPGEN]) == tg, bar);
            __builtin_amdgcn_fence(__ATOMIC_ACQUIRE, "agent");
            xb_add(&bar[XB_XGEN(b.x)], 1u);
            asm volatile("s_waitcnt vmcnt(0)" ::: "memory");
        } else {
            XB_SPIN(xb_ld(&bar[XB_XGEN(b.x)]) == gen, bar);
            __builtin_amdgcn_fence(__ATOMIC_ACQUIRE, "agent");
            asm volatile("s_waitcnt vmcnt(0)" ::: "memory");
        }
    }
    __syncthreads();
}

__device__ __forceinline__ void tr_item(const float* W, int N, bf16* dst, int ldd, int k0, int n0, LAS float* scr, int lane) {
#pragma unroll 8
    for (int i = 0; i < 32; ++i) { const int kk = 2 * i + (lane >> 5); scr[kk * 33 + (lane & 31)] = W[(size_t)(k0 + kk) * N + n0 + (lane & 31)]; }
    asm volatile("s_waitcnt lgkmcnt(0)" ::: "memory");
    const int c = lane & 7;
#pragma unroll
    for (int j = 0; j < 4; ++j) { const int n = (lane >> 3) + 8 * j; const LAS float* s = scr + (8 * c) * 33 + n;
        u32x4 o; o.x = pk2(s[0 * 33], s[1 * 33]); o.y = pk2(s[2 * 33], s[3 * 33]); o.z = pk2(s[4 * 33], s[5 * 33]); o.w = pk2(s[6 * 33], s[7 * 33]);
        *(u32x4*)(dst + (size_t)n * ldd + k0 + 8 * c) = o; }
    asm volatile("s_waitcnt lgkmcnt(0)" ::: "memory");
}

__device__ __forceinline__ void tr_item8(const float* W, int N, unsigned char* dst, int ldd, int k0, int n0, LAS float* scr, int lane) {
#pragma unroll 8
    for (int i = 0; i < 32; ++i) { const int kk = 2 * i + (lane >> 5); scr[kk * 33 + (lane & 31)] = W[(size_t)(k0 + kk) * N + n0 + (lane & 31)]; }
    asm volatile("s_waitcnt lgkmcnt(0)" ::: "memory");
    const int n = lane >> 1, kh = (lane & 1) * 32; const LAS float* sp = scr + kh * 33 + n;
    u32x4 o[2];
#pragma unroll
    for (int q = 0; q < 8; ++q) { unsigned p = 0u;
        p = __builtin_amdgcn_cvt_pk_fp8_f32(sp[(4 * q) * 33] * W8SCALE, sp[(4 * q + 1) * 33] * W8SCALE, p, false);
        p = __builtin_amdgcn_cvt_pk_fp8_f32(sp[(4 * q + 2) * 33] * W8SCALE, sp[(4 * q + 3) * 33] * W8SCALE, p, true);
        o[q >> 2][q & 3] = p; }
    *(u32x4*)(dst + (size_t)n * ldd + k0 + kh) = o[0]; *(u32x4*)(dst + (size_t)n * ldd + k0 + kh + 16) = o[1];
    asm volatile("s_waitcnt lgkmcnt(0)" ::: "memory");
}

__device__ __forceinline__ float wave_max(float v) {
#pragma unroll
    for (int o = 1; o < 64; o <<= 1) v = fmaxf(v, __shfl_xor(v, o));
    return v;
}
template <int SAMPLE> __device__ __forceinline__ void absmax_tensor(const float* W, size_t n4, unsigned* slot, int gt, int NT, int lane) {
    float m = 0.f;
    for (size_t j = (size_t)gt; j < n4 / SAMPLE; j += (size_t)NT) { const size_t i = SAMPLE == 1 ? j : ((j >> 6) * SAMPLE << 6) + (j & 63); const f32x4 v = ((const f32x4*)W)[i]; m = fmaxf(m, fmaxf(fmaxf(fabsf(v[0]), fabsf(v[1])), fmaxf(fabsf(v[2]), fabsf(v[3])))); }
    m = wave_max(m);
    if (lane == 0) atomicMax(slot, __float_as_uint(m));
}
__device__ __forceinline__ void phase_absmax(const Args& a, int tid, int lane) {
    const int gt = blockIdx.x * 512 + tid, NT = gridDim.x * 512;
    unsigned* wm = (unsigned*)(a.ws + WS_CTL) + CW_WMAX;
    for (int l = 0; l < 2; ++l) {
        absmax_tensor<1>(a.in[9] + (size_t)l * 2048 * 3872, (size_t)2048 * 3872 / 4, wm + l, gt, NT, lane);
        absmax_tensor<8>(a.in[21] + (size_t)l * 4 * 2048 * 2048, (size_t)4 * 2048 * 2048 / 4, wm + 2 + l, gt, NT, lane);
        absmax_tensor<8>(a.in[22] + (size_t)l * 2048 * 2048, (size_t)2048 * 2048 / 4, wm + 68 + l, gt, NT, lane);
    }
    { const int wv = gt >> 6, NWV = NT >> 6;
        for (int w2 = wv; w2 < 2048; w2 += NWV) { const int t = w2 & 63, sub = w2 >> 6; const float* W = (t < 32 ? a.in[25] : a.in[26]) + (size_t)(t & 31) * 2048 * 1024; float m = 0.f;
#pragma unroll 8
            for (int k = 0; k < 32; ++k) { const f32x4 v = ((const f32x4*)(W + (size_t)(sub + 32 * k) * 8 * 256))[lane]; m = fmaxf(m, fmaxf(fmaxf(fabsf(v[0]), fabsf(v[1])), fmaxf(fabsf(v[2]), fabsf(v[3])))); }
            m = wave_max(m); if (lane == 0) atomicMax(wm + 4 + t, __float_as_uint(m)); } }
}
struct TrDesc { const float* W; bf16* dst; unsigned char* dst8; int N, ldd, ldd8, k0, n0, fp8, late; float qinv; };
constexpr int TR_C0 = 2 * 3872, TR_C1 = TR_C0 + 8 * 2048, TR_C2 = TR_C1 + 8 * 512, TR_C3 = TR_C2 + 2 * 2048, TR_C4 = TR_C3 + 32 * 1024, TR_C5 = TR_C4 + 32 * 1024, TR_C6 = TR_C5 + 32 * 1024, TR_ITEMS = TR_C6 + 8 * 8;
__device__ __forceinline__ void tr_desc(const Args& a, int it, TrDesc& d) {
    unsigned char* ws = a.ws; const float* W; int N, ii; bf16* dst; int ldd; int rowsel = 0; unsigned char* dst8 = nullptr; int ldd8 = 0, widx = -1;
    if (it < TR_C0) { const int m = it / 3872; ii = it % 3872; W = a.in[9] + (size_t)m * 2048 * 3872; N = 3872; dst = (bf16*)(ws + WS_WCAT) + (size_t)m * 4096 * 2048; ldd = 2048; dst8 = (unsigned char*)(ws + WS_WCAT8) + (size_t)m * 12288 * 2048; }
    else if (it < TR_C1) { const int r = it - TR_C0, m = r / 2048; ii = r % 2048; W = a.in[21] + (size_t)m * 2048 * 2048; N = 2048; dst = nullptr; ldd = 2048; dst8 = (unsigned char*)(ws + WS_WCAT8) + ((size_t)(m >> 2) * 12288 + 4096 + (size_t)(m & 3) * 2048) * 2048; }
    else if (it < TR_C2) { const int r = it - TR_C1, m = r / 512; ii = r % 512; W = a.in[20] + (size_t)m * 512 * 2048; N = 2048; dst = (bf16*)(ws + WS_WB) + (size_t)(m >> 2) * 2048 * 2048 + (size_t)(m & 3) * 512; ldd = 2048; }
    else if (it < TR_C3) { const int r = it - TR_C2, m = r / 2048; ii = r % 2048; W = a.in[22] + (size_t)m * 2048 * 2048; N = 2048; dst = (bf16*)(ws + WS_WO) + (size_t)m * 2048 * DP; ldd = DP; dst8 = (unsigned char*)(ws + WS_WO8) + (size_t)m * 2048 * 2048; ldd8 = 2048; widx = 68 + m; }
    else if (it < TR_C4) { const int r = it - TR_C3, m = r / 1024; ii = r % 1024; W = a.in[25] + (size_t)m * 2048 * 1024; N = 1024; dst = nullptr; dst8 = (unsigned char*)(ws + WS_WGU) + (size_t)m * 2048 * 2048; ldd = 2048; rowsel = 1; widx = 4 + m; }
    else if (it < TR_C5) { const int r = it - TR_C4, m = r / 1024; ii = r % 1024; W = a.in[26] + (size_t)m * 2048 * 1024; N = 1024; dst = nullptr; dst8 = (unsigned char*)(ws + WS_WGU) + (size_t)m * 2048 * 2048; ldd = 2048; rowsel = 2; widx = 36 + m; }
    else if (it < TR_C6) { const int r = it - TR_C5, m = r / 1024; ii = r % 1024; W = a.in[27] + (size_t)m * 1024 * 2048; N = 2048; dst = (bf16*)(ws + WS_WD) + (size_t)m * 2048 * 1024; ldd = 1024; }
    else { const int r = it - TR_C6, m = r / 8; ii = r % 8; W = a.in[11] + (size_t)m * 128 * 128; N = 128; dst = (bf16*)(ws + WS_PWT) + (size_t)m * 128 * 128; ldd = 128; }
    const int nblk = N / 32, pr = ii >> 1, kb = 2 * (pr / nblk) + (ii & 1), nb = pr % nblk, n0 = 32 * nb;
    int drow = n0; if (rowsel) drow = 256 * (n0 >> 7) + 128 * (rowsel - 1) + (n0 & 127);
    d.W = W; d.N = N; d.ldd = ldd; d.k0 = 64 * kb; d.n0 = n0; d.dst = dst ? dst + (size_t)drow * ldd : nullptr; d.dst8 = dst8 ? dst8 + (size_t)drow * (ldd8 ? ldd8 : ldd) : nullptr; d.ldd8 = ldd8 ? ldd8 : ldd;
    d.qinv = 0.f; d.fp8 = 0; d.late = (it >= TR_C3 && it < TR_C6);
    if (dst8) { const unsigned* wm = (const unsigned*)(ws + WS_CTL) + CW_WMAX; if (widx < 0) widx = it < TR_C0 ? it / 3872 : 2 + ((it - TR_C0) / 2048 >> 2);
        float amax = __uint_as_float(__hip_atomic_load(wm + widx, __ATOMIC_RELAXED, __HIP_MEMORY_SCOPE_AGENT)); if (widx >= 4 && widx < 68) amax *= EXPERT_MARGIN; d.fp8 = (it >= TR_C0 && it < TR_C3); if (ldd8 == 0) ldd8 = ldd; d.qinv = amax > 0.f ? (d.fp8 ? 128.f : 127.f) / amax : 0.f; }
}
__device__ __forceinline__ void tr_load(const TrDesc& d, int lane, f32x4 (&rv)[8]) {
    const float* p = d.W + (size_t)(d.k0 + (lane >> 3)) * d.N + d.n0 + 4 * (lane & 7);
#pragma unroll
    for (int i = 0; i < 8; ++i) rv[i] = __builtin_nontemporal_load((const f32x4*)(p + (size_t)(8 * i) * d.N));
}
__device__ __forceinline__ void tr_finish(const TrDesc& d, const f32x4 (&rv)[8], LAS float* scr, int lane) {
    constexpr int SK = 68;
    { const int kr = lane >> 3, n4 = lane & 7;
#pragma unroll
        for (int i = 0; i < 8; ++i)
#pragma unroll
            for (int e = 0; e < 4; ++e) scr[(4 * n4 + e) * SK + 8 * i + kr] = rv[i][e]; }
    asm volatile("s_waitcnt lgkmcnt(0)" ::: "memory");
    if (d.dst) { const int c = lane & 7;
#pragma unroll
        for (int j = 0; j < 4; ++j) { const int n = (lane >> 3) + 8 * j; const LAS float* sp = scr + n * SK + 8 * c; const f32x4 a0 = *(const LAS f32x4*)sp, a1 = *(const LAS f32x4*)(sp + 4);
            u32x4 o; o.x = pk2(a0[0], a0[1]); o.y = pk2(a0[2], a0[3]); o.z = pk2(a1[0], a1[1]); o.w = pk2(a1[2], a1[3]);
            if (d.late) __builtin_nontemporal_store(o, (u32x4*)(d.dst + (size_t)n * d.ldd + d.k0 + 8 * c)); else *(u32x4*)(d.dst + (size_t)n * d.ldd + d.k0 + 8 * c) = o; } }
    if (d.dst8) {
#pragma unroll
        for (int hh = 0; hh < 2; ++hh) { const int n = (lane >> 2) + 16 * hh, q4 = (lane & 3) * 16; const LAS float* sp = scr + n * SK + q4; u32x4 o;
#pragma unroll
            for (int q = 0; q < 4; ++q) { const f32x4 w = *(const LAS f32x4*)(sp + 4 * q); unsigned p = 0u;
                if (d.fp8) { p = __builtin_amdgcn_cvt_pk_fp8_f32(w[0] * d.qinv, w[1] * d.qinv, p, false); p = __builtin_amdgcn_cvt_pk_fp8_f32(w[2] * d.qinv, w[3] * d.qinv, p, true); }
                else {
                    const unsigned u0 = __float_as_uint(__builtin_amdgcn_fmed3f(w[0] * d.qinv, -127.f, 127.f) + 12582912.f), u1 = __float_as_uint(__builtin_amdgcn_fmed3f(w[1] * d.qinv, -127.f, 127.f) + 12582912.f);
                    const unsigned u2 = __float_as_uint(__builtin_amdgcn_fmed3f(w[2] * d.qinv, -127.f, 127.f) + 12582912.f), u3 = __float_as_uint(__builtin_amdgcn_fmed3f(w[3] * d.qinv, -127.f, 127.f) + 12582912.f);
                    p = __builtin_amdgcn_perm(u1, u0, 0x0c0c0400u) | __builtin_amdgcn_perm(u3, u2, 0x04000c0cu); }
                o[q] = p; }
            if (d.late) __builtin_nontemporal_store(o, (u32x4*)(d.dst8 + (size_t)n * d.ldd8 + d.k0 + q4));
            else *(u32x4*)(d.dst8 + (size_t)n * d.ldd8 + d.k0 + q4) = o; } }
    asm volatile("s_waitcnt lgkmcnt(0)" ::: "memory");
}
__device__ __forceinline__ void phase_prologue(const Args& a, LAS unsigned char* lds, int tid, int wave, int lane) {
    unsigned char* ws = a.ws;
    if (blockIdx.x < 192) {
        LAS float* sv = (LAS float*)lds;
        LAS float* red = (LAS float*)(lds + 24576);
        for (int i = tid; i < 3 * 2048; i += 512) { const int r = i >> 11, k = i & 2047; const float v = r < 2 ? a.in[1][r * 2048 + k] : a.in[3][k]; sv[i] = v / (1.f + __expf(-v)); }
        __syncthreads();
        const int l = blockIdx.x / 96, cc = blockIdx.x % 96, c4 = tid & 31, kg = tid >> 5;
        const float* wp = a.in[4] + (size_t)l * 2048 * 12288 + (size_t)(kg * 128) * 12288 + cc * 128 + c4 * 4;
        f32x4 acc0 = {0, 0, 0, 0}, acc1 = acc0, acc2 = acc0;
#pragma unroll 8
        for (int k = 0; k < 128; ++k) { const f32x4 w = __builtin_nontemporal_load((const f32x4*)(wp + (size_t)k * 12288)); const int kk = kg * 128 + k;
            acc0 += w * sv[kk]; acc1 += w * sv[2048 + kk]; acc2 += w * sv[4096 + kk]; }
#pragma unroll
        for (int e = 0; e < 4; ++e) { red[(kg * 3 + 0) * 128 + c4 * 4 + e] = acc0[e]; red[(kg * 3 + 1) * 128 + c4 * 4 + e] = acc1[e]; red[(kg * 3 + 2) * 128 + c4 * 4 + e] = acc2[e]; }
        __syncthreads();
        if (tid < 384) { const int r = tid >> 7, c = tid & 127; float s = a.in[5][l * 12288 + cc * 128 + c];
#pragma unroll
            for (int g = 0; g < 16; ++g) s += red[(g * 3 + r) * 128 + c];
            ((float*)(ws + WS_MOD))[(l * 3 + r) * 12288 + cc * 128 + c] = s; }
        __syncthreads();
    }
    {
        LAS float* scr = (LAS float*)(lds + wave * 16384);
        const int gw = blockIdx.x * 8 + wave, NGW = gridDim.x * 8;
        constexpr int NPRO = DEFER_CONV ? TR_C3 + (TR_ITEMS - TR_C6) : TR_ITEMS;
#define PRO_ITEM(i) (!DEFER_CONV ? (i) : (i) < TR_C3 ? (i) : (i) - TR_C3 + TR_C6)
        TrDesc cur; f32x4 rv[8];
        int it = gw;
        if (it < NPRO) { tr_desc(a, PRO_ITEM(it), cur); tr_load(cur, lane, rv); }
        while (it < NPRO) {
            const int nit = it + NGW; TrDesc nd = cur; f32x4 rn[8];
            if (nit < NPRO) { tr_desc(a, PRO_ITEM(nit), nd); tr_load(nd, lane, rn); }
            tr_finish(cur, rv, scr, lane);
#pragma unroll
            for (int i = 0; i < 8; ++i) rv[i] = rn[i];
            cur = nd; it = nit;
        }
#undef PRO_ITEM
    }
    {
        const int gt = blockIdx.x * 512 + tid, NT = gridDim.x * 512;
        for (int i = gt; i < 2 * 224 * 256; i += NT) { const int l = i / (224 * 256), r = i % (224 * 256); ((u32x4*)((bf16*)(ws + WS_WCAT) + ((size_t)l * 4096 + 3872) * 2048))[r] = (u32x4){0u, 0u, 0u, 0u}; }
        for (int i = gt; i < 2 * 224 * 128; i += NT) { const int l = i / (224 * 128), r = i % (224 * 128); ((u32x4*)((unsigned char*)(ws + WS_WCAT8) + ((size_t)l * 12288 + 3872) * 2048))[r] = (u32x4){0u, 0u, 0u, 0u}; }
        for (int i = gt; i < 131072; i += NT) ((bf16*)(ws + WS_WSB))[i] = (bf16)f2bf(a.in[15][i]);
        for (int i = gt; i < 2048; i += NT) { const int pos = i >> 4, f = i & 15; const float inv = exp2f(-(float)f * (13.287712379549449f / 16.f));
            float rev = (float)pos * inv * 0.15915494309189535f; rev -= floorf(rev);
            ((float*)(ws + WS_ROPE))[i] = __builtin_amdgcn_cosf(rev); ((float*)(ws + WS_ROPE))[2048 + i] = __builtin_amdgcn_sinf(rev); }
    }
}

constexpr int CONV_UNIT = 64, CONV_UNITS_PH = 3 * 16384 / CONV_UNIT / 2;
__device__ __forceinline__ void conv_finish2(const f32x4 (&ra)[8], const f32x4 (&rb)[8], LAS float* scr, int lane, bool down, bf16* dstb, unsigned char* dst8, float qinv) {
    constexpr int SK = 132;
    { const int kr = lane >> 3, n4 = lane & 7;
#pragma unroll
        for (int i = 0; i < 8; ++i)
#pragma unroll
            for (int e = 0; e < 4; ++e) { scr[(4 * n4 + e) * SK + 8 * i + kr] = ra[i][e]; scr[(4 * n4 + e) * SK + 64 + 8 * i + kr] = rb[i][e]; } }
    asm volatile("s_waitcnt lgkmcnt(0)" ::: "memory");
    if (down) { const int c = lane & 15;
#pragma unroll
        for (int j = 0; j < 8; ++j) { const int n = (lane >> 4) + 4 * j; const LAS float* sp = scr + n * SK + 8 * c; const f32x4 a0 = *(const LAS f32x4*)sp, a1 = *(const LAS f32x4*)(sp + 4);
            u32x4 o; o.x = pk2(a0[0], a0[1]); o.y = pk2(a0[2], a0[3]); o.z = pk2(a1[0], a1[1]); o.w = pk2(a1[2], a1[3]);
            __builtin_nontemporal_store(o, (u32x4*)(dstb + (size_t)n * 1024 + 8 * c)); } }
    else { const int c = lane & 7;
#pragma unroll
        for (int j = 0; j < 4; ++j) { const int n = (lane >> 3) + 8 * j; const LAS float* sp = scr + n * SK + 16 * c; u32x4 o;
#pragma unroll
            for (int q = 0; q < 4; ++q) { const f32x4 w = *(const LAS f32x4*)(sp + 4 * q);
                const unsigned u0 = __float_as_uint(__builtin_amdgcn_fmed3f(w[0] * qinv, -127.f, 127.f) + 12582912.f), u1 = __float_as_uint(__builtin_amdgcn_fmed3f(w[1] * qinv, -127.f, 127.f) + 12582912.f);
                const unsigned u2 = __float_as_uint(__builtin_amdgcn_fmed3f(w[2] * qinv, -127.f, 127.f) + 12582912.f), u3 = __float_as_uint(__builtin_amdgcn_fmed3f(w[3] * qinv, -127.f, 127.f) + 12582912.f);
                o[q] = __builtin_amdgcn_perm(u1, u0, 0x0c0c0400u) | __builtin_amdgcn_perm(u3, u2, 0x04000c0cu); }
            __builtin_nontemporal_store(o, (u32x4*)(dst8 + (size_t)n * 2048 + 16 * c)); } }
    asm volatile("s_waitcnt lgkmcnt(0)" ::: "memory");
}
__device__ __forceinline__ void conv_unit(const Args& a, int l, int half, int cu, LAS unsigned char* lds, int wave, int lane) {
    LAS float* scr = (LAS float*)(lds + wave * 17408);
    const int jb = (half * CONV_UNITS_PH + cu) * CONV_UNIT, tj = jb >> 14, r = l * 16384 + (jb & 16383), m = r >> 10, uin = (r & 1023) >> 6;
    const bool down = tj == 2;
    const int N = down ? 2048 : 1024, kbA = down ? 2 * (uin >> 1) : 2 * uin, nb0 = (down ? 32 * (uin & 1) : 0) + wave;
    float qinv = 0.f;
    if (!down) { const unsigned* wm = (const unsigned*)(a.ws + WS_CTL) + CW_WMAX; const float amax = __uint_as_float(__hip_atomic_load(wm + (tj == 0 ? 4 : 36) + m, __ATOMIC_RELAXED, __HIP_MEMORY_SCOPE_AGENT)) * EXPERT_MARGIN; qinv = amax > 0.f ? 127.f / amax : 0.f; }
    const float* W = (tj == 0 ? a.in[25] : tj == 1 ? a.in[26] : a.in[27]) + (size_t)m * 2048 * 1024;
    const float* lp = W + (size_t)(64 * kbA + (lane >> 3)) * N + 4 * (lane & 7);
#define CONV_LD2(p, RA, RB) do { const float* _p = lp + 32 * (nb0 + 8 * (p)); _Pragma("unroll") for (int _i = 0; _i < 8; ++_i) { RA[_i] = __builtin_nontemporal_load((const f32x4*)(_p + (size_t)(8 * _i) * N)); RB[_i] = __builtin_nontemporal_load((const f32x4*)(_p + (size_t)(64 + 8 * _i) * N)); } } while (0)
#define CONV_FIN2(p, RA, RB) do { const int _n0 = 32 * (nb0 + 8 * (p)); \
        conv_finish2(RA, RB, scr, lane, down, (bf16*)(a.ws + WS_WD) + (size_t)m * 2048 * 1024 + (size_t)_n0 * 1024 + 64 * kbA, \
                     (unsigned char*)(a.ws + WS_WGU) + (size_t)m * 2048 * 2048 + (size_t)(256 * (_n0 >> 7) + 128 * tj + (_n0 & 127)) * 2048 + 64 * kbA, qinv); } while (0)
    f32x4 a0[8], b0[8], a1[8], b1[8];
    CONV_LD2(0, a0, b0);
    CONV_LD2(1, a1, b1); CONV_FIN2(0, a0, b0);
    CONV_LD2(2, a0, b0); CONV_FIN2(1, a1, b1);
    CONV_LD2(3, a1, b1); CONV_FIN2(2, a0, b0);
    CONV_FIN2(3, a1, b1);
#undef CONV_LD2
#undef CONV_FIN2
}

template <int MODE> __device__ __forceinline__ void norm1_load(const Args& a, int r, int lane, const float* MODp, f32x4 (&v)[8]) {
    const int mr = r < ML ? (r >> 13) : 2;
    if (MODE == 0) { const float* src = r < ML ? a.in[0] + (size_t)r * D : a.in[2] + (size_t)(r - ML) * D;
#pragma unroll
        for (int j = 0; j < 8; ++j) v[j] = __builtin_nontemporal_load((const f32x4*)(src + 4 * lane + 256 * j)); }
    else { const bf16* xr = (const bf16*)(a.ws + WS_X) + (size_t)r * D; const bf16* y0 = (const bf16*)(a.ws + WS_Y) + (size_t)(2 * r) * D; const bf16* y1 = y0 + D; const float* g2 = MODp + mr * 12288 + 5 * 2048;
#pragma unroll
        for (int j = 0; j < 8; ++j) { const int c = 4 * lane + 256 * j; const u32x2 px = __builtin_nontemporal_load((const u32x2*)(xr + c)); f32x4 x = {bf2f(px.x & 0xffffu), bf2f(px.x >> 16), bf2f(px.y & 0xffffu), bf2f(px.y >> 16)}; const u32x2 p0 = __builtin_nontemporal_load((const u32x2*)(y0 + c)), p1 = __builtin_nontemporal_load((const u32x2*)(y1 + c)); const f32x4 g = *(const f32x4*)(g2 + c);
            x[0] += g[0] * (bf2f(p0.x & 0xffffu) + bf2f(p1.x & 0xffffu)); x[1] += g[1] * (bf2f(p0.x >> 16) + bf2f(p1.x >> 16));
            x[2] += g[2] * (bf2f(p0.y & 0xffffu) + bf2f(p1.y & 0xffffu)); x[3] += g[3] * (bf2f(p0.y >> 16) + bf2f(p1.y >> 16)); v[j] = x; } }
}
template <int MODE> __device__ __forceinline__ void norm1_finish(const Args& a, int l, int r, int lane, const float* MODl, f32x4 (&v)[8]) {
    const int mr = r < ML ? (r >> 13) : 2;
    if (MODE != 2) { bf16* xr = (bf16*)(a.ws + WS_X) + (size_t)r * D;
#pragma unroll
        for (int j = 0; j < 8; ++j) { u32x2 o; o.x = pk2(v[j][0], v[j][1]); o.y = pk2(v[j][2], v[j][3]); __builtin_nontemporal_store(o, (u32x2*)(xr + 4 * lane + 256 * j)); } }
    float ss = 0.f;
#pragma unroll
    for (int j = 0; j < 8; ++j) ss += (v[j][0] * v[j][0] + v[j][1] * v[j][1]) + (v[j][2] * v[j][2] + v[j][3] * v[j][3]);
    const float rstd = rsqrtf(wave_sum(ss) * (1.f / D) + 1e-6f);
    if (MODE == 2) { float* o = a.out + (size_t)r * D; const float* g = a.in[8];
#pragma unroll
        for (int j = 0; j < 8; ++j) { const int c = 4 * lane + 256 * j; const f32x4 gg = *(const f32x4*)(g + c); __builtin_nontemporal_store(v[j] * rstd * gg, (f32x4*)(o + c)); } }
    else { bf16* h = (bf16*)(a.ws + WS_H) + (size_t)r * D; unsigned char* h8 = (unsigned char*)(a.ws + WS_H8) + (size_t)r * D; unsigned char* h8i = (unsigned char*)(a.ws + WS_H8I) + (size_t)r * D; const float* g = a.in[6] + l * D; const float* sh = MODl + mr * 12288; const float* sc = sh + 2048;
        float am = 0.f;
#pragma unroll
        for (int j = 0; j < 8; ++j) { const int c = 4 * lane + 256 * j; const f32x4 gg = *(const f32x4*)(g + c), s1 = *(const f32x4*)(sh + c), s2 = *(const f32x4*)(sc + c);
            v[j] = (v[j] * rstd * gg) * (s2 + 1.f) + s1; am = fmaxf(am, fmaxf(fmaxf(fabsf(v[j][0]), fabsf(v[j][1])), fmaxf(fabsf(v[j][2]), fabsf(v[j][3])))); }
        am = wave_max(am);
        const float qinv = am > 0.f ? 127.f / am : 0.f;
        if (lane == 0) ((float*)(a.ws + WS_RS))[r] = am * (1.f / 127.f);
#pragma unroll
        for (int j = 0; j < 8; ++j) { const int c = 4 * lane + 256 * j; const f32x4 y = v[j];
            if (r >= ML) { u32x2 o; o.x = pk2(y[0], y[1]); o.y = pk2(y[2], y[3]); *(u32x2*)(h + c) = o; }
            *(unsigned*)(h8i + c) = q8pack(y[0] * qinv, y[1] * qinv, y[2] * qinv, y[3] * qinv);
            unsigned p8 = 0u; p8 = __builtin_amdgcn_cvt_pk_fp8_f32(y[0], y[1], p8, false); p8 = __builtin_amdgcn_cvt_pk_fp8_f32(y[2], y[3], p8, true); *(unsigned*)(h8 + c) = p8; } }
}
template <int MODE> __device__ __forceinline__ void phase_norm1(const Args& a, int l, int wave, int lane, int probe = 0) {
    const int gw = blockIdx.x * 8 + wave, NGW = gridDim.x * 8;
    const float* MODl = (const float*)(a.ws + WS_MOD) + (size_t)(l < 2 ? l : 1) * 3 * 12288;
    const float* MODp = (const float*)(a.ws + WS_MOD) + (size_t)(l > 0 ? l - 1 : 0) * 3 * 12288;
    const int nrows = (MODE == 2) ? ML : MT;
    for (int r = gw; r < nrows; r += 2 * NGW) {
        const int r2 = r + NGW; const bool has2 = r2 < nrows;
        f32x4 v[8], w[8];
        norm1_load<MODE>(a, r, lane, MODp, v);
        if (has2) norm1_load<MODE>(a, r2, lane, MODp, w);
        norm1_finish<MODE>(a, l, r, lane, MODl, v);
        if (has2) norm1_finish<MODE>(a, l, r2, lane, MODl, w);
    }
}

__device__ __forceinline__ void router_row_load(const Args& a, int r, int lane, u32x2 (&pxr)[8], u32x2 (&pmr)[8]) {
    const bf16* xr = (const bf16*)(a.ws + WS_X) + (size_t)r * D; const bf16* mx = (const bf16*)(a.ws + WS_MX) + (size_t)r * D;
#pragma unroll
    for (int j = 0; j < 8; ++j) { const int c = 4 * lane + 256 * j; pxr[j] = __builtin_nontemporal_load((const u32x2*)(xr + c)); pmr[j] = __builtin_nontemporal_load((const u32x2*)(mx + c)); }
}
__device__ __forceinline__ void router_row_norm(const Args& a, int l, int r, int lane, const float* MODl, const u32x2 (&pxr)[8], const u32x2 (&pmr)[8], f32x4 (&v)[8]) {
    const int mr = r < ML ? (r >> 13) : 2; bf16* xr = (bf16*)(a.ws + WS_X) + (size_t)r * D; float ss = 0.f;
    const float* g1 = MODl + mr * 12288 + 2 * 2048;
#pragma unroll
    for (int j = 0; j < 8; ++j) { const int c = 4 * lane + 256 * j; const u32x2 px = pxr[j]; f32x4 x = {bf2f(px.x & 0xffffu), bf2f(px.x >> 16), bf2f(px.y & 0xffffu), bf2f(px.y >> 16)}; const u32x2 pm = pmr[j]; const f32x4 gg = *(const f32x4*)(g1 + c);
        x[0] += gg[0] * bf2f(pm.x & 0xffffu); x[1] += gg[1] * bf2f(pm.x >> 16); x[2] += gg[2] * bf2f(pm.y & 0xffffu); x[3] += gg[3] * bf2f(pm.y >> 16);
        { u32x2 o; o.x = pk2(x[0], x[1]); o.y = pk2(x[2], x[3]); __builtin_nontemporal_store(o, (u32x2*)(xr + c)); } v[j] = x; ss += (x[0] * x[0] + x[1] * x[1]) + (x[2] * x[2] + x[3] * x[3]); }
    const float rstd = rsqrtf(wave_sum(ss) * (1.f / D) + 1e-6f);
    bf16* h = (bf16*)(a.ws + WS_H) + (size_t)r * D; const float* g = a.in[7] + l * D; const float* sh = MODl + mr * 12288 + 3 * 2048; const float* sc = sh + 2048;
    float am = 0.f;
#pragma unroll
    for (int j = 0; j < 8; ++j) { const int c = 4 * lane + 256 * j; const f32x4 gg = *(const f32x4*)(g + c), s1 = *(const f32x4*)(sh + c), s2 = *(const f32x4*)(sc + c);
        v[j] = (v[j] * rstd * gg) * (s2 + 1.f) + s1; am = fmaxf(am, fmaxf(fmaxf(fabsf(v[j][0]), fabsf(v[j][1])), fmaxf(fabsf(v[j][2]), fabsf(v[j][3])))); }
    am = wave_max(am); const float qinv = am > 0.f ? 127.f / am : 0.f;
    if (lane == 0) ((float*)(a.ws + WS_RS))[r] = am * (1.f / 127.f);
    unsigned char* h8i = (unsigned char*)(a.ws + WS_H8I) + (size_t)r * D; (void)h;
#pragma unroll
    for (int j = 0; j < 8; ++j) { const int c = 4 * lane + 256 * j; const f32x4 y = v[j];
        *(unsigned*)(h8i + c) = q8pack(y[0] * qinv, y[1] * qinv, y[2] * qinv, y[3] * qinv); }
}
typedef float f32x2v __attribute__((ext_vector_type(2)));
__device__ __forceinline__ void router_select(float (&p)[16], int lane, const float* rb, int rl, LAS int* SELE, LAS float* SELW) {
    { const bool up = (lane & 32) != 0;
#pragma unroll
        for (int c = 0; c < 8; ++c) { const float mine = up ? p[c + 8] : p[c], other = up ? p[c] : p[c + 8]; p[c] = mine + __shfl_xor(other, 32); } }
    { const bool up = (lane & 16) != 0;
#pragma unroll
        for (int c = 0; c < 4; ++c) { const float mine = up ? p[c + 4] : p[c], other = up ? p[c] : p[c + 4]; p[c] = mine + __shfl_xor(other, 16); } }
    { const bool up = (lane & 8) != 0;
#pragma unroll
        for (int c = 0; c < 2; ++c) { const float mine = up ? p[c + 2] : p[c], other = up ? p[c] : p[c + 2]; p[c] = mine + __shfl_xor(other, 8); } }
    { const bool up = (lane & 4) != 0; const float mine = up ? p[1] : p[0], other = up ? p[0] : p[1]; p[0] = mine + __shfl_xor(other, 4); }
    p[0] += __shfl_xor(p[0], 2); p[0] += __shfl_xor(p[0], 1);
    float lg[16];
#pragma unroll
    for (int c = 0; c < 16; ++c) { const int src = ((c >> 3) & 1) * 32 + ((c >> 2) & 1) * 16 + ((c >> 1) & 1) * 8 + (c & 1) * 4; lg[c] = __builtin_bit_cast(float, __builtin_amdgcn_readlane(__builtin_bit_cast(int, p[0]), src)); }
    int best = 0; float bestv = -3.0e38f;
    float c0 = 0, c1 = 0, c2 = 0, c3 = 0, t0 = 0, t1 = 0, t2 = 0, t3 = 0;
#pragma unroll
    for (int gI = 0; gI < 4; ++gI) {
        const float s0 = 1.f / (1.f + __expf(-lg[4 * gI])), s1 = 1.f / (1.f + __expf(-lg[4 * gI + 1])), s2 = 1.f / (1.f + __expf(-lg[4 * gI + 2])), s3 = 1.f / (1.f + __expf(-lg[4 * gI + 3]));
        const float b0 = s0 + rb[4 * gI], b1 = s1 + rb[4 * gI + 1], b2 = s2 + rb[4 * gI + 2], b3 = s3 + rb[4 * gI + 3];
        const float gs = fmaxf(fmaxf(fmaxf(b0 + b1, b0 + b2), fmaxf(b0 + b3, b1 + b2)), fmaxf(b1 + b3, b2 + b3));
        if (gs > bestv) { bestv = gs; best = gI; c0 = b0; c1 = b1; c2 = b2; c3 = b3; t0 = s0; t1 = s1; t2 = s2; t3 = s3; }
    }
    int i0 = 0; float m0 = c0; if (c1 > m0) { m0 = c1; i0 = 1; } if (c2 > m0) { m0 = c2; i0 = 2; } if (c3 > m0) { m0 = c3; i0 = 3; }
    int i1 = -1; float m1 = -3.0e38f;
    if (i0 != 0 && c0 > m1) { m1 = c0; i1 = 0; } if (i0 != 1 && c1 > m1) { m1 = c1; i1 = 1; } if (i0 != 2 && c2 > m1) { m1 = c2; i1 = 2; } if (i0 != 3 && c3 > m1) { m1 = c3; i1 = 3; }
    const float w0 = i0 == 0 ? t0 : i0 == 1 ? t1 : i0 == 2 ? t2 : t3, w1 = i1 == 0 ? t0 : i1 == 1 ? t1 : i1 == 2 ? t2 : t3;
    const float wsum = w0 + w1;
    if (lane == 0) { SELE[rl] = (4 * best + i0) | ((4 * best + i1) << 8); SELW[2 * rl] = w0 / wsum; SELW[2 * rl + 1] = w1 / wsum; }
}
__device__ __forceinline__ void phase_norm2_router(const Args& a, int l, LAS unsigned char* lds, int tid, int wave, int lane, int probe = 0) {
    constexpr int RWS = 2052;
    LAS float* RW = (LAS float*)lds;
    LAS int* SELE = (LAS int*)(lds + 131328);
    LAS float* SELW = (LAS float*)(lds + 131328 + 512);
    LAS int* SLOT = (LAS int*)(lds + 131328 + 1536);
    LAS int* BASE = (LAS int*)(lds + 131328 + 2560);
    for (int i = tid; i < 32768; i += 512) { const int k = i >> 4, c = i & 15; RW[c * RWS + k] = a.in[23][i]; }
    __syncthreads();
    const float* MODl = (const float*)(a.ws + WS_MOD) + (size_t)l * 3 * 12288;
    unsigned* cnt = (unsigned*)(a.ws + WS_CTL) + CW_CNT + 64 * 16 * l;
    int* LIST = (int*)(a.ws + WS_LIST); float* LISTW = (float*)(a.ws + WS_LISTW);
    const int nrows = (l == 0) ? MT : ML;
    const int R = (nrows + (int)gridDim.x - 1) / (int)gridDim.x, rbase = (int)blockIdx.x * R;
    const int HP = R >> 1;
    u32x2 pxa[8], pma[8], pxb[8], pmb[8];
    if (wave < HP) { router_row_load(a, rbase + wave, lane, pxa, pma); router_row_load(a, rbase + wave + HP, lane, pxb, pmb); }
    for (int rl = wave; rl < HP; rl += 8) {
        const int rl2 = rl + HP, r = rbase + rl, r2 = rbase + rl2;
        f32x4 v[8], w2[8];
        router_row_norm(a, l, r, lane, MODl, pxa, pma, v);
        router_row_norm(a, l, r2, lane, MODl, pxb, pmb, w2);
        if (rl + 8 < HP) { router_row_load(a, r + 8, lane, pxa, pma); router_row_load(a, r2 + 8, lane, pxb, pmb); }
        float p[16], q[16];
#pragma unroll
        for (int c = 0; c < 16; ++c) { f32x2v s12 = {0.f, 0.f};
#pragma unroll
            for (int j = 0; j < 8; ++j) { const f32x4 w = *(const LAS f32x4*)(RW + c * RWS + 4 * lane + 256 * j);
#pragma unroll
                for (int e = 0; e < 4; ++e) s12 = __builtin_elementwise_fma((f32x2v){v[j][e], w2[j][e]}, (f32x2v){w[e], w[e]}, s12); }
            p[c] = s12[0]; q[c] = s12[1]; asm volatile("" : "+v"(p[c]), "+v"(q[c]) :: "memory"); }
        router_select(p, lane, a.in[24], rl, SELE, SELW);
        router_select(q, lane, a.in[24], rl2, SELE, SELW);
    }
    __syncthreads();
    const int nloc = (nrows - rbase) < R ? (nrows - rbase > 0 ? nrows - rbase : 0) : R;
    if (tid < 16) { int c = 0;
        for (int rl = 0; rl < nloc; ++rl) { const int se = SELE[rl]; if ((se & 255) == tid) { SLOT[2 * rl] = c; ++c; } if ((se >> 8) == tid) { SLOT[2 * rl + 1] = c; ++c; } }
        BASE[tid] = c ? (int)atomicAdd(cnt + 64 * tid, (unsigned)c) : 0; }
    __syncthreads();
    if (tid < nloc) { const int se = SELE[tid], e0 = se & 255, e1 = se >> 8, r = rbase + tid;
        const int k0 = BASE[e0] + SLOT[2 * tid], k1 = BASE[e1] + SLOT[2 * tid + 1];
        LIST[e0 * CAP + k0] = 2 * r; LISTW[e0 * CAP + k0] = SELW[2 * tid]; LIST[e1 * CAP + k1] = 2 * r + 1; LISTW[e1 * CAP + k1] = SELW[2 * tid + 1]; }
}

namespace pg8 {
constexpr int BM = 256, BK = 64, HALF = 128, HTB = HALF * BK * 2, STAGE_BYTES = 8 * HTB, NXCD = 8, WGM = 8;
__device__ __forceinline__ int lds_byte(int r, int c) { const int st = (r >> 4) * 2 + (c >> 5), rr = r & 15, cc = c & 31, ob = rr * 64 + cc * 2; return st * 1024 + (ob ^ (((ob >> 9) & 1) << 5)); }
__device__ __forceinline__ void stage_rc(int b, int& R, int& C) { const int st = b / 1024, sb = b % 1024, swz = sb ^ (((sb >> 9) & 1) << 5); R = (st >> 1) * 16 + swz / 64; C = (st & 1) * 32 + (swz % 64) / 2; }
__device__ __forceinline__ int perm32(int rho) { const int n = rho >> 4, i = rho & 15; return 8 * (i >> 2) + 4 * n + (i & 3); }
typedef int i32x4v __attribute__((ext_vector_type(4)));
typedef int i32x8v __attribute__((ext_vector_type(8)));
__device__ __forceinline__ i32x4v lo4(i32x8v v) { return __builtin_shufflevector(v, v, 0, 1, 2, 3); }
__device__ __forceinline__ i32x4v hi4(i32x8v v) { return __builtin_shufflevector(v, v, 4, 5, 6, 7); }
__device__ __forceinline__ bf16x8 lo8(i32x8v v) { return __builtin_bit_cast(bf16x8, (i32x4v)__builtin_shufflevector(v, v, 0, 1, 2, 3)); }
__device__ __forceinline__ bf16x8 hi8(i32x8v v) { return __builtin_bit_cast(bf16x8, (i32x4v)__builtin_shufflevector(v, v, 4, 5, 6, 7)); }
__device__ __forceinline__ i32x8v cat8(bf16x8 lo, bf16x8 hi) { const i32x4v a = __builtin_bit_cast(i32x4v, lo), b = __builtin_bit_cast(i32x4v, hi); return __builtin_shufflevector(a, b, 0, 1, 2, 3, 4, 5, 6, 7); }
struct Unit { int pm, pn, e, cnt; };
__device__ __forceinline__ unsigned cvt_pk_bf16(float lo, float hi) { return pk2(lo, hi); }
__device__ __forceinline__ void static_tile(int L, int nM, int nN, int& pm, int& pn) {
    const int nwg = nM * nN; int wgid = L; { const int q = nwg / NXCD, r = nwg % NXCD, xcd = wgid % NXCD, off = wgid / NXCD; wgid = (xcd < r ? xcd * (q + 1) : r * (q + 1) + (xcd - r) * q) + off; }
    const int nig = WGM * nN, gid = wgid / nig, fm = gid * WGM, gsz = (nM - fm) < WGM ? (nM - fm) : WGM;
    pm = fm + ((wgid % nig) % gsz); pn = (wgid % nig) / gsz;
}
template <class Epi, bool KHOOK> struct HookState { struct type {}; };
template <class Epi> struct HookState<Epi, true> { typedef typename Epi::State type; };
template <class Epi, class Sched, bool KHOOK, int DT = 0>
__device__ __forceinline__ void gemm256(LAS unsigned char* lds, const char* Abase, const int Kb, const Sched& S, const Epi& E) {
    const int tid = fresh_tid(), wid = __builtin_amdgcn_readfirstlane(tid >> 6), lane = tid & 63, wr = wid >> 2, wc = wid & 3, fr = lane & 15, fq = lane >> 4;
    const int nt = Kb / 128;
    unsigned voffB[2];
#pragma unroll
    for (int i = 0; i < 2; ++i) { int R, C; stage_rc(tid * 16 + i * 8192, R, C); const int Rb = Epi::PERM ? ((R & ~31) + perm32(R & 31)) : R; voffB[i] = (unsigned)Rb * S.ldb_bytes() + (unsigned)(C * 2); }
#define PG8_RS(i) ({ int _R, _C; stage_rc(tid * 16 + (i) * 8192, _R, _C); _R; })
#define PG8_CS(i) ({ int _R, _C; stage_rc(tid * 16 + (i) * 8192, _R, _C); (unsigned)(_C * 2); })
    const unsigned kstep = 128u, hstepB = (unsigned)HALF * S.ldb_bytes();
    const __amdgpu_buffer_rsrc_t rA = __builtin_amdgcn_make_buffer_rsrc((void*)Abase, 0, 0x7fffffff, 0x00020000), rB = __builtin_amdgcn_make_buffer_rsrc((void*)S.wbase(), 0, 0x7fffffff, 0x00020000);
    const unsigned ldsw = (unsigned)wid * 1024u;
    const int aoff = lds_byte(wr * 64 + fr, fq * 8), boff = lds_byte(wc * 32 + fr, fq * 8);
#define PG8_SA(b, h) (((b) * 2 + (h)) * HTB)
#define PG8_SB(b, h) ((4 + (b) * 2 + (h)) * HTB)
#define PG8_STAGE(bufoff, rsrc, soff, voff) do { _Pragma("unroll") for (int _i = 0; _i < 2; ++_i) \
        __builtin_amdgcn_raw_ptr_buffer_load_lds(rsrc, (LAS void*)(lds + (bufoff) + ldsw + _i * 8192), 16, (int)(voff)[_i], (int)(soff), 0, 0); } while (0)
#define PG8_LDA(dst, b, h) do { _Pragma("unroll") for (int m = 0; m < 4; ++m) { const i32x4v _lo = *(const LAS i32x4v*)(lds + PG8_SA(b, h) + aoff + m * 2048), _hi = *(const LAS i32x4v*)(lds + PG8_SA(b, h) + aoff + m * 2048 + 1024); dst[m] = __builtin_shufflevector(_lo, _hi, 0, 1, 2, 3, 4, 5, 6, 7); } } while (0)
#define PG8_LDB(dst, b, h) do { _Pragma("unroll") for (int n = 0; n < 2; ++n) { const i32x4v _lo = *(const LAS i32x4v*)(lds + PG8_SB(b, h) + boff + n * 2048), _hi = *(const LAS i32x4v*)(lds + PG8_SB(b, h) + boff + n * 2048 + 1024); dst[n] = __builtin_shufflevector(_lo, _hi, 0, 1, 2, 3, 4, 5, 6, 7); } } while (0)
#define PG8_MMA(ai, bj, At, Bt) do { __builtin_amdgcn_s_setprio(1); _Pragma("unroll") for (int m = 0; m < 4; ++m) _Pragma("unroll") for (int n = 0; n < 2; ++n) { \
        if constexpr (DT == 0) { acc[ai][bj][m][n] = __builtin_amdgcn_mfma_f32_16x16x32_bf16(lo8(Bt[n]), lo8(At[m]), acc[ai][bj][m][n], 0, 0, 0); acc[ai][bj][m][n] = __builtin_amdgcn_mfma_f32_16x16x32_bf16(hi8(Bt[n]), hi8(At[m]), acc[ai][bj][m][n], 0, 0, 0); } \
        else if constexpr (DT == 1) { acc[ai][bj][m][n] = __builtin_amdgcn_mfma_scale_f32_16x16x128_f8f6f4(Bt[n], At[m], acc[ai][bj][m][n], 0, 0, 0, 0, 0, 0); } \
        else { i32x4v _c = __builtin_bit_cast(i32x4v, acc[ai][bj][m][n]); _c = __builtin_amdgcn_mfma_i32_16x16x64_i8(lo4(Bt[n]), lo4(At[m]), _c, 0, 0, 0); _c = __builtin_amdgcn_mfma_i32_16x16x64_i8(hi4(Bt[n]), hi4(At[m]), _c, 0, 0, 0); acc[ai][bj][m][n] = __builtin_bit_cast(f32x4, _c); } } \
        __builtin_amdgcn_s_setprio(0); } while (0)
#define PG8_WAIT_V(n) asm volatile("s_waitcnt vmcnt(" #n ")" ::: "memory")
#define PG8_WAIT_L(n) asm volatile("s_waitcnt lgkmcnt(" #n ")" ::: "memory")
#define PG8_BAR __builtin_amdgcn_s_barrier()
#define PG8_SCHED __builtin_amdgcn_sched_barrier(0)
    Unit cur, nxt; int ui = 0;
    if (!S.next(0, cur)) return;
    f32x4 acc[2][2][4][2];
#pragma unroll
    for (int a = 0; a < 2; ++a)
#pragma unroll
        for (int b = 0; b < 2; ++b)
#pragma unroll
            for (int m = 0; m < 4; ++m)
#pragma unroll
                for (int n = 0; n < 2; ++n) acc[a][b][m][n] = (f32x4){0.f, 0.f, 0.f, 0.f};
    i32x8v At[4], B0[2], B1[2];
    typename HookState<Epi, KHOOK>::type hst;
    unsigned vA0[2], vA1[2], nA0[2], nA1[2];
    unsigned cAs = 0u, nAs = 0u;
    const unsigned hA = Sched::GATHER ? 0u : (unsigned)HALF * S.lda_bytes();
    if constexpr (Sched::GATHER) {
#pragma unroll
        for (int i = 0; i < 2; ++i) { vA0[i] = S.arow_off(cur, PG8_RS(i)) + PG8_CS(i); vA1[i] = S.arow_off(cur, HALF + PG8_RS(i)) + PG8_CS(i); }
    } else {
#pragma unroll
        for (int i = 0; i < 2; ++i) { vA0[i] = (unsigned)PG8_RS(i) * S.lda_bytes() + PG8_CS(i); vA1[i] = vA0[i]; nA0[i] = vA0[i]; nA1[i] = vA0[i]; }
        cAs = S.aoff(cur);
    }
    unsigned cB = S.boff(cur);
    S.a_ready(cur);
    PG8_STAGE(PG8_SB(0, 0), rB, cB, voffB); PG8_STAGE(PG8_SB(0, 1), rB, cB + hstepB, voffB); PG8_STAGE(PG8_SA(0, 0), rA, cAs, vA0); PG8_STAGE(PG8_SA(0, 1), rA, cAs + hA, vA1);
    if (wr == 1) PG8_BAR;
    PG8_WAIT_V(2); PG8_BAR;
    PG8_STAGE(PG8_SB(1, 0), rB, cB + kstep, voffB); PG8_STAGE(PG8_SA(1, 0), rA, cAs + kstep, vA0); PG8_STAGE(PG8_SB(1, 1), rB, cB + hstepB + kstep, voffB);
    PG8_WAIT_V(6); PG8_BAR;
    for (;;) {
        const bool has_next = S.next(ui + 1, nxt);
        const unsigned nB = has_next ? S.boff(nxt) : cB;
        if constexpr (Sched::GATHER) {
#pragma unroll
            for (int i = 0; i < 2; ++i) { nA0[i] = has_next ? S.arow_off(nxt, PG8_RS(i)) + PG8_CS(i) : vA0[i]; nA1[i] = has_next ? S.arow_off(nxt, HALF + PG8_RS(i)) + PG8_CS(i) : vA1[i]; }
        } else nAs = has_next ? S.aoff(nxt) : cAs;
        for (int t = 0; t < nt; t += 2) {
            const bool last = (t == nt - 2);
            const unsigned a1 = cAs + (unsigned)(t + 1) * kstep;
            const unsigned a2 = last ? nAs : cAs + (unsigned)(t + 2) * kstep, b2 = last ? nB : cB + (unsigned)(t + 2) * kstep;
            const unsigned a3 = a2 + kstep, b3 = b2 + kstep;
            if (last && has_next) S.a_ready(nxt);
            unsigned w0[2], w1[2];
#pragma unroll
            for (int i = 0; i < 2; ++i) { w0[i] = (Sched::GATHER && last) ? nA0[i] : vA0[i]; w1[i] = (Sched::GATHER && last) ? nA1[i] : vA1[i]; }
            PG8_LDB(B0, 0, 0); PG8_LDB(B1, 0, 1); PG8_SCHED; PG8_LDA(At, 0, 0); PG8_STAGE(PG8_SA(1, 1), rA, a1 + hA, vA1);
            PG8_WAIT_V(8); PG8_WAIT_L(0); PG8_BAR; PG8_MMA(0, 0, At, B0); PG8_MMA(0, 1, At, B1); PG8_BAR; PG8_SCHED;
            PG8_LDA(At, 0, 1); PG8_STAGE(PG8_SB(0, 0), rB, b2, voffB); PG8_STAGE(PG8_SB(0, 1), rB, b2 + hstepB, voffB); PG8_STAGE(PG8_SA(0, 0), rA, a2, w0);
            PG8_WAIT_V(8); PG8_WAIT_L(0); PG8_BAR; PG8_MMA(1, 0, At, B0); PG8_MMA(1, 1, At, B1); PG8_BAR; PG8_SCHED;
            PG8_LDB(B0, 1, 0); PG8_LDB(B1, 1, 1); PG8_SCHED; PG8_LDA(At, 1, 0); PG8_STAGE(PG8_SA(0, 1), rA, a2 + hA, w1);
            PG8_WAIT_V(8); PG8_WAIT_L(0); PG8_BAR; PG8_MMA(0, 0, At, B0); PG8_MMA(0, 1, At, B1); PG8_BAR; PG8_SCHED;
            PG8_LDA(At, 1, 1); PG8_STAGE(PG8_SB(1, 0), rB, b3, voffB); PG8_STAGE(PG8_SB(1, 1), rB, b3 + hstepB, voffB); PG8_STAGE(PG8_SA(1, 0), rA, a3, w0);
            PG8_WAIT_V(8); PG8_WAIT_L(0); PG8_BAR; PG8_MMA(1, 0, At, B0); PG8_MMA(1, 1, At, B1); PG8_BAR; PG8_SCHED;
            if constexpr (KHOOK) { if (!last && ((t + 2) & 7) == 0) { int fr2 = fr, fq2 = fq; asm volatile("" : "+v"(fr2), "+v"(fq2)); E.khook(acc, hst, cur, ((t + 2) >> 3) - 1, wr, wc, fr2, fq2); } }
        }
        if (wr == 0) PG8_BAR;
        { int fr2 = fr, fq2 = fq; asm volatile("" : "+v"(fr2), "+v"(fq2)); if constexpr (KHOOK) E.fin(acc, hst, cur, wr, wc, fr2, fq2); else E(acc, cur, wr, wc, fr2, fq2); }
        S.done(cur);
        if (!has_next) break;
#pragma unroll
        for (int a = 0; a < 2; ++a)
#pragma unroll
            for (int b = 0; b < 2; ++b)
#pragma unroll
                for (int m = 0; m < 4; ++m)
#pragma unroll
                    for (int n = 0; n < 2; ++n) acc[a][b][m][n] = (f32x4){0.f, 0.f, 0.f, 0.f};
        cur = nxt; cB = nB; cAs = nAs; ++ui;
        if constexpr (Sched::GATHER) {
#pragma unroll
            for (int i = 0; i < 2; ++i) { vA0[i] = nA0[i]; vA1[i] = nA1[i]; } }
        if (wr == 1) PG8_BAR;
    }
    PG8_WAIT_V(0);
    PG8_BAR;
#undef PG8_RS
#undef PG8_CS
#undef PG8_SA
#undef PG8_SB
#undef PG8_STAGE
#undef PG8_LDA
#undef PG8_LDB
#undef PG8_MMA
#undef PG8_WAIT_V
#undef PG8_WAIT_L
#undef PG8_BAR
#undef PG8_SCHED
}
}

template <int UNR = 2> __device__ __forceinline__ void sgemm_k(f32x4 (&acc)[4][2][2], const bf16* (&pa)[4], const bf16* (&pb)[2][2], int K) {
#pragma unroll UNR
    for (int k = 0; k < K; k += 32) {
        bf16x8 af[4], bfr[2][2];
#pragma unroll
        for (int mi = 0; mi < 4; ++mi) af[mi] = *(const bf16x8*)(pa[mi] + k);
#pragma unroll
        for (int cp = 0; cp < 2; ++cp)
#pragma unroll
            for (int n = 0; n < 2; ++n) bfr[cp][n] = *(const bf16x8*)(pb[cp][n] + k);
#pragma unroll
        for (int mi = 0; mi < 4; ++mi)
#pragma unroll
            for (int cp = 0; cp < 2; ++cp)
#pragma unroll
                for (int n = 0; n < 2; ++n) acc[mi][cp][n] = MFMA16(bfr[cp][n], af[mi], acc[mi][cp][n]);
    }
}
#define ZERO_ACC(acc) do { _Pragma("unroll") for (int _a = 0; _a < 4; ++_a) _Pragma("unroll") for (int _b = 0; _b < 2; ++_b) _Pragma("unroll") for (int _c = 0; _c < 2; ++_c) acc[_a][_b][_c] = (f32x4){0.f, 0.f, 0.f, 0.f}; } while (0)

__device__ __forceinline__ void phase_proj(const Args& a, int l, int wave, int lane) {
    const bf16* H = (const bf16*)(a.ws + WS_H); const bf16* W = (const bf16*)(a.ws + WS_WCAT) + (size_t)l * 4096 * 2048; bf16* Z = (bf16*)(a.ws + WS_Z);
    const int fr = lane & 15, fq = lane >> 4, wr = wave >> 2, wc = wave & 3;
    for (int u = blockIdx.x; u < 132 * 48; u += gridDim.x) {
        const int pn = u % 48, pm = u / 48;
        if (l == 1 && pm >= 128 && pn >= 16) continue;
        const int r0 = 128 * pm + 64 * wr, c0 = 256 * pn + 64 * wc;
        const bf16* pa[4]; const bf16* pb[2][2];
#pragma unroll
        for (int mi = 0; mi < 4; ++mi) pa[mi] = H + (size_t)(r0 + 16 * mi + fr) * D + 8 * fq;
#pragma unroll
        for (int cp = 0; cp < 2; ++cp)
#pragma unroll
            for (int n = 0; n < 2; ++n) pb[cp][n] = W + (size_t)(c0 + 32 * cp + perm16(n, fr)) * D + 8 * fq;
        f32x4 acc[4][2][2]; ZERO_ACC(acc);
        sgemm_k(acc, pa, pb, D);
        const int act = (pn >= 5 && pn < 9) ? 1 : (pn >= 16 ? 2 : 0);
#pragma unroll
        for (int mi = 0; mi < 4; ++mi)
#pragma unroll
            for (int cp = 0; cp < 2; ++cp) { float o[8];
#pragma unroll
                for (int e = 0; e < 4; ++e) { o[e] = acc[mi][cp][0][e]; o[4 + e] = acc[mi][cp][1][e]; }
                if (act == 1) {
#pragma unroll
                    for (int e = 0; e < 8; ++e) o[e] = gelu_tanh(o[e]); }
                else if (act == 2) {
#pragma unroll
                    for (int e = 0; e < 8; ++e) o[e] = sigmoidf_(o[e]); }
                *(u32x4*)(Z + (size_t)(r0 + 16 * mi + fr) * ZS + c0 + 32 * cp + 8 * fq) = pack8(o); }
    }
}

__device__ __forceinline__ void phase_merge(const Args& a, int l, int wave, int lane) {
    const bf16* OB = (const bf16*)(a.ws + WS_O); const bf16* W = (const bf16*)(a.ws + WS_WB) + (size_t)l * 2048 * 2048; const bf16* Z = (const bf16*)(a.ws + WS_Z); bf16* ACC = (bf16*)(a.ws + WS_S);
    const int fr = lane & 15, fq = lane >> 4, wr = wave >> 2, wc = wave & 3;
    const int npm = (l == 0) ? 132 : 128;
    for (int u = blockIdx.x; u < npm * 8; u += gridDim.x) {
        const int pn = u & 7, pm = u >> 3;
        const int r0 = 128 * pm + 64 * wr, c0 = 256 * pn + 64 * wc;
        f32x4 tot[4][2][2]; ZERO_ACC(tot);
#pragma unroll 1
        for (int i = 0; i < 4; ++i) {
            const bf16* pa[4]; const bf16* pb[2][2];
#pragma unroll
            for (int mi = 0; mi < 4; ++mi) pa[mi] = OB + (size_t)(r0 + 16 * mi + fr) * D + 512 * i + 8 * fq;
#pragma unroll
            for (int cp = 0; cp < 2; ++cp)
#pragma unroll
                for (int n = 0; n < 2; ++n) pb[cp][n] = W + (size_t)(c0 + 32 * cp + perm16(n, fr)) * D + 512 * i + 8 * fq;
            f32x4 acc[4][2][2]; ZERO_ACC(acc);
            sgemm_k<1>(acc, pa, pb, 512);
#pragma unroll
            for (int mi = 0; mi < 4; ++mi)
#pragma unroll
                for (int cp = 0; cp < 2; ++cp) { float gt[8]; unpack8(*(const u32x4*)(Z + (size_t)(r0 + 16 * mi + fr) * ZS + ZGATE + 2048 * i + c0 + 32 * cp + 8 * fq), gt);
#pragma unroll
                    for (int e = 0; e < 4; ++e) { tot[mi][cp][0][e] += gt[e] * acc[mi][cp][0][e]; tot[mi][cp][1][e] += gt[4 + e] * acc[mi][cp][1][e]; } }
        }
#pragma unroll
        for (int mi = 0; mi < 4; ++mi)
#pragma unroll
            for (int cp = 0; cp < 2; ++cp) { float o[8];
#pragma unroll
                for (int e = 0; e < 4; ++e) { o[e] = tot[mi][cp][0][e]; o[4 + e] = tot[mi][cp][1][e]; }
                *(u32x4*)(ACC + (size_t)(r0 + 16 * mi + fr) * D + c0 + 32 * cp + 8 * fq) = pack8(o); }
    }
}

__device__ __forceinline__ void phase_outproj(const Args& a, int l, int wave, int lane) {
    const bf16* ACC = (const bf16*)(a.ws + WS_S); const bf16* W = (const bf16*)(a.ws + WS_WO) + (size_t)l * 2048 * 2048; float* X = (float*)(a.ws + WS_X);
    const float* MODl = (const float*)(a.ws + WS_MOD) + (size_t)l * 3 * 12288;
    const int fr = lane & 15, fq = lane >> 4, wr = wave >> 2, wc = wave & 3;
    const int npm = (l == 0) ? 132 : 128;
    for (int u = blockIdx.x; u < npm * 8; u += gridDim.x) {
        const int pn = u & 7, pm = u >> 3;
        const int r0 = 128 * pm + 64 * wr, c0 = 256 * pn + 64 * wc;
        const bf16* pa[4]; const bf16* pb[2][2];
#pragma unroll
        for (int mi = 0; mi < 4; ++mi) pa[mi] = ACC + (size_t)(r0 + 16 * mi + fr) * D + 8 * fq;
#pragma unroll
        for (int cp = 0; cp < 2; ++cp)
#pragma unroll
            for (int n = 0; n < 2; ++n) pb[cp][n] = W + (size_t)(c0 + 32 * cp + perm16(n, fr)) * D + 8 * fq;
        f32x4 acc[4][2][2]; ZERO_ACC(acc);
        sgemm_k(acc, pa, pb, D);
#pragma unroll
        for (int mi = 0; mi < 4; ++mi) { const int row = r0 + 16 * mi + fr; const int mr = row < ML ? (row >> 13) : 2;
#pragma unroll
            for (int cp = 0; cp < 2; ++cp) { const int col = c0 + 32 * cp + 8 * fq; const float* g1 = MODl + mr * 12288 + 2 * 2048 + col; float* xp = X + (size_t)row * D + col;
                const f32x4 ga = *(const f32x4*)g1, gb = *(const f32x4*)(g1 + 4); f32x4 xa = *(f32x4*)xp, xb = *(f32x4*)(xp + 4);
                xa += ga * acc[mi][cp][0]; xb += gb * acc[mi][cp][1]; *(f32x4*)xp = xa; *(f32x4*)(xp + 4) = xb; } }
    }
}

__device__ __forceinline__ void moe_table(const Args& a, int l, LAS int* tab, int tid) {
    __syncthreads();
    if (tid == 0) { const unsigned* cnt = (const unsigned*)(a.ws + WS_CTL) + CW_CNT + 64 * 16 * l; int acc = 0;
        for (int e = 0; e < 16; ++e) { const int c = (int)__hip_atomic_load(cnt + 64 * e, __ATOMIC_RELAXED, __HIP_MEMORY_SCOPE_AGENT); tab[e] = c; tab[16 + e] = acc; acc += (c + 255) >> 8; }
        tab[32] = acc; }
    __syncthreads();
}
__device__ __forceinline__ void phase_moe1(const Args& a, int l, LAS unsigned char* lds, int tid, int wave, int lane) {
    LAS int* tab = (LAS int*)lds; moe_table(a, l, tab, tid);
    const bf16* H = (const bf16*)(a.ws + WS_H); const bf16* Wl = (const bf16*)(a.ws + WS_WGU) + (size_t)l * 16 * 2048 * 2048; bf16* ACT = (bf16*)(a.ws + WS_ACT);
    const int* LIST = (const int*)(a.ws + WS_LIST);
    const int fr = lane & 15, fq = lane >> 4, wr = wave >> 2, wc = wave & 3;
    const int NTl = tab[32];
    for (int u = blockIdx.x; u < NTl * 16; u += gridDim.x) {
        const int j = u & 7, hh = (u >> 3) & 1, t = u >> 4;
        int e = 0;
#pragma unroll
        for (int q = 1; q < 16; ++q) if (t >= tab[16 + q]) e = q;
        const int cnt = tab[e], tbe = tab[16 + e], ri0 = 256 * (t - tbe) + 128 * hh + 64 * wr;
        const bf16* W = Wl + (size_t)e * 2048 * 2048;
        const bf16* pa[4]; const bf16* pb[2][2];
#pragma unroll
        for (int mi = 0; mi < 4; ++mi) { int ri = ri0 + 16 * mi + fr; ri = ri < cnt ? ri : cnt - 1; const int tok = LIST[e * CAP + ri] >> 1; pa[mi] = H + (size_t)tok * D + 8 * fq; }
#pragma unroll
        for (int cp = 0; cp < 2; ++cp)
#pragma unroll
            for (int n = 0; n < 2; ++n) pb[cp][n] = W + (size_t)(256 * j + 128 * cp + 32 * wc + perm16(n, fr)) * D + 8 * fq;
        f32x4 acc[4][2][2]; ZERO_ACC(acc);
        sgemm_k(acc, pa, pb, D);
#pragma unroll
        for (int mi = 0; mi < 4; ++mi) { float o[8];
#pragma unroll
            for (int e2 = 0; e2 < 4; ++e2) { const float g0 = acc[mi][0][0][e2], g1 = acc[mi][0][1][e2]; o[e2] = g0 * sigmoidf_(g0) * acc[mi][1][0][e2]; o[4 + e2] = g1 * sigmoidf_(g1) * acc[mi][1][1][e2]; }
            *(u32x4*)(ACT + (size_t)(tbe * 256 + ri0 + 16 * mi + fr) * 1024 + 128 * j + 32 * wc + 8 * fq) = pack8(o); }
    }
}
__device__ __forceinline__ void phase_moe2(const Args& a, int l, LAS unsigned char* lds, int tid, int wave, int lane) {
    LAS int* tab = (LAS int*)lds; moe_table(a, l, tab, tid);
    const bf16* ACT = (const bf16*)(a.ws + WS_ACT); const bf16* Wl = (const bf16*)(a.ws + WS_WD) + (size_t)l * 16 * 2048 * 1024; bf16* Y = (bf16*)(a.ws + WS_Y);
    const int* LIST = (const int*)(a.ws + WS_LIST); const float* LISTW = (const float*)(a.ws + WS_LISTW);
    const int fr = lane & 15, fq = lane >> 4, wr = wave >> 2, wc = wave & 3;
    const int NTl = tab[32];
    for (int u = blockIdx.x; u < NTl * 16; u += gridDim.x) {
        const int j = u & 7, hh = (u >> 3) & 1, t = u >> 4;
        int e = 0;
#pragma unroll
        for (int q = 1; q < 16; ++q) if (t >= tab[16 + q]) e = q;
        const int cnt = tab[e], tbe = tab[16 + e], ri0 = 256 * (t - tbe) + 128 * hh + 64 * wr;
        const bf16* W = Wl + (size_t)e * 2048 * 1024;
        const bf16* pa[4]; const bf16* pb[2][2];
#pragma unroll
        for (int mi = 0; mi < 4; ++mi) pa[mi] = ACT + (size_t)(tbe * 256 + ri0 + 16 * mi + fr) * 1024 + 8 * fq;
#pragma unroll
        for (int cp = 0; cp < 2; ++cp)
#pragma unroll
            for (int n = 0; n < 2; ++n) pb[cp][n] = W + (size_t)(256 * j + 64 * wc + 32 * cp + perm16(n, fr)) * 1024 + 8 * fq;
        f32x4 acc[4][2][2]; ZERO_ACC(acc);
        sgemm_k(acc, pa, pb, 1024);
#pragma unroll
        for (int mi = 0; mi < 4; ++mi) { const int ri = ri0 + 16 * mi + fr;
            if (ri < cnt) { const int tk = LIST[e * CAP + ri]; const float w = LISTW[e * CAP + ri];
#pragma unroll
                for (int cp = 0; cp < 2; ++cp) { float o[8];
#pragma unroll
                    for (int e2 = 0; e2 < 4; ++e2) { o[e2] = w * acc[mi][cp][0][e2]; o[4 + e2] = w * acc[mi][cp][1][e2]; }
                    *(u32x4*)(Y + (size_t)tk * D + 256 * j + 64 * wc + 32 * cp + 8 * fq) = pack8(o); } } }
    }
}


template <class Pre, class Epi>
__device__ __forceinline__ void sk_gemm_ctx(LAS unsigned char* lds, const bf16* A, int lda, const bf16* Bt, int ldb, int K, int N, const Pre& pre, const Epi& epi, int tid, int wave, int lane) {
    const int fr = lane & 15, fq = lane >> 4, ntn = N / 64, ks = K / 8;
    LAS float* P = (LAS float*)lds;
    for (int task = blockIdx.x; task < 8 * ntn; task += gridDim.x) {
        const int tm = task / ntn, tn = task % ntn, r0 = ML + 64 * tm, c0 = 64 * tn;
        const bf16* pa[4]; const bf16* pb[2][2];
#pragma unroll
        for (int mi = 0; mi < 4; ++mi) pa[mi] = A + (size_t)(r0 + 16 * mi + fr) * lda + wave * ks + 8 * fq;
#pragma unroll
        for (int cp = 0; cp < 2; ++cp)
#pragma unroll
            for (int n = 0; n < 2; ++n) pb[cp][n] = Bt + (size_t)(c0 + 32 * cp + perm16(n, fr)) * ldb + wave * ks + 8 * fq;
        f32x4 acc[4][2][2]; ZERO_ACC(acc);
        sgemm_k<4>(acc, pa, pb, ks);
        pre(acc, wave, r0, c0, fr, fq);
        __syncthreads();
#pragma unroll
        for (int mi = 0; mi < 4; ++mi)
#pragma unroll
            for (int cp = 0; cp < 2; ++cp)
#pragma unroll
                for (int n = 0; n < 2; ++n) *(LAS f32x4*)(P + wave * 4096 + (16 * mi + fr) * 64 + 32 * cp + 8 * fq + 4 * n) = acc[mi][cp][n];
        __syncthreads();
        { const int row = tid >> 3, c8 = (tid & 7) * 8; f32x4 s0 = {0.f, 0.f, 0.f, 0.f}, s1 = s0;
#pragma unroll
            for (int w = 0; w < 8; ++w) { s0 += *(const LAS f32x4*)(P + w * 4096 + row * 64 + c8); s1 += *(const LAS f32x4*)(P + w * 4096 + row * 64 + c8 + 4); }
            float v[8] = {s0[0], s0[1], s0[2], s0[3], s1[0], s1[1], s1[2], s1[3]};
            epi(r0 + row, c0 + c8, v); }
    }
    __syncthreads();
}
struct SkNoPre { __device__ __forceinline__ void operator()(f32x4 (&)[4][2][2], int, int, int, int, int) const {} };
struct SkPreMerge { const bf16* Z;
    __device__ __forceinline__ void operator()(f32x4 (&acc)[4][2][2], int w, int r0, int c0, int fr, int fq) const {
#pragma unroll
        for (int mi = 0; mi < 4; ++mi)
#pragma unroll
            for (int cp = 0; cp < 2; ++cp) { const int row = r0 + 16 * mi + fr, col = c0 + 32 * cp + 8 * fq, rr = row & 255, cc = col & 255;
                const u32x2 g8 = *(const u32x2*)((const unsigned char*)Z + g8_off(w >> 1, row >> 8, col >> 8, ((rr >> 6) & 1) * 4 + ((cc >> 5) & 3), rr >> 7, (rr >> 4) & 3, cc >> 7, ((cc >> 3) & 3) * 16 + (rr & 15)));
#pragma unroll
                for (int e = 0; e < 4; ++e) { acc[mi][cp][0][e] *= (float)((g8.x >> (8 * e)) & 255u) * (1.f / 255.f); acc[mi][cp][1][e] *= (float)((g8.y >> (8 * e)) & 255u) * (1.f / 255.f); } }
    }
};
struct SkEpiProj { bf16* Z;
    __device__ __forceinline__ void operator()(int row, int col, float (&v)[8]) const { const int pn = col >> 8;
        if (pn >= 5 && pn < 9) {
#pragma unroll
            for (int e = 0; e < 8; ++e) v[e] = gelu_tanh(v[e]); }
        *(u32x4*)(Z + (size_t)row * ZS + col) = pack8(v); }
};
struct SkEpiAcc { bf16* ACC; int ld; __device__ __forceinline__ void operator()(int row, int col, float (&v)[8]) const { *(u32x4*)(ACC + (size_t)row * ld + col) = pack8(v); } };
struct SkEpiOut { float* X; const float* g1;
    __device__ __forceinline__ void operator()(int row, int col, float (&v)[8]) const { float* xp = X + (size_t)row * D + col; const f32x4 ga = *(const f32x4*)(g1 + col), gb = *(const f32x4*)(g1 + col + 4);
        f32x4 xa = *(f32x4*)xp, xb = *(f32x4*)(xp + 4); xa += ga * (f32x4){v[0], v[1], v[2], v[3]}; xb += gb * (f32x4){v[4], v[5], v[6], v[7]}; *(f32x4*)xp = xa; *(f32x4*)(xp + 4) = xb; }
};

struct DenseOrder {            static constexpr bool GATHER = false;
    int nM, nN, exN, exCnt, exM0, G, c, lda2, K2; const char* Bt; int exPn0 = 0;
    __device__ __forceinline__ bool next(int i, pg8::Unit& u) const {
        const int L = i * G + c, nmain = nM * nN;
        if (L < nmain) { pg8::static_tile(L, nM, nN, u.pm, u.pn); }
        else { const int idx = L - nmain; if (idx >= exCnt) return false; u.pm = exM0 + idx / exN; u.pn = exPn0 + idx % exN; }
        u.e = 0; u.cnt = 256; return true;
    }
    __device__ __forceinline__ unsigned arow_off(const pg8::Unit& u, int r) const { return (unsigned)(u.pm * 256 + r) * (unsigned)lda2; }
    __device__ __forceinline__ void a_ready(const pg8::Unit&) const {}
    __device__ __forceinline__ void done(const pg8::Unit&) const {}
    __device__ __forceinline__ unsigned lda_bytes() const { return (unsigned)lda2; }
    __device__ __forceinline__ unsigned ldb_bytes() const { return (unsigned)K2; }
    __device__ __forceinline__ unsigned aoff(const pg8::Unit& u) const { return (unsigned)u.pm * 256u * (unsigned)lda2; }
    __device__ __forceinline__ const char* wbase() const { return Bt; }
    __device__ __forceinline__ unsigned boff(const pg8::Unit& u) const { return (unsigned)u.pn * 256u * (unsigned)K2; }
};
struct MoeOrder {              static constexpr bool GATHER = true;
    const LAS int* tab; int G, c, K2, gather; const int* LIST; const char* W; size_t wstride;
    int i0, base; unsigned* tcnt; unsigned* tmo;
    __device__ __forceinline__ void a_ready(const pg8::Unit& u) const {
        if (gather) return;
        if (threadIdx.x < 64) { unsigned spins = 0u;
            while ((unsigned)__builtin_amdgcn_readfirstlane(__hip_atomic_load(tcnt + 64 * u.pm, __ATOMIC_RELAXED, __HIP_MEMORY_SCOPE_AGENT)) < 64u) {
                __builtin_amdgcn_s_sleep(2);
                if ((++spins & 255u) == 0u) { if (__hip_atomic_load(tmo, __ATOMIC_RELAXED, __HIP_MEMORY_SCOPE_AGENT) != 0u) break; if (spins > (1u << 20)) { if (threadIdx.x == 0) __hip_atomic_store(tmo, 1u, __ATOMIC_RELAXED, __HIP_MEMORY_SCOPE_AGENT); break; } } }
            __builtin_amdgcn_fence(__ATOMIC_ACQUIRE, "agent");
            asm volatile("s_waitcnt vmcnt(0)" ::: "memory"); }
        asm volatile("" ::: "memory"); __builtin_amdgcn_s_barrier(); asm volatile("" ::: "memory");
    }
    __device__ __forceinline__ void done(const pg8::Unit& u) const {
        if (!gather) return;
        asm volatile("s_waitcnt vmcnt(0)" ::: "memory");
        if ((threadIdx.x & 63) == 0) __hip_atomic_fetch_add(tcnt + 64 * u.pm, 1u, __ATOMIC_RELAXED, __HIP_MEMORY_SCOPE_AGENT);
    }
    __device__ __forceinline__ bool next(int i, pg8::Unit& u) const {
        const int L = (i + i0) * G + c - base; if (L >= tab[32] * 8) return false;
        const int t = L >> 3; int e = 0;
#pragma unroll
        for (int q = 1; q < 16; ++q) if (t >= tab[16 + q]) e = q;
        u.pm = t; u.pn = L & 7; u.e = e; u.cnt = tab[e] - 256 * (t - tab[16 + e]);
        return true;
    }
    __device__ __forceinline__ unsigned arow_off(const pg8::Unit& u, int r) const {
        if (gather) { const int t0 = tab[16 + u.e]; int ri = 256 * (u.pm - t0) + r; const int last = tab[u.e] - 1; ri = ri < last ? ri : last; const int tok = LIST[u.e * CAP + ri] >> 1; return (unsigned)tok * 2048u; }
        return (unsigned)(u.pm * 256 + r) * 2048u;
    }
    __device__ __forceinline__ unsigned lda_bytes() const { return 0u; }
    __device__ __forceinline__ unsigned ldb_bytes() const { return (unsigned)K2; }
    __device__ __forceinline__ unsigned aoff(const pg8::Unit&) const { return 0u; }
    __device__ __forceinline__ const char* wbase() const { return W; }
    __device__ __forceinline__ unsigned boff(const pg8::Unit& u) const { return (unsigned)u.e * (unsigned)wstride + (unsigned)u.pn * 256u * (unsigned)K2; }
};
template <bool I8> struct EpiProjT { static constexpr bool PERM = true; bf16* Z; unsigned char* G8; int pn_off; float scale; const float* RS = nullptr; float scale_g = 0.f;
    __device__ __forceinline__ void operator()(const f32x4 (&acc)[2][2][4][2], const pg8::Unit& u0, int wr, int wc, int fr, int fq) const {
        pg8::Unit u = u0; u.pn += pn_off;
        const int act = (u.pn >= 5 && u.pn < 9) ? 1 : (u.pn >= 16 ? 2 : 0);
#pragma unroll
        for (int ai = 0; ai < 2; ++ai)
#pragma unroll
            for (int m = 0; m < 4; ++m) { bf16* rowp = Z + (size_t)(u.pm * 256 + ai * 128 + wr * 64 + m * 16 + fr) * ZS + u.pn * 256 + wc * 32 + 8 * fq;
#pragma unroll
                for (int bj = 0; bj < 2; ++bj) { f32x4 v0, v1;
                    if constexpr (I8) { const float sr = RS[u.pm * 256 + ai * 128 + wr * 64 + m * 16 + fr] * (act == 2 ? scale_g : scale); const i32x4q i0 = __builtin_bit_cast(i32x4q, acc[ai][bj][m][0]), i1 = __builtin_bit_cast(i32x4q, acc[ai][bj][m][1]);
#pragma unroll
                        for (int e = 0; e < 4; ++e) { v0[e] = (float)i0[e] * sr; v1[e] = (float)i1[e] * sr; } }
                    else { v0 = acc[ai][bj][m][0] * scale; v1 = acc[ai][bj][m][1] * scale; }
                    if (act == 1) {
#pragma unroll
                        for (int e = 0; e < 4; ++e) { v0[e] = gelu_tanh(v0[e]); v1[e] = gelu_tanh(v1[e]); } }
                    else if (act == 2) {
                        unsigned q[8];
#pragma unroll
                        for (int e = 0; e < 4; ++e) { q[e] = (unsigned)fmaxf(__builtin_rintf(255.f * sigmoidf_(v0[e])), 1.f); q[4 + e] = (unsigned)fmaxf(__builtin_rintf(255.f * sigmoidf_(v1[e])), 1.f); }
                        u32x2 w8; w8.x = q[0] | (q[1] << 8) | (q[2] << 16) | (q[3] << 24); w8.y = q[4] | (q[5] << 8) | (q[6] << 16) | (q[7] << 24);
                        __builtin_nontemporal_store(w8, (u32x2*)(G8 + g8_off((u.pn - 16) >> 3, u.pm, (u.pn - 16) & 7, wr * 4 + wc, ai, m, bj, fq * 16 + fr)));
                        continue; }
                    u32x4 w; w.x = pg8::cvt_pk_bf16(v0[0], v0[1]); w.y = pg8::cvt_pk_bf16(v0[2], v0[3]); w.z = pg8::cvt_pk_bf16(v1[0], v1[1]); w.w = pg8::cvt_pk_bf16(v1[2], v1[3]);
                    *(u32x4*)(rowp + bj * 128) = w; } }
    }
};
typedef EpiProjT<false> EpiProj;
struct EpiMerge { static constexpr bool PERM = true; const bf16* Z; bf16* ACC;
    struct State { u32x2 g[2][4][2]; };
    __device__ __forceinline__ const unsigned char* gptr(const pg8::Unit& u, int i, int ai, int m, int bj, int wr, int wc, int fr, int fq) const {
        return (const unsigned char*)Z + g8_off(i, u.pm, u.pn, wr * 4 + wc, ai, m, bj, fq * 16 + fr); }
    __device__ __forceinline__ void khook(f32x4 (&acc)[2][2][4][2], State& st, const pg8::Unit& u, int i, int wr, int wc, int fr, int fq) const {
#pragma unroll
        for (int ai = 0; ai < 2; ++ai)
#pragma unroll
            for (int m = 0; m < 4; ++m) {
#pragma unroll
                for (int bj = 0; bj < 2; ++bj) { const u32x2 gn = *(const u32x2*)gptr(u, i + 1, ai, m, bj, wr, wc, fr, fq); const u32x2 gc = (i == 0) ? *(const u32x2*)gptr(u, 0, ai, m, bj, wr, wc, fr, fq) : st.g[ai][m][bj];
#pragma unroll
                    for (int e = 0; e < 4; ++e) { acc[ai][bj][m][0][e] *= (float)((gc.x >> (8 * e)) & 255u) * __builtin_amdgcn_rcpf((float)((gn.x >> (8 * e)) & 255u));
                                                  acc[ai][bj][m][1][e] *= (float)((gc.y >> (8 * e)) & 255u) * __builtin_amdgcn_rcpf((float)((gn.y >> (8 * e)) & 255u)); }
                    st.g[ai][m][bj] = gn; } }
    }
    __device__ __forceinline__ void fin(const f32x4 (&acc)[2][2][4][2], const State& st, const pg8::Unit& u, int wr, int wc, int fr, int fq) const {
#pragma unroll
        for (int ai = 0; ai < 2; ++ai)
#pragma unroll
            for (int m = 0; m < 4; ++m) { const size_t row = (size_t)(u.pm * 256 + ai * 128 + wr * 64 + m * 16 + fr); const int col = u.pn * 256 + wc * 32 + 8 * fq;
#pragma unroll
                for (int bj = 0; bj < 2; ++bj) { const u32x2 g3 = st.g[ai][m][bj]; float g[8];
#pragma unroll
                    for (int e = 0; e < 4; ++e) { g[e] = (float)((g3.x >> (8 * e)) & 255u) * (1.f / 255.f); g[4 + e] = (float)((g3.y >> (8 * e)) & 255u) * (1.f / 255.f); }
                    const f32x4 v0 = acc[ai][bj][m][0], v1 = acc[ai][bj][m][1];
                    u32x4 w; w.x = pg8::cvt_pk_bf16(v0[0] * g[0], v0[1] * g[1]); w.y = pg8::cvt_pk_bf16(v0[2] * g[2], v0[3] * g[3]); w.z = pg8::cvt_pk_bf16(v1[0] * g[4], v1[1] * g[5]); w.w = pg8::cvt_pk_bf16(v1[2] * g[6], v1[3] * g[7]);
                    (void)w;
                    u32x2 w8; unsigned p8 = 0u; p8 = __builtin_amdgcn_cvt_pk_fp8_f32(v0[0] * g[0], v0[1] * g[1], p8, false); p8 = __builtin_amdgcn_cvt_pk_fp8_f32(v0[2] * g[2], v0[3] * g[3], p8, true); w8.x = p8;
                    p8 = 0u; p8 = __builtin_amdgcn_cvt_pk_fp8_f32(v1[0] * g[4], v1[1] * g[5], p8, false); p8 = __builtin_amdgcn_cvt_pk_fp8_f32(v1[2] * g[6], v1[3] * g[7], p8, true); w8.y = p8;
                    *(u32x2*)((unsigned char*)ACC + row * 2048 + col + bj * 128) = w8; } }
    }
};
struct EpiOut { static constexpr bool PERM = true; bf16* MX; int nop; float scale;
    __device__ __forceinline__ void operator()(const f32x4 (&acc)[2][2][4][2], const pg8::Unit& u, int wr, int wc, int fr, int fq) const {
        if (nop && acc[0][0][0][0][0] != 1.2345e30f) return;
#pragma unroll
        for (int ai = 0; ai < 2; ++ai)
#pragma unroll
            for (int m = 0; m < 4; ++m) { bf16* rowp = MX + (size_t)(u.pm * 256 + ai * 128 + wr * 64 + m * 16 + fr) * D + u.pn * 256 + wc * 32 + 8 * fq;
#pragma unroll
                for (int bj = 0; bj < 2; ++bj) { const f32x4 v0 = acc[ai][bj][m][0] * scale, v1 = acc[ai][bj][m][1] * scale;
                    u32x4 w; w.x = pg8::cvt_pk_bf16(v0[0], v0[1]); w.y = pg8::cvt_pk_bf16(v0[2], v0[3]); w.z = pg8::cvt_pk_bf16(v1[0], v1[1]); w.w = pg8::cvt_pk_bf16(v1[2], v1[3]);
                    *(u32x4*)(rowp + bj * 128) = w; } }
    }
};
struct EpiMoe1 { static constexpr bool PERM = true; bf16* ACT; __amdgpu_buffer_rsrc_t rs; const float* RS; const int* LIST; const LAS int* tab; const unsigned* wm;
    __device__ __forceinline__ void operator()(const f32x4 (&acc)[2][2][4][2], const pg8::Unit& u, int wr, int wc, int fr, int fq) const {
#pragma unroll
        for (int ai = 0; ai < 2; ++ai)
#pragma unroll
            for (int m = 0; m < 4; ++m) { int ri = 256 * (u.pm - tab[16 + u.e]) + ai * 128 + wr * 64 + m * 16 + fr; const int lastr = tab[u.e] - 1; ri = ri < lastr ? ri : lastr;
                const float rsv = RS[LIST[u.e * CAP + ri] >> 1], sg = rsv * (__uint_as_float(wm[4 + u.e]) * (EXPERT_MARGIN / 127.f)), su = rsv * (__uint_as_float(wm[36 + u.e]) * (EXPERT_MARGIN / 127.f));
                const i32x4q ig0 = __builtin_bit_cast(i32x4q, acc[ai][0][m][0]), ig1 = __builtin_bit_cast(i32x4q, acc[ai][0][m][1]), iu0 = __builtin_bit_cast(i32x4q, acc[ai][1][m][0]), iu1 = __builtin_bit_cast(i32x4q, acc[ai][1][m][1]); float o[8];
#pragma unroll
                for (int e = 0; e < 4; ++e) { const float ga = (float)ig0[e] * sg, gb = (float)ig1[e] * sg; o[e] = ga * sigmoidf_(ga) * ((float)iu0[e] * su); o[4 + e] = gb * sigmoidf_(gb) * ((float)iu1[e] * su); }
                u32x4 w; w.x = pg8::cvt_pk_bf16(o[0], o[1]); w.y = pg8::cvt_pk_bf16(o[2], o[3]); w.z = pg8::cvt_pk_bf16(o[4], o[5]); w.w = pg8::cvt_pk_bf16(o[6], o[7]);
                __builtin_amdgcn_raw_buffer_store_b128(w, rs, (int)(((unsigned)(u.pm * 256 + ai * 128 + wr * 64 + m * 16 + fr) * 1024u + (unsigned)(u.pn * 128 + wc * 32 + 8 * fq)) * 2u), 0, 16); }
    }
};
struct EpiMoe2 { static constexpr bool PERM = true; bf16* Y; const int* LIST; const float* LISTW; const LAS int* tab;
    __device__ __forceinline__ void operator()(const f32x4 (&acc)[2][2][4][2], const pg8::Unit& u, int wr, int wc, int fr, int fq) const {
        const int ri0 = 256 * (u.pm - tab[16 + u.e]);
#pragma unroll
        for (int ai = 0; ai < 2; ++ai)
#pragma unroll
            for (int m = 0; m < 4; ++m) { const int rt = ai * 128 + wr * 64 + m * 16 + fr;
                if (rt < u.cnt) { const int tk = LIST[u.e * CAP + ri0 + rt]; const float wv = LISTW[u.e * CAP + ri0 + rt]; bf16* rowp = Y + (size_t)tk * D + u.pn * 256 + wc * 32 + 8 * fq;
#pragma unroll
                    for (int bj = 0; bj < 2; ++bj) { const f32x4 v0 = acc[ai][bj][m][0] * wv, v1 = acc[ai][bj][m][1] * wv;
                        u32x4 w; w.x = pg8::cvt_pk_bf16(v0[0], v0[1]); w.y = pg8::cvt_pk_bf16(v0[2], v0[3]); w.z = pg8::cvt_pk_bf16(v1[0], v1[1]); w.w = pg8::cvt_pk_bf16(v1[2], v1[3]);
                        *(u32x4*)(rowp + bj * 128) = w; } }
                __builtin_amdgcn_sched_barrier(0); }
    }
};
__device__ __forceinline__ void phase_proj2(const Args& a, int l, LAS unsigned char* lds) {
#if FP8Z
    const unsigned* wm = (const unsigned*)(a.ws + WS_CTL) + CW_WMAX;
    {
        const char* W = (const char*)(a.ws + WS_WCAT8) + (size_t)l * 12288 * 2048;
        DenseOrder S{64, 16, 16, 0, 64, (int)gridDim.x, (int)blockIdx.x, 2048, 2048, W};
        EpiProjT<true> E{(bf16*)(a.ws + WS_Z), (unsigned char*)(a.ws + WS_G8), 0, __uint_as_float(wm[l]) * (1.f / 127.f), (const float*)(a.ws + WS_RS), 0.f};
        pg8::gemm256<EpiProjT<true>, DenseOrder, false, 2>(lds, (const char*)(a.ws + WS_H8I), 2048, S, E);
        const char* Wz = (const char*)(a.ws + WS_WCAT) + (size_t)l * 4096 * 2048 * 2;
        sk_gemm_ctx(lds, (const bf16*)(a.ws + WS_H), 2048, (const bf16*)Wz, 2048, 2048, 4096, SkNoPre{}, SkEpiProj{(bf16*)(a.ws + WS_Z)}, (int)threadIdx.x, (int)(threadIdx.x >> 6), (int)(threadIdx.x & 63));
    }
    {
        const char* W = (const char*)(a.ws + WS_WCAT8) + ((size_t)l * 12288 + 4096) * 2048;
        DenseOrder S{64, 32, 32, l == 0 ? 64 : 0, 64, (int)gridDim.x, (int)blockIdx.x, 2048, 2048, W};
        EpiProj E{(bf16*)(a.ws + WS_Z), (unsigned char*)(a.ws + WS_G8), 16, __uint_as_float(wm[2 + l]) * (1.f / 128.f)};
        pg8::gemm256<EpiProj, DenseOrder, false, 1>(lds, (const char*)(a.ws + WS_H8), 2048, S, E);
    }
#if FP8Z == 2
    {
        const char* W = (const char*)(a.ws + WS_WCAT) + ((size_t)l * 4096 + 9 * 256) * 2048 * 2;
        DenseOrder S{64, 7, 7, 0, 64, (int)gridDim.x, (int)blockIdx.x, 4096, 4096, W};
        EpiProj E{(bf16*)(a.ws + WS_Z), (unsigned char*)(a.ws + WS_G8), 9, 1.f};
        pg8::gemm256<EpiProj, DenseOrder, false, 0>(lds, (const char*)(a.ws + WS_H), 4096, S, E);
    }
#elif FP8Z == 3
    {
        const char* W = (const char*)(a.ws + WS_WCAT) + ((size_t)l * 4096) * 2048 * 2;
        DenseOrder S{64, 9, 9, 0, 64, (int)gridDim.x, (int)blockIdx.x, 4096, 4096, W};
        EpiProj E{(bf16*)(a.ws + WS_Z), (unsigned char*)(a.ws + WS_G8), 0, 1.f};
        pg8::gemm256<EpiProj, DenseOrder, false, 0>(lds, (const char*)(a.ws + WS_H), 4096, S, E);
    }
#endif
#else
    {
        const char* W = (const char*)(a.ws + WS_WCAT) + (size_t)l * 4096 * 2048 * 2;
        DenseOrder S{64, 16, 16, 0, 64, (int)gridDim.x, (int)blockIdx.x, 4096, 4096, W};
        EpiProj E{(bf16*)(a.ws + WS_Z), (unsigned char*)(a.ws + WS_G8), 0, 1.f};
        pg8::gemm256<EpiProj, DenseOrder, false, 0>(lds, (const char*)(a.ws + WS_H), 4096, S, E);
        sk_gemm_ctx(lds, (const bf16*)(a.ws + WS_H), 2048, (const bf16*)W, 2048, 2048, 4096, SkNoPre{}, SkEpiProj{(bf16*)(a.ws + WS_Z)}, (int)threadIdx.x, (int)(threadIdx.x >> 6), (int)(threadIdx.x & 63));
    }
    {
        const char* W = (const char*)(a.ws + WS_WCAT8) + ((size_t)l * 12288 + 4096) * 2048;
        DenseOrder S{64, 32, 32, l == 0 ? 64 : 0, 64, (int)gridDim.x, (int)blockIdx.x, 2048, 2048, W};
        EpiProj E{(bf16*)(a.ws + WS_Z), (unsigned char*)(a.ws + WS_G8), 16, 1.f / W8SCALE};
        pg8::gemm256<EpiProj, DenseOrder, false, 1>(lds, (const char*)(a.ws + WS_H8), 2048, S, E);
    }
#endif
}
__device__ __forceinline__ void phase_merge2(const Args& a, int l, LAS unsigned char* lds) {
    const char* W = (const char*)(a.ws + WS_WB) + (size_t)l * 2048 * 2048 * 2;
    DenseOrder S{64, 8, 8, 0, 64, (int)gridDim.x, (int)blockIdx.x, 4096, 4096, W};
    EpiMerge E{(const bf16*)(a.ws + WS_G8), (bf16*)(a.ws + WS_ACC8)};
    pg8::gemm256<EpiMerge, DenseOrder, true>(lds, (const char*)(a.ws + WS_O), 4096, S, E);
    if (l == 0) sk_gemm_ctx(lds, (const bf16*)(a.ws + WS_O), 2048, (const bf16*)W, 2048, 2048, 2048, SkPreMerge{(const bf16*)(a.ws + WS_G8)}, SkEpiAcc{(bf16*)(a.ws + WS_ACC), DP}, (int)threadIdx.x, (int)(threadIdx.x >> 6), (int)(threadIdx.x & 63));
}
__device__ __forceinline__ void phase_outproj2(const Args& a, int l, LAS unsigned char* lds, int nop = 0) {
    const char* W = (const char*)(a.ws + WS_WO) + (size_t)l * 2048 * DP * 2;
    const char* W8 = (const char*)(a.ws + WS_WO8) + (size_t)l * 2048 * 2048;
    DenseOrder S{64, 8, 8, 0, 64, (int)gridDim.x, (int)blockIdx.x, 2048, 2048, W8};
    EpiOut E{(bf16*)(a.ws + WS_MX), nop, __uint_as_float(((const unsigned*)(a.ws + WS_CTL))[CW_WMAX + 68 + l]) * (1.f / 128.f)};
    pg8::gemm256<EpiOut, DenseOrder, false, 1>(lds, (const char*)(a.ws + WS_ACC8), 2048, S, E);
    if (l == 0 && !nop) sk_gemm_ctx(lds, (const bf16*)(a.ws + WS_ACC), DP, (const bf16*)W, DP, 2048, 2048, SkNoPre{}, SkEpiAcc{(bf16*)(a.ws + WS_MX), D}, (int)threadIdx.x, (int)(threadIdx.x >> 6), (int)(threadIdx.x & 63));
}
constexpr int CW_T2 = 16384;
__device__ __forceinline__ void phase_moe12(const Args& a, int l, LAS unsigned char* lds, int tid) {
    LAS int* tab = (LAS int*)(lds + pg8::STAGE_BYTES); moe_table(a, l, tab, tid);
    unsigned* tcnt = (unsigned*)(a.ws + WS_CTL) + CW_T2 + 64 * 160 * l; unsigned* tmo = (unsigned*)(a.ws + WS_CTL) + 8;
    const int G = (int)gridDim.x, c = (int)blockIdx.x, N1 = tab[32] * 8;
    {
        MoeOrder S{tab, G, c, 2048, 1, (const int*)(a.ws + WS_LIST), (const char*)(a.ws + WS_WGU) + (size_t)l * 16 * 2048 * 2048, (size_t)2048 * 2048, 0, 0, tcnt, tmo};
        EpiMoe1 E{(bf16*)(a.ws + WS_ACT), __builtin_amdgcn_make_buffer_rsrc((void*)(a.ws + WS_ACT), 0, 0x7fffffff, 0x00020000), (const float*)(a.ws + WS_RS), (const int*)(a.ws + WS_LIST), tab, (const unsigned*)(a.ws + WS_CTL) + CW_WMAX + 16 * l};
        pg8::gemm256<EpiMoe1, MoeOrder, false, 2>(lds, (const char*)(a.ws + WS_H8I), 2048, S, E);
    }
    {
        const int i0 = N1 > c ? (N1 - c + G - 1) / G : 0;
        MoeOrder S{tab, G, c, 2048, 0, (const int*)(a.ws + WS_LIST), (const char*)(a.ws + WS_WD) + (size_t)l * 16 * 2048 * 1024 * 2, (size_t)2048 * 1024 * 2, i0, N1, tcnt, tmo};
        EpiMoe2 E{(bf16*)(a.ws + WS_Y), (const int*)(a.ws + WS_LIST), (const float*)(a.ws + WS_LISTW), tab};
        pg8::gemm256<EpiMoe2, MoeOrder, false>(lds, (const char*)(a.ws + WS_ACT), 2048, S, E);
    }
}

__device__ __forceinline__ void attn_unit(const Args& a, int l, int u, LAS unsigned char* lds, int tid, int wave, int lane) {
    const bf16* Z = (const bf16*)(a.ws + WS_Z); bf16* OB = (bf16*)(a.ws + WS_O);
    const float* ROPEC = (const float*)(a.ws + WS_ROPE); const float* ROPES = ROPEC + 2048;
    LAS bf16* Ks = (LAS bf16*)lds;
    LAS bf16* VT = (LAS bf16*)(lds + 128 * 72 * 2);
    const int fr = lane & 15, fq = lane >> 4;
    {
        int b, kvh, nb; const bool isctx = u >= 256;
        if (!isctx) { b = u >> 7; kvh = (u >> 6) & 1; nb = u & 63; } else { const int v = u - 256; b = v >> 2; kvh = (v >> 1) & 1; nb = v & 1; }
        const int h = kvh * 4 + (wave >> 1), qs = (wave & 1) * 64;
        bf16x8 Qf[4][2];
#pragma unroll
        for (int qb = 0; qb < 4; ++qb) { const int tq = nb * 128 + qs + 16 * qb + fr; const size_t row = isctx ? (size_t)ML + b * 256 + tq : (size_t)b * SEQ + tq;
            const bf16* qp = Z + row * ZS + ZQ + h * 64;
#pragma unroll
            for (int ks = 0; ks < 2; ++ks) { float o[8]; unpack8(*(const u32x4*)(qp + 32 * ks + 8 * fq), o);
                if (!isctx) { float p[8]; unpack8(*(const u32x4*)(qp + 32 * ks + 8 * (fq ^ 2)), p); const int pos = ks == 0 ? (tq >> 6) : (tq & 63);
                    const float* cs = ROPEC + pos * 16 + 8 * (fq & 1); const float* sn = ROPES + pos * 16 + 8 * (fq & 1);
#pragma unroll
                    for (int e = 0; e < 8; ++e) o[e] = fq < 2 ? o[e] * cs[e] - p[e] * sn[e] : o[e] * cs[e] + p[e] * sn[e]; }
#pragma unroll
                for (int e = 0; e < 8; ++e) o[e] *= 0.125f * LOG2E;
                Qf[qb][ks] = __builtin_bit_cast(bf16x8, pack8(o)); } }
        float m[4], lsum[4]; f32x4 O[4][4];
        const float sinkv = a.in[10][l * 8 + h] * LOG2E;
#pragma unroll
        for (int qb = 0; qb < 4; ++qb) { m[qb] = sinkv; lsum[qb] = fq == 0 ? 1.f : 0.f;
#pragma unroll
            for (int db = 0; db < 4; ++db) O[qb][db] = (f32x4){0.f, 0.f, 0.f, 0.f}; }
        const int ntile = isctx ? 2 : 5;
#pragma unroll 1
        for (int kt = 0; kt < ntile; ++kt) {
            const bool isband = (!isctx && kt < 3);
            const int kblk = nb - 1 + kt;
            if (isband && (kblk < 0 || kblk > 63)) continue;
            const size_t krow0 = isband ? (size_t)b * SEQ + kblk * 128 : (size_t)ML + b * 256 + (isctx ? kt : kt - 3) * 128;
            __syncthreads();
            { const int key = tid >> 2, part = tid & 3, ks = part >> 1, sub = part & 1;
                const bf16* kp = Z + (krow0 + key) * ZS + ZK + kvh * 64 + 32 * ks + 8 * sub;
                float fa[8], fb[8]; unpack8(*(const u32x4*)kp, fa); unpack8(*(const u32x4*)(kp + 16), fb);
                if (isband) { const int tk = kblk * 128 + key; const int pos = ks == 0 ? (tk >> 6) : (tk & 63); const float* cs = ROPEC + pos * 16 + 8 * sub; const float* sn = ROPES + pos * 16 + 8 * sub;
#pragma unroll
                    for (int e = 0; e < 8; ++e) { const float x1 = fa[e], x2 = fb[e]; fa[e] = x1 * cs[e] - x2 * sn[e]; fb[e] = x2 * cs[e] + x1 * sn[e]; } }
                *(LAS u32x4*)(Ks + key * 72 + 32 * ks + 8 * sub) = pack8(fa); *(LAS u32x4*)(Ks + key * 72 + 32 * ks + 16 + 8 * sub) = pack8(fb);
                const bf16* vp = Z + (krow0 + key) * ZS + ZV + kvh * 64 + 16 * part;
                const u32x4 v0 = *(const u32x4*)vp, v1 = *(const u32x4*)(vp + 8);
                LAS bf16* vt = VT + (16 * part) * 136 + key;
                vt[0 * 136] = (bf16)(v0.x & 0xffffu); vt[1 * 136] = (bf16)(v0.x >> 16); vt[2 * 136] = (bf16)(v0.y & 0xffffu); vt[3 * 136] = (bf16)(v0.y >> 16);
                vt[4 * 136] = (bf16)(v0.z & 0xffffu); vt[5 * 136] = (bf16)(v0.z >> 16); vt[6 * 136] = (bf16)(v0.w & 0xffffu); vt[7 * 136] = (bf16)(v0.w >> 16);
                vt[8 * 136] = (bf16)(v1.x & 0xffffu); vt[9 * 136] = (bf16)(v1.x >> 16); vt[10 * 136] = (bf16)(v1.y & 0xffffu); vt[11 * 136] = (bf16)(v1.y >> 16);
                vt[12 * 136] = (bf16)(v1.z & 0xffffu); vt[13 * 136] = (bf16)(v1.z >> 16); vt[14 * 136] = (bf16)(v1.w & 0xffffu); vt[15 * 136] = (bf16)(v1.w >> 16); }
            __syncthreads();
#pragma unroll 1
            for (int kk = 0; kk < 4; ++kk) {
                bf16x8 Kf[2][2], Vf[4];
#pragma unroll
                for (int kb2 = 0; kb2 < 2; ++kb2)
#pragma unroll
                    for (int ks = 0; ks < 2; ++ks) Kf[kb2][ks] = *(const LAS bf16x8*)(Ks + (32 * kk + 16 * kb2 + fr) * 72 + 32 * ks + 8 * fq);
#pragma unroll
                for (int db = 0; db < 4; ++db) { const s16x4 lo = *(const LAS s16x4*)(VT + (16 * db + fr) * 136 + 32 * kk + 4 * fq), hi = *(const LAS s16x4*)(VT + (16 * db + fr) * 136 + 32 * kk + 16 + 4 * fq);
                    Vf[db] = (bf16x8){lo[0], lo[1], lo[2], lo[3], hi[0], hi[1], hi[2], hi[3]}; }
#pragma unroll
                for (int qb = 0; qb < 4; ++qb) {
                    f32x4 s0 = {0.f, 0.f, 0.f, 0.f}, s1 = s0;
                    s0 = MFMA16(Kf[0][0], Qf[qb][0], s0); s0 = MFMA16(Kf[0][1], Qf[qb][1], s0);
                    s1 = MFMA16(Kf[1][0], Qf[qb][0], s1); s1 = MFMA16(Kf[1][1], Qf[qb][1], s1);
                    if (isband && kt != 1) { const int tq = nb * 128 + qs + 16 * qb + fr;
#pragma unroll
                        for (int e = 0; e < 4; ++e) { const int d0 = kblk * 128 + 32 * kk + 4 * fq + e - tq, d1 = d0 + 16;
                            if (d0 > 128 || d0 < -128) s0[e] = -1e30f; if (d1 > 128 || d1 < -128) s1[e] = -1e30f; } }
                    float mx = fmaxf(fmaxf(fmaxf(s0[0], s0[1]), fmaxf(s0[2], s0[3])), fmaxf(fmaxf(s1[0], s1[1]), fmaxf(s1[2], s1[3])));
                    mx = fmaxf(mx, __shfl_xor(mx, 16)); mx = fmaxf(mx, __shfl_xor(mx, 32));
                    const float mn = fmaxf(m[qb], mx), alpha = __builtin_amdgcn_exp2f(m[qb] - mn); m[qb] = mn;
                    float p[8]; float ps = 0.f;
#pragma unroll
                    for (int e = 0; e < 4; ++e) { p[e] = __builtin_amdgcn_exp2f(s0[e] - mn); p[4 + e] = __builtin_amdgcn_exp2f(s1[e] - mn); ps += p[e] + p[4 + e]; }
                    lsum[qb] = lsum[qb] * alpha + ps;
                    const bf16x8 Pf = __builtin_bit_cast(bf16x8, pack8(p));
#pragma unroll
                    for (int db = 0; db < 4; ++db) { O[qb][db] = O[qb][db] * alpha; O[qb][db] = MFMA16(Vf[db], Pf, O[qb][db]); }
                    __builtin_amdgcn_sched_barrier(0);
                }
            }
        }
#pragma unroll
        for (int qb = 0; qb < 4; ++qb) { float ls = lsum[qb]; ls += __shfl_xor(ls, 16); ls += __shfl_xor(ls, 32); const float inv = 1.f / ls;
            const int tq = nb * 128 + qs + 16 * qb + fr; const size_t row = isctx ? (size_t)ML + b * 256 + tq : (size_t)b * SEQ + tq;
#pragma unroll
            for (int db = 0; db < 4; ++db) { u32x2 o; o.x = pk2(O[qb][db][0] * inv, O[qb][db][1] * inv); o.y = pk2(O[qb][db][2] * inv, O[qb][db][3] * inv);
                *(u32x2*)(OB + row * D + h * 64 + 16 * db + 4 * fq) = o; } }
    }
}


__device__ __forceinline__ void attn2_stage_k(LAS bf16* Ks, const bf16* Z, const float* ROPEC, const float* ROPES, size_t krow0, int kvh, int slot, bool rope, int kblk, int tid) {
    const int key = tid >> 2, part = tid & 3, ks = part >> 1, sub = part & 1;
    const bf16* kp = Z + (krow0 + key) * ZS + ZK + kvh * 64 + 32 * ks + 8 * sub;
    float fa[8], fb[8]; unpack8(*(const u32x4*)kp, fa); unpack8(*(const u32x4*)(kp + 16), fb);
    if (rope) { const int tk = kblk * 128 + key; const int pos = ks == 0 ? (tk >> 6) : (tk & 63); const float* cs = ROPEC + pos * 16 + 8 * sub; const float* sn = ROPES + pos * 16 + 8 * sub;
#pragma unroll
        for (int e = 0; e < 8; ++e) { const float x1 = fa[e], x2 = fb[e]; fa[e] = x1 * cs[e] - x2 * sn[e]; fb[e] = x2 * cs[e] + x1 * sn[e]; } }
    LAS bf16* kd = Ks + (slot * 128 + key) * 72 + 32 * ks + 8 * sub;
    *(LAS u32x4*)kd = pack8(fa); *(LAS u32x4*)(kd + 16) = pack8(fb);
}
__device__ __forceinline__ void attn2_load_v(const bf16* Z, size_t krow0, int kvh, int tid, u32x4& v0, u32x4& v1) {
    const bf16* vp = Z + (krow0 + (tid >> 2)) * ZS + ZV + kvh * 64 + 16 * (tid & 3); v0 = *(const u32x4*)vp; v1 = *(const u32x4*)(vp + 8);
}
__device__ __forceinline__ void attn2_write_vt(LAS bf16* VT, int tid, const u32x4 v0, const u32x4 v1) {
    LAS bf16* vt = VT + (16 * (tid & 3)) * 136 + (tid >> 2);
    vt[0 * 136] = (bf16)(v0.x & 0xffffu); vt[1 * 136] = (bf16)(v0.x >> 16); vt[2 * 136] = (bf16)(v0.y & 0xffffu); vt[3 * 136] = (bf16)(v0.y >> 16);
    vt[4 * 136] = (bf16)(v0.z & 0xffffu); vt[5 * 136] = (bf16)(v0.z >> 16); vt[6 * 136] = (bf16)(v0.w & 0xffffu); vt[7 * 136] = (bf16)(v0.w >> 16);
    vt[8 * 136] = (bf16)(v1.x & 0xffffu); vt[9 * 136] = (bf16)(v1.x >> 16); vt[10 * 136] = (bf16)(v1.y & 0xffffu); vt[11 * 136] = (bf16)(v1.y >> 16);
    vt[12 * 136] = (bf16)(v1.z & 0xffffu); vt[13 * 136] = (bf16)(v1.z >> 16); vt[14 * 136] = (bf16)(v1.w & 0xffffu); vt[15 * 136] = (bf16)(v1.w >> 16);
}
__device__ __forceinline__ void attn_unit2(const Args& a, int l, int u, LAS unsigned char* lds, int tid, int wave, int lane) {
    const bf16* Z = (const bf16*)(a.ws + WS_Z); bf16* OB = (bf16*)(a.ws + WS_O);
    const float* ROPEC = (const float*)(a.ws + WS_ROPE); const float* ROPES = ROPEC + 2048;
    LAS bf16* Ks = (LAS bf16*)lds;
    LAS bf16* VT0 = (LAS bf16*)(lds + 92160);
    const int fr = lane & 15, fq = lane >> 4;
    int b, kvh, nb; const bool isctx = u >= 256;
    if (!isctx) { b = u >> 7; kvh = (u >> 6) & 1; nb = u & 63; } else { const int v = u - 256; b = v >> 2; kvh = (v >> 1) & 1; nb = v & 1; }
    const int h = kvh * 4 + (wave >> 1), qs = (wave & 1) * 64;
    const int ntile = isctx ? 2 : 5;
    __syncthreads();
#pragma unroll
    for (int kt = 0; kt < 5; ++kt) {
        if (kt >= ntile) continue;
        const bool isband = (!isctx && kt < 3); const int kblk = nb - 1 + kt;
        if (isband && (kblk < 0 || kblk > 63)) continue;
        const size_t krow0 = isband ? (size_t)b * SEQ + kblk * 128 : (size_t)ML + b * 256 + (isctx ? kt : kt - 3) * 128;
        attn2_stage_k(Ks, Z, ROPEC, ROPES, krow0, kvh, kt, isband, kblk, tid);
    }
    bf16x8 Qf[4][2];
#pragma unroll
    for (int qb = 0; qb < 4; ++qb) { const int tq = nb * 128 + qs + 16 * qb + fr; const size_t row = isctx ? (size_t)ML + b * 256 + tq : (size_t)b * SEQ + tq;
        const bf16* qp = Z + row * ZS + ZQ + h * 64;
#pragma unroll
        for (int ks = 0; ks < 2; ++ks) { float o[8]; unpack8(*(const u32x4*)(qp + 32 * ks + 8 * fq), o);
            if (!isctx) { float p[8]; unpack8(*(const u32x4*)(qp + 32 * ks + 8 * (fq ^ 2)), p); const int pos = ks == 0 ? (tq >> 6) : (tq & 63);
                const float* cs = ROPEC + pos * 16 + 8 * (fq & 1); const float* sn = ROPES + pos * 16 + 8 * (fq & 1);
#pragma unroll
                for (int e = 0; e < 8; ++e) o[e] = fq < 2 ? o[e] * cs[e] - p[e] * sn[e] : o[e] * cs[e] + p[e] * sn[e]; }
#pragma unroll
            for (int e = 0; e < 8; ++e) o[e] *= 0.125f * LOG2E;
            Qf[qb][ks] = __builtin_bit_cast(bf16x8, pack8(o)); } }
    int first = 0; if (!isctx && nb == 0) first = 1;
    { const bool isband = (!isctx && first < 3); const int kblk = nb - 1 + first;
      const size_t krow0 = isband ? (size_t)b * SEQ + kblk * 128 : (size_t)ML + b * 256 + (isctx ? first : first - 3) * 128;
      u32x4 v0, v1; attn2_load_v(Z, krow0, kvh, tid, v0, v1); attn2_write_vt(VT0, tid, v0, v1); }
    __syncthreads();
    float mx[4]; const float sinkv = a.in[10][l * 8 + h] * LOG2E;
#pragma unroll
    for (int qb = 0; qb < 4; ++qb) mx[qb] = -3.0e38f;
#pragma unroll 1
    for (int kt = 0; kt < ntile; ++kt) {
        const bool isband = (!isctx && kt < 3); const int kblk = nb - 1 + kt;
        if (isband && (kblk < 0 || kblk > 63)) continue;
#pragma unroll 1
        for (int kk = 0; kk < 4; ++kk) {
            bf16x8 Kf[2][2];
#pragma unroll
            for (int kb2 = 0; kb2 < 2; ++kb2)
#pragma unroll
                for (int ks = 0; ks < 2; ++ks) Kf[kb2][ks] = *(const LAS bf16x8*)(Ks + (kt * 128 + 32 * kk + 16 * kb2 + fr) * 72 + 32 * ks + 8 * fq);
#pragma unroll
            for (int qb = 0; qb < 4; ++qb) {
                if (isband && ((kt == 0 && 32 * kk + 31 < qs + 16 * qb) || (kt == 2 && 32 * kk > qs + 16 * qb + 15))) continue;
                f32x4 s0 = {0.f, 0.f, 0.f, 0.f}, s1 = s0;
                s0 = MFMA16(Kf[0][0], Qf[qb][0], s0); s0 = MFMA16(Kf[0][1], Qf[qb][1], s0);
                s1 = MFMA16(Kf[1][0], Qf[qb][0], s1); s1 = MFMA16(Kf[1][1], Qf[qb][1], s1);
                if (isband && kt != 1) { const int tq = nb * 128 + qs + 16 * qb + fr;
#pragma unroll
                    for (int e = 0; e < 4; ++e) { const int d0 = kblk * 128 + 32 * kk + 4 * fq + e - tq, d1 = d0 + 16;
                        if (d0 > 128 || d0 < -128) s0[e] = -1e30f; if (d1 > 128 || d1 < -128) s1[e] = -1e30f; } }
                mx[qb] = fmaxf(mx[qb], fmaxf(fmaxf(fmaxf(s0[0], s0[1]), fmaxf(s0[2], s0[3])), fmaxf(fmaxf(s1[0], s1[1]), fmaxf(s1[2], s1[3]))));
            }
        }
    }
    float lsum[4]; f32x4 O[4][4]; float negm[4];
#pragma unroll
    for (int qb = 0; qb < 4; ++qb) { float m = mx[qb]; m = fmaxf(m, __shfl_xor(m, 16)); m = fmaxf(m, __shfl_xor(m, 32)); m = fmaxf(m, sinkv);
        negm[qb] = -m; lsum[qb] = fq == 0 ? __builtin_amdgcn_exp2f(sinkv - m) : 0.f;
#pragma unroll
        for (int db = 0; db < 4; ++db) O[qb][db] = (f32x4){0.f, 0.f, 0.f, 0.f}; }
    int buf = 0;
#pragma unroll 1
    for (int kt = first; kt < ntile; ++kt) {
        const bool isband = (!isctx && kt < 3); const int kblk = nb - 1 + kt;
        if (isband && (kblk < 0 || kblk > 63)) continue;
        int nk = kt + 1; if (!isctx && nk == 2 && nb == 63) nk = 3;
        const bool hasn = nk < ntile;
        u32x4 nv0 = {0u, 0u, 0u, 0u}, nv1 = nv0;
        if (hasn) { const bool nband = (!isctx && nk < 3); const size_t nrow0 = nband ? (size_t)b * SEQ + (nb - 1 + nk) * 128 : (size_t)ML + b * 256 + (isctx ? nk : nk - 3) * 128; attn2_load_v(Z, nrow0, kvh, tid, nv0, nv1); }
        LAS bf16* VT = VT0 + buf * (64 * 136);
#pragma unroll 1
        for (int kk = 0; kk < 4; ++kk) {
            bf16x8 Kf[2][2], Vf[4];
#pragma unroll
            for (int kb2 = 0; kb2 < 2; ++kb2)
#pragma unroll
                for (int ks = 0; ks < 2; ++ks) Kf[kb2][ks] = *(const LAS bf16x8*)(Ks + (kt * 128 + 32 * kk + 16 * kb2 + fr) * 72 + 32 * ks + 8 * fq);
#pragma unroll
            for (int db = 0; db < 4; ++db) { const s16x4 lo = *(const LAS s16x4*)(VT + (16 * db + fr) * 136 + 32 * kk + 4 * fq), hi = *(const LAS s16x4*)(VT + (16 * db + fr) * 136 + 32 * kk + 16 + 4 * fq);
                Vf[db] = (bf16x8){lo[0], lo[1], lo[2], lo[3], hi[0], hi[1], hi[2], hi[3]}; }
#pragma unroll
            for (int qb = 0; qb < 4; ++qb) {
                if (isband && ((kt == 0 && 32 * kk + 31 < qs + 16 * qb) || (kt == 2 && 32 * kk > qs + 16 * qb + 15))) continue;
                f32x4 s0 = {negm[qb], negm[qb], negm[qb], negm[qb]}, s1 = s0;
                s0 = MFMA16(Kf[0][0], Qf[qb][0], s0); s0 = MFMA16(Kf[0][1], Qf[qb][1], s0);
                s1 = MFMA16(Kf[1][0], Qf[qb][0], s1); s1 = MFMA16(Kf[1][1], Qf[qb][1], s1);
                if (isband && kt != 1) { const int tq = nb * 128 + qs + 16 * qb + fr;
#pragma unroll
                    for (int e = 0; e < 4; ++e) { const int d0 = kblk * 128 + 32 * kk + 4 * fq + e - tq, d1 = d0 + 16;
                        if (d0 > 128 || d0 < -128) s0[e] = -1e30f; if (d1 > 128 || d1 < -128) s1[e] = -1e30f; } }
                float p[8]; float ps = 0.f;
#pragma unroll
                for (int e = 0; e < 4; ++e) { p[e] = __builtin_amdgcn_exp2f(s0[e]); p[4 + e] = __builtin_amdgcn_exp2f(s1[e]); ps += p[e] + p[4 + e]; }
                lsum[qb] += ps;
                const bf16x8 Pf = __builtin_bit_cast(bf16x8, pack8(p));
#pragma unroll
                for (int db = 0; db < 4; ++db) O[qb][db] = MFMA16(Vf[db], Pf, O[qb][db]);
            }
        }
        if (hasn) attn2_write_vt(VT0 + (buf ^ 1) * (64 * 136), tid, nv0, nv1);
        __syncthreads();
        buf ^= 1;
    }
#pragma unroll
    for (int qb = 0; qb < 4; ++qb) { float ls = lsum[qb]; ls += __shfl_xor(ls, 16); ls += __shfl_xor(ls, 32); const float inv = 1.f / ls;
        const int tq = nb * 128 + qs + 16 * qb + fr; const size_t row = isctx ? (size_t)ML + b * 256 + tq : (size_t)b * SEQ + tq;
#pragma unroll
        for (int db = 0; db < 4; ++db) { u32x2 o; o.x = pk2(O[qb][db][0] * inv, O[qb][db][1] * inv); o.y = pk2(O[qb][db][2] * inv, O[qb][db][3] * inv);
            *(u32x2*)(OB + row * D + h * 64 + 16 * db + 4 * fq) = o; } }
}

__device__ __forceinline__ void phase_pool(const Args& a, int l, int wave, int lane) {
    const bf16* Z = (const bf16*)(a.ws + WS_Z); bf16* OB = (bf16*)(a.ws + WS_O);
    const bf16* PWT = (const bf16*)(a.ws + WS_PWT) + (size_t)l * 4 * 128 * 128; const float* pscale = a.in[12] + l * 512;
    const int fr = lane & 15, fq = lane >> 4;
    const int gw = blockIdx.x * 8 + wave, NGW = gridDim.x * 8;
    const int nblk = (l == 0 ? MT : ML) / 16;
    for (int task = gw; task < nblk * 4; task += NGW) {
        const int g = task & 3, tb = task >> 2;
        const int row = tb * 16 + fr;
        int t, n; if (row < ML) { t = row & 8191; n = SEQ; } else { t = (row - ML) & 255; n = CTXL; }
        const int seq0 = row - t, hw = 1 << g;
        const int lo = t - hw > 0 ? t - hw : 0, hi = t + hw < n ? t + hw : n;
        const float inv = 1.f / (float)(hi - lo);
        bf16x8 Af[4];
#pragma unroll
        for (int ks = 0; ks < 4; ++ks) { float s[8] = {0, 0, 0, 0, 0, 0, 0, 0}; const bf16* base = Z + ZP + g * 128 + 32 * ks + 8 * fq;
            for (int tt = lo; tt < hi; ++tt) { float x[8]; unpack8(*(const u32x4*)(base + (size_t)(seq0 + tt) * ZS), x);
#pragma unroll
                for (int e = 0; e < 8; ++e) s[e] += x[e]; }
            float own[8]; unpack8(*(const u32x4*)(base + (size_t)row * ZS), own);
#pragma unroll
            for (int e = 0; e < 8; ++e) s[e] = s[e] * inv - own[e];
            Af[ks] = __builtin_bit_cast(bf16x8, pack8(s)); }
        f32x4 acc[4][2];
#pragma unroll
        for (int cp = 0; cp < 4; ++cp) { acc[cp][0] = (f32x4){0.f, 0.f, 0.f, 0.f}; acc[cp][1] = acc[cp][0]; }
#pragma unroll
        for (int ks = 0; ks < 4; ++ks)
#pragma unroll
            for (int cp = 0; cp < 4; ++cp)
#pragma unroll
                for (int nn = 0; nn < 2; ++nn) { const bf16x8 Bf = *(const bf16x8*)(PWT + (size_t)(g * 128 + 32 * cp + perm16(nn, fr)) * 128 + 32 * ks + 8 * fq); acc[cp][nn] = MFMA16(Bf, Af[ks], acc[cp][nn]); }
#pragma unroll
        for (int cp = 0; cp < 4; ++cp) { const int ch = g * 128 + 32 * cp + 8 * fq; const f32x4 pa = *(const f32x4*)(pscale + ch), pb = *(const f32x4*)(pscale + ch + 4); float o[8];
#pragma unroll
            for (int e = 0; e < 4; ++e) { o[e] = acc[cp][0][e] * pa[e]; o[4 + e] = acc[cp][1][e] * pb[e]; }
            *(u32x4*)(OB + (size_t)row * D + 512 + ch) = pack8(o); }
    }
}

__device__ __forceinline__ void phase_cgate(const Args& a, int l, LAS unsigned char* lds, int tid, int wave, int lane) {
    const bf16* Z = (const bf16*)(a.ws + WS_Z); bf16* OB = (bf16*)(a.ws + WS_O);
    LAS bf16* VT = (LAS bf16*)lds;
    const bf16* WSB = (const bf16*)(a.ws + WS_WSB) + (size_t)l * 4 * 128 * 128;
    const float* lng = a.in[13] + l * 512; const float* lnb = a.in[14] + l * 512; const float* cbs = a.in[16] + l * 512;
    const int fr = lane & 15, fq = lane >> 4;
    const int nch = (l == 0) ? 132 : 128;
    for (int u = blockIdx.x; u < nch * 2; u += gridDim.x) {
        const int ch = u >> 1, gp = u & 1;
        const size_t row0 = (size_t)ch * 128;
        __syncthreads();
        for (int ti = 0; ti < 16; ++ti) {
            const int tok = 16 * wave + ti; float v[8]; unpack8(*(const u32x4*)(Z + (row0 + tok) * ZS + ZUV + 512 + 8 * lane), v);
            float s = 0.f;
#pragma unroll
            for (int e = 0; e < 8; ++e) s += v[e];
            const float mean = wave_sum(s) * (1.f / 512.f); float q = 0.f;
#pragma unroll
            for (int e = 0; e < 8; ++e) { v[e] -= mean; q += v[e] * v[e]; }
            const float rstd = rsqrtf(wave_sum(q) * (1.f / 512.f) + 1e-6f);
            if ((lane >> 5) == gp) { const int c0 = 8 * lane;
#pragma unroll
                for (int e = 0; e < 8; ++e) VT[(c0 - 256 * gp + e) * 136 + tok] = (bf16)f2bf(v[e] * rstd * lng[c0 + e] + lnb[c0 + e]); }
        }
        __syncthreads();
#pragma unroll
        for (int gl = 0; gl < 2; ++gl) { const int g = 2 * gp + gl;
            bf16x8 Vf[4];
#pragma unroll
            for (int ks = 0; ks < 4; ++ks) Vf[ks] = *(const LAS bf16x8*)(VT + (128 * gl + 16 * wave + fr) * 136 + 32 * ks + 8 * fq);
            for (int pb = 0; pb < 8; ++pb) { f32x4 acc = {0.f, 0.f, 0.f, 0.f};
#pragma unroll
                for (int ks = 0; ks < 4; ++ks) { const bf16x8 Wf = *(const bf16x8*)(WSB + (size_t)(g * 128 + 16 * pb + fr) * 128 + 32 * ks + 8 * fq); acc = MFMA16(Vf[ks], Wf, acc); }
                const int p = 16 * pb + fr; const float bsv = cbs[g * 128 + p];
                const u32x2 ur = *(const u32x2*)(Z + (row0 + p) * ZS + ZUV + g * 128 + 16 * wave + 4 * fq);
                u32x2 o; o.x = pk2(bf2f(ur.x & 0xffffu) * (acc[0] + bsv), bf2f(ur.x >> 16) * (acc[1] + bsv)); o.y = pk2(bf2f(ur.y & 0xffffu) * (acc[2] + bsv), bf2f(ur.y >> 16) * (acc[3] + bsv));
                *(u32x2*)(OB + (row0 + p) * D + 1024 + g * 128 + 16 * wave + 4 * fq) = o; } }
    }
}

__device__ __forceinline__ void gla_logg_cum(const Args& a, int l, LAS float* LG, const bf16* Z, size_t row0, int h, int tid) {
    const float* gw2 = a.in[17] + l * 2 * 16 * 256; const float* gb = a.in[18] + l * 2 * 256;
    for (int i = 0; i < 16; ++i) { const int idx = tid + 512 * i, dir = idx >> 12, tok = (idx >> 6) & 63, dk = idx & 63;
        const bf16* gl = Z + (row0 + tok) * ZS + ZGLR + dir * 16; float acc = gb[dir * 256 + h * 64 + dk];
        float ga[8], gc[8]; unpack8(*(const u32x4*)gl, ga); unpack8(*(const u32x4*)(gl + 8), gc);
#pragma unroll
        for (int r = 0; r < 8; ++r) acc += ga[r] * gw2[(dir * 16 + r) * 256 + h * 64 + dk] + gc[r] * gw2[(dir * 16 + 8 + r) * 256 + h * 64 + dk];
        const float ls = fminf(acc, 0.f) - __logf(1.f + __expf(-fabsf(acc)));
        LG[idx] = ls * (1.f / 16.f); }
    __syncthreads();
    if (tid < 128) { const int dir = tid >> 6, dk = tid & 63; float c = 0.f;
        if (dir == 0) { for (int tok = 0; tok < 64; ++tok) { c += LG[tok * 64 + dk]; LG[tok * 64 + dk] = c; } }
        else { for (int tok = 63; tok >= 0; --tok) { c += LG[4096 + tok * 64 + dk]; LG[4096 + tok * 64 + dk] = c; } } }
    __syncthreads();
}
__device__ __forceinline__ void gla_stage_vt(LAS bf16* VT, const bf16* Z, size_t row0, int h, int tid) {
    const int tok = tid >> 3, c8 = tid & 7;
    const bf16* vp = Z + (row0 + tok) * ZS + ZGV + h * 128 + 16 * c8;
    const u32x4 v0 = *(const u32x4*)vp, v1 = *(const u32x4*)(vp + 8);
    LAS bf16* vt = VT + (16 * c8) * 72 + tok;
    vt[0 * 72] = (bf16)(v0.x & 0xffffu); vt[1 * 72] = (bf16)(v0.x >> 16); vt[2 * 72] = (bf16)(v0.y & 0xffffu); vt[3 * 72] = (bf16)(v0.y >> 16);
    vt[4 * 72] = (bf16)(v0.z & 0xffffu); vt[5 * 72] = (bf16)(v0.z >> 16); vt[6 * 72] = (bf16)(v0.w & 0xffffu); vt[7 * 72] = (bf16)(v0.w >> 16);
    vt[8 * 72] = (bf16)(v1.x & 0xffffu); vt[9 * 72] = (bf16)(v1.x >> 16); vt[10 * 72] = (bf16)(v1.y & 0xffffu); vt[11 * 72] = (bf16)(v1.y >> 16);
    vt[12 * 72] = (bf16)(v1.z & 0xffffu); vt[13 * 72] = (bf16)(v1.z >> 16); vt[14 * 72] = (bf16)(v1.w & 0xffffu); vt[15 * 72] = (bf16)(v1.w >> 16);
}
__device__ __forceinline__ int gla_ci(int dir, int tile) { return dir == 0 ? tile : (tile < 4 ? 3 - tile : 4 + 127 - (tile - 4)); }

__device__ __forceinline__ void phase_gla1(const Args& a, int l, LAS unsigned char* lds, int tid, int wave, int lane) {
    const bf16* Z = (const bf16*)(a.ws + WS_Z);
    LAS float* LG = (LAS float*)lds; LAS bf16* KT = (LAS bf16*)(lds + 32768); LAS bf16* VT = (LAS bf16*)(lds + 32768 + 18432);
    float* S = (float*)(a.ws + WS_S); float* DEC = (float*)(a.ws + WS_DECAY);
    const int fr = lane & 15, fq = lane >> 4;
    for (int u = blockIdx.x; u < 1056; u += gridDim.x) {
        const int tile = u % 132, bh = u / 132, b = bh >> 2, h = bh & 3;
        const size_t row0 = tile < 4 ? (size_t)ML + b * 256 + tile * 64 : (size_t)b * SEQ + (tile - 4) * 64;
        __syncthreads();
        gla_logg_cum(a, l, LG, Z, row0, h, tid);
        if (tid < 128) { const int dir = tid >> 6, dk = tid & 63; const float tot = LG[dir * 4096 + (dir == 0 ? 63 : 0) * 64 + dk];
            DEC[((size_t)(bh * 2 + dir) * 132 + gla_ci(dir, tile)) * 64 + dk] = __expf(tot); }
        { const int tok = tid >> 3, c8 = tid & 7; float kv[8]; unpack8(*(const u32x4*)(Z + (row0 + tok) * ZS + ZGK + h * 64 + 8 * c8), kv);
#pragma unroll
            for (int dir = 0; dir < 2; ++dir)
#pragma unroll
                for (int e = 0; e < 8; ++e) { const int dk = 8 * c8 + e; const float f = __expf(LG[dir * 4096 + (dir == 0 ? 63 : 0) * 64 + dk] - LG[dir * 4096 + tok * 64 + dk]);
                    KT[(dir * 64 + dk) * 72 + tok] = (bf16)f2bf(kv[e] * f); } }
        gla_stage_vt(VT, Z, row0, h, tid);
        __syncthreads();
        { const int dir = wave >> 2, dkb = wave & 3; bf16x8 Kf[2];
#pragma unroll
            for (int ks = 0; ks < 2; ++ks) Kf[ks] = *(const LAS bf16x8*)(KT + (dir * 64 + 16 * dkb + fr) * 72 + 32 * ks + 8 * fq);
            float* Sd = S + ((size_t)(bh * 2 + dir) * 132 + gla_ci(dir, tile)) * 8192;
#pragma unroll
            for (int dvb = 0; dvb < 8; ++dvb) { f32x4 acc = {0.f, 0.f, 0.f, 0.f};
#pragma unroll
                for (int ks = 0; ks < 2; ++ks) { const bf16x8 Vf = *(const LAS bf16x8*)(VT + (16 * dvb + fr) * 72 + 32 * ks + 8 * fq); acc = MFMA16(Vf, Kf[ks], acc); }
#pragma unroll
                for (int e = 0; e < 4; ++e) Sd[(16 * dvb + 4 * fq + e) * 64 + 16 * dkb + fr] = acc[e]; } }
    }
}
__device__ __forceinline__ void phase_gla2(const Args& a, int tid) {
    float* S = (float*)(a.ws + WS_S); const float* DEC = (const float*)(a.ws + WS_DECAY);
    for (int el = blockIdx.x * 512 + tid; el < 131072; el += gridDim.x * 512) {
        const int seq = el >> 13, e = el & 8191, dk = e & 63;
        float* Sp = S + (size_t)seq * 132 * 8192 + e; const float* Dp = DEC + (size_t)seq * 132 * 64 + dk;
        float s = 0.f;
        for (int ci = 0; ci < 132; ci += 4) {
            const float d0 = Sp[(size_t)ci * 8192], d1 = Sp[(size_t)(ci + 1) * 8192], d2 = Sp[(size_t)(ci + 2) * 8192], d3 = Sp[(size_t)(ci + 3) * 8192];
            const float a0 = Dp[ci * 64], a1 = Dp[(ci + 1) * 64], a2 = Dp[(ci + 2) * 64], a3 = Dp[(ci + 3) * 64];
            Sp[(size_t)ci * 8192] = s; s = a0 * s + d0; Sp[(size_t)(ci + 1) * 8192] = s; s = a1 * s + d1; Sp[(size_t)(ci + 2) * 8192] = s; s = a2 * s + d2; Sp[(size_t)(ci + 3) * 8192] = s; s = a3 * s + d3;
        }
    }
}
__device__ __forceinline__ void phase_gla3(const Args& a, int l, LAS unsigned char* lds, int tid, int wave, int lane) {
    const bf16* Z = (const bf16*)(a.ws + WS_Z); bf16* OB = (bf16*)(a.ws + WS_O);
    LAS float* LG = (LAS float*)lds; LAS bf16* VT = (LAS bf16*)(lds + 32768); LAS float* OX = (LAS float*)(lds + 32768 + 18432);
    const float* S = (const float*)(a.ws + WS_S);
    const float* gn = a.in[19] + l * 512;
    const int fr = lane & 15, fq = lane >> 4;
    const int ntile = (l == 0) ? 132 : 128;
    for (int u = blockIdx.x; u < 8 * ntile; u += gridDim.x) {
        const int tile = (l == 0) ? u % 132 : 4 + u % 128, bh = u / ntile, b = bh >> 2, h = bh & 3;
        const size_t row0 = tile < 4 ? (size_t)ML + b * 256 + tile * 64 : (size_t)b * SEQ + (tile - 4) * 64;
        __syncthreads();
        gla_logg_cum(a, l, LG, Z, row0, h, tid);
        gla_stage_vt(VT, Z, row0, h, tid);
        __syncthreads();
        const int dir = wave >> 2, tb = wave & 3;
        bf16x8 Qf[2];
        { const int tok = 16 * tb + fr;
#pragma unroll
            for (int ks = 0; ks < 2; ++ks) { float q[8]; unpack8(*(const u32x4*)(Z + (row0 + tok) * ZS + ZGQ + h * 64 + 32 * ks + 8 * fq), q);
#pragma unroll
                for (int e = 0; e < 8; ++e) q[e] *= 0.125f * __expf(LG[dir * 4096 + tok * 64 + 32 * ks + 8 * fq + e]);
                Qf[ks] = __builtin_bit_cast(bf16x8, pack8(q)); } }
        f32x4 at[4];
#pragma unroll
        for (int kb = 0; kb < 4; ++kb) { const int key = 16 * kb + fr; f32x4 acc = {0.f, 0.f, 0.f, 0.f};
#pragma unroll
            for (int ks = 0; ks < 2; ++ks) { float k[8]; unpack8(*(const u32x4*)(Z + (row0 + key) * ZS + ZGK + h * 64 + 32 * ks + 8 * fq), k);
#pragma unroll
                for (int e = 0; e < 8; ++e) k[e] *= __expf(-LG[dir * 4096 + key * 64 + 32 * ks + 8 * fq + e]);
                acc = MFMA16(__builtin_bit_cast(bf16x8, pack8(k)), Qf[ks], acc); }
            const int tok = 16 * tb + fr;
#pragma unroll
            for (int e = 0; e < 4; ++e) { const int kj = 16 * kb + 4 * fq + e; const bool ok = dir == 0 ? (kj <= tok) : (kj >= tok); if (!ok) acc[e] = 0.f; }
            at[kb] = acc; }
        bf16x8 Pf[2];
#pragma unroll
        for (int kk = 0; kk < 2; ++kk) { float p[8];
#pragma unroll
            for (int e = 0; e < 4; ++e) { p[e] = at[2 * kk][e]; p[4 + e] = at[2 * kk + 1][e]; }
            Pf[kk] = __builtin_bit_cast(bf16x8, pack8(p)); }
        const float* Sp = S + ((size_t)(bh * 2 + dir) * 132 + gla_ci(dir, tile)) * 8192;
        f32x4 O[8];
#pragma unroll
        for (int dvb = 0; dvb < 8; ++dvb) { f32x4 o = {0.f, 0.f, 0.f, 0.f};
#pragma unroll
            for (int kk = 0; kk < 2; ++kk) { const s16x4 lo = *(const LAS s16x4*)(VT + (16 * dvb + fr) * 72 + 32 * kk + 4 * fq), hi = *(const LAS s16x4*)(VT + (16 * dvb + fr) * 72 + 32 * kk + 16 + 4 * fq);
                const bf16x8 Vf = (bf16x8){lo[0], lo[1], lo[2], lo[3], hi[0], hi[1], hi[2], hi[3]}; o = MFMA16(Vf, Pf[kk], o); }
#pragma unroll
            for (int ks = 0; ks < 2; ++ks) { const float* sp = Sp + (16 * dvb + fr) * 64 + 32 * ks + 8 * fq; const f32x4 s0 = *(const f32x4*)sp, s1 = *(const f32x4*)(sp + 4);
                float sv[8] = {s0[0], s0[1], s0[2], s0[3], s1[0], s1[1], s1[2], s1[3]}; o = MFMA16(__builtin_bit_cast(bf16x8, pack8(sv)), Qf[ks], o); }
            O[dvb] = o; }
        if (dir == 1) {
#pragma unroll
            for (int dvb = 0; dvb < 8; ++dvb) *(LAS f32x4*)(OX + (tb * 16 + fr) * 132 + 16 * dvb + 4 * fq) = O[dvb]; }
        __syncthreads();
        if (dir == 0) { float ss = 0.f;
#pragma unroll
            for (int dvb = 0; dvb < 8; ++dvb) { O[dvb] += *(const LAS f32x4*)(OX + (tb * 16 + fr) * 132 + 16 * dvb + 4 * fq); ss += (O[dvb][0] * O[dvb][0] + O[dvb][1] * O[dvb][1]) + (O[dvb][2] * O[dvb][2] + O[dvb][3] * O[dvb][3]); }
            ss += __shfl_xor(ss, 16); ss += __shfl_xor(ss, 32);
            const float rstd = rsqrtf(ss * (1.f / 128.f) + 1e-6f);
            const size_t row = row0 + 16 * tb + fr;
#pragma unroll
            for (int dvb = 0; dvb < 8; ++dvb) { const int c = h * 128 + 16 * dvb + 4 * fq; const f32x4 g = *(const f32x4*)(gn + c); const u32x2 rr = *(const u32x2*)(Z + row * ZS + ZGR + c);
                const float r0 = bf2f(rr.x & 0xffffu), r1 = bf2f(rr.x >> 16), r2 = bf2f(rr.y & 0xffffu), r3 = bf2f(rr.y >> 16);
                u32x2 o; o.x = pk2(O[dvb][0] * rstd * g[0] * r0 * sigmoidf_(r0), O[dvb][1] * rstd * g[1] * r1 * sigmoidf_(r1)); o.y = pk2(O[dvb][2] * rstd * g[2] * r2 * sigmoidf_(r2), O[dvb][3] * rstd * g[3] * r3 * sigmoidf_(r3));
                *(u32x2*)(OB + row * D + 1536 + c) = o; } }
    }
}


template <int G> __device__ __forceinline__ void pool_task(const bf16* Z, bf16* OB, const bf16* PWT, const float* pscale, int tb, int fr, int fq) {
    constexpr int HW = 1 << G;
    const int row = tb * 16 + fr;
    int t, n; if (row < ML) { t = row & 8191; n = SEQ; } else { t = (row - ML) & 255; n = CTXL; }
    const int seq0 = row - t;
    const int lo = t - HW > 0 ? t - HW : 0, hi = t + HW < n ? t + HW : n;
    const float inv = 1.f / (float)(hi - lo);
    f32x4 acc[4][2];
#pragma unroll
    for (int cp = 0; cp < 4; ++cp) { acc[cp][0] = (f32x4){0.f, 0.f, 0.f, 0.f}; acc[cp][1] = acc[cp][0]; }
#pragma unroll 1
    for (int ks = 0; ks < 4; ++ks) { const bf16* base = Z + ZP + G * 128 + 32 * ks + 8 * fq;
        bf16x8 Bf[4][2];
#pragma unroll
        for (int cp = 0; cp < 4; ++cp)
#pragma unroll
            for (int nn = 0; nn < 2; ++nn) Bf[cp][nn] = *(const bf16x8*)(PWT + (size_t)(G * 128 + 32 * cp + perm16(nn, fr)) * 128 + 32 * ks + 8 * fq);
        float s[8] = {0, 0, 0, 0, 0, 0, 0, 0}, own[8];
        constexpr int CH = (2 * HW < 8) ? 2 * HW : 8;
#pragma unroll
        for (int j0 = 0; j0 < 2 * HW; j0 += CH) {
            u32x4 raw[CH];
#pragma unroll
            for (int j = 0; j < CH; ++j) { int tt = t - HW + j0 + j; tt = tt < 0 ? 0 : (tt > n - 1 ? n - 1 : tt); raw[j] = *(const u32x4*)(base + (size_t)(seq0 + tt) * ZS); }
#pragma unroll
            for (int j = 0; j < CH; ++j) { const int tt = t - HW + j0 + j; const bool ok = tt >= 0 && tt < n; float x[8]; unpack8(raw[j], x);
#pragma unroll
                for (int e = 0; e < 8; ++e) { s[e] += ok ? x[e] : 0.f; if (j0 + j == HW) own[e] = x[e]; } }
            __builtin_amdgcn_sched_barrier(0);
        }
#pragma unroll
        for (int e = 0; e < 8; ++e) s[e] = s[e] * inv - own[e];
        const bf16x8 Af = __builtin_bit_cast(bf16x8, pack8(s));
#pragma unroll
        for (int cp = 0; cp < 4; ++cp)
#pragma unroll
            for (int nn = 0; nn < 2; ++nn) acc[cp][nn] = MFMA16(Bf[cp][nn], Af, acc[cp][nn]); }
#pragma unroll
    for (int cp = 0; cp < 4; ++cp) { const int ch = G * 128 + 32 * cp + 8 * fq; const f32x4 pa = *(const f32x4*)(pscale + ch), pb = *(const f32x4*)(pscale + ch + 4); float o[8];
#pragma unroll
        for (int e = 0; e < 4; ++e) { o[e] = acc[cp][0][e] * pa[e]; o[4 + e] = acc[cp][1][e] * pb[e]; }
        *(u32x4*)(OB + (size_t)row * D + 512 + ch) = pack8(o); }
}
__device__ __forceinline__ void pool_unit(const Args& a, int l, int pu, int wave, int lane) {
    const bf16* Z = (const bf16*)(a.ws + WS_Z); bf16* OB = (bf16*)(a.ws + WS_O);
    const bf16* PWT = (const bf16*)(a.ws + WS_PWT) + (size_t)l * 4 * 128 * 128; const float* pscale = a.in[12] + l * 512;
    const int fr = lane & 15, fq = lane >> 4, g = wave & 3, tb = 2 * pu + (wave >> 2);
    if (g == 0) pool_task<0>(Z, OB, PWT, pscale, tb, fr, fq); else if (g == 1) pool_task<1>(Z, OB, PWT, pscale, tb, fr, fq);
    else if (g == 2) pool_task<2>(Z, OB, PWT, pscale, tb, fr, fq); else pool_task<3>(Z, OB, PWT, pscale, tb, fr, fq);
}
__device__ __forceinline__ void cgate_unit(const Args& a, int l, int u, LAS unsigned char* lds, int tid, int wave, int lane) {
    const bf16* Z = (const bf16*)(a.ws + WS_Z); bf16* OB = (bf16*)(a.ws + WS_O);
    LAS bf16* VT = (LAS bf16*)lds;
    LAS bf16* WS = (LAS bf16*)(lds + 69632);
    const bf16* WSB = (const bf16*)(a.ws + WS_WSB) + (size_t)l * 4 * 128 * 128;
    const float* lng = a.in[13] + l * 512; const float* lnb = a.in[14] + l * 512; const float* cbs = a.in[16] + l * 512;
    const int fr = lane & 15, fq = lane >> 4;
    const int ch = u >> 1, gp = u & 1;
    const size_t row0 = (size_t)ch * 128;
    __syncthreads();
    u32x4 raw[16];
#pragma unroll
    for (int ti = 0; ti < 16; ++ti) raw[ti] = *(const u32x4*)(Z + (row0 + 16 * wave + ti) * ZS + ZUV + 512 + 8 * lane);
#pragma unroll
    for (int i = 0; i < 8; ++i) { const int p = tid + 512 * i, gl = p >> 11, r = (p >> 4) & 127, c16 = p & 15;
        *(LAS u32x4*)(WS + (gl * 128 + r) * 136 + 8 * c16) = *(const u32x4*)(WSB + (size_t)((2 * gp + gl) * 128 + r) * 128 + 8 * c16); }
    float gv[8], bv[8];
    { const int c0 = 8 * lane;
#pragma unroll
        for (int e = 0; e < 8; ++e) { gv[e] = lng[c0 + e]; bv[e] = lnb[c0 + e]; } }
#pragma unroll
    for (int ti = 0; ti < 16; ++ti) {
        const int tok = 16 * wave + ti; float v[8]; unpack8(raw[ti], v);
        float sm = 0.f;
#pragma unroll
        for (int e = 0; e < 8; ++e) sm += v[e];
        const float mean = wave_sum(sm) * (1.f / 512.f); float q = 0.f;
#pragma unroll
        for (int e = 0; e < 8; ++e) { v[e] -= mean; q += v[e] * v[e]; }
        const float rstd = rsqrtf(wave_sum(q) * (1.f / 512.f) + 1e-6f);
        if ((lane >> 5) == gp) { const int c0 = 8 * lane - 256 * gp;
#pragma unroll
            for (int e = 0; e < 8; ++e) VT[(c0 + e) * 136 + tok] = (bf16)f2bf(v[e] * rstd * gv[e] + bv[e]); }
    }
    __syncthreads();
#pragma unroll
    for (int gl = 0; gl < 2; ++gl) { const int g = 2 * gp + gl;
        bf16x8 Vf[4];
#pragma unroll
        for (int ks = 0; ks < 4; ++ks) Vf[ks] = *(const LAS bf16x8*)(VT + (128 * gl + 16 * wave + fr) * 136 + 32 * ks + 8 * fq);
        u32x2 ur[8]; float bsv[8];
#pragma unroll
        for (int pb = 0; pb < 8; ++pb) { const int p = 16 * pb + fr; ur[pb] = *(const u32x2*)(Z + (row0 + p) * ZS + ZUV + g * 128 + 16 * wave + 4 * fq); bsv[pb] = cbs[g * 128 + p]; }
#pragma unroll
        for (int pb = 0; pb < 8; ++pb) { f32x4 acc = {0.f, 0.f, 0.f, 0.f};
#pragma unroll
            for (int ks = 0; ks < 4; ++ks) { const bf16x8 Wf = *(const LAS bf16x8*)(WS + (gl * 128 + 16 * pb + fr) * 136 + 32 * ks + 8 * fq); acc = MFMA16(Vf[ks], Wf, acc); }
            const int p = 16 * pb + fr;
            u32x2 o; o.x = pk2(bf2f(ur[pb].x & 0xffffu) * (acc[0] + bsv[pb]), bf2f(ur[pb].x >> 16) * (acc[1] + bsv[pb])); o.y = pk2(bf2f(ur[pb].y & 0xffffu) * (acc[2] + bsv[pb]), bf2f(ur[pb].y >> 16) * (acc[3] + bsv[pb]));
            *(u32x2*)(OB + (row0 + p) * D + 1024 + g * 128 + 16 * wave + 4 * fq) = o; } }
}

__device__ __forceinline__ void gla_cum2(const Args& a, int l, LAS unsigned char* lds, const bf16* Z, size_t row0, int h, int tid) {
    LAS float* CUM = (LAS float*)lds; LAS float* GLR = (LAS float*)(lds + 32768); LAS float* QT = (LAS float*)(lds + 40960);
    const float* gw2 = a.in[17] + l * 2 * 16 * 256; const float* gb = a.in[18] + l * 2 * 256;
    if (tid < 256) { const int tok = tid >> 2, part = tid & 3; float g[8]; unpack8(*(const u32x4*)(Z + (row0 + tok) * ZS + ZGLR + 8 * part), g);
        *(LAS f32x4*)(GLR + tok * 32 + 8 * part) = (f32x4){g[0], g[1], g[2], g[3]}; *(LAS f32x4*)(GLR + tok * 32 + 8 * part + 4) = (f32x4){g[4], g[5], g[6], g[7]}; }
    const int dir = tid >> 8, q = (tid >> 6) & 3, dk = tid & 63;
    float w[16];
#pragma unroll
    for (int r = 0; r < 16; ++r) w[r] = gw2[(dir * 16 + r) * 256 + h * 64 + dk];
    const float bias = gb[dir * 256 + h * 64 + dk];
    __syncthreads();
    float run = 0.f;
#pragma unroll 4
    for (int i = 0; i < 16; ++i) { const int tok = dir == 0 ? 16 * q + i : 16 * q + 15 - i;
        const LAS float* gp = GLR + tok * 32 + dir * 16; const f32x4 g0 = *(const LAS f32x4*)gp, g1 = *(const LAS f32x4*)(gp + 4), g2 = *(const LAS f32x4*)(gp + 8), g3 = *(const LAS f32x4*)(gp + 12);
        float acc = bias;
#pragma unroll
        for (int e = 0; e < 4; ++e) acc += g0[e] * w[e] + g1[e] * w[4 + e] + g2[e] * w[8 + e] + g3[e] * w[12 + e];
        const float ls = fminf(acc, 0.f) - __logf(1.f + __expf(-fabsf(acc)));
        run += ls * (1.f / 16.f); CUM[dir * 4096 + tok * 64 + dk] = run; }
    QT[(dir * 4 + q) * 64 + dk] = run;
    __syncthreads();
    float off = 0.f;
#pragma unroll
    for (int qq = 0; qq < 4; ++qq) { const float v = QT[(dir * 4 + qq) * 64 + dk]; if (dir == 0 ? qq < q : qq > q) off += v; }
#pragma unroll
    for (int i = 0; i < 16; ++i) CUM[dir * 4096 + (16 * q + i) * 64 + dk] += off;
    __syncthreads();
}
__device__ __forceinline__ void gla1_unit(const Args& a, int l, int u, LAS unsigned char* lds, int tid, int wave, int lane) {
    const bf16* Z = (const bf16*)(a.ws + WS_Z);
    LAS float* CUM = (LAS float*)lds; LAS bf16* KT = (LAS bf16*)(lds + 43008); LAS bf16* VT = (LAS bf16*)(lds + 43008 + 18432);
    bf16* S = (bf16*)(a.ws + WS_S); float* DEC = (float*)(a.ws + WS_DECAY);
    const int fr = lane & 15, fq = lane >> 4;
    const int tile = u % 132, bh = u / 132, b = bh >> 2, h = bh & 3;
    const size_t row0 = tile < 4 ? (size_t)ML + b * 256 + tile * 64 : (size_t)b * SEQ + (tile - 4) * 64;
    const int tok = tid >> 3, c8 = tid & 7;
    const u32x4 kraw = *(const u32x4*)(Z + (row0 + tok) * ZS + ZGK + h * 64 + 8 * c8);
    const bf16* vp = Z + (row0 + tok) * ZS + ZGV + h * 128 + 16 * c8;
    const u32x4 v0 = *(const u32x4*)vp, v1 = *(const u32x4*)(vp + 8);
    __syncthreads();
    gla_cum2(a, l, lds, Z, row0, h, tid);
    if (tid < 128) { const int dir = tid >> 6, dk = tid & 63; DEC[((size_t)(bh * 2 + dir) * 132 + gla_ci(dir, tile)) * 64 + dk] = __expf(CUM[dir * 4096 + (dir == 0 ? 63 : 0) * 64 + dk]); }
    { float kv[8]; unpack8(kraw, kv);
#pragma unroll
        for (int dir = 0; dir < 2; ++dir)
#pragma unroll
            for (int e = 0; e < 8; ++e) { const int dk = 8 * c8 + e; const float f = __expf(CUM[dir * 4096 + (dir == 0 ? 63 : 0) * 64 + dk] - CUM[dir * 4096 + tok * 64 + dk]);
                KT[(dir * 64 + dk) * 72 + tok] = (bf16)f2bf(kv[e] * f); }
        LAS bf16* vt = VT + (16 * c8) * 72 + tok;
        vt[0 * 72] = (bf16)(v0.x & 0xffffu); vt[1 * 72] = (bf16)(v0.x >> 16); vt[2 * 72] = (bf16)(v0.y & 0xffffu); vt[3 * 72] = (bf16)(v0.y >> 16);
        vt[4 * 72] = (bf16)(v0.z & 0xffffu); vt[5 * 72] = (bf16)(v0.z >> 16); vt[6 * 72] = (bf16)(v0.w & 0xffffu); vt[7 * 72] = (bf16)(v0.w >> 16);
        vt[8 * 72] = (bf16)(v1.x & 0xffffu); vt[9 * 72] = (bf16)(v1.x >> 16); vt[10 * 72] = (bf16)(v1.y & 0xffffu); vt[11 * 72] = (bf16)(v1.y >> 16);
        vt[12 * 72] = (bf16)(v1.z & 0xffffu); vt[13 * 72] = (bf16)(v1.z >> 16); vt[14 * 72] = (bf16)(v1.w & 0xffffu); vt[15 * 72] = (bf16)(v1.w >> 16); }
    __syncthreads();
    { const int dir = wave >> 2, dkb = wave & 3; bf16x8 Kf[2];
#pragma unroll
        for (int ks = 0; ks < 2; ++ks) Kf[ks] = *(const LAS bf16x8*)(KT + (dir * 64 + 16 * dkb + fr) * 72 + 32 * ks + 8 * fq);
        bf16* Sd = S + ((size_t)(bh * 2 + dir) * 132 + gla_ci(dir, tile)) * 8192;
#pragma unroll
        for (int dvb = 0; dvb < 8; ++dvb) { f32x4 acc = {0.f, 0.f, 0.f, 0.f};
#pragma unroll
            for (int ks = 0; ks < 2; ++ks) { const bf16x8 Vf = *(const LAS bf16x8*)(VT + (16 * dvb + fr) * 72 + 32 * ks + 8 * fq); acc = MFMA16(Kf[ks], Vf, acc); }
            { u32x2 o; o.x = pk2(acc[0], acc[1]); o.y = pk2(acc[2], acc[3]); *(u32x2*)(Sd + (16 * dvb + fr) * 64 + 16 * dkb + 4 * fq) = o; } } }
}
__device__ __forceinline__ void phase_gla2b(const Args& a, int tid) {
    const bf16* S = (const bf16*)(a.ws + WS_S); const float* DEC = (const float*)(a.ws + WS_DECAY); bf16* SB = (bf16*)(a.ws + WS_SB);
    for (int el = blockIdx.x * 512 + tid; el < 131072; el += gridDim.x * 512) {
        const int seq = el >> 13, e = el & 8191, dk = e & 63;
        const bf16* Sp = S + (size_t)seq * 132 * 8192 + e; const float* Dp = DEC + (size_t)seq * 132 * 64 + dk; bf16* Bp = SB + (size_t)seq * 132 * 8192 + e;
        float s = 0.f;
#pragma unroll 1
        for (int ci = 0; ci < 132; ci += 33) { float d[33], dc[33];
#pragma unroll
            for (int j = 0; j < 33; ++j) { d[j] = bf2f((unsigned)__builtin_nontemporal_load(Sp + (size_t)(ci + j) * 8192)); dc[j] = Dp[(ci + j) * 64]; }
#pragma unroll
            for (int j = 0; j < 33; ++j) { Bp[(size_t)(ci + j) * 8192] = (bf16)f2bf(s); s = dc[j] * s + d[j]; } }
    }
}
__device__ __forceinline__ void gla3_unit(const Args& a, int l, int u, LAS unsigned char* lds, int tid, int wave, int lane) {
    const bf16* Z = (const bf16*)(a.ws + WS_Z); bf16* OB = (bf16*)(a.ws + WS_O);
    LAS float* CUM = (LAS float*)lds; LAS bf16* QS = (LAS bf16*)(lds + 43008); LAS bf16* KS = (LAS bf16*)(lds + 43008 + 18432); LAS bf16* VT = (LAS bf16*)(lds + 43008 + 36864);
    LAS float* OX = (LAS float*)(lds + 43008 + 36864 + 18432);
    const bf16* SB = (const bf16*)(a.ws + WS_SB);
    const float* gn = a.in[19] + l * 512;
    const int fr = lane & 15, fq = lane >> 4;
    const int ntile = (l == 0) ? 132 : 128;
    const int tile = (l == 0) ? u % 132 : 4 + u % 128, bh = u / ntile, b = bh >> 2, h = bh & 3;
    const size_t row0 = tile < 4 ? (size_t)ML + b * 256 + tile * 64 : (size_t)b * SEQ + (tile - 4) * 64;
    const int tok = tid >> 3, c8 = tid & 7;
    const u32x4 qraw = *(const u32x4*)(Z + (row0 + tok) * ZS + ZGQ + h * 64 + 8 * c8), kraw = *(const u32x4*)(Z + (row0 + tok) * ZS + ZGK + h * 64 + 8 * c8);
    const bf16* vp = Z + (row0 + tok) * ZS + ZGV + h * 128 + 16 * c8;
    const u32x4 v0 = *(const u32x4*)vp, v1 = *(const u32x4*)(vp + 8);
    __syncthreads();
    gla_cum2(a, l, lds, Z, row0, h, tid);
    { float qv[8], kv[8]; unpack8(qraw, qv); unpack8(kraw, kv);
#pragma unroll
        for (int dir = 0; dir < 2; ++dir) { float qo[8], ko[8];
#pragma unroll
            for (int e = 0; e < 8; ++e) { const float c = CUM[dir * 4096 + tok * 64 + 8 * c8 + e]; qo[e] = qv[e] * 0.125f * __expf(c); ko[e] = kv[e] * __expf(-c); }
            *(LAS u32x4*)(QS + (dir * 64 + tok) * 72 + 8 * c8) = pack8(qo); *(LAS u32x4*)(KS + (dir * 64 + tok) * 72 + 8 * c8) = pack8(ko); }
        LAS bf16* vt = VT + (16 * c8) * 72 + tok;
        vt[0 * 72] = (bf16)(v0.x & 0xffffu); vt[1 * 72] = (bf16)(v0.x >> 16); vt[2 * 72] = (bf16)(v0.y & 0xffffu); vt[3 * 72] = (bf16)(v0.y >> 16);
        vt[4 * 72] = (bf16)(v0.z & 0xffffu); vt[5 * 72] = (bf16)(v0.z >> 16); vt[6 * 72] = (bf16)(v0.w & 0xffffu); vt[7 * 72] = (bf16)(v0.w >> 16);
        vt[8 * 72] = (bf16)(v1.x & 0xffffu); vt[9 * 72] = (bf16)(v1.x >> 16); vt[10 * 72] = (bf16)(v1.y & 0xffffu); vt[11 * 72] = (bf16)(v1.y >> 16);
        vt[12 * 72] = (bf16)(v1.z & 0xffffu); vt[13 * 72] = (bf16)(v1.z >> 16); vt[14 * 72] = (bf16)(v1.w & 0xffffu); vt[15 * 72] = (bf16)(v1.w >> 16); }
    const int dir = wave >> 2, tb = wave & 3;
    const bf16* Sp = SB + ((size_t)(bh * 2 + dir) * 132 + gla_ci(dir, tile)) * 8192;
    bf16x8 Sf[8][2];
#pragma unroll
    for (int dvb = 0; dvb < 8; ++dvb)
#pragma unroll
        for (int ks = 0; ks < 2; ++ks) Sf[dvb][ks] = *(const bf16x8*)(Sp + (16 * dvb + fr) * 64 + 32 * ks + 8 * fq);
    __syncthreads();
    bf16x8 Qf[2];
#pragma unroll
    for (int ks = 0; ks < 2; ++ks) Qf[ks] = *(const LAS bf16x8*)(QS + (dir * 64 + 16 * tb + fr) * 72 + 32 * ks + 8 * fq);
    f32x4 at[4];
#pragma unroll
    for (int kb = 0; kb < 4; ++kb) { f32x4 acc = {0.f, 0.f, 0.f, 0.f};
        const bool need = dir == 0 ? (kb <= tb) : (kb >= tb);
        if (need) {
#pragma unroll
            for (int ks = 0; ks < 2; ++ks) { const bf16x8 Kf = *(const LAS bf16x8*)(KS + (dir * 64 + 16 * kb + fr) * 72 + 32 * ks + 8 * fq); acc = MFMA16(Kf, Qf[ks], acc); }
            const int tq = 16 * tb + fr;
#pragma unroll
            for (int e = 0; e < 4; ++e) { const int kj = 16 * kb + 4 * fq + e; const bool ok = dir == 0 ? (kj <= tq) : (kj >= tq); if (!ok) acc[e] = 0.f; } }
        at[kb] = acc; }
    bf16x8 Pf[2];
#pragma unroll
    for (int kk = 0; kk < 2; ++kk) { float p[8];
#pragma unroll
        for (int e = 0; e < 4; ++e) { p[e] = at[2 * kk][e]; p[4 + e] = at[2 * kk + 1][e]; }
        Pf[kk] = __builtin_bit_cast(bf16x8, pack8(p)); }
    f32x4 O[8];
#pragma unroll
    for (int dvb = 0; dvb < 8; ++dvb) { f32x4 o = {0.f, 0.f, 0.f, 0.f};
#pragma unroll
        for (int kk = 0; kk < 2; ++kk) { const s16x4 lo = *(const LAS s16x4*)(VT + (16 * dvb + fr) * 72 + 32 * kk + 4 * fq), hi = *(const LAS s16x4*)(VT + (16 * dvb + fr) * 72 + 32 * kk + 16 + 4 * fq);
            const bf16x8 Vf = (bf16x8){lo[0], lo[1], lo[2], lo[3], hi[0], hi[1], hi[2], hi[3]}; o = MFMA16(Vf, Pf[kk], o); }
#pragma unroll
        for (int ks = 0; ks < 2; ++ks) o = MFMA16(Sf[dvb][ks], Qf[ks], o);
        O[dvb] = o; }
    if (dir == 1) {
#pragma unroll
        for (int dvb = 0; dvb < 8; ++dvb) *(LAS f32x4*)(OX + (tb * 16 + fr) * 132 + 16 * dvb + 4 * fq) = O[dvb]; }
    __syncthreads();
    if (dir == 0) { float ss = 0.f;
#pragma unroll
        for (int dvb = 0; dvb < 8; ++dvb) { O[dvb] += *(const LAS f32x4*)(OX + (tb * 16 + fr) * 132 + 16 * dvb + 4 * fq); ss += (O[dvb][0] * O[dvb][0] + O[dvb][1] * O[dvb][1]) + (O[dvb][2] * O[dvb][2] + O[dvb][3] * O[dvb][3]); }
        ss += __shfl_xor(ss, 16); ss += __shfl_xor(ss, 32);
        const float rstd = rsqrtf(ss * (1.f / 128.f) + 1e-6f);
        const size_t row = row0 + 16 * tb + fr;
#pragma unroll
        for (int dvb = 0; dvb < 8; ++dvb) { const int c = h * 128 + 16 * dvb + 4 * fq; const f32x4 g = *(const f32x4*)(gn + c); const u32x2 rr = *(const u32x2*)(Z + row * ZS + ZGR + c);
            const float r0 = bf2f(rr.x & 0xffffu), r1 = bf2f(rr.x >> 16), r2 = bf2f(rr.y & 0xffffu), r3 = bf2f(rr.y >> 16);
            u32x2 o; o.x = pk2(O[dvb][0] * rstd * g[0] * r0 * sigmoidf_(r0), O[dvb][1] * rstd * g[1] * r1 * sigmoidf_(r1)); o.y = pk2(O[dvb][2] * rstd * g[2] * r2 * sigmoidf_(r2), O[dvb][3] * rstd * g[3] * r3 * sigmoidf_(r3));
            *(u32x2*)(OB + row * D + 1536 + c) = o; } }
}
__device__ __forceinline__ void phase_pool2(const Args& a, int l, int wave, int lane) { const int npu = (l == 0 ? MT : ML) / 32; for (int u = blockIdx.x; u < npu; u += gridDim.x) pool_unit(a, l, u, wave, lane); }
__device__ __forceinline__ void phase_cgate2(const Args& a, int l, LAS unsigned char* lds, int tid, int wave, int lane) { const int n = (l == 0 ? 132 : 128) * 2; for (int u = blockIdx.x; u < n; u += gridDim.x) cgate_unit(a, l, u, lds, tid, wave, lane); }
__device__ __forceinline__ void phase_gla1b(const Args& a, int l, LAS unsigned char* lds, int tid, int wave, int lane) { for (int u = blockIdx.x; u < 1056; u += gridDim.x) gla1_unit(a, l, u, lds, tid, wave, lane); }
__device__ __forceinline__ void phase_gla3b(const Args& a, int l, LAS unsigned char* lds, int tid, int wave, int lane) { const int n = 8 * (l == 0 ? 132 : 128); for (int u = blockIdx.x; u < n; u += gridDim.x) gla3_unit(a, l, u, lds, tid, wave, lane); }


constexpr int CW_Q = 6144;
__device__ __forceinline__ void phase_attn(const Args& a, int l, LAS unsigned char* lds, int tid, int wave, int lane) { const int n = 256 + (l == 0 ? 8 : 0); for (int u = blockIdx.x; u < n; u += gridDim.x) attn_unit(a, l, u, lds, tid, wave, lane); }
#define DYN_BEGIN(ctrword) unsigned* _ctr = (unsigned*)(a.ws + WS_CTL) + (ctrword); volatile LAS int* _qs = (volatile LAS int*)(lds + LDS_BYTES - 32); int u; \
        { if (threadIdx.x == 0) _qs[0] = (int)atomicAdd(_ctr, 1u); __syncthreads(); u = _qs[0]; __syncthreads(); }
#define DYN_SEG(hi, BODY) while (u < (hi)) { unsigned _nx = 0u; if (threadIdx.x == 0) _nx = atomicAdd(_ctr, 1u); \
        BODY; \
        if (threadIdx.x == 0) _qs[0] = (int)_nx; \
        __syncthreads(); u = _qs[0]; }
__device__ __forceinline__ void conv_queue(const Args& a, int l, int half, LAS unsigned char* lds) {
    unsigned* c2 = (unsigned*)(a.ws + WS_CTL) + CW_Q + 64 * (8 + 2 * l + half); volatile LAS int* q2 = (volatile LAS int*)(lds + LDS_BYTES - 64);
    if (threadIdx.x == 0) q2[0] = (int)atomicAdd(c2, 1u);
    __syncthreads(); int cu = q2[0]; __syncthreads();
    while (cu < CONV_UNITS_PH) { unsigned n2 = 0u; if (threadIdx.x == 0) n2 = atomicAdd(c2, 1u);
        { const int t2 = fresh_tid(); conv_unit(a, l, half, cu, lds, __builtin_amdgcn_readfirstlane(t2 >> 6), t2 & 63); }
        __syncthreads(); if (threadIdx.x == 0) q2[0] = (int)n2; __syncthreads(); cu = q2[0]; }
    __syncthreads();
}
__device__ __forceinline__ void phase_mix_a(const Args& a, int l, LAS unsigned char* lds, int tid, int wave, int lane, int qoff = 0) {
    const int natt = 256, total = natt + 1056;
    const bool conv_first = ((blockIdx.x >> 3) & 7) < 3;
    if (DEFER_CONV && conv_first && qoff == 0) conv_queue(a, l, 0, lds);
    {
        DYN_BEGIN(CW_Q + 64 * (2 * l + qoff));
        DYN_SEG(natt, { const int t2 = fresh_tid(); if (ATTN2) attn_unit2(a, l, u, lds, t2, __builtin_amdgcn_readfirstlane(t2 >> 6), t2 & 63); else attn_unit(a, l, u, lds, t2, __builtin_amdgcn_readfirstlane(t2 >> 6), t2 & 63); });
        DYN_SEG(total, { const int t2 = fresh_tid(); gla1_unit(a, l, u - natt, lds, t2, __builtin_amdgcn_readfirstlane(t2 >> 6), t2 & 63); });
        __syncthreads();
    }
    if (DEFER_CONV && !conv_first && qoff == 0) conv_queue(a, l, 0, lds);
}
__device__ __forceinline__ void phase_mix_b(const Args& a, int l, LAS unsigned char* lds, int tid, int wave, int lane, int qoff = 0) {
    const int nat = (l == 0 ? 8 : 0), ncg = nat + (l == 0 ? 132 : 128) * 2, ng3 = 8 * (l == 0 ? 132 : 128), npu = (l == 0 ? MT : ML) / 32, total = ncg + ng3 + npu;
    const bool conv_first = ((blockIdx.x >> 3) & 7) < 3;
    if (DEFER_CONV && conv_first && qoff == 0) conv_queue(a, l, 1, lds);
    {
        DYN_BEGIN(CW_Q + 64 * (2 * l + 1 + qoff));
        if (l == 0) { DYN_SEG(nat, { const int t2 = fresh_tid(); attn_unit2(a, l, 256 + u, lds, t2, __builtin_amdgcn_readfirstlane(t2 >> 6), t2 & 63); }); }
        DYN_SEG(ncg, { const int t2 = fresh_tid(); cgate_unit(a, l, u - nat, lds, t2, __builtin_amdgcn_readfirstlane(t2 >> 6), t2 & 63); });
        DYN_SEG(ncg + npu, { const int t2 = fresh_tid(); __syncthreads(); pool_unit(a, l, u - ncg, __builtin_amdgcn_readfirstlane(t2 >> 6), t2 & 63); });
        DYN_SEG(total, { const int t2 = fresh_tid(); gla3_unit(a, l, u - ncg - npu, lds, t2, __builtin_amdgcn_readfirstlane(t2 >> 6), t2 & 63); });
        __syncthreads();
    }
    if (DEFER_CONV && !conv_first && qoff == 0) conv_queue(a, l, 1, lds);
}

__global__ void __launch_bounds__(512, 2) mk_fwd(Args a_formal) {
    const Args& a = *(const Args*)(const __attribute__((address_space(4))) Args*)__builtin_amdgcn_kernarg_segment_ptr();
    extern __shared__ __attribute__((aligned(16))) unsigned char lds_raw[];
    LAS unsigned char* lds = (LAS unsigned char*)lds_raw;
    const int lo = a.ph_lo, hi = a.ph_hi;
#define tid fresh_tid()
#define lane (fresh_tid() & 63)
#define wave __builtin_amdgcn_readfirstlane(fresh_tid() >> 6)
#if N_LAUNCH_MODE == 1
    volatile LAS unsigned* xbw = (volatile LAS unsigned*)(lds + LDS_BYTES - 16);
    if (threadIdx.x == 0) { xbw[0] = 0u; xbw[1] = 0u; }
    __syncthreads();
    XcdBarrier bar = xcd_barrier_post((unsigned*)(a.ws + WS_CTL) + CW_BAR, xbw);
#define GRID_BAR() xcd_barrier(bar)
#else
#define GRID_BAR() do { } while (0)
#endif
#ifdef ONLY_PHASE
#define IN(k) ((k) % 10 == ONLY_PHASE % 10 && ((k) == 0) == (ONLY_PHASE == 0) && ((k) == 21) == (ONLY_PHASE == 21) && lo <= (k) && (k) < hi)
#else
#define IN(k) (lo <= (k) && (k) < hi)
#endif
#define SEAM(k) do { if (hi > (k) + 1) GRID_BAR(); } while (0)
#define RPT(code, call) do { call; if (REPEAT == (code)) { __syncthreads(); call; } } while (0)
    if (IN(0)) { phase_absmax(a, tid, lane); GRID_BAR(); RPT(0, phase_prologue(a, lds, tid, wave, lane)); SEAM(0); }
#define LAYER_PHASES(l) do { constexpr int pb = 1 + 10 * (l); \
        if (IN(pb + 0)) { if (l == 0) phase_norm1<0>(a, l, wave, lane); else phase_norm1<1>(a, l, wave, lane); SEAM(pb + 0); } \
        if (IN(pb + 1)) { if (USE_G256 & 1) RPT(2, phase_proj2(a, l, lds)); else phase_proj(a, l, wave, lane); SEAM(pb + 1); } \
        if (IN(pb + 2)) { if (DYNQ) { phase_mix_a(a, l, lds, tid, wave, lane); if (REPEAT == 33) { __syncthreads(); phase_mix_a(a, l, lds, tid, wave, lane, 4); } } else { RPT(31, phase_gla1b(a, l, lds, tid, wave, lane)); RPT(32, phase_attn(a, l, lds, tid, wave, lane)); } SEAM(pb + 2); } \
        if (IN(pb + 3)) { RPT(41, phase_gla2b(a, tid)); if (!DYNQ) { RPT(42, phase_pool2(a, l, wave, lane)); RPT(43, phase_cgate2(a, l, lds, tid, wave, lane)); } SEAM(pb + 3); } \
        if (IN(pb + 4)) { if (DYNQ) { phase_mix_b(a, l, lds, tid, wave, lane); if (REPEAT == 35) { __syncthreads(); phase_mix_b(a, l, lds, tid, wave, lane, 4); } } else RPT(5, phase_gla3b(a, l, lds, tid, wave, lane)); SEAM(pb + 4); } \
        if (IN(pb + 5)) { if (USE_G256 & 2) RPT(6, phase_merge2(a, l, lds)); else phase_merge(a, l, wave, lane); SEAM(pb + 5); } \
        if (IN(pb + 6)) { if (USE_G256 & 4) { RPT(7, phase_outproj2(a, l, lds)); if (REPEAT == 107) { __syncthreads(); phase_outproj2(a, l, lds, 1); } } else phase_outproj(a, l, wave, lane); SEAM(pb + 6); } \
        if (IN(pb + 7)) { phase_norm2_router(a, l, lds, tid, wave, lane); SEAM(pb + 7); } \
        if (IN(pb + 8)) { RPT(9, phase_moe12(a, l, lds, tid)); SEAM(pb + 8); } \
        if (IN(pb + 9)) {   if (N_LAUNCH_MODE == 0) { SEAM(pb + 9); } } \
    } while (0)
    LAYER_PHASES(0);
    LAYER_PHASES(1);
    if (IN(21)) RPT(21, phase_norm1<2>(a, 2, wave, lane));
#undef tid
#undef lane
#undef wave
}

extern "C" void kernel_launch(void* const* d_in, const int* in_sizes, int n_in, void* d_out, int out_size, void* d_ws, size_t ws_size, hipStream_t stream) {
    static int grid = 0;
    if (grid == 0) {
        if (n_in != 28 || ws_size < WS_END) { fprintf(stderr, "kernel_launch: unexpected n_in %d / ws %zu (need %zu)\n", n_in, ws_size, (size_t)WS_END); grid = -1; return; }
        int dev = 0, cus = 0;
        if (hipGetDevice(&dev) != hipSuccess || hipDeviceGetAttribute(&cus, hipDeviceAttributeMultiprocessorCount, dev) != hipSuccess) { grid = -1; return; }
        if (hipFuncSetAttribute((const void*)mk_fwd, hipFuncAttributeMaxDynamicSharedMemorySize, LDS_BYTES) != hipSuccess) { grid = -1; return; }
        int per_cu = 0;
        if (hipOccupancyMaxActiveBlocksPerMultiprocessor(&per_cu, (const void*)mk_fwd, 512, LDS_BYTES) != hipSuccess || per_cu < 1) fprintf(stderr, "kernel_launch: occupancy query says %d\n", per_cu);
        (void)hipGetLastError();
        grid = cus;
    }
    if (grid < 0) return;
    (void)hipMemsetAsync((char*)d_ws + WS_CTL, 0, CTL_ZERO_BYTES, stream);
    Args a{};
    for (int i = 0; i < 28; ++i) a.in[i] = (const float*)d_in[i];
    a.out = (float*)d_out; a.ws = (unsigned char*)d_ws;
#if N_LAUNCH_MODE == 1
    a.ph_lo = 0; a.ph_hi = NPH;
    hipLaunchKernelGGL(mk_fwd, dim3(grid), dim3(512), LDS_BYTES, stream, a);
#else
    for (int p = 0; p < NPH; ++p) { a.ph_lo = p; a.ph_hi = p + 1; hipLaunchKernelGGL(mk_fwd, dim3(grid), dim3(512), LDS_BYTES, stream, a); }
#endif
}
```

```cpp
#include <hip/hip_runtime.h>
#include <cstdio>
#include <cstdint>

#define GAS __attribute__((address_space(1)))
#define LAS __attribute__((address_space(3)))
typedef unsigned short bf16;
typedef short bf16x8 __attribute__((ext_vector_type(8)));
typedef short s16x4 __attribute__((ext_vector_type(4)));
typedef float f32x4 __attribute__((ext_vector_type(4)));
typedef float f32x2 __attribute__((ext_vector_type(2)));
typedef unsigned u32x4 __attribute__((ext_vector_type(4)));
typedef unsigned u32x2 __attribute__((ext_vector_type(2)));
typedef int i32x4q __attribute__((ext_vector_type(4)));

#ifndef USE_G256
#define USE_G256 31
#endif
#ifndef ATTN2
#define ATTN2 1
#endif
#ifndef DYNQ
#define DEFER_CONV 1
#define DYNQ 1
#endif
#ifndef FP8Z
#define FP8Z 1
#endif
#ifndef MIX2
#define MIX2 7
#endif
#ifndef REPEAT
#define REPEAT -1
#endif
#ifndef N_LAUNCH_MODE
#define N_LAUNCH_MODE 1
#endif

constexpr int LDS_BYTES = 147456;
constexpr int D = 2048, SEQ = 8192, CTXL = 256, ML = 16384, MT = 16896;
constexpr int ZS = 4224;
constexpr int DP = 2176;
constexpr int ZQ = 0, ZK = 512, ZV = 640, ZP = 768, ZUV = 1280, ZGQ = 2304, ZGK = 2560, ZGV = 2816, ZGR = 3328, ZGLR = 3840, ZGATE = 4096;
constexpr int NPH = 22;
constexpr int CAP = 16896;
constexpr float LOG2E = 1.4426950408889634f;

constexpr size_t MiB = 1u << 20;
constexpr size_t WS_CTL = 0, CTL_ZERO_BYTES = 1 * MiB;
constexpr size_t WS_MOD = 1 * MiB;
constexpr size_t WS_ROPE = 1 * MiB + 512 * 1024;
constexpr size_t WS_PWT = 2 * MiB;
constexpr size_t WS_WSB = 2 * MiB + 512 * 1024;
constexpr size_t WS_LIST = 3 * MiB;
constexpr size_t WS_LISTW = 5 * MiB;
constexpr size_t WS_DECAY = 7 * MiB;
constexpr size_t WS_WCAT = 8 * MiB;
constexpr size_t WS_WCAT8 = 40 * MiB;
constexpr size_t WS_H8 = 88 * MiB;
constexpr size_t WS_WB = 122 * MiB;
constexpr size_t WS_WO = 138 * MiB;
constexpr size_t WS_WGU = 156 * MiB;
constexpr size_t WS_WD = 412 * MiB;
constexpr size_t WS_X = 540 * MiB;
constexpr size_t WS_H = 672 * MiB;
constexpr size_t WS_O8 = 672 * MiB;
constexpr size_t WS_WB8 = 704 * MiB;
constexpr size_t WS_O = 738 * MiB;
constexpr size_t WS_S = 804 * MiB;
constexpr size_t WS_Z = 870 * MiB;
constexpr size_t WS_G8 = 1008 * MiB;
constexpr size_t WS_MX = 870 * MiB;
constexpr size_t WS_ACT = 870 * MiB;
constexpr size_t WS_Y = 944 * MiB;
constexpr size_t WS_SB = 1140 * MiB;
constexpr size_t WS_ACC = 1173 * MiB;
constexpr size_t WS_RS = 1244 * MiB;
constexpr size_t WS_H8I = 1245 * MiB;
constexpr size_t WS_ACC8 = 1279 * MiB;
constexpr size_t WS_WO8 = 1311 * MiB;
constexpr size_t WS_END = 1319 * MiB;
constexpr float EXPERT_MARGIN = 1.25f;
constexpr float W8SCALE = 64.f;
constexpr int CW_CNT = 64;
constexpr int CW_BAR = 8192;
constexpr int CW_WMAX = 12288;

__device__ __forceinline__ int fresh_tid() { int t; asm volatile("v_mov_b32 %0, %1" : "=v"(t) : "v"((int)threadIdx.x)); return t; }
__device__ __forceinline__ float bf2f(unsigned b) { return __uint_as_float(b << 16); }
__device__ __forceinline__ unsigned f2bf(float f) { return (unsigned)__builtin_bit_cast(unsigned short, (__bf16)f); }
typedef float f32x2v __attribute__((ext_vector_type(2)));
typedef __bf16 bf16x2n __attribute__((ext_vector_type(2)));
typedef float f32x2n __attribute__((ext_vector_type(2)));
__device__ __forceinline__ unsigned pk2(float lo, float hi) { return __builtin_bit_cast(unsigned, __builtin_convertvector((f32x2n){lo, hi}, bf16x2n)); }
__device__ __forceinline__ unsigned q8pack(float a, float b, float c, float d) {
    const unsigned u0 = __float_as_uint(a + 12582912.f), u1 = __float_as_uint(b + 12582912.f), u2 = __float_as_uint(c + 12582912.f), u3 = __float_as_uint(d + 12582912.f);
    return __builtin_amdgcn_perm(u1, u0, 0x0c0c0400u) | __builtin_amdgcn_perm(u3, u2, 0x04000c0cu); }
__device__ __forceinline__ void unpack8(const u32x4 r, float (&o)[8]) {
    o[0] = __uint_as_float(r.x << 16); o[1] = __uint_as_float(r.x & 0xffff0000u); o[2] = __uint_as_float(r.y << 16); o[3] = __uint_as_float(r.y & 0xffff0000u);
    o[4] = __uint_as_float(r.z << 16); o[5] = __uint_as_float(r.z & 0xffff0000u); o[6] = __uint_as_float(r.w << 16); o[7] = __uint_as_float(r.w & 0xffff0000u);
}
__device__ __forceinline__ u32x4 pack8(const float (&o)[8]) { u32x4 r; r.x = pk2(o[0], o[1]); r.y = pk2(o[2], o[3]); r.z = pk2(o[4], o[5]); r.w = pk2(o[6], o[7]); return r; }
__device__ __forceinline__ float wave_sum(float v) {
#pragma unroll
    for (int o = 1; o < 64; o <<= 1) v += __shfl_xor(v, o);
    return v;
}
__device__ __forceinline__ int perm16(int n, int i) { return 8 * (i >> 2) + 4 * n + (i & 3); }
__device__ __forceinline__ float sigmoidf_(float x) { return __builtin_amdgcn_rcpf(1.f + __builtin_amdgcn_exp2f(-1.4426950408889634f * x)); }
__device__ __forceinline__ float gelu_tanh(float x) { const float u = x * (2.302208198f + 0.1029432397f * x * x); return x * __builtin_amdgcn_rcpf(1.f + __builtin_amdgcn_exp2f(-u)); }
#define MFMA16(a, b, c) __builtin_amdgcn_mfma_f32_16x16x32_bf16((a), (b), (c), 0, 0, 0)

__device__ __forceinline__ size_t g8_off(int i, int pm, int pn, int wv, int ai, int m, int bj, int ln) { return ((size_t)((i * 66 + pm) * 8 + pn) << 16) + (size_t)((((wv * 2 + ai) * 4 + m) * 2 + bj) * 64 + ln) * 8; }
struct Args { const float* in[28]; float* out; unsigned char* ws; int ph_lo, ph_hi; };

#define XB_TMO      128
#define XB_XCNT(j)  (256  + 64 * (j))
#define XB_XSUB(j)  (1280 + 64 * (j))
#define XB_XGEN(j)  (2304 + 64 * (j))
#define XB_TOP      3328
#define XB_TOPGEN   3392
#define XCD_BAR_WORDS 3456
#define XB_SPIN_CAP (1u << 18)
__device__ __forceinline__ unsigned xb_ld(unsigned* p)              { return __hip_atomic_load(p, __ATOMIC_RELAXED, __HIP_MEMORY_SCOPE_AGENT); }
__device__ __forceinline__ unsigned xb_add(unsigned* p, unsigned v) { return __hip_atomic_fetch_add(p, v, __ATOMIC_RELAXED, __HIP_MEMORY_SCOPE_AGENT); }
__device__ __forceinline__ unsigned xb_xcc_id() { return (unsigned)__builtin_amdgcn_s_getreg((3 << 11) | 20) & 0xFu; }
#define XB_SPIN(cond, bar) do { unsigned _sp = 0; while (cond) { __builtin_amdgcn_s_sleep(1); \
    if ((++_sp & 255u) == 0u) { if (xb_ld(&(bar)[XB_TMO])) break; if (_sp > XB_SPIN_CAP) { atomicAdd(&(bar)[XB_TMO], 1u); break; } } } } while (0)
struct XcdBarrier { unsigned* bar; unsigned x; volatile LAS unsigned* st; };
__device__ __forceinline__ XcdBarrier xcd_barrier_post(unsigned* bar, volatile LAS unsigned* st) {
    XcdBarrier b; b.bar = bar; b.x = xb_xcc_id(); b.st = st;
    if (threadIdx.x == 0) (void)xb_add(&bar[XB_XCNT(b.x)], 1u);
    return b;
}
__device__ __forceinline__ void xcd_barrier_complete(unsigned* bar, unsigned x, unsigned& nloc, unsigned& nx) {
    const unsigned G = gridDim.x * gridDim.y * gridDim.z;
    unsigned sum, cnt, mine, sp = 0u;
    for (;;) {
        sum = 0u; cnt = 0u; mine = 0u;
#pragma unroll
        for (unsigned j = 0; j < 16; ++j) { const unsigned c = xb_ld(&bar[XB_XCNT(j)]); sum += c; cnt += (c > 0u) ? 1u : 0u; mine = (j == x) ? c : mine; }
        if (sum == G) break;
        __builtin_amdgcn_s_sleep(1);
        if ((++sp & 255u) == 0u) { if (xb_ld(&bar[XB_TMO])) break; if (sp > XB_SPIN_CAP) { atomicAdd(&bar[XB_TMO], 1u); break; } }
    }
    nloc = mine > 0u ? mine : 1u; nx = cnt > 0u ? cnt : 1u;
}
__device__ __forceinline__ void xcd_barrier(const XcdBarrier& b) {
    asm volatile("s_waitcnt vmcnt(0)" ::: "memory");
    __syncthreads();
    if (threadIdx.x == 0) {
        unsigned* bar = b.bar;
        __builtin_amdgcn_s_waitcnt(0);
        unsigned nloc = b.st[0], nx = b.st[1];
        if (nloc == 0u) { xcd_barrier_complete(bar, b.x, nloc, nx); b.st[0] = nloc; b.st[1] = nx; }
        const unsigned old = xb_add(&bar[XB_XSUB(b.x)], 1u);
        const unsigned gen = old / nloc;
        if (old + 1u == (gen + 1u) * nloc) {
            __builtin_amdgcn_fence(__ATOMIC_RELEASE, "agent");
            asm volatile("s_waitcnt vmcnt(0)" ::: "memory");
            const unsigned og = xb_add(&bar[XB_TOP], 1u);
            const unsigned tg = og / nx;
            if (og + 1u == (tg + 1u) * nx) xb_add(&bar[XB_TOPGEN], 1u);
            else XB_SPIN(xb_ld(&bar[XB_TOPGEN]) == tg, bar);
            __builtin_amdgcn_fence(__ATOMIC_ACQUIRE, "agent");
            xb_add(&bar[XB_XGEN(b.x)], 1u);
            asm volatile("s_waitcnt vmcnt(0)" ::: "memory");
        } else {
            XB_SPIN(xb_ld(&bar[XB_XGEN(b.x)]) == gen, bar);
            __builtin_amdgcn_fence(__ATOMIC_ACQUIRE, "agent");
            asm volatile("s_waitcnt vmcnt(0)" ::: "memory");
        }
    }
    __syncthreads();
}

__device__ __forceinline__ void tr_item(const float* W, int N, bf16* dst, int ldd, int k0, int n0, LAS float* scr, int lane) {
#pragma unroll 8
    for (int i = 0; i < 32; ++i) { const int kk = 2 * i + (lane >> 5); scr[kk * 33 + (lane & 31)] = W[(size_t)(k0 + kk) * N + n0 + (lane & 31)]; }
    asm volatile("s_waitcnt lgkmcnt(0)" ::: "memory");
    const int c = lane & 7;
#pragma unroll
    for (int j = 0; j < 4; ++j) { const int n = (lane >> 3) + 8 * j; const LAS float* s = scr + (8 * c) * 33 + n;
        u32x4 o; o.x = pk2(s[0 * 33], s[1 * 33]); o.y = pk2(s[2 * 33], s[3 * 33]); o.z = pk2(s[4 * 33], s[5 * 33]); o.w = pk2(s[6 * 33], s[7 * 33]);
        *(u32x4*)(dst + (size_t)n * ldd + k0 + 8 * c) = o; }
    asm volatile("s_waitcnt lgkmcnt(0)" ::: "memory");
}

__device__ __forceinline__ void tr_item8(const float* W, int N, unsigned char* dst, int ldd, int k0, int n0, LAS float* scr, int lane) {
#pragma unroll 8
    for (int i = 0; i < 32; ++i) { const int kk = 2 * i + (lane >> 5); scr[kk * 33 + (lane & 31)] = W[(size_t)(k0 + kk) * N + n0 + (lane & 31)]; }
    asm volatile("s_waitcnt lgkmcnt(0)" ::: "memory");
    const int n = lane >> 1, kh = (lane & 1) * 32; const LAS float* sp = scr + kh * 33 + n;
    u32x4 o[2];
#pragma unroll
    for (int q = 0; q < 8; ++q) { unsigned p = 0u;
        p = __builtin_amdgcn_cvt_pk_fp8_f32(sp[(4 * q) * 33] * W8SCALE, sp[(4 * q + 1) * 33] * W8SCALE, p, false);
        p = __builtin_amdgcn_cvt_pk_fp8_f32(sp[(4 * q + 2) * 33] * W8SCALE, sp[(4 * q + 3) * 33] * W8SCALE, p, true);
        o[q >> 2][q & 3] = p; }
    *(u32x4*)(dst + (size_t)n * ldd + k0 + kh) = o[0]; *(u32x4*)(dst + (size_t)n * ldd + k0 + kh + 16) = o[1];
    asm volatile("s_waitcnt lgkmcnt(0)" ::: "memory");
}

__device__ __forceinline__ float wave_max(float v) {
#pragma unroll
    for (int o = 1; o < 64; o <<= 1) v = fmaxf(v, __shfl_xor(v, o));
    return v;
}
template <int SAMPLE> __device__ __forceinline__ void absmax_tensor(const float* W, size_t n4, unsigned* slot, int gt, int NT, int lane) {
    float m = 0.f;
    for (size_t j = (size_t)gt; j < n4 / SAMPLE; j += (size_t)NT) { const size_t i = SAMPLE == 1 ? j : ((j >> 6) * SAMPLE << 6) + (j & 63); const f32x4 v = ((const f32x4*)W)[i]; m = fmaxf(m, fmaxf(fmaxf(fabsf(v[0]), fabsf(v[1])), fmaxf(fabsf(v[2]), fabsf(v[3])))); }
    m = wave_max(m);
    if (lane == 0) atomicMax(slot, __float_as_uint(m));
}
__device__ __forceinline__ void phase_absmax(const Args& a, int tid, int lane) {
    const int gt = blockIdx.x * 512 + tid, NT = gridDim.x * 512;
    unsigned* wm = (unsigned*)(a.ws + WS_CTL) + CW_WMAX;
    for (int l = 0; l < 2; ++l) {
        absmax_tensor<1>(a.in[9] + (size_t)l * 2048 * 3872, (size_t)2048 * 3872 / 4, wm + l, gt, NT, lane);
        absmax_tensor<8>(a.in[21] + (size_t)l * 4 * 2048 * 2048, (size_t)4 * 2048 * 2048 / 4, wm + 2 + l, gt, NT, lane);
        absmax_tensor<8>(a.in[22] + (size_t)l * 2048 * 2048, (size_t)2048 * 2048 / 4, wm + 68 + l, gt, NT, lane);
        absmax_tensor<8>(a.in[20] + (size_t)l * 4 * 512 * 2048, (size_t)4 * 512 * 2048 / 4, wm + 102 + l, gt, NT, lane);
    }
    { const int wv = gt >> 6, NWV = NT >> 6;
        for (int w2 = wv; w2 < 3072; w2 += NWV) { const int t = w2 % 96, sub = w2 / 96; const float* W = (t < 32 ? a.in[25] : t < 64 ? a.in[26] : a.in[27]) + (size_t)(t & 31) * 2048 * 1024; float m = 0.f;
#pragma unroll 8
            for (int k = 0; k < 32; ++k) { const f32x4 v = ((const f32x4*)(W + (size_t)(sub + 32 * k) * 8 * 256))[lane]; m = fmaxf(m, fmaxf(fmaxf(fabsf(v[0]), fabsf(v[1])), fmaxf(fabsf(v[2]), fabsf(v[3])))); }
            m = wave_max(m); if (lane == 0) atomicMax(wm + (t < 64 ? 4 + t : 70 + (t - 64)), __float_as_uint(m)); } }
}
struct TrDesc { const float* W; bf16* dst; unsigned char* dst8; int N, ldd, ldd8, k0, n0, fp8, late; float qinv; };
constexpr int TR_C0 = 2 * 3872, TR_C1 = TR_C0 + 8 * 2048, TR_C2 = TR_C1 + 8 * 512, TR_C3 = TR_C2 + 2 * 2048, TR_C4 = TR_C3 + 32 * 1024, TR_C5 = TR_C4 + 32 * 1024, TR_C6 = TR_C5 + 32 * 1024, TR_ITEMS = TR_C6 + 8 * 8;
__device__ __forceinline__ void tr_desc(const Args& a, int it, TrDesc& d) {
    unsigned char* ws = a.ws; const float* W; int N, ii; bf16* dst; int ldd; int rowsel = 0; unsigned char* dst8 = nullptr; int ldd8 = 0, widx = -1;
    if (it < TR_C0) { const int m = it / 3872; ii = it % 3872; W = a.in[9] + (size_t)m * 2048 * 3872; N = 3872; dst = (bf16*)(ws + WS_WCAT) + (size_t)m * 4096 * 2048; ldd = 2048; dst8 = (unsigned char*)(ws + WS_WCAT8) + (size_t)m * 12288 * 2048; }
    else if (it < TR_C1) { const int r = it - TR_C0, m = r / 2048; ii = r % 2048; W = a.in[21] + (size_t)m * 2048 * 2048; N = 2048; dst = nullptr; ldd = 2048; dst8 = (unsigned char*)(ws + WS_WCAT8) + ((size_t)(m >> 2) * 12288 + 4096 + (size_t)(m & 3) * 2048) * 2048; }
    else if (it < TR_C2) { const int r = it - TR_C1, m = r / 512; ii = r % 512; W = a.in[20] + (size_t)m * 512 * 2048; N = 2048; dst = (bf16*)(ws + WS_WB) + (size_t)(m >> 2) * 2048 * 2048 + (size_t)(m & 3) * 512; ldd = 2048; dst8 = (unsigned char*)(ws + WS_WB8) + (size_t)(m >> 2) * 2048 * 2048 + (size_t)(m & 3) * 512; ldd8 = 2048; widx = 102 + (m >> 2); }
    else if (it < TR_C3) { const int r = it - TR_C2, m = r / 2048; ii = r % 2048; W = a.in[22] + (size_t)m * 2048 * 2048; N = 2048; dst = (bf16*)(ws + WS_WO) + (size_t)m * 2048 * DP; ldd = DP; dst8 = (unsigned char*)(ws + WS_WO8) + (size_t)m * 2048 * 2048; ldd8 = 2048; widx = 68 + m; }
    else if (it < TR_C4) { const int r = it - TR_C3, m = r / 1024; ii = r % 1024; W = a.in[25] + (size_t)m * 2048 * 1024; N = 1024; dst = nullptr; dst8 = (unsigned char*)(ws + WS_WGU) + (size_t)m * 2048 * 2048; ldd = 2048; rowsel = 1; widx = 4 + m; }
    else if (it < TR_C5) { const int r = it - TR_C4, m = r / 1024; ii = r % 1024; W = a.in[26] + (size_t)m * 2048 * 1024; N = 1024; dst = nullptr; dst8 = (unsigned char*)(ws + WS_WGU) + (size_t)m * 2048 * 2048; ldd = 2048; rowsel = 2; widx = 36 + m; }
    else if (it < TR_C6) { const int r = it - TR_C5, m = r / 1024; ii = r % 1024; W = a.in[27] + (size_t)m * 1024 * 2048; N = 2048; dst = (bf16*)(ws + WS_WD) + (size_t)m * 2048 * 1024; ldd = 1024; }
    else { const int r = it - TR_C6, m = r / 8; ii = r % 8; W = a.in[11] + (size_t)m * 128 * 128; N = 128; dst = (bf16*)(ws + WS_PWT) + (size_t)m * 128 * 128; ldd = 128; }
    const int nblk = N / 32, pr = ii >> 1, kb = 2 * (pr / nblk) + (ii & 1), nb = pr % nblk, n0 = 32 * nb;
    int drow = n0; if (rowsel) drow = 256 * (n0 >> 7) + 128 * (rowsel - 1) + (n0 & 127);
    d.W = W; d.N = N; d.ldd = ldd; d.k0 = 64 * kb; d.n0 = n0; d.dst = dst ? dst + (size_t)drow * ldd : nullptr; d.dst8 = dst8 ? dst8 + (size_t)drow * (ldd8 ? ldd8 : ldd) : nullptr; d.ldd8 = ldd8 ? ldd8 : ldd;
    d.qinv = 0.f; d.fp8 = 0; d.late = (it >= TR_C3 && it < TR_C6);
    if (dst8) { const unsigned* wm = (const unsigned*)(ws + WS_CTL) + CW_WMAX; if (widx < 0) widx = it < TR_C0 ? it / 3872 : 2 + ((it - TR_C0) / 2048 >> 2);
        float amax = __uint_as_float(__hip_atomic_load(wm + widx, __ATOMIC_RELAXED, __HIP_MEMORY_SCOPE_AGENT)); if (widx >= 4 && widx < 68) amax *= EXPERT_MARGIN; d.fp8 = (it >= TR_C0 && it < TR_C3); if (ldd8 == 0) ldd8 = ldd; d.qinv = amax > 0.f ? (d.fp8 ? 128.f : 127.f) / amax : 0.f; }
}
__device__ __forceinline__ void tr_load(const TrDesc& d, int lane, f32x4 (&rv)[8]) {
    const float* p = d.W + (size_t)(d.k0 + (lane >> 3)) * d.N + d.n0 + 4 * (lane & 7);
#pragma unroll
    for (int i = 0; i < 8; ++i) rv[i] = __builtin_nontemporal_load((const f32x4*)(p + (size_t)(8 * i) * d.N));
}
__device__ __forceinline__ void tr_finish(const TrDesc& d, const f32x4 (&rv)[8], LAS float* scr, int lane) {
    constexpr int SK = 68;
    { const int kr = lane >> 3, n4 = lane & 7;
#pragma unroll
        for (int i = 0; i < 8; ++i)
#pragma unroll
            for (int e = 0; e < 4; ++e) scr[(4 * n4 + e) * SK + 8 * i + kr] = rv[i][e]; }
    asm volatile("s_waitcnt lgkmcnt(0)" ::: "memory");
    if (d.dst) { const int c = lane & 7;
#pragma unroll
        for (int j = 0; j < 4; ++j) { const int n = (lane >> 3) + 8 * j; const LAS float* sp = scr + n * SK + 8 * c; const f32x4 a0 = *(const LAS f32x4*)sp, a1 = *(const LAS f32x4*)(sp + 4);
            u32x4 o; o.x = pk2(a0[0], a0[1]); o.y = pk2(a0[2], a0[3]); o.z = pk2(a1[0], a1[1]); o.w = pk2(a1[2], a1[3]);
            if (d.late) __builtin_nontemporal_store(o, (u32x4*)(d.dst + (size_t)n * d.ldd + d.k0 + 8 * c)); else *(u32x4*)(d.dst + (size_t)n * d.ldd + d.k0 + 8 * c) = o; } }
    if (d.dst8) {
#pragma unroll
        for (int hh = 0; hh < 2; ++hh) { const int n = (lane >> 2) + 16 * hh, q4 = (lane & 3) * 16; const LAS float* sp = scr + n * SK + q4; u32x4 o;
#pragma unroll
            for (int q = 0; q < 4; ++q) { const f32x4 w = *(const LAS f32x4*)(sp + 4 * q); unsigned p = 0u;
                if (d.fp8) { p = __builtin_amdgcn_cvt_pk_fp8_f32(w[0] * d.qinv, w[1] * d.qinv, p, false); p = __builtin_amdgcn_cvt_pk_fp8_f32(w[2] * d.qinv, w[3] * d.qinv, p, true); }
                else {
                    const unsigned u0 = __float_as_uint(__builtin_amdgcn_fmed3f(w[0] * d.qinv, -127.f, 127.f) + 12582912.f), u1 = __float_as_uint(__builtin_amdgcn_fmed3f(w[1] * d.qinv, -127.f, 127.f) + 12582912.f);
                    const unsigned u2 = __float_as_uint(__builtin_amdgcn_fmed3f(w[2] * d.qinv, -127.f, 127.f) + 12582912.f), u3 = __float_as_uint(__builtin_amdgcn_fmed3f(w[3] * d.qinv, -127.f, 127.f) + 12582912.f);
                    p = __builtin_amdgcn_perm(u1, u0, 0x0c0c0400u) | __builtin_amdgcn_perm(u3, u2, 0x04000c0cu); }
                o[q] = p; }
            if (d.late) __builtin_nontemporal_store(o, (u32x4*)(d.dst8 + (size_t)n * d.ldd8 + d.k0 + q4));
            else *(u32x4*)(d.dst8 + (size_t)n * d.ldd8 + d.k0 + q4) = o; } }
    asm volatile("s_waitcnt lgkmcnt(0)" ::: "memory");
}
__device__ __forceinline__ void phase_prologue(const Args& a, LAS unsigned char* lds, int tid, int wave, int lane) {
    unsigned char* ws = a.ws;
    if (blockIdx.x < 192) {
        LAS float* sv = (LAS float*)lds;
        LAS float* red = (LAS float*)(lds + 24576);
        for (int i = tid; i < 3 * 2048; i += 512) { const int r = i >> 11, k = i & 2047; const float v = r < 2 ? a.in[1][r * 2048 + k] : a.in[3][k]; sv[i] = v / (1.f + __expf(-v)); }
        __syncthreads();
        const int l = blockIdx.x / 96, cc = blockIdx.x % 96, c4 = tid & 31, kg = tid >> 5;
        const float* wp = a.in[4] + (size_t)l * 2048 * 12288 + (size_t)(kg * 128) * 12288 + cc * 128 + c4 * 4;
        f32x4 acc0 = {0, 0, 0, 0}, acc1 = acc0, acc2 = acc0;
#pragma unroll 8
        for (int k = 0; k < 128; ++k) { const f32x4 w = __builtin_nontemporal_load((const f32x4*)(wp + (size_t)k * 12288)); const int kk = kg * 128 + k;
            acc0 += w * sv[kk]; acc1 += w * sv[2048 + kk]; acc2 += w * sv[4096 + kk]; }
#pragma unroll
        for (int e = 0; e < 4; ++e) { red[(kg * 3 + 0) * 128 + c4 * 4 + e] = acc0[e]; red[(kg * 3 + 1) * 128 + c4 * 4 + e] = acc1[e]; red[(kg * 3 + 2) * 128 + c4 * 4 + e] = acc2[e]; }
        __syncthreads();
        if (tid < 384) { const int r = tid >> 7, c = tid & 127; float s = a.in[5][l * 12288 + cc * 128 + c];
#pragma unroll
            for (int g = 0; g < 16; ++g) s += red[(g * 3 + r) * 128 + c];
            ((float*)(ws + WS_MOD))[(l * 3 + r) * 12288 + cc * 128 + c] = s; }
        __syncthreads();
    }
    {
        LAS float* scr = (LAS float*)(lds + wave * 16384);
        const int gw = blockIdx.x * 8 + wave, NGW = gridDim.x * 8;
        constexpr int NPRO = DEFER_CONV ? TR_C3 + (TR_ITEMS - TR_C6) : TR_ITEMS;
#define PRO_ITEM(i) (!DEFER_CONV ? (i) : (i) < TR_C3 ? (i) : (i) - TR_C3 + TR_C6)
        TrDesc cur; f32x4 rv[8];
        int it = gw;
        if (it < NPRO) { tr_desc(a, PRO_ITEM(it), cur); tr_load(cur, lane, rv); }
        while (it < NPRO) {
            const int nit = it + NGW; TrDesc nd = cur; f32x4 rn[8];
            if (nit < NPRO) { tr_desc(a, PRO_ITEM(nit), nd); tr_load(nd, lane, rn); }
            tr_finish(cur, rv, scr, lane);
#pragma unroll
            for (int i = 0; i < 8; ++i) rv[i] = rn[i];
            cur = nd; it = nit;
        }
#undef PRO_ITEM
    }
    {
        const int gt = blockIdx.x * 512 + tid, NT = gridDim.x * 512;
        for (int i = gt; i < 2 * 224 * 256; i += NT) { const int l = i / (224 * 256), r = i % (224 * 256); ((u32x4*)((bf16*)(ws + WS_WCAT) + ((size_t)l * 4096 + 3872) * 2048))[r] = (u32x4){0u, 0u, 0u, 0u}; }
        for (int i = gt; i < 2 * 224 * 128; i += NT) { const int l = i / (224 * 128), r = i % (224 * 128); ((u32x4*)((unsigned char*)(ws + WS_WCAT8) + ((size_t)l * 12288 + 3872) * 2048))[r] = (u32x4){0u, 0u, 0u, 0u}; }
        for (int i = gt; i < 131072; i += NT) ((bf16*)(ws + WS_WSB))[i] = (bf16)f2bf(a.in[15][i]);
        for (int i = gt; i < 2048; i += NT) { const int pos = i >> 4, f = i & 15; const float inv = exp2f(-(float)f * (13.287712379549449f / 16.f));
            float rev = (float)pos * inv * 0.15915494309189535f; rev -= floorf(rev);
            ((float*)(ws + WS_ROPE))[i] = __builtin_amdgcn_cosf(rev); ((float*)(ws + WS_ROPE))[2048 + i] = __builtin_amdgcn_sinf(rev); }
    }
}

constexpr int CONV_UNIT = 64, CONV_UNITS_PH = 3 * 16384 / CONV_UNIT / 2;
__device__ __forceinline__ void conv_finish2(const f32x4 (&ra)[8], const f32x4 (&rb)[8], LAS float* scr, int lane, bool down, bf16* dstb, unsigned char* dst8, float qinv) {
    constexpr int SK = 132;
    { const int kr = lane >> 3, n4 = lane & 7;
#pragma unroll
        for (int i = 0; i < 8; ++i)
#pragma unroll
            for (int e = 0; e < 4; ++e) { scr[(4 * n4 + e) * SK + 8 * i + kr] = ra[i][e]; scr[(4 * n4 + e) * SK + 64 + 8 * i + kr] = rb[i][e]; } }
    asm volatile("s_waitcnt lgkmcnt(0)" ::: "memory");
    if (down) { const int c = lane & 7;
        unsigned char* d8 = (unsigned char*)dstb;
#pragma unroll
        for (int j = 0; j < 4; ++j) { const int n = (lane >> 3) + 8 * j; const LAS float* sp = scr + n * SK + 16 * c; u32x4 o;
#pragma unroll
            for (int q = 0; q < 4; ++q) { const f32x4 w = *(const LAS f32x4*)(sp + 4 * q); unsigned p = 0u;
                p = __builtin_amdgcn_cvt_pk_fp8_f32(w[0] * qinv, w[1] * qinv, p, false); p = __builtin_amdgcn_cvt_pk_fp8_f32(w[2] * qinv, w[3] * qinv, p, true); o[q] = p; }
            __builtin_nontemporal_store(o, (u32x4*)(d8 + (size_t)n * 1024 + 16 * c)); } }
    else { const int c = lane & 7;
#pragma unroll
        for (int j = 0; j < 4; ++j) { const int n = (lane >> 3) + 8 * j; const LAS float* sp = scr + n * SK + 16 * c; u32x4 o;
#pragma unroll
            for (int q = 0; q < 4; ++q) { const f32x4 w = *(const LAS f32x4*)(sp + 4 * q); unsigned p = 0u;
                p = __builtin_amdgcn_cvt_pk_fp8_f32(w[0] * qinv, w[1] * qinv, p, false); p = __builtin_amdgcn_cvt_pk_fp8_f32(w[2] * qinv, w[3] * qinv, p, true); o[q] = p; }
            __builtin_nontemporal_store(o, (u32x4*)(dst8 + (size_t)n * 2048 + 16 * c)); } }
    asm volatile("s_waitcnt lgkmcnt(0)" ::: "memory");
}
__device__ __forceinline__ void conv_unit(const Args& a, int l, int half, int cu, LAS unsigned char* lds, int wave, int lane) {
    LAS float* scr = (LAS float*)(lds + wave * 17408);
    const int jb = (half * CONV_UNITS_PH + cu) * CONV_UNIT, tj = jb >> 14, r = l * 16384 + (jb & 16383), m = r >> 10, uin = (r & 1023) >> 6;
    const bool down = tj == 2;
    const int N = down ? 2048 : 1024, kbA = down ? 2 * (uin >> 1) : 2 * uin, nb0 = (down ? 32 * (uin & 1) : 0) + wave;
    float qinv = 0.f;
    if (down) { const float amax = __uint_as_float(__hip_atomic_load((const unsigned*)(a.ws + WS_CTL) + CW_WMAX + 70 + m, __ATOMIC_RELAXED, __HIP_MEMORY_SCOPE_AGENT)); qinv = amax > 0.f ? 128.f / amax : 0.f; }
    if (!down) { const unsigned* wm = (const unsigned*)(a.ws + WS_CTL) + CW_WMAX; const float amax = __uint_as_float(__hip_atomic_load(wm + (tj == 0 ? 4 : 36) + m, __ATOMIC_RELAXED, __HIP_MEMORY_SCOPE_AGENT)) ; qinv = amax > 0.f ? 128.f / amax : 0.f; }
    const float* W = (tj == 0 ? a.in[25] : tj == 1 ? a.in[26] : a.in[27]) + (size_t)m * 2048 * 1024;
    const float* lp = W + (size_t)(64 * kbA + (lane >> 3)) * N + 4 * (lane & 7);
#define CONV_LD2(p, RA, RB) do { const float* _p = lp + 32 * (nb0 + 8 * (p)); _Pragma("unroll") for (int _i = 0; _i < 8; ++_i) { RA[_i] = __builtin_nontemporal_load((const f32x4*)(_p + (size_t)(8 * _i) * N)); RB[_i] = __builtin_nontemporal_load((const f32x4*)(_p + (size_t)(64 + 8 * _i) * N)); } } while (0)
#define CONV_FIN2(p, RA, RB) do { const int _n0 = 32 * (nb0 + 8 * (p)); \
        conv_finish2(RA, RB, scr, lane, down, (bf16*)((unsigned char*)(a.ws + WS_WD) + (size_t)m * 2048 * 1024 + (size_t)_n0 * 1024 + 64 * kbA), \
                     (unsigned char*)(a.ws + WS_WGU) + (size_t)m * 2048 * 2048 + (size_t)(256 * (_n0 >> 7) + 128 * tj + (_n0 & 127)) * 2048 + 64 * kbA, qinv); } while (0)
    f32x4 a0[8], b0[8], a1[8], b1[8];
    CONV_LD2(0, a0, b0);
    CONV_LD2(1, a1, b1); CONV_FIN2(0, a0, b0);
    CONV_LD2(2, a0, b0); CONV_FIN2(1, a1, b1);
    CONV_LD2(3, a1, b1); CONV_FIN2(2, a0, b0);
    CONV_FIN2(3, a1, b1);
#undef CONV_LD2
#undef CONV_FIN2
}

template <int MODE> __device__ __forceinline__ void norm1_load(const Args& a, int r, int lane, const float* MODp, f32x4 (&v)[8]) {
    const int mr = r < ML ? (r >> 13) : 2;
    if (MODE == 0) { const float* src = r < ML ? a.in[0] + (size_t)r * D : a.in[2] + (size_t)(r - ML) * D;
#pragma unroll
        for (int j = 0; j < 8; ++j) v[j] = __builtin_nontemporal_load((const f32x4*)(src + 4 * lane + 256 * j)); }
    else { const bf16* xr = (const bf16*)(a.ws + WS_X) + (size_t)r * D; const bf16* y0 = (const bf16*)(a.ws + WS_Y) + (size_t)(2 * r) * D; const bf16* y1 = y0 + D; const float* g2 = MODp + mr * 12288 + 5 * 2048;
#pragma unroll
        for (int j = 0; j < 8; ++j) { const int c = 4 * lane + 256 * j; const u32x2 px = __builtin_nontemporal_load((const u32x2*)(xr + c)); f32x4 x = {bf2f(px.x & 0xffffu), bf2f(px.x >> 16), bf2f(px.y & 0xffffu), bf2f(px.y >> 16)}; const u32x2 p0 = __builtin_nontemporal_load((const u32x2*)(y0 + c)), p1 = __builtin_nontemporal_load((const u32x2*)(y1 + c)); const f32x4 g = *(const f32x4*)(g2 + c);
            x[0] += g[0] * (bf2f(p0.x & 0xffffu) + bf2f(p1.x & 0xffffu)); x[1] += g[1] * (bf2f(p0.x >> 16) + bf2f(p1.x >> 16));
            x[2] += g[2] * (bf2f(p0.y & 0xffffu) + bf2f(p1.y & 0xffffu)); x[3] += g[3] * (bf2f(p0.y >> 16) + bf2f(p1.y >> 16)); v[j] = x; } }
}
template <int MODE> __device__ __forceinline__ void norm1_finish(const Args& a, int l, int r, int lane, const float* MODl, f32x4 (&v)[8]) {
    const int mr = r < ML ? (r >> 13) : 2;
    if (MODE != 2) { bf16* xr = (bf16*)(a.ws + WS_X) + (size_t)r * D;
#pragma unroll
        for (int j = 0; j < 8; ++j) { u32x2 o; o.x = pk2(v[j][0], v[j][1]); o.y = pk2(v[j][2], v[j][3]); __builtin_nontemporal_store(o, (u32x2*)(xr + 4 * lane + 256 * j)); } }
    float ss = 0.f;
#pragma unroll
    for (int j = 0; j < 8; ++j) ss += (v[j][0] * v[j][0] + v[j][1] * v[j][1]) + (v[j][2] * v[j][2] + v[j][3] * v[j][3]);
    const float rstd = rsqrtf(wave_sum(ss) * (1.f / D) + 1e-6f);
    if (MODE == 2) { float* o = a.out + (size_t)r * D; const float* g = a.in[8];
#pragma unroll
        for (int j = 0; j < 8; ++j) { const int c = 4 * lane + 256 * j; const f32x4 gg = *(const f32x4*)(g + c); __builtin_nontemporal_store(v[j] * rstd * gg, (f32x4*)(o + c)); } }
    else { bf16* h = (bf16*)(a.ws + WS_H) + (size_t)r * D; unsigned char* h8 = (unsigned char*)(a.ws + WS_H8) + (size_t)r * D; unsigned char* h8i = (unsigned char*)(a.ws + WS_H8I) + (size_t)r * D; const float* g = a.in[6] + l * D; const float* sh = MODl + mr * 12288; const float* sc = sh + 2048;
        float am = 0.f;
#pragma unroll
        for (int j = 0; j < 8; ++j) { const int c = 4 * lane + 256 * j; const f32x4 gg = *(const f32x4*)(g + c), s1 = *(const f32x4*)(sh + c), s2 = *(const f32x4*)(sc + c);
            v[j] = (v[j] * rstd * gg) * (s2 + 1.f) + s1; am = fmaxf(am, fmaxf(fmaxf(fabsf(v[j][0]), fabsf(v[j][1])), fmaxf(fabsf(v[j][2]), fabsf(v[j][3])))); }
        am = wave_max(am);
        const float qinv = am > 0.f ? 127.f / am : 0.f;
        if (lane == 0) ((float*)(a.ws + WS_RS))[r] = am * (1.f / 127.f);
#pragma unroll
        for (int j = 0; j < 8; ++j) { const int c = 4 * lane + 256 * j; const f32x4 y = v[j];
            if (r >= ML) { u32x2 o; o.x = pk2(y[0], y[1]); o.y = pk2(y[2], y[3]); *(u32x2*)(h + c) = o; }
            *(unsigned*)(h8i + c) = q8pack(y[0] * qinv, y[1] * qinv, y[2] * qinv, y[3] * qinv);
            unsigned p8 = 0u; p8 = __builtin_amdgcn_cvt_pk_fp8_f32(y[0], y[1], p8, false); p8 = __builtin_amdgcn_cvt_pk_fp8_f32(y[2], y[3], p8, true); *(unsigned*)(h8 + c) = p8; } }
}
template <int MODE> __device__ __forceinline__ void phase_norm1(const Args& a, int l, int wave, int lane, int probe = 0) {
    const int gw = blockIdx.x * 8 + wave, NGW = gridDim.x * 8;
    const float* MODl = (const float*)(a.ws + WS_MOD) + (size_t)(l < 2 ? l : 1) * 3 * 12288;
    const float* MODp = (const float*)(a.ws + WS_MOD) + (size_t)(l > 0 ? l - 1 : 0) * 3 * 12288;
    const int nrows = (MODE == 2) ? ML : MT;
    for (int r = gw; r < nrows; r += 2 * NGW) {
        const int r2 = r + NGW; const bool has2 = r2 < nrows;
        f32x4 v[8], w[8];
        norm1_load<MODE>(a, r, lane, MODp, v);
        if (has2) norm1_load<MODE>(a, r2, lane, MODp, w);
        norm1_finish<MODE>(a, l, r, lane, MODl, v);
        if (has2) norm1_finish<MODE>(a, l, r2, lane, MODl, w);
    }
}

__device__ __forceinline__ void router_row_load(const Args& a, int r, int lane, u32x2 (&pxr)[8], u32x2 (&pmr)[8]) {
    const bf16* xr = (const bf16*)(a.ws + WS_X) + (size_t)r * D; const bf16* mx = (const bf16*)(a.ws + WS_MX) + (size_t)r * D;
#pragma unroll
    for (int j = 0; j < 8; ++j) { const int c = 4 * lane + 256 * j; pxr[j] = __builtin_nontemporal_load((const u32x2*)(xr + c)); pmr[j] = __builtin_nontemporal_load((const u32x2*)(mx + c)); }
}
__device__ __forceinline__ void router_row_norm(const Args& a, int l, int r, int lane, const float* MODl, const u32x2 (&pxr)[8], const u32x2 (&pmr)[8], f32x4 (&v)[8]) {
    const int mr = r < ML ? (r >> 13) : 2; bf16* xr = (bf16*)(a.ws + WS_X) + (size_t)r * D; float ss = 0.f;
    const float* g1 = MODl + mr * 12288 + 2 * 2048;
#pragma unroll
    for (int j = 0; j < 8; ++j) { const int c = 4 * lane + 256 * j; const u32x2 px = pxr[j]; f32x4 x = {bf2f(px.x & 0xffffu), bf2f(px.x >> 16), bf2f(px.y & 0xffffu), bf2f(px.y >> 16)}; const u32x2 pm = pmr[j]; const f32x4 gg = *(const f32x4*)(g1 + c);
        x[0] += gg[0] * bf2f(pm.x & 0xffffu); x[1] += gg[1] * bf2f(pm.x >> 16); x[2] += gg[2] * bf2f(pm.y & 0xffffu); x[3] += gg[3] * bf2f(pm.y >> 16);
        { u32x2 o; o.x = pk2(x[0], x[1]); o.y = pk2(x[2], x[3]); __builtin_nontemporal_store(o, (u32x2*)(xr + c)); } v[j] = x; ss += (x[0] * x[0] + x[1] * x[1]) + (x[2] * x[2] + x[3] * x[3]); }
    const float rstd = rsqrtf(wave_sum(ss) * (1.f / D) + 1e-6f);
    bf16* h = (bf16*)(a.ws + WS_H) + (size_t)r * D; const float* g = a.in[7] + l * D; const float* sh = MODl + mr * 12288 + 3 * 2048; const float* sc = sh + 2048;
    float am = 0.f;
#pragma unroll
    for (int j = 0; j < 8; ++j) { const int c = 4 * lane + 256 * j; const f32x4 gg = *(const f32x4*)(g + c), s1 = *(const f32x4*)(sh + c), s2 = *(const f32x4*)(sc + c);
        v[j] = (v[j] * rstd * gg) * (s2 + 1.f) + s1; am = fmaxf(am, fmaxf(fmaxf(fabsf(v[j][0]), fabsf(v[j][1])), fmaxf(fabsf(v[j][2]), fabsf(v[j][3])))); }
    am = wave_max(am); const float qinv = am > 0.f ? 127.f / am : 0.f;
    if (lane == 0) ((float*)(a.ws + WS_RS))[r] = am * (1.f / 127.f);
    unsigned char* h8i = (unsigned char*)(a.ws + WS_H8I) + (size_t)r * D; (void)h;
#pragma unroll
    for (int j = 0; j < 8; ++j) { const int c = 4 * lane + 256 * j; const f32x4 y = v[j];
        unsigned p8 = 0u; p8 = __builtin_amdgcn_cvt_pk_fp8_f32(y[0], y[1], p8, false); p8 = __builtin_amdgcn_cvt_pk_fp8_f32(y[2], y[3], p8, true); *(unsigned*)(h8i + c) = p8; }
    (void)qinv;
}
__device__ __forceinline__ void router_select(float (&p)[16], int lane, const float* rb, int rl, LAS int* SELE, LAS float* SELW) {
    { const bool up = (lane & 32) != 0;
#pragma unroll
        for (int c = 0; c < 8; ++c) { const float mine = up ? p[c + 8] : p[c], other = up ? p[c] : p[c + 8]; p[c] = mine + __shfl_xor(other, 32); } }
    { const bool up = (lane & 16) != 0;
#pragma unroll
        for (int c = 0; c < 4; ++c) { const float mine = up ? p[c + 4] : p[c], other = up ? p[c] : p[c + 4]; p[c] = mine + __shfl_xor(other, 16); } }
    { const bool up = (lane & 8) != 0;
#pragma unroll
        for (int c = 0; c < 2; ++c) { const float mine = up ? p[c + 2] : p[c], other = up ? p[c] : p[c + 2]; p[c] = mine + __shfl_xor(other, 8); } }
    { const bool up = (lane & 4) != 0; const float mine = up ? p[1] : p[0], other = up ? p[0] : p[1]; p[0] = mine + __shfl_xor(other, 4); }
    p[0] += __shfl_xor(p[0], 2); p[0] += __shfl_xor(p[0], 1);
    const int e = lane >> 2, gb = lane & 48;
    const float sv = 1.f / (1.f + __expf(-p[0])), bv = sv + rb[e];
    const float b0 = __shfl(bv, gb), b1 = __shfl(bv, gb + 4), b2 = __shfl(bv, gb + 8), b3 = __shfl(bv, gb + 12);
    const float gs = fmaxf(fmaxf(fmaxf(b0 + b1, b0 + b2), fmaxf(b0 + b3, b1 + b2)), fmaxf(b1 + b3, b2 + b3));
    const float g0 = __shfl(gs, 0), g1 = __shfl(gs, 16), g2 = __shfl(gs, 32), g3 = __shfl(gs, 48);
    int best = 0; float bestv = g0; if (g1 > bestv) { bestv = g1; best = 1; } if (g2 > bestv) { bestv = g2; best = 2; } if (g3 > bestv) { bestv = g3; best = 3; }
    const int bb = best * 16;
    const float c0 = __shfl(bv, bb), c1 = __shfl(bv, bb + 4), c2 = __shfl(bv, bb + 8), c3 = __shfl(bv, bb + 12);
    const float t0 = __shfl(sv, bb), t1 = __shfl(sv, bb + 4), t2 = __shfl(sv, bb + 8), t3 = __shfl(sv, bb + 12);
    int i0 = 0; float m0 = c0; if (c1 > m0) { m0 = c1; i0 = 1; } if (c2 > m0) { m0 = c2; i0 = 2; } if (c3 > m0) { m0 = c3; i0 = 3; }
    int i1 = -1; float m1 = -3.0e38f;
    if (i0 != 0 && c0 > m1) { m1 = c0; i1 = 0; } if (i0 != 1 && c1 > m1) { m1 = c1; i1 = 1; } if (i0 != 2 && c2 > m1) { m1 = c2; i1 = 2; } if (i0 != 3 && c3 > m1) { m1 = c3; i1 = 3; }
    const float w0 = i0 == 0 ? t0 : i0 == 1 ? t1 : i0 == 2 ? t2 : t3, w1 = i1 == 0 ? t0 : i1 == 1 ? t1 : i1 == 2 ? t2 : t3;
    const float wsum = w0 + w1;
    if (lane == 0) { SELE[rl] = (4 * best + i0) | ((4 * best + i1) << 8); SELW[2 * rl] = w0 / wsum; SELW[2 * rl + 1] = w1 / wsum; }
}
__device__ __forceinline__ void phase_norm2_router(const Args& a, int l, LAS unsigned char* lds, int tid, int wave, int lane, int probe = 0) {
    constexpr int RWS = 2052;
    LAS float* RW = (LAS float*)lds;
    LAS int* SELE = (LAS int*)(lds + 131328);
    LAS float* SELW = (LAS float*)(lds + 131328 + 512);
    LAS int* SLOT = (LAS int*)(lds + 131328 + 1536);
    LAS int* BASE = (LAS int*)(lds + 131328 + 2560);
    for (int i = tid; i < 32768; i += 512) { const int k = i >> 4, c = i & 15; RW[c * RWS + k] = a.in[23][i]; }
    __syncthreads();
    const float* MODl = (const float*)(a.ws + WS_MOD) + (size_t)l * 3 * 12288;
    unsigned* cnt = (unsigned*)(a.ws + WS_CTL) + CW_CNT + 64 * 16 * l;
    int* LIST = (int*)(a.ws + WS_LIST); float* LISTW = (float*)(a.ws + WS_LISTW);
    const int nrows = (l == 0) ? MT : ML;
    const int R = (nrows + (int)gridDim.x - 1) / (int)gridDim.x, rbase = (int)blockIdx.x * R;
    const int HP = R >> 1;
    u32x2 pxa[8], pma[8], pxb[8], pmb[8];
    if (wave < HP) { router_row_load(a, rbase + wave, lane, pxa, pma); router_row_load(a, rbase + wave + HP, lane, pxb, pmb); }
    for (int rl = wave; rl < HP; rl += 8) {
        const int rl2 = rl + HP, r = rbase + rl, r2 = rbase + rl2;
        f32x4 v[8], w2[8];
        router_row_norm(a, l, r, lane, MODl, pxa, pma, v);
        router_row_norm(a, l, r2, lane, MODl, pxb, pmb, w2);
        if (rl + 8 < HP) { router_row_load(a, r + 8, lane, pxa, pma); router_row_load(a, r2 + 8, lane, pxb, pmb); }
        float p[16], q[16];
#pragma unroll
        for (int c = 0; c < 16; ++c) { f32x2v s12 = {0.f, 0.f};
#pragma unroll
            for (int j = 0; j < 8; ++j) { const f32x4 w = *(const LAS f32x4*)(RW + c * RWS + 4 * lane + 256 * j);
#pragma unroll
                for (int e = 0; e < 4; ++e) s12 = __builtin_elementwise_fma((f32x2v){v[j][e], w2[j][e]}, (f32x2v){w[e], w[e]}, s12); }
            p[c] = s12[0]; q[c] = s12[1]; asm volatile("" : "+v"(p[c]), "+v"(q[c]) :: "memory"); }
        router_select(p, lane, a.in[24], rl, SELE, SELW);
        router_select(q, lane, a.in[24], rl2, SELE, SELW);
    }
    __syncthreads();
    const int nloc = (nrows - rbase) < R ? (nrows - rbase > 0 ? nrows - rbase : 0) : R;
    if (tid < 16) { int c = 0;
        for (int rl = 0; rl < nloc; ++rl) { const int se = SELE[rl]; if ((se & 255) == tid) { SLOT[2 * rl] = c; ++c; } if ((se >> 8) == tid) { SLOT[2 * rl + 1] = c; ++c; } }
        BASE[tid] = c ? (int)atomicAdd(cnt + 64 * tid, (unsigned)c) : 0; }
    __syncthreads();
    if (tid < nloc) { const int se = SELE[tid], e0 = se & 255, e1 = se >> 8, r = rbase + tid;
        const int k0 = BASE[e0] + SLOT[2 * tid], k1 = BASE[e1] + SLOT[2 * tid + 1];
        const unsigned* wmd = (const unsigned*)(a.ws + WS_CTL) + CW_WMAX + 70 + 16 * l;
        LIST[e0 * CAP + k0] = 2 * r; LISTW[e0 * CAP + k0] = SELW[2 * tid] * (__uint_as_float(wmd[e0]) * (1.f / 1024.f)); LIST[e1 * CAP + k1] = 2 * r + 1; LISTW[e1 * CAP + k1] = SELW[2 * tid + 1] * (__uint_as_float(wmd[e1]) * (1.f / 1024.f)); }
}

namespace pg8 {
constexpr int BM = 256, BK = 64, HALF = 128, HTB = HALF * BK * 2, STAGE_BYTES = 8 * HTB, NXCD = 8, WGM = 8;
__device__ __forceinline__ int lds_byte(int r, int c) { const int st = (r >> 4) * 2 + (c >> 5), rr = r & 15, cc = c & 31, ob = rr * 64 + cc * 2; return st * 1024 + (ob ^ (((ob >> 9) & 1) << 5)); }
__device__ __forceinline__ void stage_rc(int b, int& R, int& C) { const int st = b / 1024, sb = b % 1024, swz = sb ^ (((sb >> 9) & 1) << 5); R = (st >> 1) * 16 + swz / 64; C = (st & 1) * 32 + (swz % 64) / 2; }
__device__ __forceinline__ int perm32(int rho) { const int n = rho >> 4, i = rho & 15; return 8 * (i >> 2) + 4 * n + (i & 3); }
typedef int i32x4v __attribute__((ext_vector_type(4)));
typedef int i32x8v __attribute__((ext_vector_type(8)));
__device__ __forceinline__ i32x4v lo4(i32x8v v) { return __builtin_shufflevector(v, v, 0, 1, 2, 3); }
__device__ __forceinline__ i32x4v hi4(i32x8v v) { return __builtin_shufflevector(v, v, 4, 5, 6, 7); }
__device__ __forceinline__ bf16x8 lo8(i32x8v v) { return __builtin_bit_cast(bf16x8, (i32x4v)__builtin_shufflevector(v, v, 0, 1, 2, 3)); }
__device__ __forceinline__ bf16x8 hi8(i32x8v v) { return __builtin_bit_cast(bf16x8, (i32x4v)__builtin_shufflevector(v, v, 4, 5, 6, 7)); }
__device__ __forceinline__ i32x8v cat8(bf16x8 lo, bf16x8 hi) { const i32x4v a = __builtin_bit_cast(i32x4v, lo), b = __builtin_bit_cast(i32x4v, hi); return __builtin_shufflevector(a, b, 0, 1, 2, 3, 4, 5, 6, 7); }
struct Unit { int pm, pn, e, cnt; };
__device__ __forceinline__ unsigned cvt_pk_bf16(float lo, float hi) { return pk2(lo, hi); }
__device__ __forceinline__ void static_tile(int L, int nM, int nN, int& pm, int& pn) {
    const int nwg = nM * nN; int wgid = L; { const int q = nwg / NXCD, r = nwg % NXCD, xcd = wgid % NXCD, off = wgid / NXCD; wgid = (xcd < r ? xcd * (q + 1) : r * (q + 1) + (xcd - r) * q) + off; }
    const int nig = WGM * nN, gid = wgid / nig, fm = gid * WGM, gsz = (nM - fm) < WGM ? (nM - fm) : WGM;
    pm = fm + ((wgid % nig) % gsz); pn = (wgid % nig) / gsz;
}
template <class Epi, bool KHOOK> struct HookState { struct type {}; };
template <class Epi> struct HookState<Epi, true> { typedef typename Epi::State type; };
template <class Epi, class Sched, bool KHOOK, int DT = 0>
__device__ __forceinline__ void gemm256(LAS unsigned char* lds, const char* Abase, const int Kb, const Sched& S, const Epi& E) {
    const int tid = fresh_tid(), wid = __builtin_amdgcn_readfirstlane(tid >> 6), lane = tid & 63, wr = wid >> 2, wc = wid & 3, fr = lane & 15, fq = lane >> 4;
    const int nt = Kb / 128;
    unsigned voffB[2];
#pragma unroll
    for (int i = 0; i < 2; ++i) { int R, C; stage_rc(tid * 16 + i * 8192, R, C); const int Rb = Epi::PERM ? ((R & ~31) + perm32(R & 31)) : R; voffB[i] = (unsigned)Rb * S.ldb_bytes() + (unsigned)(C * 2); }
#define PG8_RS(i) ({ int _R, _C; stage_rc(tid * 16 + (i) * 8192, _R, _C); _R; })
#define PG8_CS(i) ({ int _R, _C; stage_rc(tid * 16 + (i) * 8192, _R, _C); (unsigned)(_C * 2); })
    const unsigned kstep = 128u, hstepB = (unsigned)HALF * S.ldb_bytes();
    const __amdgpu_buffer_rsrc_t rA = __builtin_amdgcn_make_buffer_rsrc((void*)Abase, 0, 0x7fffffff, 0x00020000), rB = __builtin_amdgcn_make_buffer_rsrc((void*)S.wbase(), 0, 0x7fffffff, 0x00020000);
    const unsigned ldsw = (unsigned)wid * 1024u;
    const int aoff = lds_byte(wr * 64 + fr, fq * 8), boff = lds_byte(wc * 32 + fr, fq * 8);
#define PG8_SA(b, h) (((b) * 2 + (h)) * HTB)
#define PG8_SB(b, h) ((4 + (b) * 2 + (h)) * HTB)
#define PG8_STAGE(bufoff, rsrc, soff, voff) do { _Pragma("unroll") for (int _i = 0; _i < 2; ++_i) \
        __builtin_amdgcn_raw_ptr_buffer_load_lds(rsrc, (LAS void*)(lds + (bufoff) + ldsw + _i * 8192), 16, (int)(voff)[_i], (int)(soff), 0, 0); } while (0)
#define PG8_LDA(dst, b, h) do { _Pragma("unroll") for (int m = 0; m < 4; ++m) { const i32x4v _lo = *(const LAS i32x4v*)(lds + PG8_SA(b, h) + aoff + m * 2048), _hi = *(const LAS i32x4v*)(lds + PG8_SA(b, h) + aoff + m * 2048 + 1024); dst[m] = __builtin_shufflevector(_lo, _hi, 0, 1, 2, 3, 4, 5, 6, 7); } } while (0)
#define PG8_LDB(dst, b, h) do { _Pragma("unroll") for (int n = 0; n < 2; ++n) { const i32x4v _lo = *(const LAS i32x4v*)(lds + PG8_SB(b, h) + boff + n * 2048), _hi = *(const LAS i32x4v*)(lds + PG8_SB(b, h) + boff + n * 2048 + 1024); dst[n] = __builtin_shufflevector(_lo, _hi, 0, 1, 2, 3, 4, 5, 6, 7); } } while (0)
#define PG8_MMA(ai, bj, At, Bt) do { __builtin_amdgcn_s_setprio(1); _Pragma("unroll") for (int m = 0; m < 4; ++m) _Pragma("unroll") for (int n = 0; n < 2; ++n) { \
        if constexpr (DT == 0) { acc[ai][bj][m][n] = __builtin_amdgcn_mfma_f32_16x16x32_bf16(lo8(Bt[n]), lo8(At[m]), acc[ai][bj][m][n], 0, 0, 0); acc[ai][bj][m][n] = __builtin_amdgcn_mfma_f32_16x16x32_bf16(hi8(Bt[n]), hi8(At[m]), acc[ai][bj][m][n], 0, 0, 0); } \
        else if constexpr (DT == 1) { acc[ai][bj][m][n] = __builtin_amdgcn_mfma_scale_f32_16x16x128_f8f6f4(Bt[n], At[m], acc[ai][bj][m][n], 0, 0, 0, 0, 0, 0); } \
        else { i32x4v _c = __builtin_bit_cast(i32x4v, acc[ai][bj][m][n]); _c = __builtin_amdgcn_mfma_i32_16x16x64_i8(lo4(Bt[n]), lo4(At[m]), _c, 0, 0, 0); _c = __builtin_amdgcn_mfma_i32_16x16x64_i8(hi4(Bt[n]), hi4(At[m]), _c, 0, 0, 0); acc[ai][bj][m][n] = __builtin_bit_cast(f32x4, _c); } } \
        __builtin_amdgcn_s_setprio(0); } while (0)
#define PG8_WAIT_V(n) asm volatile("s_waitcnt vmcnt(" #n ")" ::: "memory")
#define PG8_WAIT_L(n) asm volatile("s_waitcnt lgkmcnt(" #n ")" ::: "memory")
#define PG8_BAR __builtin_amdgcn_s_barrier()
#define PG8_SCHED __builtin_amdgcn_sched_barrier(0)
    Unit cur, nxt; int ui = 0;
    if (!S.next(0, cur)) return;
    f32x4 acc[2][2][4][2];
#pragma unroll
    for (int a = 0; a < 2; ++a)
#pragma unroll
        for (int b = 0; b < 2; ++b)
#pragma unroll
            for (int m = 0; m < 4; ++m)
#pragma unroll
                for (int n = 0; n < 2; ++n) acc[a][b][m][n] = (f32x4){0.f, 0.f, 0.f, 0.f};
    i32x8v At[4], B0[2], B1[2];
    typename HookState<Epi, KHOOK>::type hst;
    unsigned vA0[2], vA1[2], nA0[2], nA1[2];
    unsigned cAs = 0u, nAs = 0u;
    const unsigned hA = Sched::GATHER ? 0u : (unsigned)HALF * S.lda_bytes();
    if constexpr (Sched::GATHER) {
#pragma unroll
        for (int i = 0; i < 2; ++i) { vA0[i] = S.arow_off(cur, PG8_RS(i)) + PG8_CS(i); vA1[i] = S.arow_off(cur, HALF + PG8_RS(i)) + PG8_CS(i); }
    } else {
#pragma unroll
        for (int i = 0; i < 2; ++i) { vA0[i] = (unsigned)PG8_RS(i) * S.lda_bytes() + PG8_CS(i); vA1[i] = vA0[i]; nA0[i] = vA0[i]; nA1[i] = vA0[i]; }
        cAs = S.aoff(cur);
    }
    unsigned cB = S.boff(cur);
    S.a_ready(cur);
    PG8_STAGE(PG8_SB(0, 0), rB, cB, voffB); PG8_STAGE(PG8_SB(0, 1), rB, cB + hstepB, voffB); PG8_STAGE(PG8_SA(0, 0), rA, cAs, vA0); PG8_STAGE(PG8_SA(0, 1), rA, cAs + hA, vA1);
    if (wr == 1) PG8_BAR;
    PG8_WAIT_V(2); PG8_BAR;
    PG8_STAGE(PG8_SB(1, 0), rB, cB + kstep, voffB); PG8_STAGE(PG8_SA(1, 0), rA, cAs + kstep, vA0); PG8_STAGE(PG8_SB(1, 1), rB, cB + hstepB + kstep, voffB);
    PG8_WAIT_V(6); PG8_BAR;
    for (;;) {
        const bool has_next = S.next(ui + 1, nxt);
        const unsigned nB = has_next ? S.boff(nxt) : cB;
        if constexpr (Sched::GATHER) {
#pragma unroll
            for (int i = 0; i < 2; ++i) { nA0[i] = has_next ? S.arow_off(nxt, PG8_RS(i)) + PG8_CS(i) : vA0[i]; nA1[i] = has_next ? S.arow_off(nxt, HALF + PG8_RS(i)) + PG8_CS(i) : vA1[i]; }
        } else nAs = has_next ? S.aoff(nxt) : cAs;
        for (int t = 0; t < nt; t += 2) {
            const bool last = (t == nt - 2);
            const unsigned a1 = cAs + (unsigned)(t + 1) * kstep;
            const unsigned a2 = last ? nAs : cAs + (unsigned)(t + 2) * kstep, b2 = last ? nB : cB + (unsigned)(t + 2) * kstep;
            const unsigned a3 = a2 + kstep, b3 = b2 + kstep;
            if (last && has_next) S.a_ready(nxt);
            unsigned w0[2], w1[2];
#pragma unroll
            for (int i = 0; i < 2; ++i) { w0[i] = (Sched::GATHER && last) ? nA0[i] : vA0[i]; w1[i] = (Sched::GATHER && last) ? nA1[i] : vA1[i]; }
            PG8_LDB(B0, 0, 0); PG8_LDB(B1, 0, 1); PG8_SCHED; PG8_LDA(At, 0, 0); PG8_STAGE(PG8_SA(1, 1), rA, a1 + hA, vA1);
            PG8_WAIT_V(8); PG8_WAIT_L(0); PG8_BAR; PG8_MMA(0, 0, At, B0); PG8_MMA(0, 1, At, B1); PG8_BAR; PG8_SCHED;
            PG8_LDA(At, 0, 1); PG8_STAGE(PG8_SB(0, 0), rB, b2, voffB); PG8_STAGE(PG8_SB(0, 1), rB, b2 + hstepB, voffB); PG8_STAGE(PG8_SA(0, 0), rA, a2, w0);
            PG8_WAIT_V(8); PG8_WAIT_L(0); PG8_BAR; PG8_MMA(1, 0, At, B0); PG8_MMA(1, 1, At, B1); PG8_BAR; PG8_SCHED;
            PG8_LDB(B0, 1, 0); PG8_LDB(B1, 1, 1); PG8_SCHED; PG8_LDA(At, 1, 0); PG8_STAGE(PG8_SA(0, 1), rA, a2 + hA, w1);
            PG8_WAIT_V(8); PG8_WAIT_L(0); PG8_BAR; PG8_MMA(0, 0, At, B0); PG8_MMA(0, 1, At, B1); PG8_BAR; PG8_SCHED;
            PG8_LDA(At, 1, 1); PG8_STAGE(PG8_SB(1, 0), rB, b3, voffB); PG8_STAGE(PG8_SB(1, 1), rB, b3 + hstepB, voffB); PG8_STAGE(PG8_SA(1, 0), rA, a3, w0);
            PG8_WAIT_V(8); PG8_WAIT_L(0); PG8_BAR; PG8_MMA(1, 0, At, B0); PG8_MMA(1, 1, At, B1); PG8_BAR; PG8_SCHED;
            if constexpr (KHOOK) { constexpr int HS = (DT == 0) ? 3 : 2;        if (!last && ((t + 2) & ((1 << HS) - 1)) == 0) { int fr2 = fr, fq2 = fq; asm volatile("" : "+v"(fr2), "+v"(fq2)); E.khook(acc, hst, cur, ((t + 2) >> HS) - 1, wr, wc, fr2, fq2); } }
        }
        if (wr == 0) PG8_BAR;
        { int fr2 = fr, fq2 = fq; asm volatile("" : "+v"(fr2), "+v"(fq2)); if constexpr (KHOOK) E.fin(acc, hst, cur, wr, wc, fr2, fq2); else E(acc, cur, wr, wc, fr2, fq2); }
        S.done(cur);
        if (!has_next) break;
#pragma unroll
        for (int a = 0; a < 2; ++a)
#pragma unroll
            for (int b = 0; b < 2; ++b)
#pragma unroll
                for (int m = 0; m < 4; ++m)
#pragma unroll
                    for (int n = 0; n < 2; ++n) acc[a][b][m][n] = (f32x4){0.f, 0.f, 0.f, 0.f};
        cur = nxt; cB = nB; cAs = nAs; ++ui;
        if constexpr (Sched::GATHER) {
#pragma unroll
            for (int i = 0; i < 2; ++i) { vA0[i] = nA0[i]; vA1[i] = nA1[i]; } }
        if (wr == 1) PG8_BAR;
    }
    PG8_WAIT_V(0);
    PG8_BAR;
#undef PG8_RS
#undef PG8_CS
#undef PG8_SA
#undef PG8_SB
#undef PG8_STAGE
#undef PG8_LDA
#undef PG8_LDB
#undef PG8_MMA
#undef PG8_WAIT_V
#undef PG8_WAIT_L
#undef PG8_BAR
#undef PG8_SCHED
}
}

template <int UNR = 2> __device__ __forceinline__ void sgemm_k(f32x4 (&acc)[4][2][2], const bf16* (&pa)[4], const bf16* (&pb)[2][2], int K) {
#pragma unroll UNR
    for (int k = 0; k < K; k += 32) {
        bf16x8 af[4], bfr[2][2];
#pragma unroll
        for (int mi = 0; mi < 4; ++mi) af[mi] = *(const bf16x8*)(pa[mi] + k);
#pragma unroll
        for (int cp = 0; cp < 2; ++cp)
#pragma unroll
            for (int n = 0; n < 2; ++n) bfr[cp][n] = *(const bf16x8*)(pb[cp][n] + k);
#pragma unroll
        for (int mi = 0; mi < 4; ++mi)
#pragma unroll
            for (int cp = 0; cp < 2; ++cp)
#pragma unroll
                for (int n = 0; n < 2; ++n) acc[mi][cp][n] = MFMA16(bfr[cp][n], af[mi], acc[mi][cp][n]);
    }
}
#define ZERO_ACC(acc) do { _Pragma("unroll") for (int _a = 0; _a < 4; ++_a) _Pragma("unroll") for (int _b = 0; _b < 2; ++_b) _Pragma("unroll") for (int _c = 0; _c < 2; ++_c) acc[_a][_b][_c] = (f32x4){0.f, 0.f, 0.f, 0.f}; } while (0)

__device__ __forceinline__ void phase_proj(const Args& a, int l, int wave, int lane) {
    const bf16* H = (const bf16*)(a.ws + WS_H); const bf16* W = (const bf16*)(a.ws + WS_WCAT) + (size_t)l * 4096 * 2048; bf16* Z = (bf16*)(a.ws + WS_Z);
    const int fr = lane & 15, fq = lane >> 4, wr = wave >> 2, wc = wave & 3;
    for (int u = blockIdx.x; u < 132 * 48; u += gridDim.x) {
        const int pn = u % 48, pm = u / 48;
        if (l == 1 && pm >= 128 && pn >= 16) continue;
        const int r0 = 128 * pm + 64 * wr, c0 = 256 * pn + 64 * wc;
        const bf16* pa[4]; const bf16* pb[2][2];
#pragma unroll
        for (int mi = 0; mi < 4; ++mi) pa[mi] = H + (size_t)(r0 + 16 * mi + fr) * D + 8 * fq;
#pragma unroll
        for (int cp = 0; cp < 2; ++cp)
#pragma unroll
            for (int n = 0; n < 2; ++n) pb[cp][n] = W + (size_t)(c0 + 32 * cp + perm16(n, fr)) * D + 8 * fq;
        f32x4 acc[4][2][2]; ZERO_ACC(acc);
        sgemm_k(acc, pa, pb, D);
        const int act = (pn >= 5 && pn < 9) ? 1 : (pn >= 16 ? 2 : 0);
#pragma unroll
        for (int mi = 0; mi < 4; ++mi)
#pragma unroll
            for (int cp = 0; cp < 2; ++cp) { float o[8];
#pragma unroll
                for (int e = 0; e < 4; ++e) { o[e] = acc[mi][cp][0][e]; o[4 + e] = acc[mi][cp][1][e]; }
                if (act == 1) {
#pragma unroll
                    for (int e = 0; e < 8; ++e) o[e] = gelu_tanh(o[e]); }
                else if (act == 2) {
#pragma unroll
                    for (int e = 0; e < 8; ++e) o[e] = sigmoidf_(o[e]); }
                *(u32x4*)(Z + (size_t)(r0 + 16 * mi + fr) * ZS + c0 + 32 * cp + 8 * fq) = pack8(o); }
    }
}

__device__ __forceinline__ void phase_merge(const Args& a, int l, int wave, int lane) {
    const bf16* OB = (const bf16*)(a.ws + WS_O); const bf16* W = (const bf16*)(a.ws + WS_WB) + (size_t)l * 2048 * 2048; const bf16* Z = (const bf16*)(a.ws + WS_Z); bf16* ACC = (bf16*)(a.ws + WS_S);
    const int fr = lane & 15, fq = lane >> 4, wr = wave >> 2, wc = wave & 3;
    const int npm = (l == 0) ? 132 : 128;
    for (int u = blockIdx.x; u < npm * 8; u += gridDim.x) {
        const int pn = u & 7, pm = u >> 3;
        const int r0 = 128 * pm + 64 * wr, c0 = 256 * pn + 64 * wc;
        f32x4 tot[4][2][2]; ZERO_ACC(tot);
#pragma unroll 1
        for (int i = 0; i < 4; ++i) {
            const bf16* pa[4]; const bf16* pb[2][2];
#pragma unroll
            for (int mi = 0; mi < 4; ++mi) pa[mi] = OB + (size_t)(r0 + 16 * mi + fr) * D + 512 * i + 8 * fq;
#pragma unroll
            for (int cp = 0; cp < 2; ++cp)
#pragma unroll
                for (int n = 0; n < 2; ++n) pb[cp][n] = W + (size_t)(c0 + 32 * cp + perm16(n, fr)) * D + 512 * i + 8 * fq;
            f32x4 acc[4][2][2]; ZERO_ACC(acc);
            sgemm_k<1>(acc, pa, pb, 512);
#pragma unroll
            for (int mi = 0; mi < 4; ++mi)
#pragma unroll
                for (int cp = 0; cp < 2; ++cp) { float gt[8]; unpack8(*(const u32x4*)(Z + (size_t)(r0 + 16 * mi + fr) * ZS + ZGATE + 2048 * i + c0 + 32 * cp + 8 * fq), gt);
#pragma unroll
                    for (int e = 0; e < 4; ++e) { tot[mi][cp][0][e] += gt[e] * acc[mi][cp][0][e]; tot[mi][cp][1][e] += gt[4 + e] * acc[mi][cp][1][e]; } }
        }
#pragma unroll
        for (int mi = 0; mi < 4; ++mi)
#pragma unroll
            for (int cp = 0; cp < 2; ++cp) { float o[8];
#pragma unroll
                for (int e = 0; e < 4; ++e) { o[e] = tot[mi][cp][0][e]; o[4 + e] = tot[mi][cp][1][e]; }
                *(u32x4*)(ACC + (size_t)(r0 + 16 * mi + fr) * D + c0 + 32 * cp + 8 * fq) = pack8(o); }
    }
}

__device__ __forceinline__ void phase_outproj(const Args& a, int l, int wave, int lane) {
    const bf16* ACC = (const bf16*)(a.ws + WS_S); const bf16* W = (const bf16*)(a.ws + WS_WO) + (size_t)l * 2048 * 2048; float* X = (float*)(a.ws + WS_X);
    const float* MODl = (const float*)(a.ws + WS_MOD) + (size_t)l * 3 * 12288;
    const int fr = lane & 15, fq = lane >> 4, wr = wave >> 2, wc = wave & 3;
    const int npm = (l == 0) ? 132 : 128;
    for (int u = blockIdx.x; u < npm * 8; u += gridDim.x) {
        const int pn = u & 7, pm = u >> 3;
        const int r0 = 128 * pm + 64 * wr, c0 = 256 * pn + 64 * wc;
        const bf16* pa[4]; const bf16* pb[2][2];
#pragma unroll
        for (int mi = 0; mi < 4; ++mi) pa[mi] = ACC + (size_t)(r0 + 16 * mi + fr) * D + 8 * fq;
#pragma unroll
        for (int cp = 0; cp < 2; ++cp)
#pragma unroll
            for (int n = 0; n < 2; ++n) pb[cp][n] = W + (size_t)(c0 + 32 * cp + perm16(n, fr)) * D + 8 * fq;
        f32x4 acc[4][2][2]; ZERO_ACC(acc);
        sgemm_k(acc, pa, pb, D);
#pragma unroll
        for (int mi = 0; mi < 4; ++mi) { const int row = r0 + 16 * mi + fr; const int mr = row < ML ? (row >> 13) : 2;
#pragma unroll
            for (int cp = 0; cp < 2; ++cp) { const int col = c0 + 32 * cp + 8 * fq; const float* g1 = MODl + mr * 12288 + 2 * 2048 + col; float* xp = X + (size_t)row * D + col;
                const f32x4 ga = *(const f32x4*)g1, gb = *(const f32x4*)(g1 + 4); f32x4 xa = *(f32x4*)xp, xb = *(f32x4*)(xp + 4);
                xa += ga * acc[mi][cp][0]; xb += gb * acc[mi][cp][1]; *(f32x4*)xp = xa; *(f32x4*)(xp + 4) = xb; } }
    }
}

__device__ __forceinline__ void moe_table(const Args& a, int l, LAS int* tab, int tid) {
    __syncthreads();
    if (tid == 0) { const unsigned* cnt = (const unsigned*)(a.ws + WS_CTL) + CW_CNT + 64 * 16 * l; int acc = 0;
        for (int e = 0; e < 16; ++e) { const int c = (int)__hip_atomic_load(cnt + 64 * e, __ATOMIC_RELAXED, __HIP_MEMORY_SCOPE_AGENT); tab[e] = c; tab[16 + e] = acc; acc += (c + 255) >> 8; }
        tab[32] = acc; }
    __syncthreads();
}
__device__ __forceinline__ void phase_moe1(const Args& a, int l, LAS unsigned char* lds, int tid, int wave, int lane) {
    LAS int* tab = (LAS int*)lds; moe_table(a, l, tab, tid);
    const bf16* H = (const bf16*)(a.ws + WS_H); const bf16* Wl = (const bf16*)(a.ws + WS_WGU) + (size_t)l * 16 * 2048 * 2048; bf16* ACT = (bf16*)(a.ws + WS_ACT);
    const int* LIST = (const int*)(a.ws + WS_LIST);
    const int fr = lane & 15, fq = lane >> 4, wr = wave >> 2, wc = wave & 3;
    const int NTl = tab[32];
    for (int u = blockIdx.x; u < NTl * 16; u += gridDim.x) {
        const int j = u & 7, hh = (u >> 3) & 1, t = u >> 4;
        int e = 0;
#pragma unroll
        for (int q = 1; q < 16; ++q) if (t >= tab[16 + q]) e = q;
        const int cnt = tab[e], tbe = tab[16 + e], ri0 = 256 * (t - tbe) + 128 * hh + 64 * wr;
        const bf16* W = Wl + (size_t)e * 2048 * 2048;
        const bf16* pa[4]; const bf16* pb[2][2];
#pragma unroll
        for (int mi = 0; mi < 4; ++mi) { int ri = ri0 + 16 * mi + fr; ri = ri < cnt ? ri : cnt - 1; const int tok = LIST[e * CAP + ri] >> 1; pa[mi] = H + (size_t)tok * D + 8 * fq; }
#pragma unroll
        for (int cp = 0; cp < 2; ++cp)
#pragma unroll
            for (int n = 0; n < 2; ++n) pb[cp][n] = W + (size_t)(256 * j + 128 * cp + 32 * wc + perm16(n, fr)) * D + 8 * fq;
        f32x4 acc[4][2][2]; ZERO_ACC(acc);
        sgemm_k(acc, pa, pb, D);
#pragma unroll
        for (int mi = 0; mi < 4; ++mi) { float o[8];
#pragma unroll
            for (int e2 = 0; e2 < 4; ++e2) { const float g0 = acc[mi][0][0][e2], g1 = acc[mi][0][1][e2]; o[e2] = g0 * sigmoidf_(g0) * acc[mi][1][0][e2]; o[4 + e2] = g1 * sigmoidf_(g1) * acc[mi][1][1][e2]; }
            *(u32x4*)(ACT + (size_t)(tbe * 256 + ri0 + 16 * mi + fr) * 1024 + 128 * j + 32 * wc + 8 * fq) = pack8(o); }
    }
}
__device__ __forceinline__ void phase_moe2(const Args& a, int l, LAS unsigned char* lds, int tid, int wave, int lane) {
    LAS int* tab = (LAS int*)lds; moe_table(a, l, tab, tid);
    const bf16* ACT = (const bf16*)(a.ws + WS_ACT); const bf16* Wl = (const bf16*)(a.ws + WS_WD) + (size_t)l * 16 * 2048 * 1024; bf16* Y = (bf16*)(a.ws + WS_Y);
    const int* LIST = (const int*)(a.ws + WS_LIST); const float* LISTW = (const float*)(a.ws + WS_LISTW);
    const int fr = lane & 15, fq = lane >> 4, wr = wave >> 2, wc = wave & 3;
    const int NTl = tab[32];
    for (int u = blockIdx.x; u < NTl * 16; u += gridDim.x) {
        const int j = u & 7, hh = (u >> 3) & 1, t = u >> 4;
        int e = 0;
#pragma unroll
        for (int q = 1; q < 16; ++q) if (t >= tab[16 + q]) e = q;
        const int cnt = tab[e], tbe = tab[16 + e], ri0 = 256 * (t - tbe) + 128 * hh + 64 * wr;
        const bf16* W = Wl + (size_t)e * 2048 * 1024;
        const bf16* pa[4]; const bf16* pb[2][2];
#pragma unroll
        for (int mi = 0; mi < 4; ++mi) pa[mi] = ACT + (size_t)(tbe * 256 + ri0 + 16 * mi + fr) * 1024 + 8 * fq;
#pragma unroll
        for (int cp = 0; cp < 2; ++cp)
#pragma unroll
            for (int n = 0; n < 2; ++n) pb[cp][n] = W + (size_t)(256 * j + 64 * wc + 32 * cp + perm16(n, fr)) * 1024 + 8 * fq;
        f32x4 acc[4][2][2]; ZERO_ACC(acc);
        sgemm_k(acc, pa, pb, 1024);
#pragma unroll
        for (int mi = 0; mi < 4; ++mi) { const int ri = ri0 + 16 * mi + fr;
            if (ri < cnt) { const int tk = LIST[e * CAP + ri]; const float w = LISTW[e * CAP + ri];
#pragma unroll
                for (int cp = 0; cp < 2; ++cp) { float o[8];
#pragma unroll
                    for (int e2 = 0; e2 < 4; ++e2) { o[e2] = w * acc[mi][cp][0][e2]; o[4 + e2] = w * acc[mi][cp][1][e2]; }
                    *(u32x4*)(Y + (size_t)tk * D + 256 * j + 64 * wc + 32 * cp + 8 * fq) = pack8(o); } } }
    }
}


template <class Pre, class Epi>
__device__ __forceinline__ void sk_gemm_ctx(LAS unsigned char* lds, const bf16* A, int lda, const bf16* Bt, int ldb, int K, int N, const Pre& pre, const Epi& epi, int tid, int wave, int lane) {
    const int fr = lane & 15, fq = lane >> 4, ntn = N / 64, ks = K / 8;
    LAS float* P = (LAS float*)lds;
    for (int task = blockIdx.x; task < 8 * ntn; task += gridDim.x) {
        const int tm = task / ntn, tn = task % ntn, r0 = ML + 64 * tm, c0 = 64 * tn;
        const bf16* pa[4]; const bf16* pb[2][2];
#pragma unroll
        for (int mi = 0; mi < 4; ++mi) pa[mi] = A + (size_t)(r0 + 16 * mi + fr) * lda + wave * ks + 8 * fq;
#pragma unroll
        for (int cp = 0; cp < 2; ++cp)
#pragma unroll
            for (int n = 0; n < 2; ++n) pb[cp][n] = Bt + (size_t)(c0 + 32 * cp + perm16(n, fr)) * ldb + wave * ks + 8 * fq;
        f32x4 acc[4][2][2]; ZERO_ACC(acc);
        sgemm_k<4>(acc, pa, pb, ks);
        pre(acc, wave, r0, c0, fr, fq);
        __syncthreads();
#pragma unroll
        for (int mi = 0; mi < 4; ++mi)
#pragma unroll
            for (int cp = 0; cp < 2; ++cp)
#pragma unroll
                for (int n = 0; n < 2; ++n) *(LAS f32x4*)(P + wave * 4096 + (16 * mi + fr) * 64 + 32 * cp + 8 * fq + 4 * n) = acc[mi][cp][n];
        __syncthreads();
        { const int row = tid >> 3, c8 = (tid & 7) * 8; f32x4 s0 = {0.f, 0.f, 0.f, 0.f}, s1 = s0;
#pragma unroll
            for (int w = 0; w < 8; ++w) { s0 += *(const LAS f32x4*)(P + w * 4096 + row * 64 + c8); s1 += *(const LAS f32x4*)(P + w * 4096 + row * 64 + c8 + 4); }
            float v[8] = {s0[0], s0[1], s0[2], s0[3], s1[0], s1[1], s1[2], s1[3]};
            epi(r0 + row, c0 + c8, v); }
    }
    __syncthreads();
}
struct SkNoPre { __device__ __forceinline__ void operator()(f32x4 (&)[4][2][2], int, int, int, int, int) const {} };
struct SkPreMerge { const bf16* Z;
    __device__ __forceinline__ void operator()(f32x4 (&acc)[4][2][2], int w, int r0, int c0, int fr, int fq) const {
#pragma unroll
        for (int mi = 0; mi < 4; ++mi)
#pragma unroll
            for (int cp = 0; cp < 2; ++cp) { const int row = r0 + 16 * mi + fr, col = c0 + 32 * cp + 8 * fq, rr = row & 255, cc = col & 255;
                const u32x2 g8 = *(const u32x2*)((const unsigned char*)Z + g8_off(w >> 1, row >> 8, col >> 8, ((rr >> 6) & 1) * 4 + ((cc >> 5) & 3), rr >> 7, (rr >> 4) & 3, cc >> 7, ((cc >> 3) & 3) * 16 + (rr & 15)));
#pragma unroll
                for (int e = 0; e < 4; ++e) { acc[mi][cp][0][e] *= (float)((g8.x >> (8 * e)) & 255u) * (1.f / 255.f); acc[mi][cp][1][e] *= (float)((g8.y >> (8 * e)) & 255u) * (1.f / 255.f); } }
    }
};
struct SkEpiProj { bf16* Z;
    __device__ __forceinline__ void operator()(int row, int col, float (&v)[8]) const { const int pn = col >> 8;
        if (pn >= 5 && pn < 9) {
#pragma unroll
            for (int e = 0; e < 8; ++e) v[e] = gelu_tanh(v[e]); }
        *(u32x4*)(Z + (size_t)row * ZS + col) = pack8(v); }
};
struct SkEpiAcc { bf16* ACC; int ld; __device__ __forceinline__ void operator()(int row, int col, float (&v)[8]) const { *(u32x4*)(ACC + (size_t)row * ld + col) = pack8(v); } };
struct SkEpiOut { float* X; const float* g1;
    __device__ __forceinline__ void operator()(int row, int col, float (&v)[8]) const { float* xp = X + (size_t)row * D + col; const f32x4 ga = *(const f32x4*)(g1 + col), gb = *(const f32x4*)(g1 + col + 4);
        f32x4 xa = *(f32x4*)xp, xb = *(f32x4*)(xp + 4); xa += ga * (f32x4){v[0], v[1], v[2], v[3]}; xb += gb * (f32x4){v[4], v[5], v[6], v[7]}; *(f32x4*)xp = xa; *(f32x4*)(xp + 4) = xb; }
};

struct DenseOrder {            static constexpr bool GATHER = false;
    int nM, nN, exN, exCnt, exM0, G, c, lda2, K2; const char* Bt; int exPn0 = 0;
    __device__ __forceinline__ bool next(int i, pg8::Unit& u) const {
        const int L = i * G + c, nmain = nM * nN;
        if (L < nmain) { pg8::static_tile(L, nM, nN, u.pm, u.pn); }
        else { const int idx = L - nmain; if (idx >= exCnt) return false; u.pm = exM0 + idx / exN; u.pn = exPn0 + idx % exN; }
        u.e = 0; u.cnt = 256; return true;
    }
    __device__ __forceinline__ unsigned arow_off(const pg8::Unit& u, int r) const { return (unsigned)(u.pm * 256 + r) * (unsigned)lda2; }
    __device__ __forceinline__ void a_ready(const pg8::Unit&) const {}
    __device__ __forceinline__ void done(const pg8::Unit&) const {}
    __device__ __forceinline__ unsigned lda_bytes() const { return (unsigned)lda2; }
    __device__ __forceinline__ unsigned ldb_bytes() const { return (unsigned)K2; }
    __device__ __forceinline__ unsigned aoff(const pg8::Unit& u) const { return (unsigned)u.pm * 256u * (unsigned)lda2; }
    __device__ __forceinline__ const char* wbase() const { return Bt; }
    __device__ __forceinline__ unsigned boff(const pg8::Unit& u) const { return (unsigned)u.pn * 256u * (unsigned)K2; }
};
struct MoeOrder {              static constexpr bool GATHER = true;
    const LAS int* tab; int G, c, K2, gather; const int* LIST; const char* W; size_t wstride;
    int i0, base; unsigned* tcnt; unsigned* tmo;
    __device__ __forceinline__ void a_ready(const pg8::Unit& u) const {
        if (gather) return;
        if (threadIdx.x < 64) { unsigned spins = 0u;
            while ((unsigned)__builtin_amdgcn_readfirstlane(__hip_atomic_load(tcnt + 64 * u.pm, __ATOMIC_RELAXED, __HIP_MEMORY_SCOPE_AGENT)) < 64u) {
                __builtin_amdgcn_s_sleep(2);
                if ((++spins & 255u) == 0u) { if (__hip_atomic_load(tmo, __ATOMIC_RELAXED, __HIP_MEMORY_SCOPE_AGENT) != 0u) break; if (spins > (1u << 20)) { if (threadIdx.x == 0) __hip_atomic_store(tmo, 1u, __ATOMIC_RELAXED, __HIP_MEMORY_SCOPE_AGENT); break; } } }
            __builtin_amdgcn_fence(__ATOMIC_ACQUIRE, "agent");
            asm volatile("s_waitcnt vmcnt(0)" ::: "memory"); }
        asm volatile("" ::: "memory"); __builtin_amdgcn_s_barrier(); asm volatile("" ::: "memory");
    }
    __device__ __forceinline__ void done(const pg8::Unit& u) const {
        if (!gather) return;
        asm volatile("s_waitcnt vmcnt(0)" ::: "memory");
        if ((threadIdx.x & 63) == 0) __hip_atomic_fetch_add(tcnt + 64 * u.pm, 1u, __ATOMIC_RELAXED, __HIP_MEMORY_SCOPE_AGENT);
    }
    __device__ __forceinline__ bool next(int i, pg8::Unit& u) const {
        const int L = (i + i0) * G + c - base; if (L >= tab[32] * 8) return false;
        const int t = L >> 3; int e = 0;
#pragma unroll
        for (int q = 1; q < 16; ++q) if (t >= tab[16 + q]) e = q;
        u.pm = t; u.pn = L & 7; u.e = e; u.cnt = tab[e] - 256 * (t - tab[16 + e]);
        return true;
    }
    __device__ __forceinline__ unsigned arow_off(const pg8::Unit& u, int r) const {
        if (gather) { const int t0 = tab[16 + u.e]; int ri = 256 * (u.pm - t0) + r; const int last = tab[u.e] - 1; ri = ri < last ? ri : last; const int tok = LIST[u.e * CAP + ri] >> 1; return (unsigned)tok * 2048u; }
        return (unsigned)(u.pm * 256 + r) * (unsigned)K2;
    }
    __device__ __forceinline__ unsigned lda_bytes() const { return 0u; }
    __device__ __forceinline__ unsigned ldb_bytes() const { return (unsigned)K2; }
    __device__ __forceinline__ unsigned aoff(const pg8::Unit&) const { return 0u; }
    __device__ __forceinline__ const char* wbase() const { return W; }
    __device__ __forceinline__ unsigned boff(const pg8::Unit& u) const { return (unsigned)u.e * (unsigned)wstride + (unsigned)u.pn * 256u * (unsigned)K2; }
};
struct MoeDownOrder {          static constexpr bool GATHER = false;
    const LAS int* tab; int G, c, K2; const char* W; size_t wstride; int i0, base; unsigned* tcnt; unsigned* tmo;
    __device__ __forceinline__ void a_ready(const pg8::Unit& u) const {
        if (threadIdx.x < 64) { unsigned spins = 0u;
            while ((unsigned)__builtin_amdgcn_readfirstlane(__hip_atomic_load(tcnt + 64 * u.pm, __ATOMIC_RELAXED, __HIP_MEMORY_SCOPE_AGENT)) < 64u) {
                __builtin_amdgcn_s_sleep(2);
                if ((++spins & 255u) == 0u) { if (__hip_atomic_load(tmo, __ATOMIC_RELAXED, __HIP_MEMORY_SCOPE_AGENT) != 0u) break; if (spins > (1u << 20)) { if (threadIdx.x == 0) __hip_atomic_store(tmo, 1u, __ATOMIC_RELAXED, __HIP_MEMORY_SCOPE_AGENT); break; } } }
            __builtin_amdgcn_fence(__ATOMIC_ACQUIRE, "agent");
            asm volatile("s_waitcnt vmcnt(0)" ::: "memory"); }
        asm volatile("" ::: "memory"); __builtin_amdgcn_s_barrier(); asm volatile("" ::: "memory");
    }
    __device__ __forceinline__ void done(const pg8::Unit&) const {}
    __device__ __forceinline__ bool next(int i, pg8::Unit& u) const {
        const int L = (i + i0) * G + c - base; if (L >= tab[32] * 8) return false;
        const int t = L >> 3; int e = 0;
#pragma unroll
        for (int q = 1; q < 16; ++q) if (t >= tab[16 + q]) e = q;
        u.pm = t; u.pn = L & 7; u.e = e; u.cnt = tab[e] - 256 * (t - tab[16 + e]);
        return true;
    }
    __device__ __forceinline__ unsigned arow_off(const pg8::Unit& u, int r) const { return (unsigned)(u.pm * 256 + r) * (unsigned)K2; }
    __device__ __forceinline__ unsigned lda_bytes() const { return (unsigned)K2; }
    __device__ __forceinline__ unsigned ldb_bytes() const { return (unsigned)K2; }
    __device__ __forceinline__ unsigned aoff(const pg8::Unit& u) const { return (unsigned)u.pm * 256u * (unsigned)K2; }
    __device__ __forceinline__ const char* wbase() const { return W; }
    __device__ __forceinline__ unsigned boff(const pg8::Unit& u) const { return (unsigned)u.e * (unsigned)wstride + (unsigned)u.pn * 256u * (unsigned)K2; }
};
template <bool I8> struct EpiProjT { static constexpr bool PERM = true; bf16* Z; unsigned char* G8; int pn_off; float scale; const float* RS = nullptr; float scale_g = 0.f;
    __device__ __forceinline__ void operator()(const f32x4 (&acc)[2][2][4][2], const pg8::Unit& u0, int wr, int wc, int fr, int fq) const {
        pg8::Unit u = u0; u.pn += pn_off;
        const int act = (FP8Z == 1) ? (I8 ? ((u.pn >= 5 && u.pn < 9) ? 1 : 0) : 2) : ((u.pn >= 5 && u.pn < 9) ? 1 : (u.pn >= 16 ? 2 : 0));
#pragma unroll
        for (int ai = 0; ai < 2; ++ai)
#pragma unroll
            for (int m = 0; m < 4; ++m) { bf16* rowp = Z + (size_t)(u.pm * 256 + ai * 128 + wr * 64 + m * 16 + fr) * ZS + u.pn * 256 + wc * 32 + 8 * fq;
#pragma unroll
                for (int bj = 0; bj < 2; ++bj) { f32x4 v0, v1;
                    if constexpr (I8) { const float sr = RS[u.pm * 256 + ai * 128 + wr * 64 + m * 16 + fr] * (act == 2 ? scale_g : scale); const i32x4q i0 = __builtin_bit_cast(i32x4q, acc[ai][bj][m][0]), i1 = __builtin_bit_cast(i32x4q, acc[ai][bj][m][1]);
#pragma unroll
                        for (int e = 0; e < 4; ++e) { v0[e] = (float)i0[e] * sr; v1[e] = (float)i1[e] * sr; } }
                    else { v0 = acc[ai][bj][m][0] * scale; v1 = acc[ai][bj][m][1] * scale; }
                    if (act == 1) {
#pragma unroll
                        for (int e = 0; e < 4; ++e) { v0[e] = gelu_tanh(v0[e]); v1[e] = gelu_tanh(v1[e]); } }
                    else if (act == 2) {
                        u32x2 w8;
                        { float y[4];
#pragma unroll
                          for (int e = 0; e < 4; ++e) y[e] = fmaxf(__builtin_amdgcn_rcpf(__builtin_fmaf(__builtin_amdgcn_exp2f(-1.4426950408889634f * v0[e]), 1.f / 255.f, 1.f / 255.f)), 1.f);
                          w8.x = q8pack(y[0], y[1], y[2], y[3]); }
                        { float y[4];
#pragma unroll
                          for (int e = 0; e < 4; ++e) y[e] = fmaxf(__builtin_amdgcn_rcpf(__builtin_fmaf(__builtin_amdgcn_exp2f(-1.4426950408889634f * v1[e]), 1.f / 255.f, 1.f / 255.f)), 1.f);
                          w8.y = q8pack(y[0], y[1], y[2], y[3]); }
                        __builtin_nontemporal_store(w8, (u32x2*)(G8 + g8_off((u.pn - 16) >> 3, u.pm, (u.pn - 16) & 7, wr * 4 + wc, ai, m, bj, fq * 16 + fr)));
                        continue; }
                    u32x4 w; w.x = pg8::cvt_pk_bf16(v0[0], v0[1]); w.y = pg8::cvt_pk_bf16(v0[2], v0[3]); w.z = pg8::cvt_pk_bf16(v1[0], v1[1]); w.w = pg8::cvt_pk_bf16(v1[2], v1[3]);
                    *(u32x4*)(rowp + bj * 128) = w; } }
    }
};
typedef EpiProjT<false> EpiProj;
struct EpiMerge { static constexpr bool PERM = true; const bf16* Z; bf16* ACC; float gscale;
    struct State { };
    __device__ __forceinline__ const unsigned char* gptr(const pg8::Unit& u, int i, int ai, int m, int bj, int wr, int wc, int fr, int fq) const {
        return (const unsigned char*)Z + g8_off(i, u.pm, u.pn, wr * 4 + wc, ai, m, bj, fq * 16 + fr); }
    __device__ __forceinline__ void khook(f32x4 (&acc)[2][2][4][2], State& st, const pg8::Unit& u, int i, int wr, int wc, int fr, int fq) const {
#pragma unroll
        for (int ai = 0; ai < 2; ++ai)
#pragma unroll
            for (int m = 0; m < 4; ++m) {
#pragma unroll
                for (int bj = 0; bj < 2; ++bj) { const u32x2 gn = *(const u32x2*)gptr(u, i + 1, ai, m, bj, wr, wc, fr, fq); const u32x2 gc = *(const u32x2*)gptr(u, i, ai, m, bj, wr, wc, fr, fq);
#pragma unroll
                    for (int e = 0; e < 4; e += 2) {
                        { const f32x2v num = {(float)((gc.x >> (8 * e)) & 255u), (float)((gc.x >> (8 * e + 8)) & 255u)}, den = {__builtin_amdgcn_rcpf((float)((gn.x >> (8 * e)) & 255u)), __builtin_amdgcn_rcpf((float)((gn.x >> (8 * e + 8)) & 255u))};
                          const f32x2v r = num * den; f32x2v v = {acc[ai][bj][m][0][e], acc[ai][bj][m][0][e + 1]}; v = v * r; acc[ai][bj][m][0][e] = v[0]; acc[ai][bj][m][0][e + 1] = v[1]; }
                        { const f32x2v num = {(float)((gc.y >> (8 * e)) & 255u), (float)((gc.y >> (8 * e + 8)) & 255u)}, den = {__builtin_amdgcn_rcpf((float)((gn.y >> (8 * e)) & 255u)), __builtin_amdgcn_rcpf((float)((gn.y >> (8 * e + 8)) & 255u))};
                          const f32x2v r = num * den; f32x2v v = {acc[ai][bj][m][1][e], acc[ai][bj][m][1][e + 1]}; v = v * r; acc[ai][bj][m][1][e] = v[0]; acc[ai][bj][m][1][e + 1] = v[1]; } }
                    } }
    }
    __device__ __forceinline__ void fin(const f32x4 (&acc)[2][2][4][2], const State& st, const pg8::Unit& u, int wr, int wc, int fr, int fq) const {
#pragma unroll
        for (int ai = 0; ai < 2; ++ai)
#pragma unroll
            for (int m = 0; m < 4; ++m) { const size_t row = (size_t)(u.pm * 256 + ai * 128 + wr * 64 + m * 16 + fr); const int col = u.pn * 256 + wc * 32 + 8 * fq;
#pragma unroll
                for (int bj = 0; bj < 2; ++bj) { const u32x2 g3 = *(const u32x2*)gptr(u, 3, ai, m, bj, wr, wc, fr, fq); float g[8];
#pragma unroll
                    for (int e = 0; e < 4; ++e) { g[e] = (float)((g3.x >> (8 * e)) & 255u) * gscale; g[4 + e] = (float)((g3.y >> (8 * e)) & 255u) * gscale; }
                    const f32x4 v0 = acc[ai][bj][m][0], v1 = acc[ai][bj][m][1];
                    u32x4 w; w.x = pg8::cvt_pk_bf16(v0[0] * g[0], v0[1] * g[1]); w.y = pg8::cvt_pk_bf16(v0[2] * g[2], v0[3] * g[3]); w.z = pg8::cvt_pk_bf16(v1[0] * g[4], v1[1] * g[5]); w.w = pg8::cvt_pk_bf16(v1[2] * g[6], v1[3] * g[7]);
                    (void)w;
                    u32x2 w8; unsigned p8 = 0u; p8 = __builtin_amdgcn_cvt_pk_fp8_f32(v0[0] * g[0], v0[1] * g[1], p8, false); p8 = __builtin_amdgcn_cvt_pk_fp8_f32(v0[2] * g[2], v0[3] * g[3], p8, true); w8.x = p8;
                    p8 = 0u; p8 = __builtin_amdgcn_cvt_pk_fp8_f32(v1[0] * g[4], v1[1] * g[5], p8, false); p8 = __builtin_amdgcn_cvt_pk_fp8_f32(v1[2] * g[6], v1[3] * g[7], p8, true); w8.y = p8;
                    *(u32x2*)((unsigned char*)ACC + row * 2048 + col + bj * 128) = w8; } }
    }
};
struct EpiOut { static constexpr bool PERM = true; bf16* MX; int nop; float scale;
    __device__ __forceinline__ void operator()(const f32x4 (&acc)[2][2][4][2], const pg8::Unit& u, int wr, int wc, int fr, int fq) const {
        if (nop && acc[0][0][0][0][0] != 1.2345e30f) return;
#pragma unroll
        for (int ai = 0; ai < 2; ++ai)
#pragma unroll
            for (int m = 0; m < 4; ++m) { bf16* rowp = MX + (size_t)(u.pm * 256 + ai * 128 + wr * 64 + m * 16 + fr) * D + u.pn * 256 + wc * 32 + 8 * fq;
#pragma unroll
                for (int bj = 0; bj < 2; ++bj) { const f32x4 v0 = acc[ai][bj][m][0] * scale, v1 = acc[ai][bj][m][1] * scale;
                    u32x4 w; w.x = pg8::cvt_pk_bf16(v0[0], v0[1]); w.y = pg8::cvt_pk_bf16(v0[2], v0[3]); w.z = pg8::cvt_pk_bf16(v1[0], v1[1]); w.w = pg8::cvt_pk_bf16(v1[2], v1[3]);
                    *(u32x4*)(rowp + bj * 128) = w; } }
    }
};
struct EpiMoe1 { static constexpr bool PERM = true; bf16* ACT; __amdgpu_buffer_rsrc_t rs; const float* RS; const int* LIST; const LAS int* tab; const unsigned* wm;
    __device__ __forceinline__ void operator()(const f32x4 (&acc)[2][2][4][2], const pg8::Unit& u, int wr, int wc, int fr, int fq) const {
#pragma unroll
        for (int ai = 0; ai < 2; ++ai)
#pragma unroll
            for (int m = 0; m < 4; ++m) { int ri = 256 * (u.pm - tab[16 + u.e]) + ai * 128 + wr * 64 + m * 16 + fr; const int lastr = tab[u.e] - 1; ri = ri < lastr ? ri : lastr;
                const float sg = __uint_as_float(wm[4 + u.e]) * (1.f / 128.f), su = __uint_as_float(wm[36 + u.e]) * (1.f / 128.f); (void)ri;
                const f32x4 fg0 = acc[ai][0][m][0], fg1 = acc[ai][0][m][1], fu0 = acc[ai][1][m][0], fu1 = acc[ai][1][m][1]; float o[8];
#pragma unroll
                for (int e = 0; e < 4; ++e) { const float ga = fg0[e] * sg, gb = fg1[e] * sg; o[e] = ga * sigmoidf_(ga) * (fu0[e] * su); o[4 + e] = gb * sigmoidf_(gb) * (fu1[e] * su); }
                u32x2 w; unsigned p = 0u;
                p = __builtin_amdgcn_cvt_pk_fp8_f32(o[0] * 8.f, o[1] * 8.f, p, false); p = __builtin_amdgcn_cvt_pk_fp8_f32(o[2] * 8.f, o[3] * 8.f, p, true); w.x = p; p = 0u;
                p = __builtin_amdgcn_cvt_pk_fp8_f32(o[4] * 8.f, o[5] * 8.f, p, false); p = __builtin_amdgcn_cvt_pk_fp8_f32(o[6] * 8.f, o[7] * 8.f, p, true); w.y = p;
                __builtin_amdgcn_raw_buffer_store_b64(w, rs, (int)((unsigned)(u.pm * 256 + ai * 128 + wr * 64 + m * 16 + fr) * 1024u + (unsigned)(u.pn * 128 + wc * 32 + 8 * fq)), 0, 16); }
    }
};
struct EpiMoe2 { static constexpr bool PERM = true; bf16* Y; const int* LIST; const float* LISTW; const LAS int* tab;
    __device__ __forceinline__ void operator()(const f32x4 (&acc)[2][2][4][2], const pg8::Unit& u, int wr, int wc, int fr, int fq) const {
        const int ri0 = 256 * (u.pm - tab[16 + u.e]);
#pragma unroll
        for (int ai = 0; ai < 2; ++ai)
#pragma unroll
            for (int m = 0; m < 4; ++m) { const int rt = ai * 128 + wr * 64 + m * 16 + fr;
                if (rt < u.cnt) { const int tk = LIST[u.e * CAP + ri0 + rt]; const float wv = LISTW[u.e * CAP + ri0 + rt]; bf16* rowp = Y + (size_t)tk * D + u.pn * 256 + wc * 32 + 8 * fq;
#pragma unroll
                    for (int bj = 0; bj < 2; ++bj) { const f32x4 v0 = acc[ai][bj][m][0] * wv, v1 = acc[ai][bj][m][1] * wv;
                        u32x4 w; w.x = pg8::cvt_pk_bf16(v0[0], v0[1]); w.y = pg8::cvt_pk_bf16(v0[2], v0[3]); w.z = pg8::cvt_pk_bf16(v1[0], v1[1]); w.w = pg8::cvt_pk_bf16(v1[2], v1[3]);
                        *(u32x4*)(rowp + bj * 128) = w; } }
                __builtin_amdgcn_sched_barrier(0); }
    }
};
__device__ __forceinline__ void phase_proj2(const Args& a, int l, LAS unsigned char* lds) {
#if FP8Z
    const unsigned* wm = (const unsigned*)(a.ws + WS_CTL) + CW_WMAX;
    {
        const char* W = (const char*)(a.ws + WS_WCAT8) + (size_t)l * 12288 * 2048;
        DenseOrder S{64, 16, 16, 0, 64, (int)gridDim.x, (int)blockIdx.x, 2048, 2048, W};
        EpiProjT<true> E{(bf16*)(a.ws + WS_Z), (unsigned char*)(a.ws + WS_G8), 0, __uint_as_float(wm[l]) * (1.f / 127.f), (const float*)(a.ws + WS_RS), 0.f};
        pg8::gemm256<EpiProjT<true>, DenseOrder, false, 2>(lds, (const char*)(a.ws + WS_H8I), 2048, S, E);
        const char* Wz = (const char*)(a.ws + WS_WCAT) + (size_t)l * 4096 * 2048 * 2;
        sk_gemm_ctx(lds, (const bf16*)(a.ws + WS_H), 2048, (const bf16*)Wz, 2048, 2048, 4096, SkNoPre{}, SkEpiProj{(bf16*)(a.ws + WS_Z)}, (int)threadIdx.x, (int)(threadIdx.x >> 6), (int)(threadIdx.x & 63));
    }
    {
        const char* W = (const char*)(a.ws + WS_WCAT8) + ((size_t)l * 12288 + 4096) * 2048;
        DenseOrder S{64, 32, 32, l == 0 ? 64 : 0, 64, (int)gridDim.x, (int)blockIdx.x, 2048, 2048, W};
        EpiProj E{(bf16*)(a.ws + WS_Z), (unsigned char*)(a.ws + WS_G8), 16, __uint_as_float(wm[2 + l]) * (1.f / 128.f)};
        pg8::gemm256<EpiProj, DenseOrder, false, 1>(lds, (const char*)(a.ws + WS_H8), 2048, S, E);
    }
#if FP8Z == 2
    {
        const char* W = (const char*)(a.ws + WS_WCAT) + ((size_t)l * 4096 + 9 * 256) * 2048 * 2;
        DenseOrder S{64, 7, 7, 0, 64, (int)gridDim.x, (int)blockIdx.x, 4096, 4096, W};
        EpiProj E{(bf16*)(a.ws + WS_Z), (unsigned char*)(a.ws + WS_G8), 9, 1.f};
        pg8::gemm256<EpiProj, DenseOrder, false, 0>(lds, (const char*)(a.ws + WS_H), 4096, S, E);
    }
#elif FP8Z == 3
    {
        const char* W = (const char*)(a.ws + WS_WCAT) + ((size_t)l * 4096) * 2048 * 2;
        DenseOrder S{64, 9, 9, 0, 64, (int)gridDim.x, (int)blockIdx.x, 4096, 4096, W};
        EpiProj E{(bf16*)(a.ws + WS_Z), (unsigned char*)(a.ws + WS_G8), 0, 1.f};
        pg8::gemm256<EpiProj, DenseOrder, false, 0>(lds, (const char*)(a.ws + WS_H), 4096, S, E);
    }
#endif
#else
    {
        const char* W = (const char*)(a.ws + WS_WCAT) + (size_t)l * 4096 * 2048 * 2;
        DenseOrder S{64, 16, 16, 0, 64, (int)gridDim.x, (int)blockIdx.x, 4096, 4096, W};
        EpiProj E{(bf16*)(a.ws + WS_Z), (unsigned char*)(a.ws + WS_G8), 0, 1.f};
        pg8::gemm256<EpiProj, DenseOrder, false, 0>(lds, (const char*)(a.ws + WS_H), 4096, S, E);
        sk_gemm_ctx(lds, (const bf16*)(a.ws + WS_H), 2048, (const bf16*)W, 2048, 2048, 4096, SkNoPre{}, SkEpiProj{(bf16*)(a.ws + WS_Z)}, (int)threadIdx.x, (int)(threadIdx.x >> 6), (int)(threadIdx.x & 63));
    }
    {
        const char* W = (const char*)(a.ws + WS_WCAT8) + ((size_t)l * 12288 + 4096) * 2048;
        DenseOrder S{64, 32, 32, l == 0 ? 64 : 0, 64, (int)gridDim.x, (int)blockIdx.x, 2048, 2048, W};
        EpiProj E{(bf16*)(a.ws + WS_Z), (unsigned char*)(a.ws + WS_G8), 16, 1.f / W8SCALE};
        pg8::gemm256<EpiProj, DenseOrder, false, 1>(lds, (const char*)(a.ws + WS_H8), 2048, S, E);
    }
#endif
}
__device__ __forceinline__ void phase_merge2(const Args& a, int l, LAS unsigned char* lds) {
    const char* W = (const char*)(a.ws + WS_WB) + (size_t)l * 2048 * 2048 * 2;
    DenseOrder S{64, 8, 8, 0, 64, (int)gridDim.x, (int)blockIdx.x, 2048, 2048, (const char*)(a.ws + WS_WB8) + (size_t)l * 2048 * 2048};
    EpiMerge E{(const bf16*)(a.ws + WS_G8), (bf16*)(a.ws + WS_ACC8), __uint_as_float(((const unsigned*)(a.ws + WS_CTL))[CW_WMAX + 102 + l]) * (1.f / (128.f * 255.f))};
    int kbm = 2048; asm volatile("" : "+s"(kbm));
    pg8::gemm256<EpiMerge, DenseOrder, true, 1>(lds, (const char*)(a.ws + WS_O8), kbm, S, E);
    if (l == 0) sk_gemm_ctx(lds, (const bf16*)(a.ws + WS_O), 2048, (const bf16*)W, 2048, 2048, 2048, SkPreMerge{(const bf16*)(a.ws + WS_G8)}, SkEpiAcc{(bf16*)(a.ws + WS_ACC), DP}, (int)threadIdx.x, (int)(threadIdx.x >> 6), (int)(threadIdx.x & 63));
}
__device__ __forceinline__ void phase_outproj2(const Args& a, int l, LAS unsigned char* lds, int nop = 0) {
    const char* W = (const char*)(a.ws + WS_WO) + (size_t)l * 2048 * DP * 2;
    const char* W8 = (const char*)(a.ws + WS_WO8) + (size_t)l * 2048 * 2048;
    DenseOrder S{64, 8, 8, 0, 64, (int)gridDim.x, (int)blockIdx.x, 2048, 2048, W8};
    EpiOut E{(bf16*)(a.ws + WS_MX), nop, __uint_as_float(((const unsigned*)(a.ws + WS_CTL))[CW_WMAX + 68 + l]) * (1.f / 128.f)};
    pg8::gemm256<EpiOut, DenseOrder, false, 1>(lds, (const char*)(a.ws + WS_ACC8), 2048, S, E);
    if (l == 0 && !nop) sk_gemm_ctx(lds, (const bf16*)(a.ws + WS_ACC), DP, (const bf16*)W, DP, 2048, 2048, SkNoPre{}, SkEpiAcc{(bf16*)(a.ws + WS_MX), D}, (int)threadIdx.x, (int)(threadIdx.x >> 6), (int)(threadIdx.x & 63));
}
constexpr int CW_T2 = 16384;
__device__ __forceinline__ void phase_moe12(const Args& a, int l, LAS unsigned char* lds, int tid) {
    LAS int* tab = (LAS int*)(lds + pg8::STAGE_BYTES); moe_table(a, l, tab, tid);
    unsigned* tcnt = (unsigned*)(a.ws + WS_CTL) + CW_T2 + 64 * 160 * l; unsigned* tmo = (unsigned*)(a.ws + WS_CTL) + 8;
    const int G = (int)gridDim.x, c = (int)blockIdx.x, N1 = tab[32] * 8;
    {
        MoeOrder S{tab, G, c, 2048, 1, (const int*)(a.ws + WS_LIST), (const char*)(a.ws + WS_WGU) + (size_t)l * 16 * 2048 * 2048, (size_t)2048 * 2048, 0, 0, tcnt, tmo};
        EpiMoe1 E{(bf16*)(a.ws + WS_ACT), __builtin_amdgcn_make_buffer_rsrc((void*)(a.ws + WS_ACT), 0, 0x7fffffff, 0x00020000), (const float*)(a.ws + WS_RS), (const int*)(a.ws + WS_LIST), tab, (const unsigned*)(a.ws + WS_CTL) + CW_WMAX + 16 * l};
        pg8::gemm256<EpiMoe1, MoeOrder, false, 1>(lds, (const char*)(a.ws + WS_H8I), 2048, S, E);
    }
    {
        const int i0 = N1 > c ? (N1 - c + G - 1) / G : 0;
        MoeDownOrder S{tab, G, c, 1024, (const char*)(a.ws + WS_WD) + (size_t)l * 16 * 2048 * 1024, (size_t)2048 * 1024, i0, N1, tcnt, tmo};
        EpiMoe2 E{(bf16*)(a.ws + WS_Y), (const int*)(a.ws + WS_LIST), (const float*)(a.ws + WS_LISTW), tab};
        int kb2 = 1024; asm volatile("" : "+s"(kb2));
        pg8::gemm256<EpiMoe2, MoeDownOrder, false, 1>(lds, (const char*)(a.ws + WS_ACT), kb2, S, E);
    }
}

__device__ __forceinline__ void ostore4(bf16* OB, size_t row, int col, const u32x2 o) {
    if (row < (size_t)ML) { unsigned p = 0u; p = __builtin_amdgcn_cvt_pk_fp8_f32(bf2f(o.x & 0xffffu), bf2f(o.x >> 16), p, false); p = __builtin_amdgcn_cvt_pk_fp8_f32(bf2f(o.y & 0xffffu), bf2f(o.y >> 16), p, true);
        *(unsigned*)((unsigned char*)OB + (WS_O8 - WS_O) + row * 2048 + col) = p; }
    else *(u32x2*)(OB + row * D + col) = o;
}
__device__ __forceinline__ void ostore8(bf16* OB, size_t row, int col, const u32x4 o) {
    if (row < (size_t)ML) { u32x2 w; unsigned p = 0u; p = __builtin_amdgcn_cvt_pk_fp8_f32(bf2f(o.x & 0xffffu), bf2f(o.x >> 16), p, false); p = __builtin_amdgcn_cvt_pk_fp8_f32(bf2f(o.y & 0xffffu), bf2f(o.y >> 16), p, true); w.x = p; p = 0u;
        p = __builtin_amdgcn_cvt_pk_fp8_f32(bf2f(o.z & 0xffffu), bf2f(o.z >> 16), p, false); p = __builtin_amdgcn_cvt_pk_fp8_f32(bf2f(o.w & 0xffffu), bf2f(o.w >> 16), p, true); w.y = p;
        *(u32x2*)((unsigned char*)OB + (WS_O8 - WS_O) + row * 2048 + col) = w; }
    else *(u32x4*)(OB + row * D + col) = o;
}
__device__ __forceinline__ void attn_unit(const Args& a, int l, int u, LAS unsigned char* lds, int tid, int wave, int lane) {
    const bf16* Z = (const bf16*)(a.ws + WS_Z); bf16* OB = (bf16*)(a.ws + WS_O);
    const float* ROPEC = (const float*)(a.ws + WS_ROPE); const float* ROPES = ROPEC + 2048;
    LAS bf16* Ks = (LAS bf16*)lds;
    LAS bf16* VT = (LAS bf16*)(lds + 128 * 72 * 2);
    const int fr = lane & 15, fq = lane >> 4;
    {
        int b, kvh, nb; const bool isctx = u >= 256;
        if (!isctx) { b = u >> 7; kvh = (u >> 6) & 1; nb = u & 63; } else { const int v = u - 256; b = v >> 2; kvh = (v >> 1) & 1; nb = v & 1; }
        const int h = kvh * 4 + (wave >> 1), qs = (wave & 1) * 64;
        bf16x8 Qf[4][2];
#pragma unroll
        for (int qb = 0; qb < 4; ++qb) { const int tq = nb * 128 + qs + 16 * qb + fr; const size_t row = isctx ? (size_t)ML + b * 256 + tq : (size_t)b * SEQ + tq;
            const bf16* qp = Z + row * ZS + ZQ + h * 64;
#pragma unroll
            for (int ks = 0; ks < 2; ++ks) { float o[8]; unpack8(*(const u32x4*)(qp + 32 * ks + 8 * fq), o);
                if (!isctx) { float p[8]; unpack8(*(const u32x4*)(qp + 32 * ks + 8 * (fq ^ 2)), p); const int pos = ks == 0 ? (tq >> 6) : (tq & 63);
                    const float* cs = ROPEC + pos * 16 + 8 * (fq & 1); const float* sn = ROPES + pos * 16 + 8 * (fq & 1);
#pragma unroll
                    for (int e = 0; e < 8; ++e) o[e] = fq < 2 ? o[e] * cs[e] - p[e] * sn[e] : o[e] * cs[e] + p[e] * sn[e]; }
#pragma unroll
                for (int e = 0; e < 8; ++e) o[e] *= 0.125f * LOG2E;
                Qf[qb][ks] = __builtin_bit_cast(bf16x8, pack8(o)); } }
        float m[4], lsum[4]; f32x4 O[4][4];
        const float sinkv = a.in[10][l * 8 + h] * LOG2E;
#pragma unroll
        for (int qb = 0; qb < 4; ++qb) { m[qb] = sinkv; lsum[qb] = fq == 0 ? 1.f : 0.f;
#pragma unroll
            for (int db = 0; db < 4; ++db) O[qb][db] = (f32x4){0.f, 0.f, 0.f, 0.f}; }
        const int ntile = isctx ? 2 : 5;
#pragma unroll 1
        for (int kt = 0; kt < ntile; ++kt) {
            const bool isband = (!isctx && kt < 3);
            const int kblk = nb - 1 + kt;
            if (isband && (kblk < 0 || kblk > 63)) continue;
            const size_t krow0 = isband ? (size_t)b * SEQ + kblk * 128 : (size_t)ML + b * 256 + (isctx ? kt : kt - 3) * 128;
            __syncthreads();
            { const int key = tid >> 2, part = tid & 3, ks = part >> 1, sub = part & 1;
                const bf16* kp = Z + (krow0 + key) * ZS + ZK + kvh * 64 + 32 * ks + 8 * sub;
                float fa[8], fb[8]; unpack8(*(const u32x4*)kp, fa); unpack8(*(const u32x4*)(kp + 16), fb);
                if (isband) { const int tk = kblk * 128 + key; const int pos = ks == 0 ? (tk >> 6) : (tk & 63); const float* cs = ROPEC + pos * 16 + 8 * sub; const float* sn = ROPES + pos * 16 + 8 * sub;
#pragma unroll
                    for (int e = 0; e < 8; ++e) { const float x1 = fa[e], x2 = fb[e]; fa[e] = x1 * cs[e] - x2 * sn[e]; fb[e] = x2 * cs[e] + x1 * sn[e]; } }
                *(LAS u32x4*)(Ks + key * 72 + 32 * ks + 8 * sub) = pack8(fa); *(LAS u32x4*)(Ks + key * 72 + 32 * ks + 16 + 8 * sub) = pack8(fb);
                const bf16* vp = Z + (krow0 + key) * ZS + ZV + kvh * 64 + 16 * part;
                const u32x4 v0 = *(const u32x4*)vp, v1 = *(const u32x4*)(vp + 8);
                LAS bf16* vt = VT + (16 * part) * 136 + key;
                vt[0 * 136] = (bf16)(v0.x & 0xffffu); vt[1 * 136] = (bf16)(v0.x >> 16); vt[2 * 136] = (bf16)(v0.y & 0xffffu); vt[3 * 136] = (bf16)(v0.y >> 16);
                vt[4 * 136] = (bf16)(v0.z & 0xffffu); vt[5 * 136] = (bf16)(v0.z >> 16); vt[6 * 136] = (bf16)(v0.w & 0xffffu); vt[7 * 136] = (bf16)(v0.w >> 16);
                vt[8 * 136] = (bf16)(v1.x & 0xffffu); vt[9 * 136] = (bf16)(v1.x >> 16); vt[10 * 136] = (bf16)(v1.y & 0xffffu); vt[11 * 136] = (bf16)(v1.y >> 16);
                vt[12 * 136] = (bf16)(v1.z & 0xffffu); vt[13 * 136] = (bf16)(v1.z >> 16); vt[14 * 136] = (bf16)(v1.w & 0xffffu); vt[15 * 136] = (bf16)(v1.w >> 16); }
            __syncthreads();
#pragma unroll 1
            for (int kk = 0; kk < 4; ++kk) {
                bf16x8 Kf[2][2], Vf[4];
#pragma unroll
                for (int kb2 = 0; kb2 < 2; ++kb2)
#pragma unroll
                    for (int ks = 0; ks < 2; ++ks) Kf[kb2][ks] = *(const LAS bf16x8*)(Ks + (32 * kk + 16 * kb2 + fr) * 72 + 32 * ks + 8 * fq);
#pragma unroll
                for (int db = 0; db < 4; ++db) { const s16x4 lo = *(const LAS s16x4*)(VT + (16 * db + fr) * 136 + 32 * kk + 4 * fq), hi = *(const LAS s16x4*)(VT + (16 * db + fr) * 136 + 32 * kk + 16 + 4 * fq);
                    Vf[db] = (bf16x8){lo[0], lo[1], lo[2], lo[3], hi[0], hi[1], hi[2], hi[3]}; }
#pragma unroll
                for (int qb = 0; qb < 4; ++qb) {
                    f32x4 s0 = {0.f, 0.f, 0.f, 0.f}, s1 = s0;
                    s0 = MFMA16(Kf[0][0], Qf[qb][0], s0); s0 = MFMA16(Kf[0][1], Qf[qb][1], s0);
                    s1 = MFMA16(Kf[1][0], Qf[qb][0], s1); s1 = MFMA16(Kf[1][1], Qf[qb][1], s1);
                    if (isband && kt != 1) { const int tq = nb * 128 + qs + 16 * qb + fr;
#pragma unroll
                        for (int e = 0; e < 4; ++e) { const int d0 = kblk * 128 + 32 * kk + 4 * fq + e - tq, d1 = d0 + 16;
                            if (d0 > 128 || d0 < -128) s0[e] = -1e30f; if (d1 > 128 || d1 < -128) s1[e] = -1e30f; } }
                    float mx = fmaxf(fmaxf(fmaxf(s0[0], s0[1]), fmaxf(s0[2], s0[3])), fmaxf(fmaxf(s1[0], s1[1]), fmaxf(s1[2], s1[3])));
                    mx = fmaxf(mx, __shfl_xor(mx, 16)); mx = fmaxf(mx, __shfl_xor(mx, 32));
                    const float mn = fmaxf(m[qb], mx), alpha = __builtin_amdgcn_exp2f(m[qb] - mn); m[qb] = mn;
                    float p[8]; float ps = 0.f;
#pragma unroll
                    for (int e = 0; e < 4; ++e) { p[e] = __builtin_amdgcn_exp2f(s0[e] - mn); p[4 + e] = __builtin_amdgcn_exp2f(s1[e] - mn); ps += p[e] + p[4 + e]; }
                    lsum[qb] = lsum[qb] * alpha + ps;
                    const bf16x8 Pf = __builtin_bit_cast(bf16x8, pack8(p));
#pragma unroll
                    for (int db = 0; db < 4; ++db) { O[qb][db] = O[qb][db] * alpha; O[qb][db] = MFMA16(Vf[db], Pf, O[qb][db]); }
                    __builtin_amdgcn_sched_barrier(0);
                }
            }
        }
#pragma unroll
        for (int qb = 0; qb < 4; ++qb) { float ls = lsum[qb]; ls += __shfl_xor(ls, 16); ls += __shfl_xor(ls, 32); const float inv = 1.f / ls;
            const int tq = nb * 128 + qs + 16 * qb + fr; const size_t row = isctx ? (size_t)ML + b * 256 + tq : (size_t)b * SEQ + tq;
#pragma unroll
            for (int db = 0; db < 4; ++db) { u32x2 o; o.x = pk2(O[qb][db][0] * inv, O[qb][db][1] * inv); o.y = pk2(O[qb][db][2] * inv, O[qb][db][3] * inv);
                *(u32x2*)(OB + row * D + h * 64 + 16 * db + 4 * fq) = o; } }
    }
}


__device__ __forceinline__ void attn2_stage_k(LAS bf16* Ks, const bf16* Z, const float* ROPEC, const float* ROPES, size_t krow0, int kvh, int slot, bool rope, int kblk, int tid) {
    const int key = tid >> 2, part = tid & 3, ks = part >> 1, sub = part & 1;
    const bf16* kp = Z + (krow0 + key) * ZS + ZK + kvh * 64 + 32 * ks + 8 * sub;
    float fa[8], fb[8]; unpack8(*(const u32x4*)kp, fa); unpack8(*(const u32x4*)(kp + 16), fb);
    if (rope) { const int tk = kblk * 128 + key; const int pos = ks == 0 ? (tk >> 6) : (tk & 63); const float* cs = ROPEC + pos * 16 + 8 * sub; const float* sn = ROPES + pos * 16 + 8 * sub;
#pragma unroll
        for (int e = 0; e < 8; ++e) { const float x1 = fa[e], x2 = fb[e]; fa[e] = x1 * cs[e] - x2 * sn[e]; fb[e] = x2 * cs[e] + x1 * sn[e]; } }
    LAS bf16* kd = Ks + (slot * 128 + key) * 72 + 32 * ks + 8 * sub;
    *(LAS u32x4*)kd = pack8(fa); *(LAS u32x4*)(kd + 16) = pack8(fb);
}
__device__ __forceinline__ void attn2_load_v(const bf16* Z, size_t krow0, int kvh, int tid, u32x4& v0, u32x4& v1) {
    const bf16* vp = Z + (krow0 + (tid >> 2)) * ZS + ZV + kvh * 64 + 16 * (tid & 3); v0 = *(const u32x4*)vp; v1 = *(const u32x4*)(vp + 8);
}
__device__ __forceinline__ void attn2_write_vt(LAS bf16* VT, int tid, const u32x4 v0, const u32x4 v1) {
    LAS bf16* vt = VT + (16 * (tid & 3)) * 136 + 8 * ((((tid >> 2) >> 3) + 4 * (tid & 3)) & 15) + ((tid >> 2) & 7);
    vt[0 * 136] = (bf16)(v0.x & 0xffffu); vt[1 * 136] = (bf16)(v0.x >> 16); vt[2 * 136] = (bf16)(v0.y & 0xffffu); vt[3 * 136] = (bf16)(v0.y >> 16);
    vt[4 * 136] = (bf16)(v0.z & 0xffffu); vt[5 * 136] = (bf16)(v0.z >> 16); vt[6 * 136] = (bf16)(v0.w & 0xffffu); vt[7 * 136] = (bf16)(v0.w >> 16);
    vt[8 * 136] = (bf16)(v1.x & 0xffffu); vt[9 * 136] = (bf16)(v1.x >> 16); vt[10 * 136] = (bf16)(v1.y & 0xffffu); vt[11 * 136] = (bf16)(v1.y >> 16);
    vt[12 * 136] = (bf16)(v1.z & 0xffffu); vt[13 * 136] = (bf16)(v1.z >> 16); vt[14 * 136] = (bf16)(v1.w & 0xffffu); vt[15 * 136] = (bf16)(v1.w >> 16);
}
__device__ __forceinline__ void attn_unit2(const Args& a, int l, int u, LAS unsigned char* lds, int tid, int wave, int lane) {
    const bf16* Z = (const bf16*)(a.ws + WS_Z); bf16* OB = (bf16*)(a.ws + WS_O);
    const float* ROPEC = (const float*)(a.ws + WS_ROPE); const float* ROPES = ROPEC + 2048;
    LAS bf16* Ks = (LAS bf16*)lds;
    LAS bf16* VT0 = (LAS bf16*)(lds + 92160);
    const int fr = lane & 15, fq = lane >> 4;
    int b, kvh, nb; const bool isctx = u >= 256;
    if (!isctx) { b = u >> 7; kvh = (u >> 6) & 1; nb = u & 63; } else { const int v = u - 256; b = v >> 2; kvh = (v >> 1) & 1; nb = v & 1; }
    const int h = kvh * 4 + (wave >> 1), qs = (wave & 1) * 64;
    const int ntile = isctx ? 2 : 5;
    __syncthreads();
#pragma unroll
    for (int kt = 0; kt < 5; ++kt) {
        if (kt >= ntile) continue;
        const bool isband = (!isctx && kt < 3); const int kblk = nb - 1 + kt;
        if (isband && (kblk < 0 || kblk > 63)) continue;
        const size_t krow0 = isband ? (size_t)b * SEQ + kblk * 128 : (size_t)ML + b * 256 + (isctx ? kt : kt - 3) * 128;
        attn2_stage_k(Ks, Z, ROPEC, ROPES, krow0, kvh, kt, isband, kblk, tid);
    }
    bf16x8 Qf[4][2];
#pragma unroll
    for (int qb = 0; qb < 4; ++qb) { const int tq = nb * 128 + qs + 16 * qb + fr; const size_t row = isctx ? (size_t)ML + b * 256 + tq : (size_t)b * SEQ + tq;
        const bf16* qp = Z + row * ZS + ZQ + h * 64;
#pragma unroll
        for (int ks = 0; ks < 2; ++ks) { float o[8]; unpack8(*(const u32x4*)(qp + 32 * ks + 8 * fq), o);
            if (!isctx) { float p[8]; unpack8(*(const u32x4*)(qp + 32 * ks + 8 * (fq ^ 2)), p); const int pos = ks == 0 ? (tq >> 6) : (tq & 63);
                const float* cs = ROPEC + pos * 16 + 8 * (fq & 1); const float* sn = ROPES + pos * 16 + 8 * (fq & 1);
#pragma unroll
                for (int e = 0; e < 8; ++e) o[e] = fq < 2 ? o[e] * cs[e] - p[e] * sn[e] : o[e] * cs[e] + p[e] * sn[e]; }
#pragma unroll
            for (int e = 0; e < 8; ++e) o[e] *= 0.125f * LOG2E;
            Qf[qb][ks] = __builtin_bit_cast(bf16x8, pack8(o)); } }
    int first = 0; if (!isctx && nb == 0) first = 1;
    { const bool isband = (!isctx && first < 3); const int kblk = nb - 1 + first;
      const size_t krow0 = isband ? (size_t)b * SEQ + kblk * 128 : (size_t)ML + b * 256 + (isctx ? first : first - 3) * 128;
      u32x4 v0, v1; attn2_load_v(Z, krow0, kvh, tid, v0, v1); attn2_write_vt(VT0, tid, v0, v1); }
    __syncthreads();
    float mx[4]; const float sinkv = a.in[10][l * 8 + h] * LOG2E;
#pragma unroll
    for (int qb = 0; qb < 4; ++qb) mx[qb] = -3.0e38f;
#pragma unroll 1
    for (int kt = 0; kt < ntile; ++kt) {
        const bool isband = (!isctx && kt < 3); const int kblk = nb - 1 + kt;
        if (isband && (kblk < 0 || kblk > 63)) continue;
#pragma unroll 1
        for (int kk = 0; kk < 4; ++kk) {
            bf16x8 Kf[2][2];
#pragma unroll
            for (int kb2 = 0; kb2 < 2; ++kb2)
#pragma unroll
                for (int ks = 0; ks < 2; ++ks) Kf[kb2][ks] = *(const LAS bf16x8*)(Ks + (kt * 128 + 32 * kk + 16 * kb2 + fr) * 72 + 32 * ks + 8 * fq);
#pragma unroll
            for (int qb = 0; qb < 4; ++qb) {
                if (isband && ((kt == 0 && 32 * kk + 31 < qs + 16 * qb) || (kt == 2 && 32 * kk > qs + 16 * qb + 15))) continue;
                f32x4 s0 = {0.f, 0.f, 0.f, 0.f}, s1 = s0;
                s0 = MFMA16(Kf[0][0], Qf[qb][0], s0); s0 = MFMA16(Kf[0][1], Qf[qb][1], s0);
                s1 = MFMA16(Kf[1][0], Qf[qb][0], s1); s1 = MFMA16(Kf[1][1], Qf[qb][1], s1);
                if (isband && kt != 1) { const int tq = nb * 128 + qs + 16 * qb + fr;
#pragma unroll
                    for (int e = 0; e < 4; ++e) { const int d0 = kblk * 128 + 32 * kk + 4 * fq + e - tq, d1 = d0 + 16;
                        if (d0 > 128 || d0 < -128) s0[e] = -1e30f; if (d1 > 128 || d1 < -128) s1[e] = -1e30f; } }
                mx[qb] = fmaxf(mx[qb], fmaxf(fmaxf(fmaxf(s0[0], s0[1]), fmaxf(s0[2], s0[3])), fmaxf(fmaxf(s1[0], s1[1]), fmaxf(s1[2], s1[3]))));
            }
        }
    }
    float lsum[4]; f32x4 O[4][4]; float negm[4];
#pragma unroll
    for (int qb = 0; qb < 4; ++qb) { float m = mx[qb]; m = fmaxf(m, __shfl_xor(m, 16)); m = fmaxf(m, __shfl_xor(m, 32)); m = fmaxf(m, sinkv);
        negm[qb] = -m; lsum[qb] = fq == 0 ? __builtin_amdgcn_exp2f(sinkv - m) : 0.f;
#pragma unroll
        for (int db = 0; db < 4; ++db) O[qb][db] = (f32x4){0.f, 0.f, 0.f, 0.f}; }
    int buf = 0;
#pragma unroll 1
    for (int kt = first; kt < ntile; ++kt) {
        const bool isband = (!isctx && kt < 3); const int kblk = nb - 1 + kt;
        if (isband && (kblk < 0 || kblk > 63)) continue;
        int nk = kt + 1; if (!isctx && nk == 2 && nb == 63) nk = 3;
        const bool hasn = nk < ntile;
        u32x4 nv0 = {0u, 0u, 0u, 0u}, nv1 = nv0;
        if (hasn) { const bool nband = (!isctx && nk < 3); const size_t nrow0 = nband ? (size_t)b * SEQ + (nb - 1 + nk) * 128 : (size_t)ML + b * 256 + (isctx ? nk : nk - 3) * 128; attn2_load_v(Z, nrow0, kvh, tid, nv0, nv1); }
        LAS bf16* VT = VT0 + buf * (64 * 136);
#pragma unroll 1
        for (int kk = 0; kk < 4; ++kk) {
            bf16x8 Kf[2][2], Vf[4];
#pragma unroll
            for (int kb2 = 0; kb2 < 2; ++kb2)
#pragma unroll
                for (int ks = 0; ks < 2; ++ks) Kf[kb2][ks] = *(const LAS bf16x8*)(Ks + (kt * 128 + 32 * kk + 16 * kb2 + fr) * 72 + 32 * ks + 8 * fq);
#pragma unroll
            for (int db = 0; db < 4; ++db) { const s16x4 lo = *(const LAS s16x4*)(VT + (16 * db + fr) * 136 + 8 * ((4 * kk + (fq >> 1) + 4 * db) & 15) + 4 * (fq & 1)), hi = *(const LAS s16x4*)(VT + (16 * db + fr) * 136 + 8 * ((4 * kk + 2 + (fq >> 1) + 4 * db) & 15) + 4 * (fq & 1));
                Vf[db] = (bf16x8){lo[0], lo[1], lo[2], lo[3], hi[0], hi[1], hi[2], hi[3]}; }
#pragma unroll
            for (int qb = 0; qb < 4; ++qb) {
                if (isband && ((kt == 0 && 32 * kk + 31 < qs + 16 * qb) || (kt == 2 && 32 * kk > qs + 16 * qb + 15))) continue;
                f32x4 s0 = {negm[qb], negm[qb], negm[qb], negm[qb]}, s1 = s0;
                s0 = MFMA16(Kf[0][0], Qf[qb][0], s0); s0 = MFMA16(Kf[0][1], Qf[qb][1], s0);
                s1 = MFMA16(Kf[1][0], Qf[qb][0], s1); s1 = MFMA16(Kf[1][1], Qf[qb][1], s1);
                if (isband && kt != 1) { const int tq = nb * 128 + qs + 16 * qb + fr;
#pragma unroll
                    for (int e = 0; e < 4; ++e) { const int d0 = kblk * 128 + 32 * kk + 4 * fq + e - tq, d1 = d0 + 16;
                        if (d0 > 128 || d0 < -128) s0[e] = -1e30f; if (d1 > 128 || d1 < -128) s1[e] = -1e30f; } }
                float p[8]; float ps = 0.f;
#pragma unroll
                for (int e = 0; e < 4; ++e) { p[e] = __builtin_amdgcn_exp2f(s0[e]); p[4 + e] = __builtin_amdgcn_exp2f(s1[e]); ps += p[e] + p[4 + e]; }
                lsum[qb] += ps;
                const bf16x8 Pf = __builtin_bit_cast(bf16x8, pack8(p));
#pragma unroll
                for (int db = 0; db < 4; ++db) O[qb][db] = MFMA16(Vf[db], Pf, O[qb][db]);
            }
        }
        if (hasn) attn2_write_vt(VT0 + (buf ^ 1) * (64 * 136), tid, nv0, nv1);
        __syncthreads();
        buf ^= 1;
    }
#pragma unroll
    for (int qb = 0; qb < 4; ++qb) { float ls = lsum[qb]; ls += __shfl_xor(ls, 16); ls += __shfl_xor(ls, 32); const float inv = 1.f / ls;
        const int tq = nb * 128 + qs + 16 * qb + fr; const size_t row = isctx ? (size_t)ML + b * 256 + tq : (size_t)b * SEQ + tq;
#pragma unroll
        for (int db = 0; db < 4; ++db) { u32x2 o; o.x = pk2(O[qb][db][0] * inv, O[qb][db][1] * inv); o.y = pk2(O[qb][db][2] * inv, O[qb][db][3] * inv);
            ostore4(OB, row, h * 64 + 16 * db + 4 * fq, o); } }
}

__device__ __forceinline__ void phase_pool(const Args& a, int l, int wave, int lane) {
    const bf16* Z = (const bf16*)(a.ws + WS_Z); bf16* OB = (bf16*)(a.ws + WS_O);
    const bf16* PWT = (const bf16*)(a.ws + WS_PWT) + (size_t)l * 4 * 128 * 128; const float* pscale = a.in[12] + l * 512;
    const int fr = lane & 15, fq = lane >> 4;
    const int gw = blockIdx.x * 8 + wave, NGW = gridDim.x * 8;
    const int nblk = (l == 0 ? MT : ML) / 16;
    for (int task = gw; task < nblk * 4; task += NGW) {
        const int g = task & 3, tb = task >> 2;
        const int row = tb * 16 + fr;
        int t, n; if (row < ML) { t = row & 8191; n = SEQ; } else { t = (row - ML) & 255; n = CTXL; }
        const int seq0 = row - t, hw = 1 << g;
        const int lo = t - hw > 0 ? t - hw : 0, hi = t + hw < n ? t + hw : n;
        const float inv = 1.f / (float)(hi - lo);
        bf16x8 Af[4];
#pragma unroll
        for (int ks = 0; ks < 4; ++ks) { float s[8] = {0, 0, 0, 0, 0, 0, 0, 0}; const bf16* base = Z + ZP + g * 128 + 32 * ks + 8 * fq;
            for (int tt = lo; tt < hi; ++tt) { float x[8]; unpack8(*(const u32x4*)(base + (size_t)(seq0 + tt) * ZS), x);
#pragma unroll
                for (int e = 0; e < 8; ++e) s[e] += x[e]; }
            float own[8]; unpack8(*(const u32x4*)(base + (size_t)row * ZS), own);
#pragma unroll
            for (int e = 0; e < 8; ++e) s[e] = s[e] * inv - own[e];
            Af[ks] = __builtin_bit_cast(bf16x8, pack8(s)); }
        f32x4 acc[4][2];
#pragma unroll
        for (int cp = 0; cp < 4; ++cp) { acc[cp][0] = (f32x4){0.f, 0.f, 0.f, 0.f}; acc[cp][1] = acc[cp][0]; }
#pragma unroll
        for (int ks = 0; ks < 4; ++ks)
#pragma unroll
            for (int cp = 0; cp < 4; ++cp)
#pragma unroll
                for (int nn = 0; nn < 2; ++nn) { const bf16x8 Bf = *(const bf16x8*)(PWT + (size_t)(g * 128 + 32 * cp + perm16(nn, fr)) * 128 + 32 * ks + 8 * fq); acc[cp][nn] = MFMA16(Bf, Af[ks], acc[cp][nn]); }
#pragma unroll
        for (int cp = 0; cp < 4; ++cp) { const int ch = g * 128 + 32 * cp + 8 * fq; const f32x4 pa = *(const f32x4*)(pscale + ch), pb = *(const f32x4*)(pscale + ch + 4); float o[8];
#pragma unroll
            for (int e = 0; e < 4; ++e) { o[e] = acc[cp][0][e] * pa[e]; o[4 + e] = acc[cp][1][e] * pb[e]; }
            *(u32x4*)(OB + (size_t)row * D + 512 + ch) = pack8(o); }
    }
}

__device__ __forceinline__ void phase_cgate(const Args& a, int l, LAS unsigned char* lds, int tid, int wave, int lane) {
    const bf16* Z = (const bf16*)(a.ws + WS_Z); bf16* OB = (bf16*)(a.ws + WS_O);
    LAS bf16* VT = (LAS bf16*)lds;
    const bf16* WSB = (const bf16*)(a.ws + WS_WSB) + (size_t)l * 4 * 128 * 128;
    const float* lng = a.in[13] + l * 512; const float* lnb = a.in[14] + l * 512; const float* cbs = a.in[16] + l * 512;
    const int fr = lane & 15, fq = lane >> 4;
    const int nch = (l == 0) ? 132 : 128;
    for (int u = blockIdx.x; u < nch * 2; u += gridDim.x) {
        const int ch = u >> 1, gp = u & 1;
        const size_t row0 = (size_t)ch * 128;
        __syncthreads();
        for (int ti = 0; ti < 16; ++ti) {
            const int tok = 16 * wave + ti; float v[8]; unpack8(*(const u32x4*)(Z + (row0 + tok) * ZS + ZUV + 512 + 8 * lane), v);
            float s = 0.f;
#pragma unroll
            for (int e = 0; e < 8; ++e) s += v[e];
            const float mean = wave_sum(s) * (1.f / 512.f); float q = 0.f;
#pragma unroll
            for (int e = 0; e < 8; ++e) { v[e] -= mean; q += v[e] * v[e]; }
            const float rstd = rsqrtf(wave_sum(q) * (1.f / 512.f) + 1e-6f);
            if ((lane >> 5) == gp) { const int c0 = 8 * lane;
#pragma unroll
                for (int e = 0; e < 8; ++e) VT[(c0 - 256 * gp + e) * 136 + tok] = (bf16)f2bf(v[e] * rstd * lng[c0 + e] + lnb[c0 + e]); }
        }
        __syncthreads();
#pragma unroll
        for (int gl = 0; gl < 2; ++gl) { const int g = 2 * gp + gl;
            bf16x8 Vf[4];
#pragma unroll
            for (int ks = 0; ks < 4; ++ks) Vf[ks] = *(const LAS bf16x8*)(VT + (128 * gl + 16 * wave + fr) * 136 + 32 * ks + 8 * fq);
            for (int pb = 0; pb < 8; ++pb) { f32x4 acc = {0.f, 0.f, 0.f, 0.f};
#pragma unroll
                for (int ks = 0; ks < 4; ++ks) { const bf16x8 Wf = *(const bf16x8*)(WSB + (size_t)(g * 128 + 16 * pb + fr) * 128 + 32 * ks + 8 * fq); acc = MFMA16(Vf[ks], Wf, acc); }
                const int p = 16 * pb + fr; const float bsv = cbs[g * 128 + p];
                const u32x2 ur = *(const u32x2*)(Z + (row0 + p) * ZS + ZUV + g * 128 + 16 * wave + 4 * fq);
                u32x2 o; o.x = pk2(bf2f(ur.x & 0xffffu) * (acc[0] + bsv), bf2f(ur.x >> 16) * (acc[1] + bsv)); o.y = pk2(bf2f(ur.y & 0xffffu) * (acc[2] + bsv), bf2f(ur.y >> 16) * (acc[3] + bsv));
                *(u32x2*)(OB + (row0 + p) * D + 1024 + g * 128 + 16 * wave + 4 * fq) = o; } }
    }
}

__device__ __forceinline__ void gla_logg_cum(const Args& a, int l, LAS float* LG, const bf16* Z, size_t row0, int h, int tid) {
    const float* gw2 = a.in[17] + l * 2 * 16 * 256; const float* gb = a.in[18] + l * 2 * 256;
    for (int i = 0; i < 16; ++i) { const int idx = tid + 512 * i, dir = idx >> 12, tok = (idx >> 6) & 63, dk = idx & 63;
        const bf16* gl = Z + (row0 + tok) * ZS + ZGLR + dir * 16; float acc = gb[dir * 256 + h * 64 + dk];
        float ga[8], gc[8]; unpack8(*(const u32x4*)gl, ga); unpack8(*(const u32x4*)(gl + 8), gc);
#pragma unroll
        for (int r = 0; r < 8; ++r) acc += ga[r] * gw2[(dir * 16 + r) * 256 + h * 64 + dk] + gc[r] * gw2[(dir * 16 + 8 + r) * 256 + h * 64 + dk];
        const float ls = fminf(acc, 0.f) - __logf(1.f + __expf(-fabsf(acc)));
        LG[idx] = ls * (1.f / 16.f); }
    __syncthreads();
    if (tid < 128) { const int dir = tid >> 6, dk = tid & 63; float c = 0.f;
        if (dir == 0) { for (int tok = 0; tok < 64; ++tok) { c += LG[tok * 64 + dk]; LG[tok * 64 + dk] = c; } }
        else { for (int tok = 63; tok >= 0; --tok) { c += LG[4096 + tok * 64 + dk]; LG[4096 + tok * 64 + dk] = c; } } }
    __syncthreads();
}
__device__ __forceinline__ void gla_stage_vt(LAS bf16* VT, const bf16* Z, size_t row0, int h, int tid) {
    const int tok = tid >> 3, c8 = tid & 7;
    const bf16* vp = Z + (row0 + tok) * ZS + ZGV + h * 128 + 16 * c8;
    const u32x4 v0 = *(const u32x4*)vp, v1 = *(const u32x4*)(vp + 8);
    LAS bf16* vt = VT + (16 * c8) * 72 + tok;
    vt[0 * 72] = (bf16)(v0.x & 0xffffu); vt[1 * 72] = (bf16)(v0.x >> 16); vt[2 * 72] = (bf16)(v0.y & 0xffffu); vt[3 * 72] = (bf16)(v0.y >> 16);
    vt[4 * 72] = (bf16)(v0.z & 0xffffu); vt[5 * 72] = (bf16)(v0.z >> 16); vt[6 * 72] = (bf16)(v0.w & 0xffffu); vt[7 * 72] = (bf16)(v0.w >> 16);
    vt[8 * 72] = (bf16)(v1.x & 0xffffu); vt[9 * 72] = (bf16)(v1.x >> 16); vt[10 * 72] = (bf16)(v1.y & 0xffffu); vt[11 * 72] = (bf16)(v1.y >> 16);
    vt[12 * 72] = (bf16)(v1.z & 0xffffu); vt[13 * 72] = (bf16)(v1.z >> 16); vt[14 * 72] = (bf16)(v1.w & 0xffffu); vt[15 * 72] = (bf16)(v1.w >> 16);
}
__device__ __forceinline__ int gla_ci(int dir, int tile) { return dir == 0 ? tile : (tile < 4 ? 3 - tile : 4 + 127 - (tile - 4)); }

__device__ __forceinline__ void phase_gla1(const Args& a, int l, LAS unsigned char* lds, int tid, int wave, int lane) {
    const bf16* Z = (const bf16*)(a.ws + WS_Z);
    LAS float* LG = (LAS float*)lds; LAS bf16* KT = (LAS bf16*)(lds + 32768); LAS bf16* VT = (LAS bf16*)(lds + 32768 + 18432);
    float* S = (float*)(a.ws + WS_S); float* DEC = (float*)(a.ws + WS_DECAY);
    const int fr = lane & 15, fq = lane >> 4;
    for (int u = blockIdx.x; u < 1056; u += gridDim.x) {
        const int tile = u % 132, bh = u / 132, b = bh >> 2, h = bh & 3;
        const size_t row0 = tile < 4 ? (size_t)ML + b * 256 + tile * 64 : (size_t)b * SEQ + (tile - 4) * 64;
        __syncthreads();
        gla_logg_cum(a, l, LG, Z, row0, h, tid);
        if (tid < 128) { const int dir = tid >> 6, dk = tid & 63; const float tot = LG[dir * 4096 + (dir == 0 ? 63 : 0) * 64 + dk];
            DEC[((size_t)(bh * 2 + dir) * 132 + gla_ci(dir, tile)) * 64 + dk] = __expf(tot); }
        { const int tok = tid >> 3, c8 = tid & 7; float kv[8]; unpack8(*(const u32x4*)(Z + (row0 + tok) * ZS + ZGK + h * 64 + 8 * c8), kv);
#pragma unroll
            for (int dir = 0; dir < 2; ++dir)
#pragma unroll
                for (int e = 0; e < 8; ++e) { const int dk = 8 * c8 + e; const float f = __expf(LG[dir * 4096 + (dir == 0 ? 63 : 0) * 64 + dk] - LG[dir * 4096 + tok * 64 + dk]);
                    KT[(dir * 64 + dk) * 72 + tok] = (bf16)f2bf(kv[e] * f); } }
        gla_stage_vt(VT, Z, row0, h, tid);
        __syncthreads();
        { const int dir = wave >> 2, dkb = wave & 3; bf16x8 Kf[2];
#pragma unroll
            for (int ks = 0; ks < 2; ++ks) Kf[ks] = *(const LAS bf16x8*)(KT + (dir * 64 + 16 * dkb + fr) * 72 + 32 * ks + 8 * fq);
            float* Sd = S + ((size_t)(bh * 2 + dir) * 132 + gla_ci(dir, tile)) * 8192;
#pragma unroll
            for (int dvb = 0; dvb < 8; ++dvb) { f32x4 acc = {0.f, 0.f, 0.f, 0.f};
#pragma unroll
                for (int ks = 0; ks < 2; ++ks) { const bf16x8 Vf = *(const LAS bf16x8*)(VT + (16 * dvb + fr) * 72 + 32 * ks + 8 * fq); acc = MFMA16(Vf, Kf[ks], acc); }
#pragma unroll
                for (int e = 0; e < 4; ++e) Sd[(16 * dvb + 4 * fq + e) * 64 + 16 * dkb + fr] = acc[e]; } }
    }
}
__device__ __forceinline__ void phase_gla2(const Args& a, int tid) {
    float* S = (float*)(a.ws + WS_S); const float* DEC = (const float*)(a.ws + WS_DECAY);
    for (int el = blockIdx.x * 512 + tid; el < 131072; el += gridDim.x * 512) {
        const int seq = el >> 13, e = el & 8191, dk = e & 63;
        float* Sp = S + (size_t)seq * 132 * 8192 + e; const float* Dp = DEC + (size_t)seq * 132 * 64 + dk;
        float s = 0.f;
        for (int ci = 0; ci < 132; ci += 4) {
            const float d0 = Sp[(size_t)ci * 8192], d1 = Sp[(size_t)(ci + 1) * 8192], d2 = Sp[(size_t)(ci + 2) * 8192], d3 = Sp[(size_t)(ci + 3) * 8192];
            const float a0 = Dp[ci * 64], a1 = Dp[(ci + 1) * 64], a2 = Dp[(ci + 2) * 64], a3 = Dp[(ci + 3) * 64];
            Sp[(size_t)ci * 8192] = s; s = a0 * s + d0; Sp[(size_t)(ci + 1) * 8192] = s; s = a1 * s + d1; Sp[(size_t)(ci + 2) * 8192] = s; s = a2 * s + d2; Sp[(size_t)(ci + 3) * 8192] = s; s = a3 * s + d3;
        }
    }
}
__device__ __forceinline__ void phase_gla3(const Args& a, int l, LAS unsigned char* lds, int tid, int wave, int lane) {
    const bf16* Z = (const bf16*)(a.ws + WS_Z); bf16* OB = (bf16*)(a.ws + WS_O);
    LAS float* LG = (LAS float*)lds; LAS bf16* VT = (LAS bf16*)(lds + 32768); LAS float* OX = (LAS float*)(lds + 32768 + 18432);
    const float* S = (const float*)(a.ws + WS_S);
    const float* gn = a.in[19] + l * 512;
    const int fr = lane & 15, fq = lane >> 4;
    const int ntile = (l == 0) ? 132 : 128;
    for (int u = blockIdx.x; u < 8 * ntile; u += gridDim.x) {
        const int tile = (l == 0) ? u % 132 : 4 + u % 128, bh = u / ntile, b = bh >> 2, h = bh & 3;
        const size_t row0 = tile < 4 ? (size_t)ML + b * 256 + tile * 64 : (size_t)b * SEQ + (tile - 4) * 64;
        __syncthreads();
        gla_logg_cum(a, l, LG, Z, row0, h, tid);
        gla_stage_vt(VT, Z, row0, h, tid);
        __syncthreads();
        const int dir = wave >> 2, tb = wave & 3;
        bf16x8 Qf[2];
        { const int tok = 16 * tb + fr;
#pragma unroll
            for (int ks = 0; ks < 2; ++ks) { float q[8]; unpack8(*(const u32x4*)(Z + (row0 + tok) * ZS + ZGQ + h * 64 + 32 * ks + 8 * fq), q);
#pragma unroll
                for (int e = 0; e < 8; ++e) q[e] *= 0.125f * __expf(LG[dir * 4096 + tok * 64 + 32 * ks + 8 * fq + e]);
                Qf[ks] = __builtin_bit_cast(bf16x8, pack8(q)); } }
        f32x4 at[4];
#pragma unroll
        for (int kb = 0; kb < 4; ++kb) { const int key = 16 * kb + fr; f32x4 acc = {0.f, 0.f, 0.f, 0.f};
#pragma unroll
            for (int ks = 0; ks < 2; ++ks) { float k[8]; unpack8(*(const u32x4*)(Z + (row0 + key) * ZS + ZGK + h * 64 + 32 * ks + 8 * fq), k);
#pragma unroll
                for (int e = 0; e < 8; ++e) k[e] *= __expf(-LG[dir * 4096 + key * 64 + 32 * ks + 8 * fq + e]);
                acc = MFMA16(__builtin_bit_cast(bf16x8, pack8(k)), Qf[ks], acc); }
            const int tok = 16 * tb + fr;
#pragma unroll
            for (int e = 0; e < 4; ++e) { const int kj = 16 * kb + 4 * fq + e; const bool ok = dir == 0 ? (kj <= tok) : (kj >= tok); if (!ok) acc[e] = 0.f; }
            at[kb] = acc; }
        bf16x8 Pf[2];
#pragma unroll
        for (int kk = 0; kk < 2; ++kk) { float p[8];
#pragma unroll
            for (int e = 0; e < 4; ++e) { p[e] = at[2 * kk][e]; p[4 + e] = at[2 * kk + 1][e]; }
            Pf[kk] = __builtin_bit_cast(bf16x8, pack8(p)); }
        const float* Sp = S + ((size_t)(bh * 2 + dir) * 132 + gla_ci(dir, tile)) * 8192;
        f32x4 O[8];
#pragma unroll
        for (int dvb = 0; dvb < 8; ++dvb) { f32x4 o = {0.f, 0.f, 0.f, 0.f};
#pragma unroll
            for (int kk = 0; kk < 2; ++kk) { const s16x4 lo = *(const LAS s16x4*)(VT + (16 * dvb + fr) * 72 + 32 * kk + 4 * fq), hi = *(const LAS s16x4*)(VT + (16 * dvb + fr) * 72 + 32 * kk + 16 + 4 * fq);
                const bf16x8 Vf = (bf16x8){lo[0], lo[1], lo[2], lo[3], hi[0], hi[1], hi[2], hi[3]}; o = MFMA16(Vf, Pf[kk], o); }
#pragma unroll
            for (int ks = 0; ks < 2; ++ks) { const float* sp = Sp + (16 * dvb + fr) * 64 + 32 * ks + 8 * fq; const f32x4 s0 = *(const f32x4*)sp, s1 = *(const f32x4*)(sp + 4);
                float sv[8] = {s0[0], s0[1], s0[2], s0[3], s1[0], s1[1], s1[2], s1[3]}; o = MFMA16(__builtin_bit_cast(bf16x8, pack8(sv)), Qf[ks], o); }
            O[dvb] = o; }
        if (dir == 1) {
#pragma unroll
            for (int dvb = 0; dvb < 8; ++dvb) *(LAS f32x4*)(OX + (tb * 16 + fr) * 132 + 16 * dvb + 4 * fq) = O[dvb]; }
        __syncthreads();
        if (dir == 0) { float ss = 0.f;
#pragma unroll
            for (int dvb = 0; dvb < 8; ++dvb) { O[dvb] += *(const LAS f32x4*)(OX + (tb * 16 + fr) * 132 + 16 * dvb + 4 * fq); ss += (O[dvb][0] * O[dvb][0] + O[dvb][1] * O[dvb][1]) + (O[dvb][2] * O[dvb][2] + O[dvb][3] * O[dvb][3]); }
            ss += __shfl_xor(ss, 16); ss += __shfl_xor(ss, 32);
            const float rstd = rsqrtf(ss * (1.f / 128.f) + 1e-6f);
            const size_t row = row0 + 16 * tb + fr;
#pragma unroll
            for (int dvb = 0; dvb < 8; ++dvb) { const int c = h * 128 + 16 * dvb + 4 * fq; const f32x4 g = *(const f32x4*)(gn + c); const u32x2 rr = *(const u32x2*)(Z + row * ZS + ZGR + c);
                const float r0 = bf2f(rr.x & 0xffffu), r1 = bf2f(rr.x >> 16), r2 = bf2f(rr.y & 0xffffu), r3 = bf2f(rr.y >> 16);
                u32x2 o; o.x = pk2(O[dvb][0] * rstd * g[0] * r0 * sigmoidf_(r0), O[dvb][1] * rstd * g[1] * r1 * sigmoidf_(r1)); o.y = pk2(O[dvb][2] * rstd * g[2] * r2 * sigmoidf_(r2), O[dvb][3] * rstd * g[3] * r3 * sigmoidf_(r3));
                *(u32x2*)(OB + row * D + 1536 + c) = o; } }
    }
}


template <int G> __device__ __forceinline__ void pool_task(const bf16* Z, bf16* OB, const bf16* PWT, const float* pscale, int tb, int fr, int fq) {
    constexpr int HW = 1 << G;
    const int row = tb * 16 + fr;
    int t, n; if (row < ML) { t = row & 8191; n = SEQ; } else { t = (row - ML) & 255; n = CTXL; }
    const int seq0 = row - t;
    const int lo = t - HW > 0 ? t - HW : 0, hi = t + HW < n ? t + HW : n;
    const float inv = 1.f / (float)(hi - lo);
    f32x4 acc[4][2];
#pragma unroll
    for (int cp = 0; cp < 4; ++cp) { acc[cp][0] = (f32x4){0.f, 0.f, 0.f, 0.f}; acc[cp][1] = acc[cp][0]; }
#pragma unroll 1
    for (int ks = 0; ks < 4; ++ks) { const bf16* base = Z + ZP + G * 128 + 32 * ks + 8 * fq;
        bf16x8 Bf[4][2];
#pragma unroll
        for (int cp = 0; cp < 4; ++cp)
#pragma unroll
            for (int nn = 0; nn < 2; ++nn) Bf[cp][nn] = *(const bf16x8*)(PWT + (size_t)(G * 128 + 32 * cp + perm16(nn, fr)) * 128 + 32 * ks + 8 * fq);
        float s[8] = {0, 0, 0, 0, 0, 0, 0, 0}, own[8];
        constexpr int CH = (2 * HW < 8) ? 2 * HW : 8;
#pragma unroll
        for (int j0 = 0; j0 < 2 * HW; j0 += CH) {
            u32x4 raw[CH];
#pragma unroll
            for (int j = 0; j < CH; ++j) { int tt = t - HW + j0 + j; tt = tt < 0 ? 0 : (tt > n - 1 ? n - 1 : tt); raw[j] = *(const u32x4*)(base + (size_t)(seq0 + tt) * ZS); }
#pragma unroll
            for (int j = 0; j < CH; ++j) { const int tt = t - HW + j0 + j; const bool ok = tt >= 0 && tt < n; float x[8]; unpack8(raw[j], x);
#pragma unroll
                for (int e = 0; e < 8; ++e) { s[e] += ok ? x[e] : 0.f; if (j0 + j == HW) own[e] = x[e]; } }
            __builtin_amdgcn_sched_barrier(0);
        }
#pragma unroll
        for (int e = 0; e < 8; ++e) s[e] = s[e] * inv - own[e];
        const bf16x8 Af = __builtin_bit_cast(bf16x8, pack8(s));
#pragma unroll
        for (int cp = 0; cp < 4; ++cp)
#pragma unroll
            for (int nn = 0; nn < 2; ++nn) acc[cp][nn] = MFMA16(Bf[cp][nn], Af, acc[cp][nn]); }
#pragma unroll
    for (int cp = 0; cp < 4; ++cp) { const int ch = G * 128 + 32 * cp + 8 * fq; const f32x4 pa = *(const f32x4*)(pscale + ch), pb = *(const f32x4*)(pscale + ch + 4); float o[8];
#pragma unroll
        for (int e = 0; e < 4; ++e) { o[e] = acc[cp][0][e] * pa[e]; o[4 + e] = acc[cp][1][e] * pb[e]; }
        ostore8(OB, (size_t)row, 512 + ch, pack8(o)); }
}
__device__ __forceinline__ void pool_unit(const Args& a, int l, int pu, int wave, int lane) {
    const bf16* Z = (const bf16*)(a.ws + WS_Z); bf16* OB = (bf16*)(a.ws + WS_O);
    const bf16* PWT = (const bf16*)(a.ws + WS_PWT) + (size_t)l * 4 * 128 * 128; const float* pscale = a.in[12] + l * 512;
    const int fr = lane & 15, fq = lane >> 4, g = wave & 3, tb = 2 * pu + (wave >> 2);
    if (g == 0) pool_task<0>(Z, OB, PWT, pscale, tb, fr, fq); else if (g == 1) pool_task<1>(Z, OB, PWT, pscale, tb, fr, fq);
    else if (g == 2) pool_task<2>(Z, OB, PWT, pscale, tb, fr, fq); else pool_task<3>(Z, OB, PWT, pscale, tb, fr, fq);
}
__device__ __forceinline__ void cgate_unit(const Args& a, int l, int u, LAS unsigned char* lds, int tid, int wave, int lane) {
    const bf16* Z = (const bf16*)(a.ws + WS_Z); bf16* OB = (bf16*)(a.ws + WS_O);
    LAS bf16* VT = (LAS bf16*)lds;
    LAS bf16* WS = (LAS bf16*)(lds + 69632);
    const bf16* WSB = (const bf16*)(a.ws + WS_WSB) + (size_t)l * 4 * 128 * 128;
    const float* lng = a.in[13] + l * 512; const float* lnb = a.in[14] + l * 512; const float* cbs = a.in[16] + l * 512;
    const int fr = lane & 15, fq = lane >> 4;
    const int ch = u >> 1, gp = u & 1;
    const size_t row0 = (size_t)ch * 128;
    __syncthreads();
    u32x4 raw[16];
#pragma unroll
    for (int ti = 0; ti < 16; ++ti) raw[ti] = *(const u32x4*)(Z + (row0 + 16 * wave + ti) * ZS + ZUV + 512 + 8 * lane);
#pragma unroll
    for (int i = 0; i < 8; ++i) { const int p = tid + 512 * i, gl = p >> 11, r = (p >> 4) & 127, c16 = p & 15;
        *(LAS u32x4*)(WS + (gl * 128 + r) * 136 + 8 * c16) = *(const u32x4*)(WSB + (size_t)((2 * gp + gl) * 128 + r) * 128 + 8 * c16); }
    float gv[8], bv[8];
    { const int c0 = 8 * lane;
#pragma unroll
        for (int e = 0; e < 8; ++e) { gv[e] = lng[c0 + e]; bv[e] = lnb[c0 + e]; } }
#pragma unroll
    for (int ti = 0; ti < 16; ++ti) {
        const int tok = 16 * wave + ti; float v[8]; unpack8(raw[ti], v);
        float sm = 0.f;
#pragma unroll
        for (int e = 0; e < 8; ++e) sm += v[e];
        const float mean = wave_sum(sm) * (1.f / 512.f); float q = 0.f;
#pragma unroll
        for (int e = 0; e < 8; ++e) { v[e] -= mean; q += v[e] * v[e]; }
        const float rstd = rsqrtf(wave_sum(q) * (1.f / 512.f) + 1e-6f);
        if ((lane >> 5) == gp) { const int c0 = 8 * lane - 256 * gp;
#pragma unroll
            for (int e = 0; e < 8; ++e) VT[(c0 + e) * 136 + 8 * (((tok >> 3) + (lane & 15)) & 15) + (tok & 7)] = (bf16)f2bf(v[e] * rstd * gv[e] + bv[e]); }
    }
    __syncthreads();
#pragma unroll
    for (int gl = 0; gl < 2; ++gl) { const int g = 2 * gp + gl;
        bf16x8 Vf[4];
#pragma unroll
        for (int ks = 0; ks < 4; ++ks) Vf[ks] = *(const LAS bf16x8*)(VT + (128 * gl + 16 * wave + fr) * 136 + 8 * ((4 * ks + fq + 2 * wave + (fr >> 3)) & 15));
        u32x2 ur[8]; float bsv[8];
#pragma unroll
        for (int pb = 0; pb < 8; ++pb) { const int p = 16 * pb + fr; ur[pb] = *(const u32x2*)(Z + (row0 + p) * ZS + ZUV + g * 128 + 16 * wave + 4 * fq); bsv[pb] = cbs[g * 128 + p]; }
#pragma unroll
        for (int pb = 0; pb < 8; ++pb) { f32x4 acc = {0.f, 0.f, 0.f, 0.f};
#pragma unroll
            for (int ks = 0; ks < 4; ++ks) { const bf16x8 Wf = *(const LAS bf16x8*)(WS + (gl * 128 + 16 * pb + fr) * 136 + 32 * ks + 8 * fq); acc = MFMA16(Vf[ks], Wf, acc); }
            const int p = 16 * pb + fr;
            u32x2 o; o.x = pk2(bf2f(ur[pb].x & 0xffffu) * (acc[0] + bsv[pb]), bf2f(ur[pb].x >> 16) * (acc[1] + bsv[pb])); o.y = pk2(bf2f(ur[pb].y & 0xffffu) * (acc[2] + bsv[pb]), bf2f(ur[pb].y >> 16) * (acc[3] + bsv[pb]));
            ostore4(OB, row0 + p, 1024 + g * 128 + 16 * wave + 4 * fq, o); } }
}

__device__ __forceinline__ void gla_cum2(const Args& a, int l, LAS unsigned char* lds, const bf16* Z, size_t row0, int h, int tid) {
    LAS float* CUM = (LAS float*)lds; LAS float* GLR = (LAS float*)(lds + 32768); LAS float* QT = (LAS float*)(lds + 40960);
    const float* gw2 = a.in[17] + l * 2 * 16 * 256; const float* gb = a.in[18] + l * 2 * 256;
    if (tid < 256) { const int tok = tid >> 2, part = tid & 3; float g[8]; unpack8(*(const u32x4*)(Z + (row0 + tok) * ZS + ZGLR + 8 * part), g);
        *(LAS f32x4*)(GLR + tok * 32 + 8 * part) = (f32x4){g[0], g[1], g[2], g[3]}; *(LAS f32x4*)(GLR + tok * 32 + 8 * part + 4) = (f32x4){g[4], g[5], g[6], g[7]}; }
    const int dir = tid >> 8, q = (tid >> 6) & 3, dk = tid & 63;
    float w[16];
#pragma unroll
    for (int r = 0; r < 16; ++r) w[r] = gw2[(dir * 16 + r) * 256 + h * 64 + dk];
    const float bias = gb[dir * 256 + h * 64 + dk];
    __syncthreads();
    float run = 0.f;
#pragma unroll 4
    for (int i = 0; i < 16; ++i) { const int tok = dir == 0 ? 16 * q + i : 16 * q + 15 - i;
        const LAS float* gp = GLR + tok * 32 + dir * 16; const f32x4 g0 = *(const LAS f32x4*)gp, g1 = *(const LAS f32x4*)(gp + 4), g2 = *(const LAS f32x4*)(gp + 8), g3 = *(const LAS f32x4*)(gp + 12);
        float acc = bias;
#pragma unroll
        for (int e = 0; e < 4; ++e) acc += g0[e] * w[e] + g1[e] * w[4 + e] + g2[e] * w[8 + e] + g3[e] * w[12 + e];
        const float ls = fminf(acc, 0.f) - __logf(1.f + __expf(-fabsf(acc)));
        run += ls * (1.f / 16.f); CUM[dir * 4096 + tok * 64 + dk] = run; }
    QT[(dir * 4 + q) * 64 + dk] = run;
    __syncthreads();
    float off = 0.f;
#pragma unroll
    for (int qq = 0; qq < 4; ++qq) { const float v = QT[(dir * 4 + qq) * 64 + dk]; if (dir == 0 ? qq < q : qq > q) off += v; }
#pragma unroll
    for (int i = 0; i < 16; ++i) CUM[dir * 4096 + (16 * q + i) * 64 + dk] += off;
    __syncthreads();
}
__device__ __forceinline__ void gla1_unit(const Args& a, int l, int u, LAS unsigned char* lds, int tid, int wave, int lane) {
    const bf16* Z = (const bf16*)(a.ws + WS_Z);
    LAS float* CUM = (LAS float*)lds; LAS bf16* KT = (LAS bf16*)(lds + 43008); LAS bf16* VT = (LAS bf16*)(lds + 43008 + 18432);
    bf16* S = (bf16*)(a.ws + WS_S); float* DEC = (float*)(a.ws + WS_DECAY);
    const int fr = lane & 15, fq = lane >> 4;
    const int tile = u % 132, bh = u / 132, b = bh >> 2, h = bh & 3;
    const size_t row0 = tile < 4 ? (size_t)ML + b * 256 + tile * 64 : (size_t)b * SEQ + (tile - 4) * 64;
    const int tok = tid >> 3, c8 = tid & 7;
    const u32x4 kraw = *(const u32x4*)(Z + (row0 + tok) * ZS + ZGK + h * 64 + 8 * c8);
    const bf16* vp = Z + (row0 + tok) * ZS + ZGV + h * 128 + 16 * c8;
    const u32x4 v0 = *(const u32x4*)vp, v1 = *(const u32x4*)(vp + 8);
    __syncthreads();
    gla_cum2(a, l, lds, Z, row0, h, tid);
    if (tid < 128) { const int dir = tid >> 6, dk = tid & 63; DEC[((size_t)(bh * 2 + dir) * 132 + gla_ci(dir, tile)) * 64 + dk] = __expf(CUM[dir * 4096 + (dir == 0 ? 63 : 0) * 64 + dk]); }
    { float kv[8]; unpack8(kraw, kv);
#pragma unroll
        for (int dir = 0; dir < 2; ++dir)
#pragma unroll
            for (int e = 0; e < 8; ++e) { const int dk = 8 * c8 + e; const float f = __expf(CUM[dir * 4096 + (dir == 0 ? 63 : 0) * 64 + dk] - CUM[dir * 4096 + tok * 64 + dk]);
                KT[(dir * 64 + dk) * 72 + 8 * (((tok >> 3) + c8) & 7) + (tok & 7)] = (bf16)f2bf(kv[e] * f); }
        LAS bf16* vt = VT + (16 * c8) * 72 + 8 * (((tok >> 3) + c8) & 7) + (tok & 7);
        vt[0 * 72] = (bf16)(v0.x & 0xffffu); vt[1 * 72] = (bf16)(v0.x >> 16); vt[2 * 72] = (bf16)(v0.y & 0xffffu); vt[3 * 72] = (bf16)(v0.y >> 16);
        vt[4 * 72] = (bf16)(v0.z & 0xffffu); vt[5 * 72] = (bf16)(v0.z >> 16); vt[6 * 72] = (bf16)(v0.w & 0xffffu); vt[7 * 72] = (bf16)(v0.w >> 16);
        vt[8 * 72] = (bf16)(v1.x & 0xffffu); vt[9 * 72] = (bf16)(v1.x >> 16); vt[10 * 72] = (bf16)(v1.y & 0xffffu); vt[11 * 72] = (bf16)(v1.y >> 16);
        vt[12 * 72] = (bf16)(v1.z & 0xffffu); vt[13 * 72] = (bf16)(v1.z >> 16); vt[14 * 72] = (bf16)(v1.w & 0xffffu); vt[15 * 72] = (bf16)(v1.w >> 16); }
    __syncthreads();
    { const int dir = wave >> 2, dkb = wave & 3; bf16x8 Kf[2];
#pragma unroll
        for (int ks = 0; ks < 2; ++ks) Kf[ks] = *(const LAS bf16x8*)(KT + (dir * 64 + 16 * dkb + fr) * 72 + 8 * ((4 * ks + fq + 2 * dkb + (fr >> 3)) & 7));
        bf16* Sd = S + ((size_t)(bh * 2 + dir) * 132 + gla_ci(dir, tile)) * 8192;
#pragma unroll
        for (int dvb = 0; dvb < 8; ++dvb) { f32x4 acc = {0.f, 0.f, 0.f, 0.f};
#pragma unroll
            for (int ks = 0; ks < 2; ++ks) { const bf16x8 Vf = *(const LAS bf16x8*)(VT + (16 * dvb + fr) * 72 + 8 * ((4 * ks + fq + dvb) & 7)); acc = MFMA16(Kf[ks], Vf, acc); }
            { u32x2 o; o.x = pk2(acc[0], acc[1]); o.y = pk2(acc[2], acc[3]); *(u32x2*)(Sd + (16 * dvb + fr) * 64 + 16 * dkb + 4 * fq) = o; } } }
}
__device__ __forceinline__ void phase_gla2b(const Args& a, int tid) {
    const bf16* S = (const bf16*)(a.ws + WS_S); const float* DEC = (const float*)(a.ws + WS_DECAY); bf16* SB = (bf16*)(a.ws + WS_SB);
    for (int el = blockIdx.x * 512 + tid; el < 131072; el += gridDim.x * 512) {
        const int seq = el >> 13, e = el & 8191, dk = e & 63;
        const bf16* Sp = S + (size_t)seq * 132 * 8192 + e; const float* Dp = DEC + (size_t)seq * 132 * 64 + dk; bf16* Bp = SB + (size_t)seq * 132 * 8192 + e;
        float s = 0.f;
#pragma unroll 1
        for (int ci = 0; ci < 132; ci += 33) { float d[33], dc[33];
#pragma unroll
            for (int j = 0; j < 33; ++j) { d[j] = bf2f((unsigned)__builtin_nontemporal_load(Sp + (size_t)(ci + j) * 8192)); dc[j] = Dp[(ci + j) * 64]; }
#pragma unroll
            for (int j = 0; j < 33; ++j) { Bp[(size_t)(ci + j) * 8192] = (bf16)f2bf(s); s = dc[j] * s + d[j]; } }
    }
}
__device__ __forceinline__ void gla3_unit(const Args& a, int l, int u, LAS unsigned char* lds, int tid, int wave, int lane) {
    const bf16* Z = (const bf16*)(a.ws + WS_Z); bf16* OB = (bf16*)(a.ws + WS_O);
    LAS float* CUM = (LAS float*)lds; LAS bf16* QS = (LAS bf16*)(lds + 43008); LAS bf16* KS = (LAS bf16*)(lds + 43008 + 18432); LAS bf16* VT = (LAS bf16*)(lds + 43008 + 36864);
    LAS float* OX = (LAS float*)(lds + 43008 + 36864 + 18432);
    const bf16* SB = (const bf16*)(a.ws + WS_SB);
    const float* gn = a.in[19] + l * 512;
    const int fr = lane & 15, fq = lane >> 4;
    const int ntile = (l == 0) ? 132 : 128;
    const int tile = (l == 0) ? u % 132 : 4 + u % 128, bh = u / ntile, b = bh >> 2, h = bh & 3;
    const size_t row0 = tile < 4 ? (size_t)ML + b * 256 + tile * 64 : (size_t)b * SEQ + (tile - 4) * 64;
    const int tok = tid >> 3, c8 = tid & 7;
    const u32x4 qraw = *(const u32x4*)(Z + (row0 + tok) * ZS + ZGQ + h * 64 + 8 * c8), kraw = *(const u32x4*)(Z + (row0 + tok) * ZS + ZGK + h * 64 + 8 * c8);
    const bf16* vp = Z + (row0 + tok) * ZS + ZGV + h * 128 + 16 * c8;
    const u32x4 v0 = *(const u32x4*)vp, v1 = *(const u32x4*)(vp + 8);
    __syncthreads();
    gla_cum2(a, l, lds, Z, row0, h, tid);
    { float qv[8], kv[8]; unpack8(qraw, qv); unpack8(kraw, kv);
#pragma unroll
        for (int dir = 0; dir < 2; ++dir) { float qo[8], ko[8];
#pragma unroll
            for (int e = 0; e < 8; ++e) { const float c = CUM[dir * 4096 + tok * 64 + 8 * c8 + e]; qo[e] = qv[e] * 0.125f * __expf(c); ko[e] = kv[e] * __expf(-c); }
            *(LAS u32x4*)(QS + (dir * 64 + tok) * 72 + 8 * c8) = pack8(qo); *(LAS u32x4*)(KS + (dir * 64 + tok) * 72 + 8 * c8) = pack8(ko); }
        LAS bf16* vt = VT + (16 * c8) * 72 + 8 * (((tok >> 3) + c8) & 7) + (tok & 7);
        vt[0 * 72] = (bf16)(v0.x & 0xffffu); vt[1 * 72] = (bf16)(v0.x >> 16); vt[2 * 72] = (bf16)(v0.y & 0xffffu); vt[3 * 72] = (bf16)(v0.y >> 16);
        vt[4 * 72] = (bf16)(v0.z & 0xffffu); vt[5 * 72] = (bf16)(v0.z >> 16); vt[6 * 72] = (bf16)(v0.w & 0xffffu); vt[7 * 72] = (bf16)(v0.w >> 16);
        vt[8 * 72] = (bf16)(v1.x & 0xffffu); vt[9 * 72] = (bf16)(v1.x >> 16); vt[10 * 72] = (bf16)(v1.y & 0xffffu); vt[11 * 72] = (bf16)(v1.y >> 16);
        vt[12 * 72] = (bf16)(v1.z & 0xffffu); vt[13 * 72] = (bf16)(v1.z >> 16); vt[14 * 72] = (bf16)(v1.w & 0xffffu); vt[15 * 72] = (bf16)(v1.w >> 16); }
    const int dir = wave >> 2, tb = wave & 3;
    const bf16* Sp = SB + ((size_t)(bh * 2 + dir) * 132 + gla_ci(dir, tile)) * 8192;
    bf16x8 Sf[8][2];
#pragma unroll
    for (int dvb = 0; dvb < 8; ++dvb)
#pragma unroll
        for (int ks = 0; ks < 2; ++ks) Sf[dvb][ks] = *(const bf16x8*)(Sp + (16 * dvb + fr) * 64 + 32 * ks + 8 * fq);
    __syncthreads();
    bf16x8 Qf[2];
#pragma unroll
    for (int ks = 0; ks < 2; ++ks) Qf[ks] = *(const LAS bf16x8*)(QS + (dir * 64 + 16 * tb + fr) * 72 + 32 * ks + 8 * fq);
    f32x4 at[4];
#pragma unroll
    for (int kb = 0; kb < 4; ++kb) { f32x4 acc = {0.f, 0.f, 0.f, 0.f};
        const bool need = dir == 0 ? (kb <= tb) : (kb >= tb);
        if (need) {
#pragma unroll
            for (int ks = 0; ks < 2; ++ks) { const bf16x8 Kf = *(const LAS bf16x8*)(KS + (dir * 64 + 16 * kb + fr) * 72 + 32 * ks + 8 * fq); acc = MFMA16(Kf, Qf[ks], acc); }
            const int tq = 16 * tb + fr;
#pragma unroll
            for (int e = 0; e < 4; ++e) { const int kj = 16 * kb + 4 * fq + e; const bool ok = dir == 0 ? (kj <= tq) : (kj >= tq); if (!ok) acc[e] = 0.f; } }
        at[kb] = acc; }
    bf16x8 Pf[2];
#pragma unroll
    for (int kk = 0; kk < 2; ++kk) { float p[8];
#pragma unroll
        for (int e = 0; e < 4; ++e) { p[e] = at[2 * kk][e]; p[4 + e] = at[2 * kk + 1][e]; }
        Pf[kk] = __builtin_bit_cast(bf16x8, pack8(p)); }
    f32x4 O[8];
#pragma unroll
    for (int dvb = 0; dvb < 8; ++dvb) { f32x4 o = {0.f, 0.f, 0.f, 0.f};
#pragma unroll
        for (int kk = 0; kk < 2; ++kk) { const s16x4 lo = *(const LAS s16x4*)(VT + (16 * dvb + fr) * 72 + 8 * ((4 * kk + (fq >> 1) + dvb) & 7) + 4 * (fq & 1)), hi = *(const LAS s16x4*)(VT + (16 * dvb + fr) * 72 + 8 * ((4 * kk + 2 + (fq >> 1) + dvb) & 7) + 4 * (fq & 1));
            const bf16x8 Vf = (bf16x8){lo[0], lo[1], lo[2], lo[3], hi[0], hi[1], hi[2], hi[3]}; o = MFMA16(Vf, Pf[kk], o); }
#pragma unroll
        for (int ks = 0; ks < 2; ++ks) o = MFMA16(Sf[dvb][ks], Qf[ks], o);
        O[dvb] = o; }
    if (dir == 1) {
#pragma unroll
        for (int dvb = 0; dvb < 8; ++dvb) *(LAS f32x4*)(OX + (tb * 16 + fr) * 132 + 16 * dvb + 4 * fq) = O[dvb]; }
    __syncthreads();
    if (dir == 0) { float ss = 0.f;
#pragma unroll
        for (int dvb = 0; dvb < 8; ++dvb) { O[dvb] += *(const LAS f32x4*)(OX + (tb * 16 + fr) * 132 + 16 * dvb + 4 * fq); ss += (O[dvb][0] * O[dvb][0] + O[dvb][1] * O[dvb][1]) + (O[dvb][2] * O[dvb][2] + O[dvb][3] * O[dvb][3]); }
        ss += __shfl_xor(ss, 16); ss += __shfl_xor(ss, 32);
        const float rstd = rsqrtf(ss * (1.f / 128.f) + 1e-6f);
        const size_t row = row0 + 16 * tb + fr;
#pragma unroll
        for (int dvb = 0; dvb < 8; ++dvb) { const int c = h * 128 + 16 * dvb + 4 * fq; const f32x4 g = *(const f32x4*)(gn + c); const u32x2 rr = *(const u32x2*)(Z + row * ZS + ZGR + c);
            const float r0 = bf2f(rr.x & 0xffffu), r1 = bf2f(rr.x >> 16), r2 = bf2f(rr.y & 0xffffu), r3 = bf2f(rr.y >> 16);
            u32x2 o; o.x = pk2(O[dvb][0] * rstd * g[0] * r0 * sigmoidf_(r0), O[dvb][1] * rstd * g[1] * r1 * sigmoidf_(r1)); o.y = pk2(O[dvb][2] * rstd * g[2] * r2 * sigmoidf_(r2), O[dvb][3] * rstd * g[3] * r3 * sigmoidf_(r3));
            ostore4(OB, row, 1536 + c, o); } }
}
__device__ __forceinline__ void phase_pool2(const Args& a, int l, int wave, int lane) { const int npu = (l == 0 ? MT : ML) / 32; for (int u = blockIdx.x; u < npu; u += gridDim.x) pool_unit(a, l, u, wave, lane); }
__device__ __forceinline__ void phase_cgate2(const Args& a, int l, LAS unsigned char* lds, int tid, int wave, int lane) { const int n = (l == 0 ? 132 : 128) * 2; for (int u = blockIdx.x; u < n; u += gridDim.x) cgate_unit(a, l, u, lds, tid, wave, lane); }
__device__ __forceinline__ void phase_gla1b(const Args& a, int l, LAS unsigned char* lds, int tid, int wave, int lane) { for (int u = blockIdx.x; u < 1056; u += gridDim.x) gla1_unit(a, l, u, lds, tid, wave, lane); }
__device__ __forceinline__ void phase_gla3b(const Args& a, int l, LAS unsigned char* lds, int tid, int wave, int lane) { const int n = 8 * (l == 0 ? 132 : 128); for (int u = blockIdx.x; u < n; u += gridDim.x) gla3_unit(a, l, u, lds, tid, wave, lane); }


constexpr int CW_Q = 6144;
__device__ __forceinline__ void phase_attn(const Args& a, int l, LAS unsigned char* lds, int tid, int wave, int lane) { const int n = 256 + (l == 0 ? 8 : 0); for (int u = blockIdx.x; u < n; u += gridDim.x) attn_unit(a, l, u, lds, tid, wave, lane); }
#define DYN_BEGIN(ctrword) unsigned* _ctr = (unsigned*)(a.ws + WS_CTL) + (ctrword); volatile LAS int* _qs = (volatile LAS int*)(lds + LDS_BYTES - 32); int u; \
        { if (threadIdx.x == 0) _qs[0] = (int)atomicAdd(_ctr, 1u); __syncthreads(); u = _qs[0]; __syncthreads(); }
#define DYN_SEG(hi, BODY) while (u < (hi)) { unsigned _nx = 0u; if (threadIdx.x == 0) _nx = atomicAdd(_ctr, 1u); \
        BODY; \
        if (threadIdx.x == 0) _qs[0] = (int)_nx; \
        __syncthreads(); u = _qs[0]; }
__device__ __forceinline__ void conv_queue(const Args& a, int l, int half, LAS unsigned char* lds) {
    unsigned* c2 = (unsigned*)(a.ws + WS_CTL) + CW_Q + 64 * (8 + 2 * l + half); volatile LAS int* q2 = (volatile LAS int*)(lds + LDS_BYTES - 64);
    if (threadIdx.x == 0) q2[0] = (int)atomicAdd(c2, 1u);
    __syncthreads(); int cu = q2[0]; __syncthreads();
    while (cu < CONV_UNITS_PH) { unsigned n2 = 0u; if (threadIdx.x == 0) n2 = atomicAdd(c2, 1u);
        { const int t2 = fresh_tid(); conv_unit(a, l, half, cu, lds, __builtin_amdgcn_readfirstlane(t2 >> 6), t2 & 63); }
        __syncthreads(); if (threadIdx.x == 0) q2[0] = (int)n2; __syncthreads(); cu = q2[0]; }
    __syncthreads();
}
__device__ __forceinline__ void phase_mix_a(const Args& a, int l, LAS unsigned char* lds, int tid, int wave, int lane, int qoff = 0) {
    const int natt = 256, total = natt + 1056;
    const bool conv_first = ((blockIdx.x >> 3) & 7) < 3;
    if (DEFER_CONV && conv_first && qoff == 0) conv_queue(a, l, 0, lds);
    {
        DYN_BEGIN(CW_Q + 64 * (2 * l + qoff));
        DYN_SEG(natt, { const int t2 = fresh_tid(); if (ATTN2) attn_unit2(a, l, u, lds, t2, __builtin_amdgcn_readfirstlane(t2 >> 6), t2 & 63); else attn_unit(a, l, u, lds, t2, __builtin_amdgcn_readfirstlane(t2 >> 6), t2 & 63); });
        DYN_SEG(total, { const int t2 = fresh_tid(); gla1_unit(a, l, u - natt, lds, t2, __builtin_amdgcn_readfirstlane(t2 >> 6), t2 & 63); });
        __syncthreads();
    }
    if (DEFER_CONV && !conv_first && qoff == 0) conv_queue(a, l, 0, lds);
}
__device__ __forceinline__ void phase_mix_b(const Args& a, int l, LAS unsigned char* lds, int tid, int wave, int lane, int qoff = 0) {
    const int nat = (l == 0 ? 8 : 0), ncg = nat + (l == 0 ? 132 : 128) * 2, ng3 = 8 * (l == 0 ? 132 : 128), npu = (l == 0 ? MT : ML) / 32, total = ncg + ng3 + npu;
    const bool conv_first = ((blockIdx.x >> 3) & 7) < 3;
    if (DEFER_CONV && conv_first && qoff == 0) conv_queue(a, l, 1, lds);
    {
        DYN_BEGIN(CW_Q + 64 * (2 * l + 1 + qoff));
        if (l == 0) { DYN_SEG(nat, { const int t2 = fresh_tid(); attn_unit2(a, l, 256 + u, lds, t2, __builtin_amdgcn_readfirstlane(t2 >> 6), t2 & 63); }); }
        DYN_SEG(ncg, { const int t2 = fresh_tid(); cgate_unit(a, l, u - nat, lds, t2, __builtin_amdgcn_readfirstlane(t2 >> 6), t2 & 63); });
        DYN_SEG(ncg + npu, { const int t2 = fresh_tid(); __syncthreads(); pool_unit(a, l, u - ncg, __builtin_amdgcn_readfirstlane(t2 >> 6), t2 & 63); });
        DYN_SEG(total, { const int t2 = fresh_tid(); gla3_unit(a, l, u - ncg - npu, lds, t2, __builtin_amdgcn_readfirstlane(t2 >> 6), t2 & 63); });
        __syncthreads();
    }
    if (DEFER_CONV && !conv_first && qoff == 0) conv_queue(a, l, 1, lds);
}

__global__ void __launch_bounds__(512, 2) mk_fwd(Args a_formal) {
    const Args& a = *(const Args*)(const __attribute__((address_space(4))) Args*)__builtin_amdgcn_kernarg_segment_ptr();
    extern __shared__ __attribute__((aligned(16))) unsigned char lds_raw[];
    LAS unsigned char* lds = (LAS unsigned char*)lds_raw;
    const int lo = a.ph_lo, hi = a.ph_hi;
#define tid fresh_tid()
#define lane (fresh_tid() & 63)
#define wave __builtin_amdgcn_readfirstlane(fresh_tid() >> 6)
#if N_LAUNCH_MODE == 1
    volatile LAS unsigned* xbw = (volatile LAS unsigned*)(lds + LDS_BYTES - 16);
    if (threadIdx.x == 0) { xbw[0] = 0u; xbw[1] = 0u; }
    __syncthreads();
    XcdBarrier bar = xcd_barrier_post((unsigned*)(a.ws + WS_CTL) + CW_BAR, xbw);
#define GRID_BAR() xcd_barrier(bar)
#else
#define GRID_BAR() do { } while (0)
#endif
#ifdef ONLY_PHASE
#define IN(k) ((k) % 10 == ONLY_PHASE % 10 && ((k) == 0) == (ONLY_PHASE == 0) && ((k) == 21) == (ONLY_PHASE == 21) && lo <= (k) && (k) < hi)
#else
#define IN(k) (lo <= (k) && (k) < hi)
#endif
#define SEAM(k) do { if (hi > (k) + 1) GRID_BAR(); } while (0)
#define RPT(code, call) do { call; if (REPEAT == (code)) { __syncthreads(); call; } } while (0)
    if (IN(0)) { phase_absmax(a, tid, lane); GRID_BAR(); RPT(0, phase_prologue(a, lds, tid, wave, lane)); SEAM(0); }
#define LAYER_PHASES(l) do { constexpr int pb = 1 + 10 * (l); \
        if (IN(pb + 0)) { if (l == 0) phase_norm1<0>(a, l, wave, lane); else phase_norm1<1>(a, l, wave, lane); SEAM(pb + 0); } \
        if (IN(pb + 1)) { if (USE_G256 & 1) RPT(2, phase_proj2(a, l, lds)); else phase_proj(a, l, wave, lane); SEAM(pb + 1); } \
        if (IN(pb + 2)) { if (DYNQ) { phase_mix_a(a, l, lds, tid, wave, lane); if (REPEAT == 33) { __syncthreads(); phase_mix_a(a, l, lds, tid, wave, lane, 4); } } else { RPT(31, phase_gla1b(a, l, lds, tid, wave, lane)); RPT(32, phase_attn(a, l, lds, tid, wave, lane)); } SEAM(pb + 2); } \
        if (IN(pb + 3)) { RPT(41, phase_gla2b(a, tid)); if (!DYNQ) { RPT(42, phase_pool2(a, l, wave, lane)); RPT(43, phase_cgate2(a, l, lds, tid, wave, lane)); } SEAM(pb + 3); } \
        if (IN(pb + 4)) { if (DYNQ) { phase_mix_b(a, l, lds, tid, wave, lane); if (REPEAT == 35) { __syncthreads(); phase_mix_b(a, l, lds, tid, wave, lane, 4); } } else RPT(5, phase_gla3b(a, l, lds, tid, wave, lane)); SEAM(pb + 4); } \
        if (IN(pb + 5)) { if (USE_G256 & 2) RPT(6, phase_merge2(a, l, lds)); else phase_merge(a, l, wave, lane); SEAM(pb + 5); } \
        if (IN(pb + 6)) { if (USE_G256 & 4) { RPT(7, phase_outproj2(a, l, lds)); if (REPEAT == 107) { __syncthreads(); phase_outproj2(a, l, lds, 1); } } else phase_outproj(a, l, wave, lane); SEAM(pb + 6); } \
        if (IN(pb + 7)) { phase_norm2_router(a, l, lds, tid, wave, lane); SEAM(pb + 7); } \
        if (IN(pb + 8)) { RPT(9, phase_moe12(a, l, lds, tid)); SEAM(pb + 8); } \
        if (IN(pb + 9)) {   if (N_LAUNCH_MODE == 0) { SEAM(pb + 9); } } \
    } while (0)
    LAYER_PHASES(0);
    LAYER_PHASES(1);
    if (IN(21)) RPT(21, phase_norm1<2>(a, 2, wave, lane));
#undef tid
#undef lane
#undef wave
}

extern "C" void kernel_launch(void* const* d_in, const int* in_sizes, int n_in, void* d_out, int out_size, void* d_ws, size_t ws_size, hipStream_t stream) {
    static int grid = 0;
    if (grid == 0) {
        if (n_in != 28 || ws_size < WS_END) { fprintf(stderr, "kernel_launch: unexpected n_in %d / ws %zu (need %zu)\n", n_in, ws_size, (size_t)WS_END); grid = -1; return; }
        int dev = 0, cus = 0;
        if (hipGetDevice(&dev) != hipSuccess || hipDeviceGetAttribute(&cus, hipDeviceAttributeMultiprocessorCount, dev) != hipSuccess) { grid = -1; return; }
        if (hipFuncSetAttribute((const void*)mk_fwd, hipFuncAttributeMaxDynamicSharedMemorySize, LDS_BYTES) != hipSuccess) { grid = -1; return; }
        int per_cu = 0;
        if (hipOccupancyMaxActiveBlocksPerMultiprocessor(&per_cu, (const void*)mk_fwd, 512, LDS_BYTES) != hipSuccess || per_cu < 1) fprintf(stderr, "kernel_launch: occupancy query says %d\n", per_cu);
        (void)hipGetLastError();
        grid = cus;
    }
    if (grid < 0) return;
    (void)hipMemsetAsync((char*)d_ws + WS_CTL, 0, CTL_ZERO_BYTES, stream);
    Args a{};
    for (int i = 0; i < 28; ++i) a.in[i] = (const float*)d_in[i];
    a.out = (float*)d_out; a.ws = (unsigned char*)d_ws;
#if N_LAUNCH_MODE == 1
    a.ph_lo = 0; a.ph_hi = NPH;
    hipLaunchKernelGGL(mk_fwd, dim3(grid), dim3(512), LDS_BYTES, stream, a);
#else
    for (int p = 0; p < NPH; ++p) { a.ph_lo = p; a.ph_hi = p + 1; hipLaunchKernelGGL(mk_fwd, dim3(grid), dim3(512), LDS_BYTES, stream, a); }
#endif
}
```
